# Optimizing an MI355X kernel written in HIP

```python
import math
import jax, jax.numpy as jnp
from jax import lax
import numpy as np

D_MODEL = 1024
BATCH = 16
SEQ = 256
DEPTH = 4
DEC_BATCH = 2
DEC_SEQ = 2048
PAST_LEN = 256

GRID_W = 64
BRANCH_W = 512
N_BRANCH = 3
SSM_P = 16
SSM_G = BRANCH_W // SSM_P
SSM_N = 64
N_DIR = 2
FOURIER_GROUPS = 4
FOURIER_C = BRANCH_W // FOURIER_GROUPS
HEAD_DIM = 64
N_HEADS = BRANCH_W // HEAD_DIM
N_KV = 2
KV_GROUP = N_HEADS // N_KV
KV_W = N_KV * HEAD_DIM
Q_BLOCK = 128
ROPE_THETA = 10000.0
EPS = 1e-6
DT_MIN = 1e-3
DT_MAX = 1e-1
SPLITS = (BRANCH_W, 2 * BRANCH_W, 3 * BRANCH_W, 4 * BRANCH_W, 5 * BRANCH_W,
          5 * BRANCH_W + KV_W, 5 * BRANCH_W + 2 * KV_W)
IN_WIDTH = 6 * BRANCH_W + 2 * KV_W

kernel_name = 'hybrid_s5_fnet_gqa_diffusion_step'


def rmsnorm(x, g):
    x32 = x.astype(jnp.float32)
    y = x32 * lax.rsqrt(jnp.mean(x32 * x32, axis=-1, keepdims=True) + EPS)
    return (y * g.astype(jnp.float32)).astype(x.dtype)


def adaln(cvec, w, b):
    m = jax.nn.silu(cvec) @ w + b
    shift, scale, gate = jnp.split(m[:, None, :], 3, axis=-1)
    return shift, scale, gate


def axial_rope(seq):
    rows = seq // GRID_W
    row = jnp.repeat(jnp.arange(rows), GRID_W).astype(jnp.float32)
    col = jnp.tile(jnp.arange(GRID_W), rows).astype(jnp.float32)
    n_freq = HEAD_DIM // 4
    inv = ROPE_THETA ** (-jnp.arange(n_freq, dtype=jnp.float32) / n_freq)
    ang = jnp.concatenate([row[:, None] * inv, col[:, None] * inv], axis=-1)
    return jnp.cos(ang), jnp.sin(ang)


def apply_rope(x, cos, sin):
    x32 = x.astype(jnp.float32)
    x1, x2 = x32[..., 0::2], x32[..., 1::2]
    c, s = cos[None, :, None, :], sin[None, :, None, :]
    out = jnp.stack([x1 * c - x2 * s, x1 * s + x2 * c], axis=-1)
    return out.reshape(x.shape).astype(x.dtype)


def blocked_attention(q, k, v):
    b, s = q.shape[0], q.shape[1]
    nblk = s // Q_BLOCK
    qb = q.reshape(b, nblk, Q_BLOCK, N_KV, KV_GROUP, HEAD_DIM).transpose(1, 0, 2, 3, 4, 5)
    scale = HEAD_DIM ** -0.5

    def one_block(qi):
        sc = jnp.einsum('bqkgd,bskd->bkgqs', qi, k).astype(jnp.float32) * scale
        p = jax.nn.softmax(sc, axis=-1).astype(v.dtype)
        return jnp.einsum('bkgqs,bskd->bqkgd', p, v)

    o = lax.map(one_block, qb)
    return o.transpose(1, 0, 2, 3, 4, 5).reshape(b, s, N_HEADS * HEAD_DIM)


def s5_discretise(a_re, a_im, log_dt, b_re, b_im):
    lam = lax.complex(a_re.astype(jnp.float32), a_im.astype(jnp.float32))
    dt = jnp.exp(log_dt.astype(jnp.float32))[:, None]
    a_bar = jnp.exp(lam * dt)
    b_mat = lax.complex(b_re.astype(jnp.float32), b_im.astype(jnp.float32))
    b_bar = ((a_bar - 1.0) / lam)[..., None] * b_mat
    return a_bar, b_bar


def s5_scan(u32, a_bar, b_bar, h0, reverse):
    bu = jnp.einsum('bsgp,gnp->bsgn', u32.astype(jnp.complex64), b_bar)
    if h0 is not None:
        first = -1 if reverse else 0
        bu = bu.at[:, first].add(a_bar * h0)
    a = jnp.broadcast_to(a_bar, bu.shape)

    def combine(e1, e2):
        a1, b1 = e1
        a2, b2 = e2
        return a1 * a2, a2 * b1 + b2

    _, hs = lax.associative_scan(combine, (a, bu), axis=1, reverse=reverse)
    return hs


def s5_mixer(u, a_re, a_im, log_dt, b_re, b_im, c_re, c_im, d_skip, h0_f, h0_b):
    b, s, _ = u.shape
    u32 = u.astype(jnp.float32).reshape(b, s, SSM_G, SSM_P)
    y = d_skip.astype(jnp.float32).reshape(SSM_G, SSM_P) * u32
    finals = []
    for d, (h0, rev) in enumerate(((h0_f, False), (h0_b, True))):
        a_bar, b_bar = s5_discretise(a_re[d], a_im[d], log_dt[d], b_re[d], b_im[d])
        hs = s5_scan(u32, a_bar, b_bar, h0, rev)
        c_mat = lax.complex(c_re[d].astype(jnp.float32), c_im[d].astype(jnp.float32))
        y = y + jnp.real(jnp.einsum('bsgn,gpn->bsgp', hs, c_mat))
        finals.append(hs[:, 0] if rev else hs[:, -1])
    return y.reshape(b, s, BRANCH_W).astype(u.dtype), finals


def fourier_mix(u):
    b, s, _ = u.shape
    u32 = u.astype(jnp.float32).reshape(b, s, FOURIER_GROUPS, FOURIER_C)
    z = jnp.real(jnp.fft.fft2(u32, axes=(1, 3), norm='ortho'))
    return z.reshape(b, s, BRANCH_W).astype(u.dtype)


def mixer_layer(x, cvec, lw, ctx_kv, ssm_h0, rope):
    (norm_g, ada_w, ada_b, w_in, a_re, a_im, log_dt, b_re, b_im, c_re, c_im, d_skip,
     glu_w, fnet_w, q_gain, k_gain, w_branch, merge_w, merge_b, w_out) = lw
    b, s, _ = x.shape
    shift, scale, gate = adaln(cvec, ada_w, ada_b)
    h = rmsnorm(x, norm_g) * (1.0 + scale) + shift
    a_in, a_gate, f_in, f_gate, q, k, v, c_gate = jnp.split(h @ w_in, SPLITS, axis=-1)
    h0_f, h0_b = (None, None) if ssm_h0 is None else ssm_h0
    ya, finals = s5_mixer(a_in, a_re, a_im, log_dt, b_re, b_im, c_re, c_im, d_skip, h0_f, h0_b)
    za = jax.nn.gelu(ya) @ glu_w
    ya = za[..., :BRANCH_W] * jax.nn.sigmoid(za[..., BRANCH_W:])
    yf = fourier_mix(f_in) @ fnet_w
    q = rmsnorm(q.reshape(b, s, N_HEADS, HEAD_DIM), q_gain)
    k = rmsnorm(k.reshape(b, s, N_KV, HEAD_DIM), k_gain)
    v = v.reshape(b, s, N_KV, HEAD_DIM)
    if rope is None:
        yc = blocked_attention(q, k, v)
    else:
        cos, sin = rope
        k_all = jnp.concatenate([apply_rope(k, cos, sin), ctx_kv[0]], axis=1)
        v_all = jnp.concatenate([v, ctx_kv[1]], axis=1)
        yc = blocked_attention(apply_rope(q, cos, sin), k_all, v_all)
    branches = jnp.stack([ya * jax.nn.silu(a_gate), yf * jax.nn.silu(f_gate),
                          yc * jax.nn.silu(c_gate)], axis=2)
    proj = jnp.einsum('bsnw,nwd->bsnd', branches, w_branch)
    g = jax.nn.sigmoid(h @ merge_w + merge_b).reshape(b, s, N_BRANCH, D_MODEL)
    merged = jnp.sum(g * proj, axis=2)
    return x + gate * (merged @ w_out), k, v, finals


def setup_inputs(seed: int = 0) -> dict:
    key = jax.random.key(seed)
    ks = jax.random.split(key, 32)
    f32 = jnp.float32

    def nrm(k, shape, scale):
        return jax.random.normal(k, shape, f32) * scale

    a_im = (math.pi * jnp.arange(SSM_N, dtype=f32))[None, None, None, :] + nrm(ks[12], (DEPTH, N_DIR, SSM_G, SSM_N), 0.01)
    return {
        'x_prompt': nrm(ks[0], (BATCH, SEQ, D_MODEL), 1.0),
        'x_sample': nrm(ks[1], (DEC_BATCH, DEC_SEQ, D_MODEL), 1.0),
        'cache_k': nrm(ks[2], (DEC_BATCH, DEPTH, PAST_LEN, N_KV, HEAD_DIM), 1.0),
        'cache_v': nrm(ks[3], (DEC_BATCH, DEPTH, PAST_LEN, N_KV, HEAD_DIM), 1.0),
        'state_ssm': nrm(ks[4], (DEC_BATCH, DEPTH, N_DIR, SSM_G, SSM_N, 2), 0.1),
        'c': nrm(ks[5], (DEC_BATCH, D_MODEL), 1.0),
        'c_ctx': nrm(ks[6], (D_MODEL,), 1.0),
        'norm_g': 1.0 + nrm(ks[7], (DEPTH, D_MODEL), 0.02),
        'ada_w': nrm(ks[8], (DEPTH, D_MODEL, 3 * D_MODEL), D_MODEL ** -0.5),
        'ada_b': nrm(ks[9], (DEPTH, 3 * D_MODEL), 0.02),
        'w_in': nrm(ks[10], (DEPTH, D_MODEL, IN_WIDTH), D_MODEL ** -0.5),
        'ssm_a_re': -0.5 + nrm(ks[11], (DEPTH, N_DIR, SSM_G, SSM_N), 0.01),
        'ssm_a_im': a_im,
        'ssm_log_dt': jax.random.uniform(ks[13], (DEPTH, N_DIR, SSM_G), f32, math.log(DT_MIN), math.log(DT_MAX)),
        'ssm_b_re': nrm(ks[14], (DEPTH, N_DIR, SSM_G, SSM_N, SSM_P), (2 * SSM_P) ** -0.5),
        'ssm_b_im': nrm(ks[15], (DEPTH, N_DIR, SSM_G, SSM_N, SSM_P), (2 * SSM_P) ** -0.5),
        'ssm_c_re': nrm(ks[16], (DEPTH, N_DIR, SSM_G, SSM_P, SSM_N), SSM_N ** -0.5),
        'ssm_c_im': nrm(ks[17], (DEPTH, N_DIR, SSM_G, SSM_P, SSM_N), SSM_N ** -0.5),
        'ssm_d': nrm(ks[18], (DEPTH, BRANCH_W), 1.0),
        'glu_w': nrm(ks[19], (DEPTH, BRANCH_W, 2 * BRANCH_W), BRANCH_W ** -0.5),
        'fnet_w': nrm(ks[20], (DEPTH, BRANCH_W, BRANCH_W), BRANCH_W ** -0.5),
        'q_gain': 1.0 + nrm(ks[21], (DEPTH, HEAD_DIM), 0.02),
        'k_gain': 1.0 + nrm(ks[22], (DEPTH, HEAD_DIM), 0.02),
        'w_branch': nrm(ks[23], (DEPTH, N_BRANCH, BRANCH_W, D_MODEL), BRANCH_W ** -0.5),
        'merge_w': nrm(ks[24], (DEPTH, D_MODEL, N_BRANCH * D_MODEL), D_MODEL ** -0.5),
        'merge_b': nrm(ks[25], (DEPTH, N_BRANCH * D_MODEL), 0.02),
        'w_out': nrm(ks[26], (DEPTH, D_MODEL, D_MODEL), D_MODEL ** -0.5),
        'final_g': 1.0 + nrm(ks[27], (D_MODEL,), 0.02),
    }


def reference(x_prompt, x_sample, cache_k, cache_v, state_ssm, c, c_ctx,
              norm_g, ada_w, ada_b, w_in, ssm_a_re, ssm_a_im, ssm_log_dt,
              ssm_b_re, ssm_b_im, ssm_c_re, ssm_c_im, ssm_d, glu_w, fnet_w,
              q_gain, k_gain, w_branch, merge_w, merge_b, w_out, final_g):
    rope = axial_rope(x_sample.shape[1])
    xp, xs = x_prompt, x_sample
    new_k, new_v, new_s = [], [], []
    for l in range(DEPTH):
        lw = (norm_g[l], ada_w[l], ada_b[l], w_in[l], ssm_a_re[l], ssm_a_im[l], ssm_log_dt[l],
              ssm_b_re[l], ssm_b_im[l], ssm_c_re[l], ssm_c_im[l], ssm_d[l], glu_w[l], fnet_w[l],
              q_gain[l], k_gain[l], w_branch[l], merge_w[l], merge_b[l], w_out[l])
        xp, k_l, v_l, fin = mixer_layer(xp, c_ctx[None, :], lw, None, None, None)
        new_k.append(k_l)
        new_v.append(v_l)
        new_s.append(jnp.stack([jnp.stack([jnp.real(hf), jnp.imag(hf)], axis=-1) for hf in fin], axis=1))
        st = state_ssm[:, l].astype(jnp.float32)
        h0 = lax.complex(st[..., 0], st[..., 1])
        xs, _, _, _ = mixer_layer(xs, c, lw, (cache_k[:, l], cache_v[:, l]), (h0[:, 0], h0[:, 1]), rope)
    y_prompt = rmsnorm(xp, final_g)
    y_sample = rmsnorm(xs, final_g)
    new_cache_k = jnp.stack(new_k, axis=1)
    new_cache_v = jnp.stack(new_v, axis=1)
    new_state_ssm = jnp.stack(new_s, axis=1)
    return (y_prompt, y_sample, new_cache_k, new_cache_v, new_state_ssm)
```

```cpp
#include <hip/hip_runtime.h>
#include <hip/hip_bf16.h>
#include <cstdio>
#include <cstdint>
#include <cmath>
namespace pg8 {
#define PG8_LAS __attribute__((address_space(3)))
typedef unsigned short bf16_t;
typedef short bf16x8 __attribute__((ext_vector_type(8)));
typedef float f32x4 __attribute__((ext_vector_type(4)));
typedef unsigned u32x4 __attribute__((ext_vector_type(4)));
constexpr int BM = 256, BK = 64, HALF = 128, HTB = HALF * BK * 2  , STAGE_BYTES = 8 * HTB, NXCD = 8, WGM = 8;

__host__ __device__ __forceinline__ int lds_byte(int r, int c) { const int st = (r >> 4) * 2 + (c >> 5), rr = r & 15, cc = c & 31, ob = rr * 64 + cc * 2; return st * 1024 + (ob ^ (((ob >> 9) & 1) << 5)); }
__host__ __device__ __forceinline__ void stage_rc(int b, int& R, int& C) { const int st = b / 1024, sb = b % 1024, swz = sb ^ (((sb >> 9) & 1) << 5); R = (st >> 1) * 16 + swz / 64; C = (st & 1) * 32 + (swz % 64) / 2; }
__host__ __device__ __forceinline__ int perm32(int rho) { const int n = rho >> 4, i = rho & 15; return 8 * (i >> 2) + 4 * n + (i & 3); }


struct Unit { int pm, pn, z; };
struct Gemm { const bf16_t* A; const bf16_t* Bt; int lda, ldb, K; long zA, zB; };
struct StaticOrder {
    int nM, nN, nwg, G, c;
    __host__ __device__ void init(int M, int N, int G_, int c_) { nM = M / BM; nN = N / BM; nwg = nM * nN; G = G_; c = c_; }
    __host__ __device__ bool next(int i, Unit& u) const {
        const long L = (long)i * G + c; if (L >= nwg) return false;
        int wgid = (int)L; { const int q = nwg / NXCD, r = nwg % NXCD, xcd = wgid % NXCD, off = wgid / NXCD; wgid = (xcd < r ? xcd * (q + 1) : r * (q + 1) + (xcd - r) * q) + off; }
        const int nig = WGM * nN, gid = wgid / nig, fm = gid * WGM, gsz = (nM - fm) < WGM ? (nM - fm) : WGM;
        u.pm = fm + ((wgid % nig) % gsz); u.pn = (wgid % nig) / gsz; return true;
    }
    __device__ __forceinline__ void a_ready(const Unit&) const {}
    __device__ __forceinline__ void done(const Unit&) const {}
};
template <class Epi, class Sched, bool ALIGN_EPI = false, bool SP2 = false>
__device__ __forceinline__ void gemm_phase(PG8_LAS unsigned char* lds, const Gemm g, const Sched& S, const Epi& E, const int tid_in) {
    const int tid = tid_in, wid = __builtin_amdgcn_readfirstlane(tid >> 6), lane = tid & 63, wr = wid >> 2, wc = wid & 3, fr = lane & 15, fq = lane >> 4;
    const int K = g.K, nt = K / BK, lda = g.lda, ldb = g.ldb;
    unsigned voffA[2], voffB[2];
#pragma unroll
    for (int i = 0; i < 2; ++i) { int R, C; stage_rc(tid * 16 + i * 8192, R, C); const int Rb = Epi::PERM ? ((R & ~31) + perm32(R & 31)) : R;
        voffA[i] = (unsigned)(R * lda + C) * 2u; voffB[i] = (unsigned)(Rb * ldb + C) * 2u; }
    const size_t kstep = (size_t)(BK * 2);
    const size_t hstepA = (size_t)HALF * lda * 2, hstepB = (size_t)HALF * ldb * 2;
    const size_t tstepA = 2 * hstepA, tstepB = 2 * hstepB;
    const unsigned ldsw = (unsigned)wid * 1024u;
    const int aoff = lds_byte(wr * 64 + fr, fq * 8), boff = lds_byte(wc * 32 + fr, fq * 8);
#define PG8_SA(b, h) (((b) * 2 + (h)) * HTB)
#define PG8_SB(b, h) ((4 + (b) * 2 + (h)) * HTB)
#define PG8_STAGE(bufoff, gbase, voff) do { _Pragma("unroll") for (int _i = 0; _i < 2; ++_i) \
        __builtin_amdgcn_global_load_lds((const unsigned*)((const char*)(gbase) + (voff)[_i]), (PG8_LAS unsigned*)(lds + (bufoff) + ldsw + _i * 8192), 16, 0, 0); } while (0)
#define PG8_LDA(dst, b, h) do { _Pragma("unroll") for (int m = 0; m < 4; ++m) _Pragma("unroll") for (int k = 0; k < 2; ++k) dst[m][k] = *(const PG8_LAS bf16x8*)(lds + PG8_SA(b, h) + aoff + m * 2048 + k * 1024); } while (0)
#define PG8_LDB(dst, b, h) do { _Pragma("unroll") for (int n = 0; n < 2; ++n) _Pragma("unroll") for (int k = 0; k < 2; ++k) dst[n][k] = *(const PG8_LAS bf16x8*)(lds + PG8_SB(b, h) + boff + n * 2048 + k * 1024); } while (0)
#define PG8_MMA(ai, bj, At, Bt) do { __builtin_amdgcn_s_setprio(1); _Pragma("unroll") for (int m = 0; m < 4; ++m) _Pragma("unroll") for (int n = 0; n < 2; ++n) _Pragma("unroll") for (int k = 0; k < 2; ++k) \
        acc[ai][bj][m][n] = __builtin_amdgcn_mfma_f32_16x16x32_bf16(Bt[n][k], At[m][k], acc[ai][bj][m][n], 0, 0, 0); __builtin_amdgcn_s_setprio(0); } while (0)
#define PG8_WAIT_V(n) asm volatile("s_waitcnt vmcnt(" #n ")" ::: "memory")
#define PG8_WAIT_L(n) asm volatile("s_waitcnt lgkmcnt(" #n ")" ::: "memory")
#define PG8_BAR __builtin_amdgcn_s_barrier()
#define PG8_SCHED __builtin_amdgcn_sched_barrier(0)
    Unit cur, nxt; int ui = 0;
    if (!S.next(0, cur)) return;
    f32x4 acc[2][2][4][2];
#pragma unroll
    for (int a = 0; a < 2; ++a)
#pragma unroll
        for (int b = 0; b < 2; ++b)
#pragma unroll
            for (int m = 0; m < 4; ++m)
#pragma unroll
                for (int n = 0; n < 2; ++n) acc[a][b][m][n] = (f32x4){0.f, 0.f, 0.f, 0.f};
    bf16x8 At[4][2], B0[2][2], B1[2][2];
    const char* cA = (const char*)g.A + (size_t)cur.z * g.zA * 2 + (size_t)cur.pm * tstepA; const char* cB = (const char*)g.Bt + (size_t)cur.z * g.zB * 2 + (size_t)cur.pn * tstepB;
    S.a_ready(cur);
    if constexpr (SP2) {
        PG8_STAGE(PG8_SB(0, 0), cB, voffB); PG8_STAGE(PG8_SB(0, 1), cB + hstepB, voffB); PG8_STAGE(PG8_SA(0, 0), cA, voffA); PG8_STAGE(PG8_SA(0, 1), cA + hstepA, voffA);
        if (wr == 1) PG8_BAR;
        PG8_WAIT_V(2); PG8_BAR;
        PG8_STAGE(PG8_SB(1, 0), cB + kstep, voffB); PG8_STAGE(PG8_SA(1, 0), cA + kstep, voffA); PG8_STAGE(PG8_SB(1, 1), cB + hstepB + kstep, voffB);
        PG8_WAIT_V(6); PG8_BAR;
    } else {
        PG8_STAGE(PG8_SB(0, 0), cB, voffB); PG8_STAGE(PG8_SA(0, 0), cA, voffA); PG8_STAGE(PG8_SB(0, 1), cB + hstepB, voffB); PG8_STAGE(PG8_SA(0, 1), cA + hstepA, voffA);
        if (wr == 1) PG8_BAR;
        PG8_WAIT_V(4); PG8_BAR;
        PG8_STAGE(PG8_SB(1, 0), cB + kstep, voffB); PG8_STAGE(PG8_SA(1, 0), cA + kstep, voffA); PG8_STAGE(PG8_SB(1, 1), cB + hstepB + kstep, voffB);
        PG8_WAIT_V(6); PG8_BAR;
    }
    for (;;) {
        const bool has_next = S.next(ui + 1, nxt);
        const char* nA = has_next ? (const char*)g.A + (size_t)nxt.z * g.zA * 2 + (size_t)nxt.pm * tstepA : cA; const char* nB = has_next ? (const char*)g.Bt + (size_t)nxt.z * g.zB * 2 + (size_t)nxt.pn * tstepB : cB;
        for (int t = 0; t < nt; t += 2) {
            const bool last = (t == nt - 2);
            const char* a1 = cA + (size_t)(t + 1) * kstep;
            const char* a2 = last ? nA : cA + (size_t)(t + 2) * kstep; const char* b2 = last ? nB : cB + (size_t)(t + 2) * kstep;
            const char* a3 = a2 + kstep; const char* b3 = b2 + kstep;
            if (last && has_next) S.a_ready(nxt);
            if constexpr (SP2) {
            PG8_LDB(B0, 0, 0); PG8_LDB(B1, 0, 1); PG8_SCHED; PG8_LDA(At, 0, 0); PG8_STAGE(PG8_SA(1, 1), a1 + hstepA, voffA);
            PG8_WAIT_V(8); PG8_WAIT_L(0); PG8_BAR; PG8_MMA(0, 0, At, B0); PG8_MMA(0, 1, At, B1); PG8_BAR; PG8_SCHED;
            PG8_LDA(At, 0, 1); PG8_STAGE(PG8_SB(0, 0), b2, voffB); PG8_STAGE(PG8_SB(0, 1), b2 + hstepB, voffB); PG8_STAGE(PG8_SA(0, 0), a2, voffA);
            PG8_WAIT_V(8); PG8_WAIT_L(0); PG8_BAR; PG8_MMA(1, 0, At, B0); PG8_MMA(1, 1, At, B1); PG8_BAR; PG8_SCHED;
            PG8_LDB(B0, 1, 0); PG8_LDB(B1, 1, 1); PG8_SCHED; PG8_LDA(At, 1, 0); PG8_STAGE(PG8_SA(0, 1), a2 + hstepA, voffA);
            PG8_WAIT_V(8); PG8_WAIT_L(0); PG8_BAR; PG8_MMA(0, 0, At, B0); PG8_MMA(0, 1, At, B1); PG8_BAR; PG8_SCHED;
            PG8_LDA(At, 1, 1); PG8_STAGE(PG8_SB(1, 0), b3, voffB); PG8_STAGE(PG8_SB(1, 1), b3 + hstepB, voffB); PG8_STAGE(PG8_SA(1, 0), a3, voffA);
            PG8_WAIT_V(8); PG8_WAIT_L(0); PG8_BAR; PG8_MMA(1, 0, At, B0); PG8_MMA(1, 1, At, B1); PG8_BAR; PG8_SCHED;
            } else {
            PG8_LDB(B0, 0, 0); PG8_SCHED; PG8_LDA(At, 0, 0); PG8_STAGE(PG8_SA(1, 1), a1 + hstepA, voffA);
            PG8_WAIT_L(8); PG8_BAR; PG8_WAIT_L(0); PG8_MMA(0, 0, At, B0); PG8_BAR; PG8_SCHED;
            PG8_LDB(B1, 0, 1); PG8_STAGE(PG8_SB(0, 0), b2, voffB);
            PG8_BAR; PG8_WAIT_L(0); PG8_MMA(0, 1, At, B1); PG8_BAR;
            PG8_LDA(At, 0, 1); PG8_STAGE(PG8_SA(0, 0), a2, voffA);
            PG8_BAR; PG8_WAIT_L(0); PG8_MMA(1, 0, At, B0); PG8_BAR; PG8_SCHED;
            PG8_STAGE(PG8_SB(0, 1), b2 + hstepB, voffB);
            PG8_WAIT_V(6); PG8_BAR; PG8_MMA(1, 1, At, B1); PG8_BAR;
            PG8_LDB(B0, 1, 0); PG8_SCHED; PG8_LDA(At, 1, 0); PG8_STAGE(PG8_SA(0, 1), a2 + hstepA, voffA);
            PG8_WAIT_L(8); PG8_BAR; PG8_WAIT_L(0); PG8_MMA(0, 0, At, B0); PG8_BAR; PG8_SCHED;
            PG8_LDB(B1, 1, 1); PG8_STAGE(PG8_SB(1, 0), b3, voffB);
            PG8_BAR; PG8_WAIT_L(0); PG8_MMA(0, 1, At, B1); PG8_BAR;
            PG8_LDA(At, 1, 1); PG8_STAGE(PG8_SA(1, 0), a3, voffA);
            PG8_BAR; PG8_WAIT_L(0); PG8_MMA(1, 0, At, B0); PG8_BAR; PG8_SCHED;
            PG8_STAGE(PG8_SB(1, 1), b3 + hstepB, voffB);
            PG8_WAIT_V(6); PG8_BAR; PG8_MMA(1, 1, At, B1); PG8_BAR;
            }
        }
        if constexpr (ALIGN_EPI) { if (wr == 0) PG8_BAR; }
        if constexpr (!Epi::AFTER_DRAIN) { E(acc, cur, wr, wc, fr, fq); S.done(cur); }
        if (!has_next) break;
#pragma unroll
        for (int a = 0; a < 2; ++a)
#pragma unroll
            for (int b = 0; b < 2; ++b)
#pragma unroll
                for (int m = 0; m < 4; ++m)
#pragma unroll
                    for (int n = 0; n < 2; ++n) acc[a][b][m][n] = (f32x4){0.f, 0.f, 0.f, 0.f};
        cur = nxt; cA = nA; cB = nB; ++ui;
        if constexpr (ALIGN_EPI) { if (wr == 1) PG8_BAR; }
    }
    PG8_WAIT_V(0);
    if constexpr (!ALIGN_EPI) { if (wr == 0) PG8_BAR; }
    PG8_BAR;
    if constexpr (Epi::AFTER_DRAIN) { E.fused(acc, cur, wr, wc, fr, fq, lds, wid, lane); S.done(cur); }
#undef PG8_SA
#undef PG8_SB
#undef PG8_STAGE
#undef PG8_LDA
#undef PG8_LDB
#undef PG8_MMA
#undef PG8_WAIT_V
#undef PG8_WAIT_L
#undef PG8_BAR
#undef PG8_SCHED
}
}

#include <hip/hip_bf16.h>
#include <cmath>
namespace attn_body {
using bf16=__hip_bfloat16;
using bf16x8=__attribute__((ext_vector_type(8)))short;
using s16x4=__attribute__((ext_vector_type(4)))short;
using f32x16=__attribute__((ext_vector_type(16)))float;
using u32x4=__attribute__((ext_vector_type(4)))unsigned;
constexpr int D=64;
constexpr int NW=8,QBLK=32,QB=QBLK*NW,KVBLK=64;
__device__ __forceinline__ int crow(int r,int hi){return (r&3)+8*(r>>2)+4*hi;}
#define SBAR() __builtin_amdgcn_sched_barrier(0)
constexpr int NSLOT=3, SLOTB=8192;
constexpr int LDS_K=0, LDS_V=NSLOT*SLOTB, LDS_WS=2*NSLOT*SLOTB, LDS_OST=LDS_WS+NW*64*4, LDS_BYTES=LDS_OST+NW*4096;
constexpr float C2=0.125f*1.4426950408889634f;
__device__ __forceinline__ void glds16(const void*gsrc,unsigned lds_dst){unsigned keep;
  asm volatile("s_mov_b32 %0, m0\n\ts_mov_b32 m0, %2\n\ts_nop 0\n\tglobal_load_lds_dwordx4 %1, off\n\ts_mov_b32 m0, %0":"=&s"(keep):"v"(gsrc),"s"(lds_dst):"memory");}
__device__ __forceinline__ float max3f(float a,float b,float c){float r;asm("v_max3_f32 %0, %1, %2, %3":"=v"(r):"v"(a),"v"(b),"v"(c));return r;}
__device__ __forceinline__ float max2f(float a,float b){float r;asm("v_max_f32_e32 %0, %1, %2":"=v"(r):"v"(a),"v"(b));return r;}
__device__ __forceinline__ float fadd_s(float a,float b){float r;asm("v_add_f32_e32 %0, %1, %2":"=v"(r):"v"(a),"v"(b));return r;}
__device__ __forceinline__ float fsub_s(float a,float b){float r;asm("v_sub_f32_e32 %0, %1, %2":"=v"(r):"v"(a),"v"(b));return r;}
typedef float f32x2_t __attribute__((ext_vector_type(2))); typedef __bf16 bf16x2_t __attribute__((ext_vector_type(2)));
__device__ __forceinline__ unsigned cvtpk_s(float lo,float hi){f32x2_t v={lo,hi};bf16x2_t b=__builtin_convertvector(v,bf16x2_t);return __builtin_bit_cast(unsigned,b);}
#define WAIT_BAR(N) asm volatile("s_waitcnt vmcnt(" #N ") lgkmcnt(0)\n\ts_barrier":::"memory")

__device__ __forceinline__ void qkt(f32x16&p0,f32x16&p1,const char*Kslot,const bf16x8*qr,const f32x16&negm,int r32,int hi){
  const char*kb=Kslot+hi*1024+r32*16;
  #pragma unroll
  for(int d0=0;d0<4;++d0){
    const bf16x8 b0=*reinterpret_cast<const bf16x8*>(kb+d0*2048);
    const bf16x8 b1=*reinterpret_cast<const bf16x8*>(kb+d0*2048+512);
    if(d0==0){p0=__builtin_amdgcn_mfma_f32_32x32x16_bf16(b0,qr[0],negm,0,0,0);p1=__builtin_amdgcn_mfma_f32_32x32x16_bf16(b1,qr[0],negm,0,0,0);}
    else{p0=__builtin_amdgcn_mfma_f32_32x32x16_bf16(b0,qr[d0],p0,0,0,0);p1=__builtin_amdgcn_mfma_f32_32x32x16_bf16(b1,qr[d0],p1,0,0,0);}}
}
typedef __attribute__((address_space(3))) const char* lds_cptr;
typedef short v4i16_t __attribute__((ext_vector_type(4)));
__device__ __forceinline__ void kload8(bf16x8*kf,lds_cptr kp){
  kf[0]=*(const __attribute__((address_space(3))) bf16x8*)(kp);      kf[1]=*(const __attribute__((address_space(3))) bf16x8*)(kp+512);
  kf[2]=*(const __attribute__((address_space(3))) bf16x8*)(kp+2048); kf[3]=*(const __attribute__((address_space(3))) bf16x8*)(kp+2560);
  kf[4]=*(const __attribute__((address_space(3))) bf16x8*)(kp+4096); kf[5]=*(const __attribute__((address_space(3))) bf16x8*)(kp+4608);
  kf[6]=*(const __attribute__((address_space(3))) bf16x8*)(kp+6144); kf[7]=*(const __attribute__((address_space(3))) bf16x8*)(kp+6656);
}
__device__ __forceinline__ void kload2(bf16x8*kf,lds_cptr kp,int j){ kf[2*j]=*(const __attribute__((address_space(3))) bf16x8*)(kp+j*2048); kf[2*j+1]=*(const __attribute__((address_space(3))) bf16x8*)(kp+j*2048+512); }
__device__ __forceinline__ s16x4 vtr(lds_cptr p){ return __builtin_bit_cast(s16x4,__builtin_amdgcn_ds_read_tr16_b64_v4i16((__attribute__((address_space(3))) v4i16_t*)p)); }
__device__ __forceinline__ float rowmax(const f32x16&p0,const f32x16&p1){
  float a=max3f(p0[0],p0[1],p1[0]),b=max3f(p0[2],p0[3],p1[1]);a=max3f(a,p1[2],p1[3]);
  #pragma unroll
  for(int r=4;r<16;r+=4){a=max3f(a,p0[r],p0[r+1]);b=max3f(b,p0[r+2],p0[r+3]);a=max3f(a,p1[r],p1[r+1]);b=max3f(b,p1[r+2],p1[r+3]);}
  const float m=max2f(a,b);
  auto rr=__builtin_amdgcn_permlane32_swap(__float_as_uint(m),__float_as_uint(m),false,false);
  return max2f(__uint_as_float(rr[0]),__uint_as_float(rr[1]));
}
__device__ __forceinline__ void pv(f32x16*o,int vb,bf16x8 pa0,bf16x8 pa1,bf16x8 pa2,bf16x8 pa3){
  #pragma unroll
  for(int d0=0;d0<2;++d0){s16x4 lo[4],hi[4];
    #pragma unroll
    for(int ks=0;ks<4;++ks){
      asm volatile("ds_read_b64_tr_b16 %0,%1 offset:%c2":"=&v"(lo[ks]):"v"(vb),"i"(d0*4096+ks*1024):"memory");
      asm volatile("ds_read_b64_tr_b16 %0,%1 offset:%c2":"=&v"(hi[ks]):"v"(vb),"i"(d0*4096+ks*1024+512):"memory");}
    asm volatile("s_waitcnt lgkmcnt(0)":::"memory");SBAR();
    #define PK(k) (bf16x8){lo[k][0],lo[k][1],lo[k][2],lo[k][3],hi[k][0],hi[k][1],hi[k][2],hi[k][3]}
    o[d0]=__builtin_amdgcn_mfma_f32_32x32x16_bf16(pa0,PK(0),o[d0],0,0,0);
    o[d0]=__builtin_amdgcn_mfma_f32_32x32x16_bf16(pa1,PK(1),o[d0],0,0,0);
    o[d0]=__builtin_amdgcn_mfma_f32_32x32x16_bf16(pa2,PK(2),o[d0],0,0,0);
    o[d0]=__builtin_amdgcn_mfma_f32_32x32x16_bf16(pa3,PK(3),o[d0],0,0,0);
    #undef PK
  }
}

#ifndef ATTN_STORE16
#define ATTN_STORE16(p,v) (*(u32x4*)(p)=(v))
#endif
template<int THRL> __device__ __forceinline__ void attn_unit(const bf16*Qu,const bf16*Kh,const bf16*Vh,bf16*Ou,const bf16*Gu,const int QP,const int KP,const int NT,char*shm,const int tid_in){
  const int tid=tid_in,lane=tid&63,r32=lane&31,hi=lane>>5; const int wid=__builtin_amdgcn_readfirstlane(tid>>6);
  const bf16*Qw=Qu+(long)(wid*QBLK)*QP;
  const unsigned lds0=(unsigned)(uintptr_t)shm;
  float*wsf=(float*)(shm+LDS_WS)+wid*64;
  const bf16*ksrc=Kh+(long)lane*KP+wid*8;
  const bf16*vsrc=Vh+(long)(16*(wid&3)+(lane>>2))*KP+(wid>>2)*32+(lane&3)*8;
  const unsigned kdst=lds0+LDS_K+wid*1024, vdst=lds0+LDS_V+wid*1024;
  #define DMA_K(t,slot) glds16(ksrc+(long)(t)*KVBLK*KP,(unsigned)__builtin_amdgcn_readfirstlane(kdst+(slot)))
  #define DMA_V(t,slot) glds16(vsrc+(long)(t)*KVBLK*KP,(unsigned)__builtin_amdgcn_readfirstlane(vdst+(slot)))
  const int vb0=(int)(lds0+LDS_V)+((lane>>4)&1)*32+(lane&3)*8+(4*hi+((lane&15)>>2))*64;
  const char*Kbase=shm+LDS_K; bf16x8 kf[8];
  const lds_cptr shm3=(lds_cptr)shm; const lds_cptr kp0=shm3+LDS_K+hi*1024+r32*16; const lds_cptr vp0=shm3+LDS_V+((lane>>4)&1)*32+(lane&3)*8+(4*hi+((lane&15)>>2))*64;
  DMA_K(0,0);DMA_V(0,0);DMA_K(1,SLOTB);
  bf16x8 qr[4];
  #pragma unroll
  for(int d0=0;d0<4;++d0)qr[d0]=*reinterpret_cast<const bf16x8*>(&Qw[(long)r32*QP+d0*16+hi*8]);
  float mhat=0.f,l_reg=0.f;f32x16 o[2];o[0]=f32x16{};o[1]=f32x16{};f32x16 negm; {float zf_; asm volatile("v_mov_b32 %0, 0":"=v"(zf_)); _Pragma("unroll") for(int r=0;r<16;++r)negm[r]=zf_;} asm volatile("":"+v"(negm));
  #define CMASK(P0,P1,t) do{}while(0)
  bool resc=false;
  #define START(P0,P1) do{ const float rm=rowmax(P0,P1); resc=false; \
    { const float dl=rm; mhat=fadd_s(mhat,dl); \
      _Pragma("unroll") for(int r=0;r<16;++r){P0[r]=fsub_s(P0[r],dl);P1[r]=fsub_s(P1[r],dl);} \
      _Pragma("unroll") for(int r=0;r<16;++r)negm[r]=-mhat; asm volatile("":"+v"(negm)); } \
    _Pragma("unroll") for(int r=0;r<16;++r)P0[r]=__builtin_amdgcn_exp2f(P0[r]); }while(0)
  #define RESC() do{ if(resc){ asm volatile("s_waitcnt lgkmcnt(0)":::"memory"); \
      _Pragma("unroll") for(int d_=0;d_<2;++d_) _Pragma("unroll") for(int r=0;r<16;++r)o[d_][r]*=wsf[crow(r,hi)]; } }while(0)
  f32x16 pA0,pA1,pB0,pB1;
  int sl_prev=0,sl_cur=0,sl_next=SLOTB;
  #define ROT() do{sl_prev=sl_cur;sl_cur=sl_next;sl_next=(sl_next==(NSLOT-1)*SLOTB)?0:sl_next+SLOTB;}while(0)
  DMA_K(2,2*SLOTB);
  WAIT_BAR(3);
  qkt(pA0,pA1,Kbase,qr,negm,r32,hi);asm volatile("s_nop 15\n\ts_nop 7":"+v"(pA0),"+v"(pA1));CMASK(pA0,pA1,0);
  START(pA0,pA1);
  _Pragma("unroll") for(int r=0;r<16;++r)pA1[r]=__builtin_amdgcn_exp2f(pA1[r]);
  WAIT_BAR(0);
  DMA_K(3,0);DMA_V(1,SLOTB);
  ROT();
  kload8(kf,kp0+sl_cur);
  WAIT_BAR(2);
  s16x4 vlo[8],vhi[8]; u32x4 pw0,pw1,pw2,pw3;
  #define PKW(P,B) cvtpk_s(P[B],P[B+1])
  #define PAF(k) __builtin_bit_cast(bf16x8,pw##k)
  #define VFR(i) (bf16x8){vlo[i][0],vlo[i][1],vlo[i][2],vlo[i][3],vhi[i][0],vhi[i][1],vhi[i][2],vhi[i][3]}
  #define PIN(x) asm volatile("":"+v"(x))
  #define MX3(a,b,c) __builtin_fmaxf(__builtin_fmaxf((a),(b)),(c))
  #define GAPA(MF,A0,A1,A2,A3,W0,W1,PW) do{ MF; sacc+=A0; sacc+=A1; sacc+=A2; sacc+=A3; PIN(sacc); W0; W1; PIN(PW); SBAR(); }while(0)
  #define EX(v) __builtin_amdgcn_exp2f(v)
  #define GAPB(MF,X,B) do{ MF; X[B]=EX(X[B]); X[B+1]=EX(X[B+1]); X[B+2]=EX(X[B+2]); X[B+3]=EX(X[B+3]); PIN(X); SBAR(); }while(0)
  #define VRD(i) do{ vlo[i]=vtr(vp_+(((i)>>2)*4096+((i)&3)*1024)); vhi[i]=vtr(vp_+(((i)>>2)*4096+((i)&3)*1024+512)); }while(0)
  #define KRD(G,j) do{ if(G){ kload2(kf,kp0+sl_next,j); SBAR(); } }while(0)
  #define STEP(C0,C1,P0,P1,t,GK,GV,GL) do{ SBAR(); \
    const lds_cptr vp_=vp0+sl_prev; \
    VRD(0); SBAR(); float sacc=(P0[0]+P0[1]); \
    GAPA(C0=__builtin_amdgcn_mfma_f32_32x32x16_bf16(kf[0],qr[0],negm,0,0,0), P0[2],P0[3],P0[4],P0[5],     pw0[0]=PKW(P0,0), pw0[1]=PKW(P0,2), pw0); \
    VRD(4); SBAR(); GAPA(C1=__builtin_amdgcn_mfma_f32_32x32x16_bf16(kf[1],qr[0],negm,0,0,0), P0[6],P0[7],P0[8],P0[9],     pw0[2]=PKW(P0,4), pw0[3]=PKW(P0,6), pw0); \
    VRD(1); SBAR(); GAPA(C0=__builtin_amdgcn_mfma_f32_32x32x16_bf16(kf[2],qr[1],C0,0,0,0),   P0[10],P0[11],P0[12],P0[13], pw1[0]=PKW(P0,8), pw1[1]=PKW(P0,10), pw1); \
    VRD(5); SBAR(); GAPA(C1=__builtin_amdgcn_mfma_f32_32x32x16_bf16(kf[3],qr[1],C1,0,0,0),   P0[14],P0[15],P1[0],P1[1],   pw1[2]=PKW(P0,12),pw1[3]=PKW(P0,14), pw1); \
    VRD(2); SBAR(); GAPA(C0=__builtin_amdgcn_mfma_f32_32x32x16_bf16(kf[4],qr[2],C0,0,0,0),   P1[2],P1[3],P1[4],P1[5],     pw2[0]=PKW(P1,0), pw2[1]=PKW(P1,2), pw2); \
    VRD(6); SBAR(); GAPA(C1=__builtin_amdgcn_mfma_f32_32x32x16_bf16(kf[5],qr[2],C1,0,0,0),   P1[6],P1[7],P1[8],P1[9],     pw2[2]=PKW(P1,4), pw2[3]=PKW(P1,6), pw2); \
    VRD(3); SBAR(); GAPA(C0=__builtin_amdgcn_mfma_f32_32x32x16_bf16(kf[6],qr[3],C0,0,0,0),   P1[10],P1[11],P1[12],P1[13], pw3[0]=PKW(P1,8), pw3[1]=PKW(P1,10), pw3); \
    VRD(7); SBAR(); GAPA(C1=__builtin_amdgcn_mfma_f32_32x32x16_bf16(kf[7],qr[3],C1,0,0,0),   P1[14],P1[15],0.f,0.f,       pw3[2]=PKW(P1,12),pw3[3]=PKW(P1,14), pw3); \
    l_reg+=sacc; \
    if(GK){DMA_K((t)+3,sl_cur);} if(GV){DMA_V((t)+1,sl_next);} \
    CMASK(C0,C1,t); \
    { float a=MX3(C0[0],C0[1],C1[0]),b=MX3(C0[2],C0[3],C1[1]); a=MX3(a,C1[2],C1[3]); \
      _Pragma("unroll") for(int r=4;r<16;r+=4){a=MX3(a,C0[r],C0[r+1]);b=MX3(b,C0[r+2],C0[r+3]);a=MX3(a,C1[r],C1[r+1]);b=MX3(b,C1[r+2],C1[r+3]);} \
      float rm=__builtin_fmaxf(a,b); { auto rr=__builtin_amdgcn_permlane32_swap(__float_as_uint(rm),__float_as_uint(rm),false,false); rm=__builtin_fmaxf(__uint_as_float(rr[0]),__uint_as_float(rr[1])); } \
      resc=false; \
      if(__builtin_expect(__any(rm>(float)THRL),0)){ const float dl=__builtin_fmaxf(rm,0.f); mhat+=dl; \
        _Pragma("unroll") for(int r=0;r<16;++r){C0[r]-=dl;C1[r]-=dl;} \
        _Pragma("unroll") for(int r=0;r<16;++r)negm[r]=-mhat; asm volatile("":"+v"(negm)); \
        const float f=__builtin_amdgcn_exp2f(-dl); l_reg*=f; if(hi==0)wsf[r32]=f; resc=true; } } \
    SBAR(); \
    GAPB(o[0]=__builtin_amdgcn_mfma_f32_32x32x16_bf16(PAF(0),VFR(0),o[0],0,0,0), C0,0); \
    GAPB(o[1]=__builtin_amdgcn_mfma_f32_32x32x16_bf16(PAF(0),VFR(4),o[1],0,0,0), C0,4); \
    KRD(GL,0); GAPB(o[0]=__builtin_amdgcn_mfma_f32_32x32x16_bf16(PAF(1),VFR(1),o[0],0,0,0), C0,8); \
    KRD(GL,1); GAPB(o[1]=__builtin_amdgcn_mfma_f32_32x32x16_bf16(PAF(1),VFR(5),o[1],0,0,0), C0,12); \
    KRD(GL,2); GAPB(o[0]=__builtin_amdgcn_mfma_f32_32x32x16_bf16(PAF(2),VFR(2),o[0],0,0,0), C1,0); \
    KRD(GL,3); GAPB(o[1]=__builtin_amdgcn_mfma_f32_32x32x16_bf16(PAF(2),VFR(6),o[1],0,0,0), C1,4); \
    GAPB(o[0]=__builtin_amdgcn_mfma_f32_32x32x16_bf16(PAF(3),VFR(3),o[0],0,0,0), C1,8); \
    GAPB(o[1]=__builtin_amdgcn_mfma_f32_32x32x16_bf16(PAF(3),VFR(7),o[1],0,0,0), C1,12); \
    }while(0)
  int t=1;
  #undef CMASK
  #define CMASK(P0,P1,t) do{}while(0)
  for(;t+5<NT;t+=2){
    STEP(pB0,pB1,pA0,pA1,t,true,true,true);     WAIT_BAR(2); RESC(); ROT();
    STEP(pA0,pA1,pB0,pB1,t+1,true,true,true);   WAIT_BAR(2); RESC(); ROT();
  }
  #undef CMASK
  #define CMASK(P0,P1,t) do{}while(0)
  #define ENDW(tt) do{ if((tt)+3<NT){WAIT_BAR(2);} else if((tt)+2<NT){WAIT_BAR(1);} else {WAIT_BAR(0);} }while(0)
  for(;t+1<NT;t+=2){
    STEP(pB0,pB1,pA0,pA1,t,(t+3<NT),(t+1<NT),(t+1<NT));       ENDW(t);   RESC(); ROT();
    STEP(pA0,pA1,pB0,pB1,t+1,(t+4<NT),(t+2<NT),(t+2<NT));     ENDW(t+1); RESC(); ROT();
  }
  STEP(pB0,pB1,pA0,pA1,NT-1,false,false,false); RESC();
  { float sacc=pB0[0]+pB0[1]; _Pragma("unroll") for(int r=2;r<16;++r)sacc+=pB0[r]; _Pragma("unroll") for(int r=0;r<16;++r)sacc+=pB1[r]; l_reg+=sacc;
    pw0=(u32x4){PKW(pB0,0),PKW(pB0,2),PKW(pB0,4),PKW(pB0,6)};pw1=(u32x4){PKW(pB0,8),PKW(pB0,10),PKW(pB0,12),PKW(pB0,14)};pw2=(u32x4){PKW(pB1,0),PKW(pB1,2),PKW(pB1,4),PKW(pB1,6)};pw3=(u32x4){PKW(pB1,8),PKW(pB1,10),PKW(pB1,12),PKW(pB1,14)};
    SBAR(); pv(o,vb0+sl_cur,PAF(0),PAF(1),PAF(2),PAF(3)); }
  #undef PKW
  #undef PAF
  #undef VFR
  #undef PIN
  #undef MX3
  #undef GAPA
  #undef GAPB
  #undef EX
  #undef VRD
  #undef KRD
  #undef STEP
  #undef ENDW
  {auto rr=__builtin_amdgcn_permlane32_swap(__float_as_uint(l_reg),__float_as_uint(l_reg),false,false);l_reg=__uint_as_float(rr[0])+__uint_as_float(rr[1]);}
  if(hi==0)wsf[32+r32]=l_reg;asm volatile("s_waitcnt lgkmcnt(0)":::"memory");
  float rli[16];
  #pragma unroll
  for(int r=0;r<16;++r)rli[r]=__builtin_amdgcn_rcpf(wsf[32+crow(r,hi)]);
  bf16*Ow=Ou+(long)(wid*QBLK)*QP; const bf16*Gw=Gu+(long)(wid*QBLK)*QP;
  { bf16*stg=(bf16*)(shm+LDS_OST)+wid*2048;
    #pragma unroll
    for(int r=0;r<16;++r){const int orow=crow(r,hi);
      #pragma unroll
      for(int d0=0;d0<2;++d0)stg[orow*64+d0*32+r32]=__float2bfloat16(o[d0][r]*rli[r]);}
    asm volatile("s_waitcnt lgkmcnt(0)":::"memory");
    #pragma unroll
    for(int i=0;i<4;++i){const int row=i*8+(lane>>3),ch=lane&7; const u32x4 v=*(const u32x4*)(stg+row*64+ch*8); const u32x4 gv=*(const u32x4*)(Gw+(long)row*QP+ch*8); u32x4 w;
      #pragma unroll
      for(int e=0;e<4;++e){const float a0=__uint_as_float(v[e]<<16)*__uint_as_float(gv[e]<<16),a1=__uint_as_float(v[e]&0xffff0000u)*__uint_as_float(gv[e]&0xffff0000u); w[e]=cvtpk_s(a0,a1);}
      *(u32x4*)(Ow+(long)row*QP+ch*8)=w;} }
  asm volatile("s_waitcnt lgkmcnt(0)\n\ts_barrier":::"memory");
  #undef DMA_K
  #undef DMA_V
  #undef CMASK
  #undef START
  #undef RESC
  #undef ROT
}
constexpr int ATTN_LDS_BYTES=LDS_BYTES;
#undef SBAR
#undef WAIT_BAR
}

#define GAS __attribute__((address_space(1)))
#define LAS __attribute__((address_space(3)))
typedef unsigned short bf16;
typedef unsigned v4u __attribute__((ext_vector_type(4)));
typedef float f32x4 __attribute__((ext_vector_type(4)));
typedef short bf16x8 __attribute__((ext_vector_type(8)));
typedef GAS unsigned gu32;
typedef GAS unsigned long long gu64;
#define RLX_AGENT __ATOMIC_RELAXED, __HIP_MEMORY_SCOPE_AGENT
#define LDS_WAIT() asm volatile("s_waitcnt lgkmcnt(0)" ::: "memory")
#define VM_WAIT() asm volatile("s_waitcnt vmcnt(0)" ::: "memory")
__device__ __forceinline__ unsigned long long rt() { return __builtin_amdgcn_s_memrealtime(); }
__device__ __forceinline__ unsigned f2bf(float f) { unsigned u = __builtin_bit_cast(unsigned, f); return (u + 0x7fffu + ((u >> 16) & 1u)) >> 16; }
__device__ __forceinline__ unsigned pk2(float lo, float hi) { return f2bf(lo) | (f2bf(hi) << 16); }

#define XB_TMO      128
#define XB_XCNT(j)  (256  + 64 * (j))
#define XB_XSUB(j)  (1280 + 64 * (j))
#define XB_XGEN(j)  (2304 + 64 * (j))
#define XB_TOP      3328
#define XB_TOPGEN   3392
#define XCD_BAR_WORDS 3456
#define XB_SPIN_CAP (1u << 18)

__device__ __forceinline__ unsigned xb_ld(unsigned* p)              { return __hip_atomic_load(p, __ATOMIC_RELAXED, __HIP_MEMORY_SCOPE_AGENT); }
__device__ __forceinline__ unsigned xb_add(unsigned* p, unsigned v) { return __hip_atomic_fetch_add(p, v, __ATOMIC_RELAXED, __HIP_MEMORY_SCOPE_AGENT); }
__device__ __forceinline__ unsigned xb_xcc_id() { return (unsigned)__builtin_amdgcn_s_getreg((3 << 11) | 20) & 0xFu; }
#define XB_SPIN(cond, bar) do { unsigned _sp = 0; while (cond) { __builtin_amdgcn_s_sleep(1); \
    if ((++_sp & 255u) == 0u) { if (xb_ld(&(bar)[XB_TMO])) break; if (_sp > XB_SPIN_CAP) { atomicAdd(&(bar)[XB_TMO], 1u); break; } } } } while (0)

struct XcdBarrier {
    unsigned* bar; unsigned x;
    volatile LAS unsigned* st;
};

__device__ __forceinline__ XcdBarrier xcd_barrier_post(unsigned* bar, volatile LAS unsigned* st, const int tid) {
    XcdBarrier b; b.bar = bar; b.x = xb_xcc_id(); b.st = st;
    if (tid == 0) (void)xb_add(&bar[XB_XCNT(b.x)], 1u);
    return b;
}
__device__ __forceinline__ void xcd_barrier_complete(unsigned* bar, unsigned x, unsigned& nloc, unsigned& nx) {
    const unsigned G = gridDim.x * gridDim.y * gridDim.z;
    unsigned sum, cnt, mine, sp = 0u;
    for (;;) {
        sum = 0u; cnt = 0u; mine = 0u;
#pragma unroll
        for (unsigned j = 0; j < 16; ++j) { const unsigned c = xb_ld(&bar[XB_XCNT(j)]); sum += c; cnt += (c > 0u) ? 1u : 0u; mine = (j == x) ? c : mine; }
        if (sum == G) break;
        __builtin_amdgcn_s_sleep(1);
        if ((++sp & 255u) == 0u) { if (xb_ld(&bar[XB_TMO])) break; if (sp > XB_SPIN_CAP) { atomicAdd(&bar[XB_TMO], 1u); break; } }
    }
    nloc = mine > 0u ? mine : 1u; nx = cnt > 0u ? cnt : 1u;
}

__device__ __forceinline__ void xcd_barrier(const XcdBarrier& b, const int tid) {
    asm volatile("s_waitcnt vmcnt(0)" ::: "memory");
    __syncthreads();
    if (tid == 0) {
        unsigned* bar = b.bar; asm volatile("" : "+s"(bar));
        __builtin_amdgcn_s_waitcnt(0);
        unsigned nloc = b.st[0], nx = b.st[1];
        if (nloc == 0u) { unsigned xx = b.x; asm volatile("" : "+s"(xx)); xcd_barrier_complete(bar, xx, nloc, nx); b.st[0] = nloc; b.st[1] = nx; }
        const unsigned old = xb_add(&bar[XB_XSUB(b.x)], 1u);
        const unsigned gen = old / nloc;
        if (old + 1u == (gen + 1u) * nloc) {
            __builtin_amdgcn_fence(__ATOMIC_RELEASE, "agent");
            asm volatile("s_waitcnt vmcnt(0)" ::: "memory");
            const unsigned og = xb_add(&bar[XB_TOP], 1u);
            const unsigned tg = og / nx;
            if (og + 1u == (tg + 1u) * nx) xb_add(&bar[XB_TOPGEN], 1u);
            else XB_SPIN(xb_ld(&bar[XB_TOPGEN]) == tg, bar);
            __builtin_amdgcn_fence(__ATOMIC_ACQUIRE, "agent");
            xb_add(&bar[XB_XGEN(b.x)], 1u);
            asm volatile("s_waitcnt vmcnt(0)" ::: "memory");
        } else {
            XB_SPIN(xb_ld(&bar[XB_XGEN(b.x)]) == gen, bar);
            __builtin_amdgcn_fence(__ATOMIC_ACQUIRE, "agent");
            asm volatile("s_waitcnt vmcnt(0)" ::: "memory");
        }
    }
    __syncthreads();
}


constexpr int NWAVES = 8, NTHR = 512, GRID = 256;
constexpr int T_TOK = 8192, T_CTX = 4096, DMOD = 1024, BW = 512, INW = 3328, NCAT = 6400, DEPTH = 4;
constexpr int S_LAT = 2048, LKV = 2304, KVW = 128;
constexpr float RMS_EPS = 1e-6f;
constexpr float QSCALE = 0.125f * 1.4426950408889634f;
constexpr size_t MiB = 1u << 20;
constexpr size_t WS_CTL = 0, CTL_ZERO_BYTES = MiB;
constexpr size_t WS_MODP = 1 * MiB;
constexpr size_t WS_ROPE = 1 * MiB + 768 * 1024;
constexpr size_t WS_A16 = 1 * MiB + 832 * 1024;
constexpr size_t WS_WCAT = 2 * MiB;
constexpr size_t WS_WGLU = 15 * MiB;
constexpr size_t WS_WFN = 16 * MiB;
constexpr size_t WS_WBR = 17 * MiB;
constexpr size_t WS_WOUT = 20 * MiB;
constexpr size_t WS_BTS = 22 * MiB;
constexpr size_t WS_FTS = 30 * MiB;
constexpr size_t WS_A2L = 34 * MiB;
constexpr size_t WS_A2C = 50 * MiB;
constexpr size_t WS_A1P = 50 * MiB + 512 * 1024;
constexpr size_t WS_XRES = 51 * MiB;
constexpr size_t WS_G = 83 * MiB;
constexpr size_t WS_H = 131 * MiB;
constexpr size_t WS_U5 = 147 * MiB;
constexpr size_t WS_GA = 155 * MiB;
constexpr size_t WS_GF = 163 * MiB;
constexpr size_t WS_Q = 171 * MiB;
constexpr size_t WS_UF = 179 * MiB;
constexpr size_t WS_GC = 187 * MiB;
constexpr size_t WS_KC = 195 * MiB, WS_KL = 196 * MiB;
constexpr size_t WS_VC = WS_KC + 5 * MiB / 2, WS_VL = WS_KL + 5 * MiB / 2;
constexpr size_t WS_YI = 200 * MiB;
constexpr size_t WS_SC = 216 * MiB;
constexpr size_t WS_MP = 200 * MiB;
constexpr size_t WS_HC = 232 * MiB;
constexpr size_t WS_END = 240 * MiB;
constexpr int CW_BAR = 4096;
constexpr size_t OUT_K = 8388608, OUT_V = 10485760, OUT_S = 12582912, OUT_N = 13107200;
constexpr int RING_BYTES = 131072, LDSCTL_OFF = RING_BYTES, MISC_OFF = LDSCTL_OFF + 320, LDS_BYTES = 147456;

typedef float f32x2 __attribute__((ext_vector_type(2)));
typedef unsigned u32x2 __attribute__((ext_vector_type(2)));
__device__ __forceinline__ unsigned cvtpk(float lo, float hi) { typedef __bf16 bf16x2_t __attribute__((ext_vector_type(2))); f32x2 v = {lo, hi}; bf16x2_t b = __builtin_convertvector(v, bf16x2_t); return __builtin_bit_cast(unsigned, b); }
__device__ __forceinline__ void st_bf4(bf16* p, f32x4 v) { u32x2 w; w.x = cvtpk(v[0], v[1]); w.y = cvtpk(v[2], v[3]); *(u32x2*)p = w; }
__device__ __forceinline__ f32x4 ld_bf4(const bf16* p) { const u32x2 w = *(const u32x2*)p; f32x4 r; r[0] = __uint_as_float(w.x << 16); r[1] = __uint_as_float(w.x & 0xffff0000u); r[2] = __uint_as_float(w.y << 16); r[3] = __uint_as_float(w.y & 0xffff0000u); return r; }
__device__ __forceinline__ float bf2f(bf16 h) { return __uint_as_float((unsigned)h << 16); }
__device__ __forceinline__ float sigmoidf_(float x) { return __builtin_amdgcn_rcpf(1.0f + __expf(-x)); }
__device__ __forceinline__ f32x4 sigmoid4(f32x4 v) { f32x4 r; r[0] = sigmoidf_(v[0]); r[1] = sigmoidf_(v[1]); r[2] = sigmoidf_(v[2]); r[3] = sigmoidf_(v[3]); return r; }
__device__ __forceinline__ f32x4 silu4(f32x4 v) { return v * sigmoid4(v); }
__device__ __forceinline__ float gelu_tanh(float x) { const float y = 0.7978845608028654f * (x + 0.044715f * x * x * x); return x * sigmoidf_(2.0f * y); }
__device__ __forceinline__ float shx(float v, int mask, int lane) { return __int_as_float(__builtin_amdgcn_ds_bpermute((lane ^ mask) << 2, __float_as_int(v))); }
__device__ __forceinline__ float wave_sum(float v, int lane) {
#pragma unroll
    for (int o = 1; o < 64; o <<= 1) v += shx(v, o, lane);
    return v;
}

struct KArgs { const float* in[28]; float* out; unsigned char* ws; int ph_lo, ph_hi; };
enum { I_XP = 0, I_XS, I_CK, I_CV, I_ST, I_C, I_CCTX, I_NORMG, I_ADAW, I_ADAB, I_WIN, I_ARE, I_AIM, I_LDT, I_BRE, I_BIM, I_CRE, I_CIM, I_SD, I_GLU, I_FN, I_QG, I_KG, I_WBR, I_MW, I_MB, I_WOUT, I_FG };

struct Ctx {
    LAS unsigned char* lds; int tid, lane, wave, bid, gw, ngw;
    const float* const* in; float* out; unsigned char* ws;
    template <class Tp> __device__ __forceinline__ Tp* w(size_t off) const { return (Tp*)(ws + off); }
};

__device__ __forceinline__ f32x4 load_mod4(const float* modp, const float* adab, int l, int ci, int j) {
    const float* mp = modp + ((size_t)l * 3 + ci) * 3072 + j;
    f32x4 r = *(const f32x4*)(adab + (size_t)l * 3072 + j);
#pragma unroll
    for (int kq = 0; kq < 4; ++kq) r += *(const f32x4*)(mp + (size_t)kq * (4 * 3 * 3072));
    return r;
}

template <class Dec> struct SchedR {
    int n, lo, cnt, c; Dec d;
    __device__ __forceinline__ bool next(int i, pg8::Unit& u) const { if (c < lo || c >= lo + cnt) return false; const int L = i * cnt + (c - lo); if (L >= n) return false; d(L, u); return true; }
    __device__ __forceinline__ void a_ready(const pg8::Unit&) const {}
    __device__ __forceinline__ void done(const pg8::Unit&) const {}
};
struct DecS5A { __device__ __forceinline__ void operator()(int L, pg8::Unit& u) const { u.z = L >> 2; u.pm = (L >> 1) & 1; u.pn = L & 1; } };
struct DecDFT1 { __device__ __forceinline__ void operator()(int L, pg8::Unit& u) const { u.z = L >> 6; u.pm = (L >> 5) & 1; u.pn = L & 31; } };
struct DecDFT2C { __device__ __forceinline__ void operator()(int L, pg8::Unit& u) const { u.z = 0; u.pm = 0; u.pn = L; } };
struct DecDFT2L { __device__ __forceinline__ void operator()(int L, pg8::Unit& u) const { u.z = 0; u.pm = L >> 2; u.pn = L & 3; } };
struct DecS5B { __device__ __forceinline__ void operator()(int L, pg8::Unit& u) const { u.z = L >> 1; u.pm = L & 1; u.pn = 0; } };
struct DecN4 { __device__ __forceinline__ void operator()(int L, pg8::Unit& u) const { u.z = 0; u.pm = L >> 2; u.pn = L & 3; } };
struct DecN2 { __device__ __forceinline__ void operator()(int L, pg8::Unit& u) const { u.z = 0; u.pm = L >> 1; u.pn = L & 1; } };
struct DecG4 { __device__ __forceinline__ void operator()(int L, pg8::Unit& u) const { const int t = L / 3; u.z = L - 3 * t; u.pm = t >> 2; u.pn = t & 3; } };
struct SchedG4 {
    int cnt, c;
    __device__ __forceinline__ bool next(int i, pg8::Unit& u) const { const int t = (i / 3) * cnt + c; if (c >= cnt || t >= 128) return false; u.z = i % 3; u.pm = t >> 2; u.pn = t & 3; return true; }
    __device__ __forceinline__ void a_ready(const pg8::Unit&) const {}
    __device__ __forceinline__ void done(const pg8::Unit&) const {}
};
struct SchedG1 : pg8::StaticOrder {
    __device__ __forceinline__ bool next(int i, pg8::Unit& u) const { u.z = 0; return pg8::StaticOrder::next(i, u); }
};

#define EPI_ROWS for (int ai = 0; ai < 2; ++ai) _Pragma("unroll") for (int m = 0; m < 4; ++m)
#define EPI_COLS for (int bj = 0; bj < 2; ++bj) _Pragma("unroll") for (int n = 0; n < 2; ++n)
#define EPI_ROW (u.pm * 256 + ai * 128 + wr * 64 + m * 16 + fr)
#define EPI_COL (u.pn * 256 + bj * 128 + wc * 32 + n * 16 + fq * 4)
typedef const f32x4 (&AccRef)[2][2][4][2];

struct EpiG1 {
    static constexpr bool PERM = false, AFTER_DRAIN = false;
    bf16 *U5, *GA, *UF, *GF, *Q, *GC, *Gm, *Kc, *Vc, *Kl, *Vl; float *outK, *outV; const float *qg, *kg, *mb, *rope; int layer;
    __device__ __forceinline__ void qkv(AccRef acc, const pg8::Unit& u, int wr, int wc, int fr, int fq) const {
        const int pn = u.pn; const bool isq = pn < 10;
        const int kind = isq ? 0 : (wc < 2 ? 1 : 2);
        const int head = isq ? (pn - 8) * 4 + wc : (wc & 1);
        f32x4 gv[2][2];
        if (kind == 0) {
#pragma unroll
            EPI_COLS gv[bj][n] = *(const f32x4*)(qg + layer * 64 + 32 * bj + 16 * n + 4 * fq);
        } else {
#pragma unroll
            EPI_COLS gv[bj][n] = *(const f32x4*)(kg + layer * 64 + 32 * bj + 16 * n + 4 * fq);
        }
        const bool lat = u.pm >= 16;
#pragma unroll
        EPI_ROWS {
            const int row = EPI_ROW;
            f32x4 x[2][2];
#pragma unroll
            EPI_COLS x[bj][n] = acc[ai][bj][m][n];
            if (kind != 2) {
                float ss = 0.f;
#pragma unroll
                EPI_COLS { const f32x4 t = x[bj][n]; ss += (t[0] * t[0] + t[1] * t[1]) + (t[2] * t[2] + t[3] * t[3]); }
                ss += shx(ss, 16, fq * 16 + fr); ss += shx(ss, 32, fq * 16 + fr);
                const float rstd = rsqrtf(ss * (1.0f / 64.0f) + RMS_EPS);
#pragma unroll
                EPI_COLS x[bj][n] = x[bj][n] * rstd * gv[bj][n];
            }
            int b, s;
            if (lat) { const int tl = row - T_CTX; b = tl >> 11; s = tl & 2047; } else { b = row >> 8; s = row & 255; }
            if (lat && kind != 2) {
                const int gr = s >> 6, gc = s & 63;
#pragma unroll
                EPI_COLS { const int pos = bj ? gc : gr; const f32x4 cs = *(const f32x4*)(rope + (pos * 16 + 8 * n + 2 * fq) * 2); const f32x4 t = x[bj][n];
                    f32x4 r; r[0] = t[0] * cs[0] - t[1] * cs[1]; r[1] = t[0] * cs[1] + t[1] * cs[0]; r[2] = t[2] * cs[2] - t[3] * cs[3]; r[3] = t[2] * cs[3] + t[3] * cs[2]; x[bj][n] = r; }
            }
#pragma unroll
            EPI_COLS { const int j = 32 * bj + 16 * n + 4 * fq; const f32x4 t = x[bj][n];
                const size_t ol = ((size_t)b * LKV + s) * KVW + head * 64 + j, oc = (size_t)row * KVW + head * 64 + j, oo = (((size_t)b * DEPTH + layer) * 256 + s) * KVW + head * 64 + j;
                if (kind == 0) st_bf4(Q + (size_t)row * 512 + head * 64 + j, t * QSCALE);
                else if (kind == 1) { if (lat) st_bf4(Kl + ol, t); else { st_bf4(Kc + oc, t); *(f32x4*)(outK + oo) = t; } }
                else { if (lat) st_bf4(Vl + ol, t); else { st_bf4(Vc + oc, t); *(f32x4*)(outV + oo) = t; } } }
            asm volatile("" ::: "memory");
        }
    }
    __device__ __forceinline__ void operator()(AccRef acc, const pg8::Unit& u, int wr, int wc, int fr, int fq) const {
        const int pn = u.pn;
        if (pn >= 8 && pn <= 10) { qkv(acc, u, wr, wc, fr, fq); return; }
#pragma unroll
        EPI_ROWS { const int row = EPI_ROW;
#pragma unroll
            EPI_COLS { const int col = EPI_COL; const f32x4 v = acc[ai][bj][m][n];
                if (pn < 2) { const int g = col >> 4, q = col & 15; st_bf4(U5 + (((size_t)g * 512 + (row >> 4)) * 16 + (row & 15)) * 16 + q, v); }
                else if (pn < 4) st_bf4(GA + (size_t)row * 512 + (col - 512), silu4(v));
                else if (pn < 6) st_bf4(UF + (size_t)row * 512 + (col - 1024), v);
                else if (pn < 8) st_bf4(GF + (size_t)row * 512 + (col - 1536), silu4(v));
                else if (pn < 13) st_bf4(GC + (size_t)row * 512 + (col - 2816), silu4(v));
                else { const int cm = col - INW; const f32x4 bb = *(const f32x4*)(mb + cm); st_bf4(Gm + (size_t)row * 3072 + cm, sigmoid4(v + bb)); }
            } asm volatile("" ::: "memory"); }
    }
};
struct EpiS5A {
    static constexpr bool PERM = false, AFTER_DRAIN = false;
    float *YI, *SC;
    __device__ __forceinline__ void operator()(AccRef acc, const pg8::Unit& u, int wr, int wc, int fr, int fq) const {
#pragma unroll
        EPI_ROWS { const int chunk = EPI_ROW;
#pragma unroll
            EPI_COLS { const int col = bj * 128 + wc * 32 + n * 16 + fq * 4; const f32x4 v = acc[ai][bj][m][n];
                if (u.pn == 0) *(f32x4*)(YI + ((size_t)chunk * 16 + (col >> 4)) * 512 + u.z * 16 + (col & 15)) = v;
                else *(f32x4*)(SC + ((size_t)u.z * 512 + chunk) * 256 + col) = v; } asm volatile("" ::: "memory"); }
    }
};
struct EpiS5B {
    static constexpr bool PERM = false, AFTER_DRAIN = false;
    const float *YI, *dskip; const bf16* U5; bf16* GY;
    __device__ __forceinline__ void operator()(AccRef acc, const pg8::Unit& u, int wr, int wc, int fr, int fq) const {
#pragma unroll
        EPI_ROWS { int chunk = EPI_ROW; asm volatile("" : "+v"(chunk));
#pragma unroll
            EPI_COLS { const int col = bj * 128 + wc * 32 + n * 16 + fq * 4, t = col >> 4, p = col & 15, ch = u.z * 16 + p; const size_t tok = (size_t)chunk * 16 + t;
                const f32x4 yi = *(const f32x4*)(YI + tok * 512 + ch), dk = *(const f32x4*)(dskip + ch), uu = ld_bf4(U5 + (((size_t)u.z * 512 + chunk) * 16 + t) * 16 + p);
                f32x4 y = acc[ai][bj][m][n] + yi + dk * uu; y[0] = gelu_tanh(y[0]); y[1] = gelu_tanh(y[1]); y[2] = gelu_tanh(y[2]); y[3] = gelu_tanh(y[3]);
                st_bf4(GY + tok * 512 + ch, y); } asm volatile("" ::: "memory"); }
    }
};
struct EpiDFT1 {
    static constexpr bool PERM = false, AFTER_DRAIN = false;
    bf16 *VtC, *VtL;
    __device__ __forceinline__ void operator()(AccRef acc, const pg8::Unit& u, int wr, int wc, int fr, int fq) const {
        const int grp = 2 * u.z + u.pm;
#pragma unroll
        EPI_ROWS { const int j = wr * 64 + m * 16 + fr, reim = ai;
#pragma unroll
            EPI_COLS { const int tok = EPI_COL; const f32x4 v = acc[ai][bj][m][n];
                if (tok < T_CTX) { const int b = tok >> 8, s = tok & 255; st_bf4(VtC + ((size_t)b * 512 + grp * 128 + j) * 512 + reim * 256 + s, v); }
                else { const int tl = tok - T_CTX, b = tl >> 11, s = tl & 2047; st_bf4(VtL + ((size_t)b * 512 + grp * 128 + j) * 4096 + reim * 2048 + s, v); } } asm volatile("" ::: "memory"); }
    }
};
struct EpiDFT2 {
    static constexpr bool PERM = false, AFTER_DRAIN = false;
    bf16* ZF; int lat;
    __device__ __forceinline__ void operator()(AccRef acc, const pg8::Unit& u, int wr, int wc, int fr, int fq) const {
#pragma unroll
        EPI_ROWS { const int k = EPI_ROW;
#pragma unroll
            EPI_COLS { const int col = EPI_COL, b = col >> 9, ch = col & 511; const size_t tok = lat ? (size_t)T_CTX + b * 2048 + k : (size_t)b * 256 + k;
                st_bf4(ZF + tok * 512 + ch, acc[ai][bj][m][n]); } asm volatile("" ::: "memory"); }
    }
};
struct EpiGLU {
    static constexpr bool PERM = false, AFTER_DRAIN = false;
    bf16* GA;
    __device__ __forceinline__ void operator()(AccRef acc, const pg8::Unit& u, int wr, int wc, int fr, int fq) const {
#pragma unroll
        EPI_ROWS { const size_t row = EPI_ROW;
#pragma unroll
            for (int n = 0; n < 2; ++n) { const int oc = u.pn * 128 + wc * 32 + n * 16 + fq * 4; bf16* p = GA + row * 512 + oc;
                st_bf4(p, acc[ai][0][m][n] * sigmoid4(acc[ai][1][m][n]) * ld_bf4(p)); } asm volatile("" ::: "memory"); }
    }
};
struct EpiMul {
    static constexpr bool PERM = false, AFTER_DRAIN = false;
    bf16* GF;
    __device__ __forceinline__ void operator()(AccRef acc, const pg8::Unit& u, int wr, int wc, int fr, int fq) const {
#pragma unroll
        EPI_ROWS { const size_t row = EPI_ROW;
#pragma unroll
            EPI_COLS { bf16* p = GF + row * 512 + EPI_COL; st_bf4(p, acc[ai][bj][m][n] * ld_bf4(p)); } asm volatile("" ::: "memory"); }
    }
};
struct EpiG4 {
    static constexpr bool PERM = false, AFTER_DRAIN = false;
    const bf16* Gm; float* MP; bf16* MG;
    __device__ __forceinline__ void operator()(AccRef acc, const pg8::Unit& u, int wr, int wc, int fr, int fq) const {
#pragma unroll
        EPI_ROWS { const size_t row = EPI_ROW;
#pragma unroll
            EPI_COLS { const int col = EPI_COL; f32x4 t = acc[ai][bj][m][n] * ld_bf4(Gm + row * 3072 + u.z * 1024 + col); float* mp = MP + row * 1024 + col;
                if (u.z > 0) t += *(const f32x4*)mp;
                if (u.z < 2) *(f32x4*)mp = t; else st_bf4(MG + row * 1024 + col, t); } asm volatile("" ::: "memory"); }
    }
};
struct EpiG5 {
    static constexpr bool PERM = false, AFTER_DRAIN = false;
    const float *xc, *xl; float* XR; const float *modp, *adab; int layer;
    __device__ __forceinline__ void operator()(AccRef acc, const pg8::Unit& u, int wr, int wc, int fr, int fq) const {
        const int ci = u.pm < 16 ? 0 : 1 + ((u.pm - 16) >> 3);
        f32x4 g[2][2];
#pragma unroll
        EPI_COLS g[bj][n] = load_mod4(modp, adab, layer, ci, 2048 + EPI_COL);
#pragma unroll
        EPI_ROWS { const size_t row = EPI_ROW; const float* xin = u.pm < 16 ? xc + row * 1024 : xl + (row - T_CTX) * 1024;
#pragma unroll
            EPI_COLS { const int col = EPI_COL; *(f32x4*)(XR + row * 1024 + col) = *(const f32x4*)(xin + col) + g[bj][n] * acc[ai][bj][m][n]; } asm volatile("" ::: "memory"); }
    }
};

template <class RowMap>
__device__ __forceinline__ void transpose_item(const float* W, int K, int N, bf16* WT, const RowMap& rm, LAS float* scr, int item, int lane) {
    const int nblk = N / 32, kb = item / nblk, nb = item % nblk, k0 = 64 * kb, n0 = 32 * nb;
#pragma unroll 8
    for (int i = 0; i < 32; ++i) { const int kk = 2 * i + (lane >> 5); scr[kk * 33 + (lane & 31)] = W[(size_t)(k0 + kk) * N + n0 + (lane & 31)]; }
    LDS_WAIT(); asm volatile("" ::: "memory");
    const int c = lane & 7;
#pragma unroll
    for (int j = 0; j < 4; ++j) { const int n = (lane >> 3) + 8 * j; const LAS float* s = scr + (8 * c) * 33 + n;
        v4u o; o.x = cvtpk(s[0 * 33], s[1 * 33]); o.y = cvtpk(s[2 * 33], s[3 * 33]); o.z = cvtpk(s[4 * 33], s[5 * 33]); o.w = cvtpk(s[6 * 33], s[7 * 33]);
        *(v4u*)(WT + (size_t)rm(n0 + n) * K + k0 + 8 * c) = o; }
    LDS_WAIT(); asm volatile("" ::: "memory");
}
struct RmId { int off; __device__ __forceinline__ int operator()(int n) const { return off + n; } };
struct RmWin { __device__ __forceinline__ int operator()(int n) const {
        if (n < 2048 || n >= 2816) return n; const int t = (n - 2048) >> 8, cl = (n - 2048) & 255, hh = cl >> 6, jl = cl & 63; return 2048 + t * 256 + 128 * (jl >> 5) + 32 * hh + (jl & 31); } };
struct RmGlu { __device__ __forceinline__ int operator()(int c) const { const int half = c >> 9, cc = c & 511; return 256 * (cc >> 7) + 128 * half + (cc & 127); } };

__device__ __forceinline__ void ph_prologue(const Ctx& C) {
    LAS float* red = (LAS float*)C.lds;
    const float* cc = C.in[I_CCTX]; const float* cl = C.in[I_C];
    for (int item = C.bid; item < 192; item += GRID) {
        const int kq = item & 3, ch = (item >> 2) % 12, l = item / 48;
        const float* W = C.in[I_ADAW] + (size_t)l * 1024 * 3072 + ch * 256 + C.lane * 4;
        f32x4 a0 = {0.f, 0.f, 0.f, 0.f}, a1 = a0, a2 = a0;
#pragma unroll 4
        for (int i = 0; i < 32; ++i) { const int k = kq * 256 + C.wave * 32 + i; const f32x4 w = *(const f32x4*)(W + (size_t)k * 3072);
            const float x0 = cc[k], x1 = cl[k], x2 = cl[1024 + k]; const float s0 = x0 * sigmoidf_(x0), s1 = x1 * sigmoidf_(x1), s2 = x2 * sigmoidf_(x2);
            a0 += w * s0; a1 += w * s1; a2 += w * s2; }
        *(LAS f32x4*)(red + (C.wave * 3 + 0) * 256 + C.lane * 4) = a0; *(LAS f32x4*)(red + (C.wave * 3 + 1) * 256 + C.lane * 4) = a1; *(LAS f32x4*)(red + (C.wave * 3 + 2) * 256 + C.lane * 4) = a2;
        __syncthreads();
        for (int idx = C.tid; idx < 768; idx += NTHR) { const int ci = idx >> 8, col = idx & 255; float s = 0.f;
#pragma unroll
            for (int w = 0; w < 8; ++w) s += red[(w * 3 + ci) * 256 + col];
            C.w<float>(WS_MODP)[(((size_t)kq * 4 + l) * 3 + ci) * 3072 + ch * 256 + col] = s; }
        __syncthreads();
    }
    const int gt = C.bid * NTHR + C.tid, ngt = GRID * NTHR;
    constexpr int T_A2L = 2048 * 4096 / 8, T_A2C = 256 * 512 / 8, T_A1P = 512 * 256 / 8;
    for (int t = gt; t < T_A2L + T_A2C + T_A1P; t += ngt) {
        float v[8]; bf16* dst;
        if (t < T_A2L) { const int k = t >> 9, c0 = (t & 511) * 8; dst = C.w<bf16>(WS_A2L) + (size_t)k * 4096 + c0;
#pragma unroll
            for (int e = 0; e < 8; ++e) { const int col = c0 + e, s = col & 2047, mm = (k * s) & 2047; float sn, cs; sincospif((float)mm * (1.0f / 1024.0f), &sn, &cs); v[e] = (col < 2048 ? cs : sn) * 0.02209708691207961f; } }
        else if (t < T_A2L + T_A2C) { const int tt = t - T_A2L, k = tt >> 6, c0 = (tt & 63) * 8; dst = C.w<bf16>(WS_A2C) + (size_t)k * 512 + c0;
#pragma unroll
            for (int e = 0; e < 8; ++e) { const int col = c0 + e, s = col & 255, mm = (k * s) & 255; float sn, cs; sincospif((float)mm * (1.0f / 128.0f), &sn, &cs); v[e] = (col < 256 ? cs : sn) * 0.0625f; } }
        else { const int tt = t - T_A2L - T_A2C, r = tt >> 5, c0 = (tt & 31) * 8; dst = C.w<bf16>(WS_A1P) + (size_t)r * 256 + c0; const int gl = r >> 8, reim = (r >> 7) & 1, j = r & 127;
#pragma unroll
            for (int e = 0; e < 8; ++e) { const int col = c0 + e, glc = col >> 7, c = col & 127, mm = (j * c) & 127; float sn, cs; sincospif((float)mm * (1.0f / 64.0f), &sn, &cs);
                v[e] = (glc == gl) ? (reim ? -sn : cs) * 0.08838834764831845f : 0.f; } }
        v4u o; o.x = cvtpk(v[0], v[1]); o.y = cvtpk(v[2], v[3]); o.z = cvtpk(v[4], v[5]); o.w = cvtpk(v[6], v[7]); *(v4u*)dst = o;
    }
    if (gt < 1024) { const int pos = gt >> 4, f = gt & 15; const float inv = powf(10000.0f, -(float)f / 16.0f), ang = (float)pos * inv;
        C.w<float>(WS_ROPE)[gt * 2] = cosf(ang); C.w<float>(WS_ROPE)[gt * 2 + 1] = sinf(ang); }
}

__device__ __forceinline__ void s5_mats_block(const Ctx& C, int l, int g) {
    LAS f32x2* pw = (LAS f32x2*)C.lds;
    LAS f32x2* Bb = pw + 2 * 17 * 64;
    LAS f32x2* Cm = Bb + 2 * 64 * 16;
    LAS float* Kl = (LAS float*)(Cm + 2 * 16 * 64);
    const int tid = C.tid;
    if (tid < 128) {
        const int d = tid >> 6, n = tid & 63; const size_t gi = ((size_t)(l * 2 + d) * 32 + g);
        const float lr = C.in[I_ARE][gi * 64 + n], li = C.in[I_AIM][gi * 64 + n], dt = expf(C.in[I_LDT][gi]);
        for (int tau = 0; tau <= 16; ++tau) { const float mag = expf((float)tau * dt * lr), ang = (float)tau * dt * li; float sn, cs; sincosf(ang, &sn, &cs); pw[(d * 17 + tau) * 64 + n] = (f32x2){mag * cs, mag * sn}; }
        float mag = expf(dt * lr), sn, cs; sincosf(dt * li, &sn, &cs);
        const float x = mag * cs - 1.0f, y = mag * sn, den = 1.0f / (lr * lr + li * li), cr = (x * lr + y * li) * den, cim = (y * lr - x * li) * den;
        const float* br = C.in[I_BRE] + (gi * 64 + n) * 16; const float* bi = C.in[I_BIM] + (gi * 64 + n) * 16;
#pragma unroll
        for (int q = 0; q < 16; ++q) Bb[(d * 64 + n) * 16 + q] = (f32x2){cr * br[q] - cim * bi[q], cr * bi[q] + cim * br[q]};
        const float m16 = expf(16.0f * dt * lr); sincosf(16.0f * dt * li, &sn, &cs);
        C.w<float>(WS_A16)[(gi * 64 + n) * 2] = m16 * cs; C.w<float>(WS_A16)[(gi * 64 + n) * 2 + 1] = m16 * sn;
    }
    for (int idx = tid; idx < 2048; idx += NTHR) { const int d = idx >> 10, p = (idx >> 6) & 15, n = idx & 63; const size_t o = (((size_t)(l * 2 + d) * 32 + g) * 16 + p) * 64 + n;
        Cm[idx] = (f32x2){C.in[I_CRE][o], C.in[I_CIM][o]}; }
    __syncthreads();
    {
        const int d = tid >> 8, p = (tid >> 4) & 15, q = tid & 15; float acc[16];
#pragma unroll
        for (int t = 0; t < 16; ++t) acc[t] = 0.f;
        for (int n = 0; n < 64; ++n) { const f32x2 c = Cm[(d * 16 + p) * 64 + n], b = Bb[(d * 64 + n) * 16 + q]; const float wr = c.x * b.x - c.y * b.y, wi = c.x * b.y + c.y * b.x;
#pragma unroll
            for (int t = 0; t < 16; ++t) { const f32x2 a = pw[(d * 17 + t) * 64 + n]; acc[t] += wr * a.x - wi * a.y; } }
#pragma unroll
        for (int t = 0; t < 16; ++t) Kl[(d * 16 + t) * 256 + p * 16 + q] = acc[t];
    }
    __syncthreads();
    bf16* Bt = C.w<bf16>(WS_BTS) + (size_t)g * 512 * 256; bf16* Ft = C.w<bf16>(WS_FTS) + (size_t)g * 256 * 256;
    for (int task = tid; task < 3 * 8192; task += NTHR) {
        const int which = task >> 13, r = (task >> 5) & 255, c0 = (task & 31) * 8; float v[8]; bf16* dst;
        if (which == 0) { const int t = r >> 4, p = r & 15, j = c0 >> 4, q0 = c0 & 15; dst = Bt + (size_t)r * 256 + c0;
#pragma unroll
            for (int e = 0; e < 8; ++e) { float s = 0.f; if (j <= t) s += Kl[(0 * 16 + (t - j)) * 256 + p * 16 + q0 + e]; if (j >= t) s += Kl[(1 * 16 + (j - t)) * 256 + p * 16 + q0 + e]; v[e] = s; } }
        else if (which == 1) { const int d = r >> 7, reim = (r >> 6) & 1, n = r & 63, j = c0 >> 4, q0 = c0 & 15, ex = d == 0 ? 15 - j : j; dst = Bt + (size_t)(256 + r) * 256 + c0; const f32x2 a = pw[(d * 17 + ex) * 64 + n];
#pragma unroll
            for (int e = 0; e < 8; ++e) { const f32x2 b = Bb[(d * 64 + n) * 16 + q0 + e]; v[e] = reim ? (a.x * b.y + a.y * b.x) : (a.x * b.x - a.y * b.y); } }
        else { const int t = r >> 4, p = r & 15, d = c0 >> 7, reim = (c0 >> 6) & 1, n0 = c0 & 63, ex = d == 0 ? t + 1 : 16 - t; dst = Ft + (size_t)r * 256 + c0;
#pragma unroll
            for (int e = 0; e < 8; ++e) { const f32x2 c = Cm[(d * 16 + p) * 64 + n0 + e], a = pw[(d * 17 + ex) * 64 + n0 + e]; v[e] = reim ? -(c.x * a.y + c.y * a.x) : (c.x * a.x - c.y * a.y); } }
        v4u o; o.x = cvtpk(v[0], v[1]); o.y = cvtpk(v[2], v[3]); o.z = cvtpk(v[4], v[5]); o.w = cvtpk(v[6], v[7]); *(v4u*)dst = o;
    }
    __syncthreads();
}

__device__ __forceinline__ void ph_l1(const Ctx& C, int l) {
    for (int g = C.bid; g < 32; g += GRID) s5_mats_block(C, l, g);
    LAS float* scr = (LAS float*)(C.lds + C.wave * 16384);
    constexpr int I_1 = 16 * 104, I_2 = 16 * 96, I_3 = 8 * 32, I_4 = 8 * 16, I_5 = 8 * 32, I_6 = 16 * 32;
    constexpr int NIT = I_1 + I_2 + I_3 + I_4 + 3 * I_5 + I_6;
    for (int it = C.gw; it < NIT; it += C.ngw) {
        int r = it;
        if (r < I_1) { transpose_item(C.in[I_WIN] + (size_t)l * 1024 * INW, 1024, INW, C.w<bf16>(WS_WCAT), RmWin{}, scr, r, C.lane); continue; } r -= I_1;
        if (r < I_2) { transpose_item(C.in[I_MW] + (size_t)l * 1024 * 3072, 1024, 3072, C.w<bf16>(WS_WCAT), RmId{INW}, scr, r, C.lane); continue; } r -= I_2;
        if (r < I_3) { transpose_item(C.in[I_GLU] + (size_t)l * 512 * 1024, 512, 1024, C.w<bf16>(WS_WGLU), RmGlu{}, scr, r, C.lane); continue; } r -= I_3;
        if (r < I_4) { transpose_item(C.in[I_FN] + (size_t)l * 512 * 512, 512, 512, C.w<bf16>(WS_WFN), RmId{0}, scr, r, C.lane); continue; } r -= I_4;
        if (r < 3 * I_5) { const int nb = r / I_5; transpose_item(C.in[I_WBR] + ((size_t)l * 3 + nb) * 512 * 1024, 512, 1024, C.w<bf16>(WS_WBR) + (size_t)nb * 1024 * 512, RmId{0}, scr, r - nb * I_5, C.lane); continue; } r -= 3 * I_5;
        transpose_item(C.in[I_WOUT] + (size_t)l * 1024 * 1024, 1024, 1024, C.w<bf16>(WS_WOUT), RmId{0}, scr, r, C.lane);
    }
    for (int t = C.bid * NTHR + C.tid; t < 2 * 2 * 256 * 16; t += GRID * NTHR) {
        const int kv = t >> 13, r = t & 8191, b = r >> 12, s = (r >> 4) & 255, c0 = (r & 15) * 8;
        const float* src = C.in[kv ? I_CV : I_CK] + (((size_t)b * DEPTH + l) * 256 + s) * KVW + c0;
        const f32x4 a = *(const f32x4*)src, bq = *(const f32x4*)(src + 4);
        v4u o; o.x = cvtpk(a[0], a[1]); o.y = cvtpk(a[2], a[3]); o.z = cvtpk(bq[0], bq[1]); o.w = cvtpk(bq[2], bq[3]);
        *(v4u*)(C.w<bf16>(kv ? WS_VL : WS_KL) + ((size_t)b * LKV + S_LAT + s) * KVW + c0) = o;
    }
    const float* modp = C.w<float>(WS_MODP); const float* adab = C.in[I_ADAB];
    for (int row = C.gw; row < T_TOK; row += C.ngw) {
        const int ci = row < T_CTX ? 0 : 1 + ((row - T_CTX) >> 11);
        const float* xr = l == 0 ? (row < T_CTX ? C.in[I_XP] + (size_t)row * 1024 : C.in[I_XS] + (size_t)(row - T_CTX) * 1024) : C.w<float>(WS_XRES) + (size_t)row * 1024;
        f32x4 v[4]; float ss = 0.f;
#pragma unroll
        for (int j = 0; j < 4; ++j) { v[j] = *(const f32x4*)(xr + C.lane * 4 + 256 * j); ss += (v[j][0] * v[j][0] + v[j][1] * v[j][1]) + (v[j][2] * v[j][2] + v[j][3] * v[j][3]); }
        const float rstd = rsqrtf(wave_sum(ss, C.lane) * (1.0f / 1024.0f) + RMS_EPS);
        bf16* hr = C.w<bf16>(WS_H) + (size_t)row * 1024;
#pragma unroll
        for (int j = 0; j < 4; ++j) { const int col = C.lane * 4 + 256 * j; const f32x4 ng = *(const f32x4*)(C.in[I_NORMG] + l * 1024 + col), sc = load_mod4(modp, adab, l, ci, 1024 + col), sh = load_mod4(modp, adab, l, ci, col);
            st_bf4(hr + col, v[j] * rstd * ng * (sc + 1.0f) + sh); }
    }
}

__device__ __forceinline__ void scan_items(const Ctx& C, int l, int w0, int nw) {
    const float* SC = C.w<float>(WS_SC); bf16* HC = C.w<bf16>(WS_HC); const int lane = C.lane;
    for (int item = w0; item < 1152; item += nw) {
        int d, g, nch, c0, bsel; bool lat;
        if (item < 128) { lat = true; bsel = item >> 6; d = (item >> 5) & 1; g = item & 31; nch = 128; c0 = 256 + bsel * 128; }
        else { const int it = item - 128; lat = false; bsel = it >> 6; d = (it >> 5) & 1; g = it & 31; nch = 16; c0 = bsel * 16; }
        const size_t gi = ((size_t)(l * 2 + d) * 32 + g) * 64 + lane;
        const float ar = C.w<float>(WS_A16)[gi * 2], ai = C.w<float>(WS_A16)[gi * 2 + 1];
        float hr = 0.f, hi = 0.f;
        if (lat) { const float* st = C.in[I_ST] + ((((size_t)bsel * DEPTH + l) * 2 + d) * 32 + g) * 128 + lane * 2; hr = st[0]; hi = st[1]; }
#pragma unroll 4
        for (int i = 0; i < nch; ++i) { const int c = d == 0 ? c0 + i : c0 + nch - 1 - i; const size_t o = ((size_t)g * 512 + c) * 256 + d * 128 + lane;
            const float sr = SC[o], si = SC[o + 64];
            HC[o] = (bf16)(cvtpk(hr, hr) & 0xffffu); HC[o + 64] = (bf16)(cvtpk(hi, hi) & 0xffffu);
            const float nr = ar * hr - ai * hi + sr, ni = ar * hi + ai * hr + si; hr = nr; hi = ni; }
        if (!lat) { float* o = C.out + OUT_S + ((((size_t)bsel * DEPTH + l) * 2 + d) * 32 + g) * 128 + lane * 2; o[0] = hr; o[1] = hi; }
    }
}

__device__ __forceinline__ void ph_final(const Ctx& C) {
    for (int row = C.gw; row < T_TOK; row += C.ngw) {
        const float* xr = C.w<float>(WS_XRES) + (size_t)row * 1024; f32x4 v[4]; float ss = 0.f;
#pragma unroll
        for (int j = 0; j < 4; ++j) { v[j] = *(const f32x4*)(xr + C.lane * 4 + 256 * j); ss += (v[j][0] * v[j][0] + v[j][1] * v[j][1]) + (v[j][2] * v[j][2] + v[j][3] * v[j][3]); }
        const float rstd = rsqrtf(wave_sum(ss, C.lane) * (1.0f / 1024.0f) + RMS_EPS);
#pragma unroll
        for (int j = 0; j < 4; ++j) { const int col = C.lane * 4 + 256 * j; *(f32x4*)(C.out + (size_t)row * 1024 + col) = v[j] * rstd * *(const f32x4*)(C.in[I_FG] + col); }
    }
}

__device__ __forceinline__ void attn_any(const Ctx& C, int uidx) {
    size_t tok0, kvoff; int NT, h;
    if (uidx < 128) { const int b = uidx >> 6, qb = uidx & 7; h = (uidx >> 3) & 7; tok0 = (size_t)T_CTX + b * 2048 + qb * 256; kvoff = (size_t)(WS_KL - WS_KC) / 2 + (size_t)b * LKV * KVW; NT = LKV / 64; }
    else { const int u2 = uidx - 128, b = u2 >> 3; h = u2 & 7; tok0 = (size_t)b * 256; kvoff = tok0 * KVW; NT = 4; }
    kvoff += (h >> 2) * 64;
    const attn_body::bf16* Q = (const attn_body::bf16*)C.w<bf16>(WS_Q) + tok0 * 512 + h * 64;
    const attn_body::bf16* Kp = (const attn_body::bf16*)C.w<bf16>(WS_KC) + kvoff;
    attn_body::attn_unit<8>(Q, Kp, Kp + (WS_VC - WS_KC) / 2, (attn_body::bf16*)Q, (const attn_body::bf16*)C.w<bf16>(WS_GC) + tok0 * 512 + h * 64, 512, KVW, NT, (char*)C.lds, C.tid);
}

#ifndef MK_PER_PHASE
#define MK_PER_PHASE 1
#endif
constexpr int N_PHASES = 2 + 8 * DEPTH;
#ifndef ONLY
#define ONLY -1
#endif
#define PON(k) (ONLY < 0 || ONLY == (k))
#define GEMM_PHASE(EpiT, SchedT, g, S, E) do { asm volatile("" : "+s"(g.K), "+s"(g.lda), "+s"(g.ldb)); pg8::gemm_phase<EpiT, SchedT, true, true>(C.lds, g, S, E, C.tid); } while (0)

__global__ void __launch_bounds__(NTHR, 2) fwd_kernel(KArgs args) {
    extern __shared__ __attribute__((aligned(16))) unsigned char lds_raw[];
    Ctx C; C.lds = (LAS unsigned char*)lds_raw; C.tid = threadIdx.x; C.lane = C.tid & 63; C.wave = __builtin_amdgcn_readfirstlane(C.tid >> 6); C.bid = blockIdx.x;
    int wave_s = C.wave;
    C.gw = C.bid * NWAVES + C.wave; C.ngw = GRID * NWAVES; C.in = args.in; C.out = args.out; C.ws = args.ws;
    for (int u = C.tid; u < (LDS_BYTES - LDSCTL_OFF) / 4; u += NTHR) ((LAS unsigned*)(C.lds + LDSCTL_OFF))[u] = 0u;
    __syncthreads();
    volatile LAS unsigned* MISC = (volatile LAS unsigned*)(C.lds + MISC_OFF);
    XcdBarrier bar; bar.bar = (unsigned*)(C.ws + WS_CTL) + CW_BAR; bar.x = 0; bar.st = nullptr;
    const bool multi = args.ph_hi - args.ph_lo > 1;
    if (multi) bar = xcd_barrier_post((unsigned*)(C.ws + WS_CTL) + CW_BAR, MISC + 8, C.tid);

    for (int ph = args.ph_lo; ph < args.ph_hi; ++ph) {
        { int l_; asm volatile("v_mbcnt_lo_u32_b32 %0, -1, 0\n\tv_mbcnt_hi_u32_b32 %0, -1, %0" : "=v"(l_)); asm volatile("" : "+s"(wave_s)); int b_ = blockIdx.x; asm volatile("" : "+s"(b_)); C.bid = b_; C.lane = l_; C.wave = wave_s; C.tid = wave_s * 64 + l_; C.gw = C.bid * NWAVES + C.wave;
          unsigned char* w_ = args.ws; asm volatile("" : "+s"(w_)); C.ws = w_; float* o_ = args.out; asm volatile("" : "+s"(o_)); C.out = o_; }
        const int c = C.bid;
        if (ph == 0) { if (PON(8)) ph_prologue(C); }
        else if (ph == N_PHASES - 1) { if (PON(9)) ph_final(C); }
        else {
            const int l = (ph - 1) >> 3, sub = (ph - 1) & 7;
            if (sub == 0) { if (PON(0)) ph_l1(C, l); }
            else if (sub == 1 && PON(1)) {
                pg8::Gemm g{C.w<bf16>(WS_H), C.w<bf16>(WS_WCAT), 1024, 1024, 1024, 0, 0};
                SchedG1 S; S.init(T_TOK, NCAT, GRID, c);
                EpiG1 E{C.w<bf16>(WS_U5), C.w<bf16>(WS_GA), C.w<bf16>(WS_UF), C.w<bf16>(WS_GF), C.w<bf16>(WS_Q), C.w<bf16>(WS_GC), C.w<bf16>(WS_G), C.w<bf16>(WS_KC), C.w<bf16>(WS_VC), C.w<bf16>(WS_KL), C.w<bf16>(WS_VL),
                        C.out + OUT_K, C.out + OUT_V, C.in[I_QG], C.in[I_KG], C.in[I_MB] + (size_t)l * 3072, C.w<float>(WS_ROPE), l};
                GEMM_PHASE(EpiG1, SchedG1, g, S, E);
            } else if (sub == 2 && PON(2)) {
                { pg8::Gemm g{C.w<bf16>(WS_U5), C.w<bf16>(WS_BTS), 256, 256, 256, 512 * 256, 512 * 256};
                  SchedR<DecS5A> S{128, 0, 128, c, DecS5A{}}; EpiS5A E{C.w<float>(WS_YI), C.w<float>(WS_SC)};
                  GEMM_PHASE(EpiS5A, SchedR<DecS5A>, g, S, E); }
                __syncthreads();
                { pg8::Gemm g{C.w<bf16>(WS_A1P), C.w<bf16>(WS_UF), 256, 512, 256, 0, 256};
                  SchedR<DecDFT1> S{128, 0, 128, c, DecDFT1{}}; EpiDFT1 E{C.w<bf16>(WS_H), C.w<bf16>(WS_H) + (size_t)8192 * 512};
                  GEMM_PHASE(EpiDFT1, SchedR<DecDFT1>, g, S, E); }
            } else if (sub == 3 && PON(3)) {
                { pg8::Gemm g{C.w<bf16>(WS_A2L), C.w<bf16>(WS_H) + (size_t)8192 * 512, 4096, 4096, 4096, 0, 0};
                  SchedR<DecDFT2L> S{32, 0, 32, c, DecDFT2L{}}; EpiDFT2 E{C.w<bf16>(WS_UF), 1};
                  GEMM_PHASE(EpiDFT2, SchedR<DecDFT2L>, g, S, E); }
                __syncthreads();
                { pg8::Gemm g{C.w<bf16>(WS_A2C), C.w<bf16>(WS_H), 512, 512, 512, 0, 0};
                  SchedR<DecDFT2C> S{32, 32, 32, c, DecDFT2C{}}; EpiDFT2 E{C.w<bf16>(WS_UF), 0};
                  GEMM_PHASE(EpiDFT2, SchedR<DecDFT2C>, g, S, E); }
                __syncthreads();
                if (c >= 64) { const int nu = c < 192 ? 1 : 2;
                    for (int i = 0; i < nu; ++i) attn_any(C, c < 192 ? c - 64 : 128 + (c - 192) * 2 + i); }
                if (c >= 192) scan_items(C, l, (c - 192) * NWAVES + C.wave, 64 * NWAVES);
            } else if (sub == 4 && PON(4)) {
                pg8::Gemm g{C.w<bf16>(WS_HC), C.w<bf16>(WS_FTS), 256, 256, 256, 512 * 256, 256 * 256};
                SchedR<DecS5B> S{64, 0, GRID, c, DecS5B{}}; EpiS5B E{C.w<float>(WS_YI), C.in[I_SD] + (size_t)l * 512, C.w<bf16>(WS_U5), C.w<bf16>(WS_SC)};
                GEMM_PHASE(EpiS5B, SchedR<DecS5B>, g, S, E);
            } else if (sub == 5 && PON(5)) {
                { pg8::Gemm g{C.w<bf16>(WS_SC), C.w<bf16>(WS_WGLU), 512, 512, 512, 0, 0};
                  SchedR<DecN4> S{128, 0, 128, c, DecN4{}}; EpiGLU E{C.w<bf16>(WS_GA)};
                  GEMM_PHASE(EpiGLU, SchedR<DecN4>, g, S, E); }
                __syncthreads();
                { pg8::Gemm g{C.w<bf16>(WS_UF), C.w<bf16>(WS_WFN), 512, 512, 512, 0, 0};
                  SchedR<DecN2> S{64, 128, 64, c, DecN2{}}; EpiMul E{C.w<bf16>(WS_GF)};
                  GEMM_PHASE(EpiMul, SchedR<DecN2>, g, S, E); }
            } else if (sub == 6 && PON(6)) {
                pg8::Gemm g{C.w<bf16>(WS_GA), C.w<bf16>(WS_WBR), 512, 512, 512, (long)(8 * MiB / 2), 1024 * 512};
                SchedG4 S{128, c}; EpiG4 E{C.w<bf16>(WS_G), C.w<float>(WS_MP), C.w<bf16>(WS_H)};
                GEMM_PHASE(EpiG4, SchedG4, g, S, E);
            } else if (PON(7)) {
                pg8::Gemm g{C.w<bf16>(WS_H), C.w<bf16>(WS_WOUT), 1024, 1024, 1024, 0, 0};
                SchedR<DecN4> S{128, 0, GRID, c, DecN4{}};
                EpiG5 E{l == 0 ? C.in[I_XP] : C.w<float>(WS_XRES), l == 0 ? C.in[I_XS] : C.w<float>(WS_XRES) + (size_t)T_CTX * 1024, C.w<float>(WS_XRES), C.w<float>(WS_MODP), C.in[I_ADAB], l};
                GEMM_PHASE(EpiG5, SchedR<DecN4>, g, S, E);
            }
        }
        if (ph + 1 < args.ph_hi) xcd_barrier(bar, C.tid);
    }
}

extern "C" void kernel_launch(void* const* d_in, const int* in_sizes, int n_in, void* d_out, int out_size, void* d_ws, size_t ws_size, hipStream_t stream) {
    static int ready = 0;
    if (ready == 0) {
        if (n_in != 28 || out_size != (int)OUT_N || ws_size < WS_END) { fprintf(stderr, "kernel_launch: unexpected problem shape (n_in %d, out %d, ws %zu)\n", n_in, out_size, ws_size); ready = -1; return; }
        int dev = 0, cus = 0;
        if (hipGetDevice(&dev) != hipSuccess || hipDeviceGetAttribute(&cus, hipDeviceAttributeMultiprocessorCount, dev) != hipSuccess) { ready = -1; return; }
        if (hipFuncSetAttribute((const void*)fwd_kernel, hipFuncAttributeMaxDynamicSharedMemorySize, LDS_BYTES) != hipSuccess) { fprintf(stderr, "kernel_launch: hipFuncSetAttribute failed\n"); ready = -1; return; }
        if (cus < GRID) { fprintf(stderr, "kernel_launch: device has %d CUs, this kernel needs %d resident workgroups\n", cus, GRID); ready = -1; return; }
        ready = 1;
    }
    if (ready < 0) return;
    (void)hipMemsetAsync((char*)d_ws + WS_CTL, 0, CTL_ZERO_BYTES, stream);
    KArgs a{};
    for (int i = 0; i < 28; ++i) a.in[i] = (const float*)d_in[i];
    a.out = (float*)d_out; a.ws = (unsigned char*)d_ws;
#if MK_PER_PHASE
#ifndef MAXPH
#define MAXPH N_PHASES
#endif
    for (int ph = 0; ph < MAXPH; ++ph) { a.ph_lo = ph; a.ph_hi = ph + 1; hipLaunchKernelGGL(fwd_kernel, dim3(GRID), dim3(NTHR), LDS_BYTES, stream, a); }
#else
    a.ph_lo = 0; a.ph_hi = N_PHASES; hipLaunchKernelGGL(fwd_kernel, dim3(GRID), dim3(NTHR), LDS_BYTES, stream, a);
#endif
}
```

```cpp
#include <hip/hip_runtime.h>
#include <hip/hip_bf16.h>
#include <cstdio>
#include <cstdint>
#include <cmath>
namespace pg8 {
#define PG8_LAS __attribute__((address_space(3)))
typedef unsigned short bf16_t;
typedef short bf16x8 __attribute__((ext_vector_type(8)));
typedef float f32x4 __attribute__((ext_vector_type(4)));
typedef unsigned u32x4 __attribute__((ext_vector_type(4)));
constexpr int BM = 256, BK = 64, HALF = 128, HTB = HALF * BK * 2  , STAGE_BYTES = 8 * HTB, NXCD = 8, WGM = 8;

__host__ __device__ __forceinline__ int lds_byte(int r, int c) { const int st = (r >> 4) * 2 + (c >> 5), rr = r & 15, cc = c & 31, ob = rr * 64 + cc * 2; return st * 1024 + (ob ^ (((ob >> 9) & 1) << 5)); }
__host__ __device__ __forceinline__ void stage_rc(int b, int& R, int& C) { const int st = b / 1024, sb = b % 1024, swz = sb ^ (((sb >> 9) & 1) << 5); R = (st >> 1) * 16 + swz / 64; C = (st & 1) * 32 + (swz % 64) / 2; }
__host__ __device__ __forceinline__ int perm32(int rho) { const int n = rho >> 4, i = rho & 15; return 8 * (i >> 2) + 4 * n + (i & 3); }


struct Unit { int pm, pn, z; };
struct StaticOrder {
    int nM, nN, nwg, G, c;
    __host__ __device__ void init(int M, int N, int G_, int c_) { nM = M / BM; nN = N / BM; nwg = nM * nN; G = G_; c = c_; }
    __host__ __device__ bool next(int i, Unit& u) const {
        const long L = (long)i * G + c; if (L >= nwg) return false;
        int wgid = (int)L; { const int q = nwg / NXCD, r = nwg % NXCD, xcd = wgid % NXCD, off = wgid / NXCD; wgid = (xcd < r ? xcd * (q + 1) : r * (q + 1) + (xcd - r) * q) + off; }
        const int nig = WGM * nN, gid = wgid / nig, fm = gid * WGM, gsz = (nM - fm) < WGM ? (nM - fm) : WGM;
        u.pm = fm + ((wgid % nig) % gsz); u.pn = (wgid % nig) / gsz; return true;
    }
    __device__ __forceinline__ void a_ready(const Unit&) const {}
    __device__ __forceinline__ void done(const Unit&) const {}
};
struct UDesc { const bf16_t* A; const bf16_t* Bt; int lda, ldb, K, hB; int kind, pm, pn, z, keep; };
template <class Epi, class Sched>
__device__ __forceinline__ void gemm_stream(PG8_LAS unsigned char* lds, const Sched& S, const Epi& E, const int tid_in) {
    const int tid = tid_in, wid = __builtin_amdgcn_readfirstlane(tid >> 6), lane = tid & 63, wr = wid >> 2, wc = wid & 3, fr = lane & 15, fq = lane >> 4;
    int RA, RB, CC;
    { int R, C; stage_rc(tid * 16, R, C); RA = R; RB = (R & ~31) + perm32(R & 31); CC = C; }
    const size_t kstep = (size_t)(BK * 2);
    const unsigned ldsw = (unsigned)wid * 1024u;
    const int aoff = lds_byte(wr * 64 + fr, fq * 8), boff = lds_byte(wc * 32 + fr, fq * 8);
#define PG8_SA(b, h) (((b) * 2 + (h)) * HTB)
#define PG8_SB(b, h) ((4 + (b) * 2 + (h)) * HTB)
#define PG8_STAGE_X(bufoff, gbase, RR, ld) do { const unsigned _vo = (unsigned)(RR * (ld) + CC) * 2u; \
        __builtin_amdgcn_global_load_lds((const unsigned*)((const char*)(gbase) + _vo), (PG8_LAS unsigned*)(lds + (bufoff) + ldsw), 16, 0, 0); \
        __builtin_amdgcn_global_load_lds((const unsigned*)((const char*)(gbase) + (size_t)(ld) * 128 + _vo), (PG8_LAS unsigned*)(lds + (bufoff) + ldsw + 8192), 16, 0, 0); } while (0)
#define PG8_STAGE_A(bufoff, gbase, ld) PG8_STAGE_X(bufoff, gbase, RA, ld)
#define PG8_STAGE_B(bufoff, gbase, ld) PG8_STAGE_X(bufoff, gbase, RB, ld)
#define PG8_LDA(dst, b, h) do { _Pragma("unroll") for (int m = 0; m < 4; ++m) _Pragma("unroll") for (int k = 0; k < 2; ++k) dst[m][k] = *(const PG8_LAS bf16x8*)(lds + PG8_SA(b, h) + aoff + m * 2048 + k * 1024); } while (0)
#define PG8_LDB(dst, b, h) do { _Pragma("unroll") for (int n = 0; n < 2; ++n) _Pragma("unroll") for (int k = 0; k < 2; ++k) dst[n][k] = *(const PG8_LAS bf16x8*)(lds + PG8_SB(b, h) + boff + n * 2048 + k * 1024); } while (0)
#define PG8_MMA(ai, bj, At, Bt) do { __builtin_amdgcn_s_setprio(1); _Pragma("unroll") for (int m = 0; m < 4; ++m) _Pragma("unroll") for (int n = 0; n < 2; ++n) _Pragma("unroll") for (int k = 0; k < 2; ++k) \
        acc[ai][bj][m][n] = __builtin_amdgcn_mfma_f32_16x16x32_bf16(Bt[n][k], At[m][k], acc[ai][bj][m][n], 0, 0, 0); __builtin_amdgcn_s_setprio(0); } while (0)
#define PG8_WAIT_V(n) asm volatile("s_waitcnt vmcnt(" #n ")" ::: "memory")
#define PG8_WAIT_L(n) asm volatile("s_waitcnt lgkmcnt(" #n ")" ::: "memory")
#define PG8_BAR __builtin_amdgcn_s_barrier()
#define PG8_SCHED __builtin_amdgcn_sched_barrier(0)
    UDesc cur, nxt; int ui = 0;
    if (!S.next(0, cur)) return;
    f32x4 acc[2][2][4][2];
#pragma unroll
    for (int a = 0; a < 2; ++a)
#pragma unroll
        for (int b = 0; b < 2; ++b)
#pragma unroll
            for (int m = 0; m < 4; ++m)
#pragma unroll
                for (int n = 0; n < 2; ++n) acc[a][b][m][n] = (f32x4){0.f, 0.f, 0.f, 0.f};
    bf16x8 At[4][2], B0[2][2], B1[2][2];
    const char* cA = (const char*)cur.A; const char* cB = (const char*)cur.Bt; int ldaC = cur.lda, ldbC = cur.ldb; unsigned hstepA = (unsigned)HALF * ldaC * 2, hstepB = (unsigned)cur.hB * ldbC * 2;
    PG8_STAGE_B(PG8_SB(0, 0), cB, ldbC); PG8_STAGE_B(PG8_SB(0, 1), cB + hstepB, ldbC); PG8_STAGE_A(PG8_SA(0, 0), cA, ldaC); PG8_STAGE_A(PG8_SA(0, 1), cA + hstepA, ldaC);
    if (wr == 1) PG8_BAR;
    PG8_WAIT_V(2); PG8_BAR;
    PG8_STAGE_B(PG8_SB(1, 0), cB + kstep, ldbC); PG8_STAGE_A(PG8_SA(1, 0), cA + kstep, ldaC); PG8_STAGE_B(PG8_SB(1, 1), cB + hstepB + kstep, ldbC);
    PG8_WAIT_V(6); PG8_BAR;
    for (;;) {
        const bool has_next = S.next(ui + 1, nxt);
        const char* nA = has_next ? (const char*)nxt.A : cA; const char* nB = has_next ? (const char*)nxt.Bt : cB;
        const int ldaN = has_next ? nxt.lda : ldaC, ldbN = has_next ? nxt.ldb : ldbC; const unsigned hstepAN = (unsigned)HALF * ldaN * 2, hstepBN = has_next ? (unsigned)nxt.hB * ldbN * 2 : hstepB;
        const int nt = cur.K / BK;
        for (int t = 0; t < nt; t += 2) {
            const bool last = (t == nt - 2);
            const char* a1 = cA + (size_t)(t + 1) * kstep;
            const char* a2 = last ? nA : cA + (size_t)(t + 2) * kstep; const char* b2 = last ? nB : cB + (size_t)(t + 2) * kstep;
            const char* a3 = a2 + kstep; const char* b3 = b2 + kstep;
            const int lda2 = last ? ldaN : ldaC, ldb2 = last ? ldbN : ldbC; const unsigned hA2 = last ? hstepAN : hstepA, hB2 = last ? hstepBN : hstepB;
            PG8_LDB(B0, 0, 0); PG8_LDB(B1, 0, 1); PG8_SCHED; PG8_LDA(At, 0, 0); PG8_STAGE_A(PG8_SA(1, 1), a1 + hstepA, ldaC);
            PG8_WAIT_V(8); PG8_WAIT_L(0); PG8_BAR; PG8_MMA(0, 0, At, B0); PG8_MMA(0, 1, At, B1); PG8_BAR; PG8_SCHED;
            PG8_LDA(At, 0, 1); PG8_STAGE_B(PG8_SB(0, 0), b2, ldb2); PG8_STAGE_B(PG8_SB(0, 1), b2 + hB2, ldb2); PG8_STAGE_A(PG8_SA(0, 0), a2, lda2);
            PG8_WAIT_V(8); PG8_WAIT_L(0); PG8_BAR; PG8_MMA(1, 0, At, B0); PG8_MMA(1, 1, At, B1); PG8_BAR; PG8_SCHED;
            PG8_LDB(B0, 1, 0); PG8_LDB(B1, 1, 1); PG8_SCHED; PG8_LDA(At, 1, 0); PG8_STAGE_A(PG8_SA(0, 1), a2 + hA2, lda2);
            PG8_WAIT_V(8); PG8_WAIT_L(0); PG8_BAR; PG8_MMA(0, 0, At, B0); PG8_MMA(0, 1, At, B1); PG8_BAR; PG8_SCHED;
            PG8_LDA(At, 1, 1); PG8_STAGE_B(PG8_SB(1, 0), b3, ldb2); PG8_STAGE_B(PG8_SB(1, 1), b3 + hB2, ldb2); PG8_STAGE_A(PG8_SA(1, 0), a3, lda2);
            PG8_WAIT_V(8); PG8_WAIT_L(0); PG8_BAR; PG8_MMA(1, 0, At, B0); PG8_MMA(1, 1, At, B1); PG8_BAR; PG8_SCHED;
        }
        if (wr == 0) PG8_BAR;
        const bool chained = E.transform(acc, cur, wr, wc, fr, fq);
        if (!chained) E(acc, cur, wr, wc, fr, fq);
        if (!has_next) break;
        if (!chained) {
#pragma unroll
        for (int a = 0; a < 2; ++a)
#pragma unroll
            for (int b = 0; b < 2; ++b)
#pragma unroll
                for (int m = 0; m < 4; ++m)
#pragma unroll
                    for (int n = 0; n < 2; ++n) acc[a][b][m][n] = (f32x4){0.f, 0.f, 0.f, 0.f};
        }
        cur = nxt; cA = nA; cB = nB; ldaC = ldaN; ldbC = ldbN; hstepA = hstepAN; hstepB = hstepBN; ++ui;
        if (wr == 1) PG8_BAR;
    }
    PG8_WAIT_V(0);
    PG8_BAR;
#undef PG8_SA
#undef PG8_SB
#undef PG8_STAGE_X
#undef PG8_STAGE_A
#undef PG8_STAGE_B
#undef PG8_LDA
#undef PG8_LDB
#undef PG8_MMA
#undef PG8_WAIT_V
#undef PG8_WAIT_L
#undef PG8_BAR
#undef PG8_SCHED
}
}

#include <hip/hip_bf16.h>
#include <cmath>
namespace attn_body {
using bf16=__hip_bfloat16;
using bf16x8=__attribute__((ext_vector_type(8)))short;
using s16x4=__attribute__((ext_vector_type(4)))short;
using f32x16=__attribute__((ext_vector_type(16)))float;
using u32x4=__attribute__((ext_vector_type(4)))unsigned;
constexpr int D=64;
constexpr int NW=8,QBLK=32,QB=QBLK*NW,KVBLK=64;
__device__ __forceinline__ int crow(int r,int hi){return (r&3)+8*(r>>2)+4*hi;}
#define SBAR() __builtin_amdgcn_sched_barrier(0)
constexpr int NSLOT=3, SLOTB=8192;
constexpr int LDS_K=0, LDS_V=NSLOT*SLOTB, LDS_WS=2*NSLOT*SLOTB, LDS_OST=LDS_WS+NW*64*4, LDS_BYTES=LDS_OST+NW*4096;
constexpr float C2=0.125f*1.4426950408889634f;
__device__ __forceinline__ void glds16(const void*gsrc,unsigned lds_dst){unsigned keep;
  asm volatile("s_mov_b32 %0, m0\n\ts_mov_b32 m0, %2\n\ts_nop 0\n\tglobal_load_lds_dwordx4 %1, off\n\ts_mov_b32 m0, %0":"=&s"(keep):"v"(gsrc),"s"(lds_dst):"memory");}
__device__ __forceinline__ float max3f(float a,float b,float c){float r;asm("v_max3_f32 %0, %1, %2, %3":"=v"(r):"v"(a),"v"(b),"v"(c));return r;}
__device__ __forceinline__ float max2f(float a,float b){float r;asm("v_max_f32_e32 %0, %1, %2":"=v"(r):"v"(a),"v"(b));return r;}
__device__ __forceinline__ float fadd_s(float a,float b){float r;asm("v_add_f32_e32 %0, %1, %2":"=v"(r):"v"(a),"v"(b));return r;}
__device__ __forceinline__ float fsub_s(float a,float b){float r;asm("v_sub_f32_e32 %0, %1, %2":"=v"(r):"v"(a),"v"(b));return r;}
typedef float f32x2_t __attribute__((ext_vector_type(2))); typedef __bf16 bf16x2_t __attribute__((ext_vector_type(2)));
__device__ __forceinline__ unsigned cvtpk_s(float lo,float hi){f32x2_t v={lo,hi};bf16x2_t b=__builtin_convertvector(v,bf16x2_t);return __builtin_bit_cast(unsigned,b);}
#define WAIT_BAR(N) asm volatile("s_waitcnt vmcnt(" #N ") lgkmcnt(0)\n\ts_barrier":::"memory")

__device__ __forceinline__ void qkt(f32x16&p0,f32x16&p1,const char*Kslot,const bf16x8*qr,const f32x16&negm,int r32,int hi){
  const char*kb=Kslot+hi*1024+r32*16;
  #pragma unroll
  for(int d0=0;d0<4;++d0){
    const bf16x8 b0=*reinterpret_cast<const bf16x8*>(kb+d0*2048);
    const bf16x8 b1=*reinterpret_cast<const bf16x8*>(kb+d0*2048+512);
    if(d0==0){p0=__builtin_amdgcn_mfma_f32_32x32x16_bf16(b0,qr[0],negm,0,0,0);p1=__builtin_amdgcn_mfma_f32_32x32x16_bf16(b1,qr[0],negm,0,0,0);}
    else{p0=__builtin_amdgcn_mfma_f32_32x32x16_bf16(b0,qr[d0],p0,0,0,0);p1=__builtin_amdgcn_mfma_f32_32x32x16_bf16(b1,qr[d0],p1,0,0,0);}}
}
typedef __attribute__((address_space(3))) const char* lds_cptr;
typedef short v4i16_t __attribute__((ext_vector_type(4)));
__device__ __forceinline__ void kload8(bf16x8*kf,lds_cptr kp){
  kf[0]=*(const __attribute__((address_space(3))) bf16x8*)(kp);      kf[1]=*(const __attribute__((address_space(3))) bf16x8*)(kp+512);
  kf[2]=*(const __attribute__((address_space(3))) bf16x8*)(kp+2048); kf[3]=*(const __attribute__((address_space(3))) bf16x8*)(kp+2560);
  kf[4]=*(const __attribute__((address_space(3))) bf16x8*)(kp+4096); kf[5]=*(const __attribute__((address_space(3))) bf16x8*)(kp+4608);
  kf[6]=*(const __attribute__((address_space(3))) bf16x8*)(kp+6144); kf[7]=*(const __attribute__((address_space(3))) bf16x8*)(kp+6656);
}
__device__ __forceinline__ void kload2(bf16x8*kf,lds_cptr kp,int j){ kf[2*j]=*(const __attribute__((address_space(3))) bf16x8*)(kp+j*2048); kf[2*j+1]=*(const __attribute__((address_space(3))) bf16x8*)(kp+j*2048+512); }
__device__ __forceinline__ s16x4 vtr(lds_cptr p){ return __builtin_bit_cast(s16x4,__builtin_amdgcn_ds_read_tr16_b64_v4i16((__attribute__((address_space(3))) v4i16_t*)p)); }
__device__ __forceinline__ float rowmax(const f32x16&p0,const f32x16&p1){
  float a=max3f(p0[0],p0[1],p1[0]),b=max3f(p0[2],p0[3],p1[1]);a=max3f(a,p1[2],p1[3]);
  #pragma unroll
  for(int r=4;r<16;r+=4){a=max3f(a,p0[r],p0[r+1]);b=max3f(b,p0[r+2],p0[r+3]);a=max3f(a,p1[r],p1[r+1]);b=max3f(b,p1[r+2],p1[r+3]);}
  const float m=max2f(a,b);
  auto rr=__builtin_amdgcn_permlane32_swap(__float_as_uint(m),__float_as_uint(m),false,false);
  return max2f(__uint_as_float(rr[0]),__uint_as_float(rr[1]));
}
__device__ __forceinline__ void pv(f32x16*o,int vb,bf16x8 pa0,bf16x8 pa1,bf16x8 pa2,bf16x8 pa3){
  #pragma unroll
  for(int d0=0;d0<2;++d0){s16x4 lo[4],hi[4];
    #pragma unroll
    for(int ks=0;ks<4;++ks){
      asm volatile("ds_read_b64_tr_b16 %0,%1 offset:%c2":"=&v"(lo[ks]):"v"(vb),"i"(d0*4096+ks*1024):"memory");
      asm volatile("ds_read_b64_tr_b16 %0,%1 offset:%c2":"=&v"(hi[ks]):"v"(vb),"i"(d0*4096+ks*1024+512):"memory");}
    asm volatile("s_waitcnt lgkmcnt(0)":::"memory");SBAR();
    #define PK(k) (bf16x8){lo[k][0],lo[k][1],lo[k][2],lo[k][3],hi[k][0],hi[k][1],hi[k][2],hi[k][3]}
    o[d0]=__builtin_amdgcn_mfma_f32_32x32x16_bf16(pa0,PK(0),o[d0],0,0,0);
    o[d0]=__builtin_amdgcn_mfma_f32_32x32x16_bf16(pa1,PK(1),o[d0],0,0,0);
    o[d0]=__builtin_amdgcn_mfma_f32_32x32x16_bf16(pa2,PK(2),o[d0],0,0,0);
    o[d0]=__builtin_amdgcn_mfma_f32_32x32x16_bf16(pa3,PK(3),o[d0],0,0,0);
    #undef PK
  }
}

#ifndef ATTN_STORE16
#define ATTN_STORE16(p,v) (*(u32x4*)(p)=(v))
#endif
template<int THRL> __device__ __forceinline__ void attn_unit(const bf16*Qu,const bf16*Kh,const bf16*Vh,bf16*Ou,const bf16*Gu,const int QP,const int KP,const int NT,char*shm,const int tid_in){
  const int tid=tid_in,lane=tid&63,r32=lane&31,hi=lane>>5; const int wid=__builtin_amdgcn_readfirstlane(tid>>6);
  const bf16*Qw=Qu+(long)(wid*QBLK)*QP;
  const unsigned lds0=(unsigned)(uintptr_t)shm;
  float*wsf=(float*)(shm+LDS_WS)+wid*64;
  const bf16*ksrc=Kh+(long)lane*KP+wid*8;
  const bf16*vsrc=Vh+(long)(16*(wid&3)+(lane>>2))*KP+(wid>>2)*32+(lane&3)*8;
  const unsigned kdst=lds0+LDS_K+wid*1024, vdst=lds0+LDS_V+wid*1024;
  #define DMA_K(t,slot) glds16(ksrc+(long)(t)*KVBLK*KP,(unsigned)__builtin_amdgcn_readfirstlane(kdst+(slot)))
  #define DMA_V(t,slot) glds16(vsrc+(long)(t)*KVBLK*KP,(unsigned)__builtin_amdgcn_readfirstlane(vdst+(slot)))
  const int vb0=(int)(lds0+LDS_V)+((lane>>4)&1)*32+(lane&3)*8+(4*hi+((lane&15)>>2))*64;
  const char*Kbase=shm+LDS_K; bf16x8 kf[8];
  const lds_cptr shm3=(lds_cptr)shm; const lds_cptr kp0=shm3+LDS_K+hi*1024+r32*16; const lds_cptr vp0=shm3+LDS_V+((lane>>4)&1)*32+(lane&3)*8+(4*hi+((lane&15)>>2))*64;
  DMA_K(0,0);DMA_V(0,0);DMA_K(1,SLOTB);
  bf16x8 qr[4];
  #pragma unroll
  for(int d0=0;d0<4;++d0)qr[d0]=*reinterpret_cast<const bf16x8*>(&Qw[(long)r32*QP+d0*16+hi*8]);
  float mhat=0.f,l_reg=0.f;f32x16 o[2];o[0]=f32x16{};o[1]=f32x16{};f32x16 negm; {float zf_; asm volatile("v_mov_b32 %0, 0":"=v"(zf_)); _Pragma("unroll") for(int r=0;r<16;++r)negm[r]=zf_;} asm volatile("":"+v"(negm));
  #define CMASK(P0,P1,t) do{}while(0)
  bool resc=false;
  #define START(P0,P1) do{ const float rm=rowmax(P0,P1); resc=false; \
    { const float dl=rm; mhat=fadd_s(mhat,dl); \
      _Pragma("unroll") for(int r=0;r<16;++r){P0[r]=fsub_s(P0[r],dl);P1[r]=fsub_s(P1[r],dl);} \
      _Pragma("unroll") for(int r=0;r<16;++r)negm[r]=-mhat; asm volatile("":"+v"(negm)); } \
    _Pragma("unroll") for(int r=0;r<16;++r)P0[r]=__builtin_amdgcn_exp2f(P0[r]); }while(0)
  #define RESC() do{ if(resc){ asm volatile("s_waitcnt lgkmcnt(0)":::"memory"); \
      _Pragma("unroll") for(int d_=0;d_<2;++d_) _Pragma("unroll") for(int r=0;r<16;++r)o[d_][r]*=wsf[crow(r,hi)]; } }while(0)
  f32x16 pA0,pA1,pB0,pB1;
  int sl_prev=0,sl_cur=0,sl_next=SLOTB;
  #define ROT() do{sl_prev=sl_cur;sl_cur=sl_next;sl_next=(sl_next==(NSLOT-1)*SLOTB)?0:sl_next+SLOTB;}while(0)
  DMA_K(2,2*SLOTB);
  WAIT_BAR(3);
  qkt(pA0,pA1,Kbase,qr,negm,r32,hi);asm volatile("s_nop 15\n\ts_nop 7":"+v"(pA0),"+v"(pA1));CMASK(pA0,pA1,0);
  START(pA0,pA1);
  _Pragma("unroll") for(int r=0;r<16;++r)pA1[r]=__builtin_amdgcn_exp2f(pA1[r]);
  WAIT_BAR(0);
  DMA_K(3,0);DMA_V(1,SLOTB);
  ROT();
  kload8(kf,kp0+sl_cur);
  WAIT_BAR(2);
  s16x4 vlo[8],vhi[8]; u32x4 pw0,pw1,pw2,pw3;
  #define PKW(P,B) cvtpk_s(P[B],P[B+1])
  #define PAF(k) __builtin_bit_cast(bf16x8,pw##k)
  #define VFR(i) (bf16x8){vlo[i][0],vlo[i][1],vlo[i][2],vlo[i][3],vhi[i][0],vhi[i][1],vhi[i][2],vhi[i][3]}
  #define PIN(x) asm volatile("":"+v"(x))
  #define MX3(a,b,c) __builtin_fmaxf(__builtin_fmaxf((a),(b)),(c))
  #define GAPA(MF,A0,A1,A2,A3,W0,W1,PW) do{ MF; sacc+=A0; sacc+=A1; sacc+=A2; sacc+=A3; PIN(sacc); W0; W1; PIN(PW); SBAR(); }while(0)
  #define EX(v) __builtin_amdgcn_exp2f(v)
  #define GAPB(MF,X,B) do{ MF; X[B]=EX(X[B]); X[B+1]=EX(X[B+1]); X[B+2]=EX(X[B+2]); X[B+3]=EX(X[B+3]); PIN(X); SBAR(); }while(0)
  #define VRD(i) do{ vlo[i]=vtr(vp_+(((i)>>2)*4096+((i)&3)*1024)); vhi[i]=vtr(vp_+(((i)>>2)*4096+((i)&3)*1024+512)); }while(0)
  #define KRD(G,j) do{ if(G){ kload2(kf,kp0+sl_next,j); SBAR(); } }while(0)
  #define STEP(C0,C1,P0,P1,t,GK,GV,GL) do{ SBAR(); \
    const lds_cptr vp_=vp0+sl_prev; \
    VRD(0); SBAR(); float sacc=(P0[0]+P0[1]); \
    GAPA(C0=__builtin_amdgcn_mfma_f32_32x32x16_bf16(kf[0],qr[0],negm,0,0,0), P0[2],P0[3],P0[4],P0[5],     pw0[0]=PKW(P0,0), pw0[1]=PKW(P0,2), pw0); \
    VRD(4); SBAR(); GAPA(C1=__builtin_amdgcn_mfma_f32_32x32x16_bf16(kf[1],qr[0],negm,0,0,0), P0[6],P0[7],P0[8],P0[9],     pw0[2]=PKW(P0,4), pw0[3]=PKW(P0,6), pw0); \
    VRD(1); SBAR(); GAPA(C0=__builtin_amdgcn_mfma_f32_32x32x16_bf16(kf[2],qr[1],C0,0,0,0),   P0[10],P0[11],P0[12],P0[13], pw1[0]=PKW(P0,8), pw1[1]=PKW(P0,10), pw1); \
    VRD(5); SBAR(); GAPA(C1=__builtin_amdgcn_mfma_f32_32x32x16_bf16(kf[3],qr[1],C1,0,0,0),   P0[14],P0[15],P1[0],P1[1],   pw1[2]=PKW(P0,12),pw1[3]=PKW(P0,14), pw1); \
    VRD(2); SBAR(); GAPA(C0=__builtin_amdgcn_mfma_f32_32x32x16_bf16(kf[4],qr[2],C0,0,0,0),   P1[2],P1[3],P1[4],P1[5],     pw2[0]=PKW(P1,0), pw2[1]=PKW(P1,2), pw2); \
    VRD(6); SBAR(); GAPA(C1=__builtin_amdgcn_mfma_f32_32x32x16_bf16(kf[5],qr[2],C1,0,0,0),   P1[6],P1[7],P1[8],P1[9],     pw2[2]=PKW(P1,4), pw2[3]=PKW(P1,6), pw2); \
    VRD(3); SBAR(); GAPA(C0=__builtin_amdgcn_mfma_f32_32x32x16_bf16(kf[6],qr[3],C0,0,0,0),   P1[10],P1[11],P1[12],P1[13], pw3[0]=PKW(P1,8), pw3[1]=PKW(P1,10), pw3); \
    VRD(7); SBAR(); GAPA(C1=__builtin_amdgcn_mfma_f32_32x32x16_bf16(kf[7],qr[3],C1,0,0,0),   P1[14],P1[15],0.f,0.f,       pw3[2]=PKW(P1,12),pw3[3]=PKW(P1,14), pw3); \
    l_reg+=sacc; \
    if(GK){DMA_K((t)+3,sl_cur);} if(GV){DMA_V((t)+1,sl_next);} \
    CMASK(C0,C1,t); \
    { float a=MX3(C0[0],C0[1],C1[0]),b=MX3(C0[2],C0[3],C1[1]); a=MX3(a,C1[2],C1[3]); \
      _Pragma("unroll") for(int r=4;r<16;r+=4){a=MX3(a,C0[r],C0[r+1]);b=MX3(b,C0[r+2],C0[r+3]);a=MX3(a,C1[r],C1[r+1]);b=MX3(b,C1[r+2],C1[r+3]);} \
      float rm=__builtin_fmaxf(a,b); { auto rr=__builtin_amdgcn_permlane32_swap(__float_as_uint(rm),__float_as_uint(rm),false,false); rm=__builtin_fmaxf(__uint_as_float(rr[0]),__uint_as_float(rr[1])); } \
      resc=false; \
      if(__builtin_expect(__any(rm>(float)THRL),0)){ const float dl=__builtin_fmaxf(rm,0.f); mhat+=dl; \
        _Pragma("unroll") for(int r=0;r<16;++r){C0[r]-=dl;C1[r]-=dl;} \
        _Pragma("unroll") for(int r=0;r<16;++r)negm[r]=-mhat; asm volatile("":"+v"(negm)); \
        const float f=__builtin_amdgcn_exp2f(-dl); l_reg*=f; if(hi==0)wsf[r32]=f; resc=true; } } \
    SBAR(); \
    GAPB(o[0]=__builtin_amdgcn_mfma_f32_32x32x16_bf16(PAF(0),VFR(0),o[0],0,0,0), C0,0); \
    GAPB(o[1]=__builtin_amdgcn_mfma_f32_32x32x16_bf16(PAF(0),VFR(4),o[1],0,0,0), C0,4); \
    KRD(GL,0); GAPB(o[0]=__builtin_amdgcn_mfma_f32_32x32x16_bf16(PAF(1),VFR(1),o[0],0,0,0), C0,8); \
    KRD(GL,1); GAPB(o[1]=__builtin_amdgcn_mfma_f32_32x32x16_bf16(PAF(1),VFR(5),o[1],0,0,0), C0,12); \
    KRD(GL,2); GAPB(o[0]=__builtin_amdgcn_mfma_f32_32x32x16_bf16(PAF(2),VFR(2),o[0],0,0,0), C1,0); \
    KRD(GL,3); GAPB(o[1]=__builtin_amdgcn_mfma_f32_32x32x16_bf16(PAF(2),VFR(6),o[1],0,0,0), C1,4); \
    GAPB(o[0]=__builtin_amdgcn_mfma_f32_32x32x16_bf16(PAF(3),VFR(3),o[0],0,0,0), C1,8); \
    GAPB(o[1]=__builtin_amdgcn_mfma_f32_32x32x16_bf16(PAF(3),VFR(7),o[1],0,0,0), C1,12); \
    }while(0)
  int t=1;
  #undef CMASK
  #define CMASK(P0,P1,t) do{}while(0)
  for(;t+5<NT;t+=2){
    STEP(pB0,pB1,pA0,pA1,t,true,true,true);     WAIT_BAR(2); RESC(); ROT();
    STEP(pA0,pA1,pB0,pB1,t+1,true,true,true);   WAIT_BAR(2); RESC(); ROT();
  }
  #undef CMASK
  #define CMASK(P0,P1,t) do{}while(0)
  #define ENDW(tt) do{ if((tt)+3<NT){WAIT_BAR(2);} else if((tt)+2<NT){WAIT_BAR(1);} else {WAIT_BAR(0);} }while(0)
  for(;t+1<NT;t+=2){
    STEP(pB0,pB1,pA0,pA1,t,(t+3<NT),(t+1<NT),(t+1<NT));       ENDW(t);   RESC(); ROT();
    STEP(pA0,pA1,pB0,pB1,t+1,(t+4<NT),(t+2<NT),(t+2<NT));     ENDW(t+1); RESC(); ROT();
  }
  STEP(pB0,pB1,pA0,pA1,NT-1,false,false,false); RESC();
  { float sacc=pB0[0]+pB0[1]; _Pragma("unroll") for(int r=2;r<16;++r)sacc+=pB0[r]; _Pragma("unroll") for(int r=0;r<16;++r)sacc+=pB1[r]; l_reg+=sacc;
    pw0=(u32x4){PKW(pB0,0),PKW(pB0,2),PKW(pB0,4),PKW(pB0,6)};pw1=(u32x4){PKW(pB0,8),PKW(pB0,10),PKW(pB0,12),PKW(pB0,14)};pw2=(u32x4){PKW(pB1,0),PKW(pB1,2),PKW(pB1,4),PKW(pB1,6)};pw3=(u32x4){PKW(pB1,8),PKW(pB1,10),PKW(pB1,12),PKW(pB1,14)};
    SBAR(); pv(o,vb0+sl_cur,PAF(0),PAF(1),PAF(2),PAF(3)); }
  #undef PKW
  #undef PAF
  #undef VFR
  #undef PIN
  #undef MX3
  #undef GAPA
  #undef GAPB
  #undef EX
  #undef VRD
  #undef KRD
  #undef STEP
  #undef ENDW
  {auto rr=__builtin_amdgcn_permlane32_swap(__float_as_uint(l_reg),__float_as_uint(l_reg),false,false);l_reg=__uint_as_float(rr[0])+__uint_as_float(rr[1]);}
  if(hi==0)wsf[32+r32]=l_reg;asm volatile("s_waitcnt lgkmcnt(0)":::"memory");
  float rli[16];
  #pragma unroll
  for(int r=0;r<16;++r)rli[r]=__builtin_amdgcn_rcpf(wsf[32+crow(r,hi)]);
  bf16*Ow=Ou+(long)(wid*QBLK)*QP; const bf16*Gw=Gu+(long)(wid*QBLK)*QP;
  { bf16*stg=(bf16*)(shm+LDS_OST)+wid*2048;
    #pragma unroll
    for(int r=0;r<16;++r){const int orow=crow(r,hi);
      #pragma unroll
      for(int d0=0;d0<2;++d0)stg[orow*64+d0*32+r32]=__float2bfloat16(o[d0][r]*rli[r]);}
    asm volatile("s_waitcnt lgkmcnt(0)":::"memory");
    #pragma unroll
    for(int i=0;i<4;++i){const int row=i*8+(lane>>3),ch=lane&7; const u32x4 v=*(const u32x4*)(stg+row*64+ch*8); const u32x4 gv=*(const u32x4*)(Gw+(long)row*QP+ch*8); u32x4 w;
      #pragma unroll
      for(int e=0;e<4;++e){const float a0=__uint_as_float(v[e]<<16)*__uint_as_float(gv[e]<<16),a1=__uint_as_float(v[e]&0xffff0000u)*__uint_as_float(gv[e]&0xffff0000u); w[e]=cvtpk_s(a0,a1);}
      *(u32x4*)(Ow+(long)row*QP+ch*8)=w;} }
  asm volatile("s_waitcnt lgkmcnt(0)\n\ts_barrier":::"memory");
  #undef DMA_K
  #undef DMA_V
  #undef CMASK
  #undef START
  #undef RESC
  #undef ROT
}
constexpr int ATTN_LDS_BYTES=LDS_BYTES;
#undef SBAR
#undef WAIT_BAR
}

#define GAS __attribute__((address_space(1)))
#define LAS __attribute__((address_space(3)))
typedef unsigned short bf16;
typedef unsigned v4u __attribute__((ext_vector_type(4)));
typedef float f32x4 __attribute__((ext_vector_type(4)));
typedef short bf16x8 __attribute__((ext_vector_type(8)));
typedef GAS unsigned gu32;
typedef GAS unsigned long long gu64;
#define RLX_AGENT __ATOMIC_RELAXED, __HIP_MEMORY_SCOPE_AGENT
#define LDS_WAIT() asm volatile("s_waitcnt lgkmcnt(0)" ::: "memory")
#define VM_WAIT() asm volatile("s_waitcnt vmcnt(0)" ::: "memory")
__device__ __forceinline__ unsigned long long rt() { return __builtin_amdgcn_s_memrealtime(); }
__device__ __forceinline__ unsigned f2bf(float f) { unsigned u = __builtin_bit_cast(unsigned, f); return (u + 0x7fffu + ((u >> 16) & 1u)) >> 16; }
__device__ __forceinline__ unsigned pk2(float lo, float hi) { return f2bf(lo) | (f2bf(hi) << 16); }

#define XB_TMO      128
#define XB_XCNT(j)  (256  + 64 * (j))
#define XB_XSUB(j)  (1280 + 64 * (j))
#define XB_XGEN(j)  (2304 + 64 * (j))
#define XB_TOP      3328
#define XB_TOPGEN   3392
#define XCD_BAR_WORDS 3456
#define XB_SPIN_CAP (1u << 18)

__device__ __forceinline__ unsigned xb_ld(unsigned* p)              { return __hip_atomic_load(p, __ATOMIC_RELAXED, __HIP_MEMORY_SCOPE_AGENT); }
__device__ __forceinline__ unsigned xb_add(unsigned* p, unsigned v) { return __hip_atomic_fetch_add(p, v, __ATOMIC_RELAXED, __HIP_MEMORY_SCOPE_AGENT); }
__device__ __forceinline__ unsigned xb_xcc_id() { return (unsigned)__builtin_amdgcn_s_getreg((3 << 11) | 20) & 0xFu; }
#define XB_SPIN(cond, bar) do { unsigned _sp = 0; while (cond) { __builtin_amdgcn_s_sleep(1); \
    if ((++_sp & 255u) == 0u) { if (xb_ld(&(bar)[XB_TMO])) break; if (_sp > XB_SPIN_CAP) { atomicAdd(&(bar)[XB_TMO], 1u); break; } } } } while (0)

struct XcdBarrier {
    unsigned* bar; unsigned x;
    volatile LAS unsigned* st;
};

__device__ __forceinline__ XcdBarrier xcd_barrier_post(unsigned* bar, volatile LAS unsigned* st, const int tid) {
    XcdBarrier b; b.bar = bar; b.x = xb_xcc_id(); b.st = st;
    if (tid == 0) (void)xb_add(&bar[XB_XCNT(b.x)], 1u);
    return b;
}
__device__ __forceinline__ void xcd_barrier_complete(unsigned* bar, unsigned x, unsigned& nloc, unsigned& nx) {
    const unsigned G = gridDim.x * gridDim.y * gridDim.z;
    unsigned sum, cnt, mine, sp = 0u;
    for (;;) {
        sum = 0u; cnt = 0u; mine = 0u;
#pragma unroll
        for (unsigned j = 0; j < 16; ++j) { const unsigned c = xb_ld(&bar[XB_XCNT(j)]); sum += c; cnt += (c > 0u) ? 1u : 0u; mine = (j == x) ? c : mine; }
        if (sum == G) break;
        __builtin_amdgcn_s_sleep(1);
        if ((++sp & 255u) == 0u) { if (xb_ld(&bar[XB_TMO])) break; if (sp > XB_SPIN_CAP) { atomicAdd(&bar[XB_TMO], 1u); break; } }
    }
    nloc = mine > 0u ? mine : 1u; nx = cnt > 0u ? cnt : 1u;
}

__device__ __forceinline__ void xcd_barrier(const XcdBarrier& b, const int tid) {
    asm volatile("s_waitcnt vmcnt(0)" ::: "memory");
    __syncthreads();
    if (tid == 0) {
        unsigned* bar = b.bar; asm volatile("" : "+s"(bar));
        __builtin_amdgcn_s_waitcnt(0);
        unsigned nloc = b.st[0], nx = b.st[1];
        if (nloc == 0u) { unsigned xx = b.x; asm volatile("" : "+s"(xx)); xcd_barrier_complete(bar, xx, nloc, nx); b.st[0] = nloc; b.st[1] = nx; }
        const unsigned old = xb_add(&bar[XB_XSUB(b.x)], 1u);
        const unsigned gen = old / nloc;
        if (old + 1u == (gen + 1u) * nloc) {
            __builtin_amdgcn_fence(__ATOMIC_RELEASE, "agent");
            asm volatile("s_waitcnt vmcnt(0)" ::: "memory");
            const unsigned og = xb_add(&bar[XB_TOP], 1u);
            const unsigned tg = og / nx;
            if (og + 1u == (tg + 1u) * nx) xb_add(&bar[XB_TOPGEN], 1u);
            else XB_SPIN(xb_ld(&bar[XB_TOPGEN]) == tg, bar);
            __builtin_amdgcn_fence(__ATOMIC_ACQUIRE, "agent");
            xb_add(&bar[XB_XGEN(b.x)], 1u);
            asm volatile("s_waitcnt vmcnt(0)" ::: "memory");
        } else {
            XB_SPIN(xb_ld(&bar[XB_XGEN(b.x)]) == gen, bar);
            __builtin_amdgcn_fence(__ATOMIC_ACQUIRE, "agent");
            asm volatile("s_waitcnt vmcnt(0)" ::: "memory");
        }
    }
    __syncthreads();
}


constexpr int NWAVES = 8, NTHR = 512, GRID = 256;
constexpr int T_TOK = 8192, T_CTX = 4096, DMOD = 1024, BW = 512, INW = 3328, NCAT = 6400, DEPTH = 4;
constexpr int S_LAT = 2048, LKV = 2304, KVW = 128;
constexpr float RMS_EPS = 1e-6f;
constexpr float QSCALE = 0.125f * 1.4426950408889634f;
constexpr size_t MiB = 1u << 20;
constexpr size_t WS_CTL = 0, CTL_ZERO_BYTES = MiB;
constexpr size_t WS_MODF = 1 * MiB;
constexpr size_t WS_ROPE = 1 * MiB + 768 * 1024;
constexpr size_t WS_A16 = 1 * MiB + 832 * 1024;
constexpr size_t WS_WCAT = 2 * MiB;
constexpr size_t WS_WGLU = 15 * MiB;
constexpr size_t WS_WFN = 16 * MiB;
constexpr size_t WS_WBR = 17 * MiB;
constexpr size_t WS_WOUT = 20 * MiB;
constexpr size_t WS_BTE = 22 * MiB;
constexpr size_t WS_BTY = 26 * MiB;
constexpr size_t WS_A2L = 34 * MiB;
constexpr size_t WS_GY = 42 * MiB;
constexpr size_t WS_A2C = 50 * MiB;
constexpr size_t WS_A1P = 50 * MiB + 512 * 1024;
constexpr size_t WS_XRES = 51 * MiB;
constexpr size_t WS_G = 83 * MiB;
constexpr size_t WS_H = 131 * MiB;
constexpr size_t WS_VTC = 147 * MiB;
constexpr size_t WS_VTL = 248 * MiB;
constexpr size_t WS_GA = 155 * MiB;
constexpr size_t WS_GF = 163 * MiB;
constexpr size_t WS_Q = 171 * MiB;
constexpr size_t WS_UF = 179 * MiB;
constexpr size_t WS_GC = 187 * MiB;
constexpr size_t WS_KC = 195 * MiB, WS_KL = 196 * MiB;
constexpr size_t WS_VC = WS_KC + 5 * MiB / 2, WS_VL = WS_KL + 5 * MiB / 2;
constexpr size_t WS_PB = 200 * MiB;
constexpr size_t WS_SC = 216 * MiB;
constexpr size_t WS_UH = 232 * MiB;
constexpr size_t WS_END = 256 * MiB;
constexpr int CW_BAR = 4096;
constexpr size_t OUT_K = 8388608, OUT_V = 10485760, OUT_S = 12582912, OUT_N = 13107200;
constexpr int RING_BYTES = 131072, LDSCTL_OFF = RING_BYTES, MISC_OFF = LDSCTL_OFF + 320, LDS_BYTES = 147456;

typedef float f32x2 __attribute__((ext_vector_type(2)));
typedef unsigned u32x2 __attribute__((ext_vector_type(2)));
__device__ __forceinline__ unsigned cvtpk(float lo, float hi) { typedef __bf16 bf16x2_t __attribute__((ext_vector_type(2))); f32x2 v = {lo, hi}; bf16x2_t b = __builtin_convertvector(v, bf16x2_t); return __builtin_bit_cast(unsigned, b); }
__device__ __forceinline__ void st_bf4(bf16* p, f32x4 v) { u32x2 w; w.x = cvtpk(v[0], v[1]); w.y = cvtpk(v[2], v[3]); *(u32x2*)p = w; }
__device__ __forceinline__ f32x4 ld_bf4(const bf16* p) { const u32x2 w = *(const u32x2*)p; f32x4 r; r[0] = __uint_as_float(w.x << 16); r[1] = __uint_as_float(w.x & 0xffff0000u); r[2] = __uint_as_float(w.y << 16); r[3] = __uint_as_float(w.y & 0xffff0000u); return r; }
__device__ __forceinline__ f32x4 bf4_to_f(u32x2 w) { f32x4 r; r[0] = __uint_as_float(w.x << 16); r[1] = __uint_as_float(w.x & 0xffff0000u); r[2] = __uint_as_float(w.y << 16); r[3] = __uint_as_float(w.y & 0xffff0000u); return r; }
__device__ __forceinline__ float bf2f(bf16 h) { return __uint_as_float((unsigned)h << 16); }
__device__ __forceinline__ float sigmoidf_(float x) { return __builtin_amdgcn_rcpf(1.0f + __expf(-x)); }
__device__ __forceinline__ f32x4 sigmoid4(f32x4 v) { f32x4 r; r[0] = sigmoidf_(v[0]); r[1] = sigmoidf_(v[1]); r[2] = sigmoidf_(v[2]); r[3] = sigmoidf_(v[3]); return r; }
__device__ __forceinline__ f32x4 silu4(f32x4 v) { return v * sigmoid4(v); }
__device__ __forceinline__ float gelu_tanh(float x) { const float y = 0.7978845608028654f * (x + 0.044715f * x * x * x); return x * sigmoidf_(2.0f * y); }
__device__ __forceinline__ float shx(float v, int mask, int lane) { return __int_as_float(__builtin_amdgcn_ds_bpermute((lane ^ mask) << 2, __float_as_int(v))); }
__device__ __forceinline__ float wave_sum(float v, int lane) {
#pragma unroll
    for (int o = 1; o < 64; o <<= 1) v += shx(v, o, lane);
    return v;
}

struct KArgs { const float* in[28]; float* out; unsigned char* ws; int ph_lo, ph_hi; };
enum { I_XP = 0, I_XS, I_CK, I_CV, I_ST, I_C, I_CCTX, I_NORMG, I_ADAW, I_ADAB, I_WIN, I_ARE, I_AIM, I_LDT, I_BRE, I_BIM, I_CRE, I_CIM, I_SD, I_GLU, I_FN, I_QG, I_KG, I_WBR, I_MW, I_MB, I_WOUT, I_FG };

struct Ctx {
    LAS unsigned char* lds; int tid, lane, wave, bid, vcu, gw, ngw;
    const float* const* in; float* out; unsigned char* ws;
    template <class Tp> __device__ __forceinline__ Tp* w(size_t off) const { return (Tp*)(ws + off); }
};

__device__ __forceinline__ int epi_opaque(int x) { asm volatile("" : "+v"(x)); return x; }
#define EPI_ROWS for (int ai = 0; ai < 2; ++ai) _Pragma("unroll") for (int m = 0; m < 4; ++m)
#define EPI_BJ for (int bj = 0; bj < 2; ++bj)
#define EPI_ROW epi_opaque(u.pm * 256 + ai * 128 + wr * 64 + m * 16 + fr)
#define EPI_C8 (bj * 128 + wc * 32 + fq * 8)
#define EPI_COL8 (u.pn * 256 + EPI_C8)
typedef const f32x4 (&AccRef)[2][2][4][2];
__device__ __forceinline__ void st_bf8(bf16* p, f32x4 lo, f32x4 hi) { v4u w; w.x = cvtpk(lo[0], lo[1]); w.y = cvtpk(lo[2], lo[3]); w.z = cvtpk(hi[0], hi[1]); w.w = cvtpk(hi[2], hi[3]); *(v4u*)p = w; }
__device__ __forceinline__ f32x4 bf8_lo(v4u w) { f32x4 r; r[0] = __uint_as_float(w.x << 16); r[1] = __uint_as_float(w.x & 0xffff0000u); r[2] = __uint_as_float(w.y << 16); r[3] = __uint_as_float(w.y & 0xffff0000u); return r; }
__device__ __forceinline__ f32x4 bf8_hi(v4u w) { f32x4 r; r[0] = __uint_as_float(w.z << 16); r[1] = __uint_as_float(w.z & 0xffff0000u); r[2] = __uint_as_float(w.w << 16); r[3] = __uint_as_float(w.w & 0xffff0000u); return r; }

struct EpiG1 {
    static constexpr bool PERM = true, AFTER_DRAIN = false;
    unsigned char* ws; float* out; const float *qg, *kg; int layer;
#define EG1_P(name, off) bf16* const name = (bf16*)(ws + (off))
    __device__ __forceinline__ void qkv(AccRef acc, const pg8::Unit& u, int wr, int wc, int fr, int fq) const {
        const int pn = u.pn; const bool isq = pn < 10;
        EG1_P(Q, WS_Q); EG1_P(Kc, WS_KC); EG1_P(Vc, WS_VC); EG1_P(Kl, WS_KL); EG1_P(Vl, WS_VL); float* const outK = out + OUT_K; float* const outV = out + OUT_V; const float* const rope = (const float*)(ws + WS_ROPE);
        const int kind = isq ? 0 : (wc < 2 ? 1 : 2);
        const int head = isq ? (pn - 8) * 4 + wc : (wc & 1);
        f32x4 gv[2][2];
        if (kind == 0) {
#pragma unroll
            EPI_BJ { gv[bj][0] = *(const f32x4*)(qg + layer * 64 + 32 * bj + 8 * fq); gv[bj][1] = *(const f32x4*)(qg + layer * 64 + 32 * bj + 8 * fq + 4); }
        } else {
#pragma unroll
            EPI_BJ { gv[bj][0] = *(const f32x4*)(kg + layer * 64 + 32 * bj + 8 * fq); gv[bj][1] = *(const f32x4*)(kg + layer * 64 + 32 * bj + 8 * fq + 4); }
        }
        const bool lat = u.pm >= 16;
#pragma unroll
        EPI_ROWS {
            const int row = EPI_ROW;
            f32x4 x[2][2];
#pragma unroll
            EPI_BJ { x[bj][0] = acc[ai][bj][m][0]; x[bj][1] = acc[ai][bj][m][1]; }
            if (kind != 2) {
                float ss = 0.f;
#pragma unroll
                EPI_BJ {
#pragma unroll
                    for (int n = 0; n < 2; ++n) { const f32x4 t = x[bj][n]; ss += (t[0] * t[0] + t[1] * t[1]) + (t[2] * t[2] + t[3] * t[3]); } }
                ss += shx(ss, 16, fq * 16 + fr); ss += shx(ss, 32, fq * 16 + fr);
                const float rstd = rsqrtf(ss * (1.0f / 64.0f) + RMS_EPS);
#pragma unroll
                EPI_BJ { x[bj][0] = x[bj][0] * rstd * gv[bj][0]; x[bj][1] = x[bj][1] * rstd * gv[bj][1]; }
            }
            int b, s;
            if (lat) { const int tl = row - T_CTX; b = tl >> 11; s = tl & 2047; } else { b = row >> 8; s = row & 255; }
            if (lat && kind != 2) {
                const int gr = s >> 6, gc = s & 63;
#pragma unroll
                EPI_BJ {
#pragma unroll
                    for (int n = 0; n < 2; ++n) { const int pos = bj ? gc : gr; const f32x4 cs = *(const f32x4*)(rope + (pos * 16 + 4 * fq + 2 * n) * 2); const f32x4 t = x[bj][n];
                        f32x4 r; r[0] = t[0] * cs[0] - t[1] * cs[1]; r[1] = t[0] * cs[1] + t[1] * cs[0]; r[2] = t[2] * cs[2] - t[3] * cs[3]; r[3] = t[2] * cs[3] + t[3] * cs[2]; x[bj][n] = r; } }
            }
#pragma unroll
            EPI_BJ { const int j = 32 * bj + 8 * fq;
                const size_t ol = ((size_t)b * LKV + s) * KVW + head * 64 + j, oc = (size_t)row * KVW + head * 64 + j, oo = (((size_t)b * DEPTH + layer) * 256 + s) * KVW + head * 64 + j;
                if (kind == 0) st_bf8(Q + (size_t)row * 512 + head * 64 + j, x[bj][0] * QSCALE, x[bj][1] * QSCALE);
                else if (kind == 1) { if (lat) st_bf8(Kl + ol, x[bj][0], x[bj][1]); else { st_bf8(Kc + oc, x[bj][0], x[bj][1]); *(f32x4*)(outK + oo) = x[bj][0]; *(f32x4*)(outK + oo + 4) = x[bj][1]; } }
                else { if (lat) st_bf8(Vl + ol, x[bj][0], x[bj][1]); else { st_bf8(Vc + oc, x[bj][0], x[bj][1]); *(f32x4*)(outV + oo) = x[bj][0]; *(f32x4*)(outV + oo + 4) = x[bj][1]; } } }
            asm volatile("" ::: "memory");
        }
    }
    __device__ __forceinline__ void operator()(AccRef acc, const pg8::Unit& u, int wr, int wc, int fr, int fq) const {
        const int pn = u.pn;
        if (pn >= 8 && pn <= 10) { qkv(acc, u, wr, wc, fr, fq); return; }
        EG1_P(UH, WS_UH); EG1_P(GA, WS_GA); EG1_P(UF, WS_UF); EG1_P(GF, WS_GF); EG1_P(GC, WS_GC);
#pragma unroll
        EPI_ROWS { const int row = EPI_ROW;
#pragma unroll
            EPI_BJ { const int col = EPI_COL8; const f32x4 lo = acc[ai][bj][m][0], hi = acc[ai][bj][m][1];
                if (pn < 2) { const int g = col >> 4, q = col & 15; st_bf8(UH + ((size_t)g * 512 + (row >> 4)) * 512 + (row & 15) * 16 + q, lo, hi); }
                else if (pn < 4) st_bf8(GA + (size_t)row * 512 + (col - 512), silu4(lo), silu4(hi));
                else if (pn < 6) st_bf8(UF + (size_t)row * 512 + (col - 1024), lo, hi);
                else if (pn < 8) st_bf8(GF + (size_t)row * 512 + (col - 1536), silu4(lo), silu4(hi));
                else st_bf8(GC + (size_t)row * 512 + (col - 2816), silu4(lo), silu4(hi));
            } }
    }
};
struct EpiMerge {
    static constexpr bool PERM = true, AFTER_DRAIN = false;
    bf16* Gm; const float* mb;
    __device__ __forceinline__ void operator()(AccRef acc, const pg8::Unit& u, int wr, int wc, int fr, int fq) const {
        f32x4 bb[2][2];
#pragma unroll
        EPI_BJ { bb[bj][0] = *(const f32x4*)(mb + EPI_COL8); bb[bj][1] = *(const f32x4*)(mb + EPI_COL8 + 4); }
#pragma unroll
        EPI_ROWS { const size_t row = EPI_ROW;
#pragma unroll
            EPI_BJ st_bf8(Gm + row * 3072 + EPI_COL8, sigmoid4(acc[ai][bj][m][0] + bb[bj][0]), sigmoid4(acc[ai][bj][m][1] + bb[bj][1])); }
    }
};
struct EpiS5A {
    static constexpr bool PERM = true, AFTER_DRAIN = false;
    float* SC;
    __device__ __forceinline__ void operator()(AccRef acc, const pg8::Unit& u, int wr, int wc, int fr, int fq) const {
#pragma unroll
        EPI_ROWS { const int chunk = EPI_ROW;
#pragma unroll
            EPI_BJ { float* p = SC + ((size_t)u.z * 512 + chunk) * 256 + EPI_C8; *(f32x4*)p = acc[ai][bj][m][0]; *(f32x4*)(p + 4) = acc[ai][bj][m][1]; } }
    }
};
__device__ __forceinline__ f32x4 gelu4(f32x4 y) { y[0] = gelu_tanh(y[0]); y[1] = gelu_tanh(y[1]); y[2] = gelu_tanh(y[2]); y[3] = gelu_tanh(y[3]); return y; }
struct EpiS5B {
    static constexpr bool PERM = true, AFTER_DRAIN = false;
    bf16* GY;
    __device__ __forceinline__ void operator()(AccRef acc, const pg8::Unit& u, int wr, int wc, int fr, int fq) const {
#pragma unroll
        EPI_ROWS { const int chunk = EPI_ROW;
#pragma unroll
            EPI_BJ { const int col = EPI_C8, t = col >> 4, p = col & 15; st_bf8(GY + ((size_t)chunk * 16 + t) * 512 + u.z * 16 + p, gelu4(acc[ai][bj][m][0]), gelu4(acc[ai][bj][m][1])); } }
    }
};
struct EpiDFT1C {
    static constexpr bool PERM = true, AFTER_DRAIN = false;
    bf16* VtC;
    __device__ __forceinline__ void operator()(AccRef acc, const pg8::Unit& u, int wr, int wc, int fr, int fq) const {
        const int grp = 2 * u.z + u.pm;
#pragma unroll
        EPI_ROWS { const int j = epi_opaque(wr * 64 + m * 16 + fr), reim = ai;
#pragma unroll
            EPI_BJ { const int tok = EPI_COL8, b = tok >> 8, s = tok & 255; st_bf8(VtC + ((size_t)b * 512 + grp * 128 + j) * 512 + reim * 256 + s, acc[ai][bj][m][0], acc[ai][bj][m][1]); } }
    }
};
struct EpiDFT1L {
    static constexpr bool PERM = true, AFTER_DRAIN = false;
    bf16* VtL;
    __device__ __forceinline__ void operator()(AccRef acc, const pg8::Unit& u, int wr, int wc, int fr, int fq) const {
        const int grp = 2 * u.z + u.pm, b = u.pn >> 4, nn = u.pn & 15;
#pragma unroll
        EPI_ROWS { const int j = epi_opaque(wr * 64 + m * 16 + fr), reim = ai; bf16* dst = VtL + ((size_t)b * 512 + grp * 128 + j) * 2048 + reim * 1024 + nn * 128 + wc * 32 + fq * 8;
            st_bf8(dst, acc[ai][0][m][0] + acc[ai][1][m][0], acc[ai][0][m][1] + acc[ai][1][m][1]);
            st_bf8(dst + (size_t)1024 * 2048, acc[ai][0][m][0] - acc[ai][1][m][0], acc[ai][0][m][1] - acc[ai][1][m][1]); }
    }
};
struct EpiDFT2 {
    static constexpr bool PERM = true, AFTER_DRAIN = false;
    bf16* ZF; int lat, half;
    __device__ __forceinline__ void operator()(AccRef acc, const pg8::Unit& u, int wr, int wc, int fr, int fq) const {
#pragma unroll
        EPI_ROWS { const int k = EPI_ROW;
#pragma unroll
            EPI_BJ { const int col = EPI_COL8, b = col >> 9, ch = col & 511;
                bf16* dst = lat ? ZF + ((size_t)b * 2048 + 2 * k + u.z) * 1024 + half * 512 + ch : ZF + ((size_t)b * 256 + k) * 512 + ch;
                st_bf8(dst, acc[ai][bj][m][0], acc[ai][bj][m][1]); } }
    }
};
#define EPI_BATCH for (int ai = 0; ai < 2; ++ai)
#define EPI_M for (int m = 0; m < 4; ++m)
struct EpiGLU {
    static constexpr bool PERM = true, AFTER_DRAIN = false;
    bf16* GA;
    __device__ __forceinline__ void operator()(AccRef acc, const pg8::Unit& u, int wr, int wc, int fr, int fq) const {
#pragma unroll
        EPI_BATCH { v4u gl[4];
#pragma unroll
            EPI_M { const size_t row = EPI_ROW; gl[m] = *(const v4u*)(GA + row * 512 + u.pn * 128 + wc * 32 + fq * 8); }
            asm volatile("" ::: "memory");
#pragma unroll
            EPI_M { const size_t row = EPI_ROW;
                st_bf8(GA + row * 512 + u.pn * 128 + wc * 32 + fq * 8, acc[ai][0][m][0] * sigmoid4(acc[ai][1][m][0]) * bf8_lo(gl[m]), acc[ai][0][m][1] * sigmoid4(acc[ai][1][m][1]) * bf8_hi(gl[m])); }
            asm volatile("" ::: "memory"); }
    }
};
struct EpiMul {
    static constexpr bool PERM = true, AFTER_DRAIN = false;
    bf16* GF;
    __device__ __forceinline__ void operator()(AccRef acc, const pg8::Unit& u, int wr, int wc, int fr, int fq) const {
#pragma unroll
        EPI_BATCH { v4u gl[4][2];
#pragma unroll
            EPI_M { const size_t row = EPI_ROW;
#pragma unroll
                EPI_BJ gl[m][bj] = *(const v4u*)(GF + row * 512 + EPI_COL8); }
            asm volatile("" ::: "memory");
#pragma unroll
            EPI_M { const size_t row = EPI_ROW;
#pragma unroll
                EPI_BJ st_bf8(GF + row * 512 + EPI_COL8, acc[ai][bj][m][0] * bf8_lo(gl[m][bj]), acc[ai][bj][m][1] * bf8_hi(gl[m][bj])); }
            asm volatile("" ::: "memory"); }
    }
};
struct EpiG4 {
    static constexpr bool PERM = true, AFTER_DRAIN = false;
    const bf16* Gm; bf16* PB; bf16* MG; int mode0;
    __device__ __forceinline__ void operator()(AccRef acc, const pg8::Unit& u, int wr, int wc, int fr, int fq) const {
        const int mode = mode0 + u.z, gsel = mode == 0 ? 2 : mode - 1;
#pragma unroll
        EPI_BATCH { v4u gl[4][2], pl[4][2];
#pragma unroll
            EPI_M { const size_t row = EPI_ROW;
#pragma unroll
                EPI_BJ { gl[m][bj] = *(const v4u*)(Gm + row * 3072 + gsel * 1024 + EPI_COL8); if (mode > 0) pl[m][bj] = *(const v4u*)(PB + row * 1024 + EPI_COL8); } }
            asm volatile("" ::: "memory");
#pragma unroll
            EPI_M { const size_t row = EPI_ROW;
#pragma unroll
                EPI_BJ { f32x4 lo = acc[ai][bj][m][0] * bf8_lo(gl[m][bj]), hi = acc[ai][bj][m][1] * bf8_hi(gl[m][bj]); if (mode > 0) { lo += bf8_lo(pl[m][bj]); hi += bf8_hi(pl[m][bj]); }
                    if (mode < 2) st_bf8(PB + row * 1024 + EPI_COL8, lo, hi); else st_bf8(MG + row * 1024 + EPI_COL8, lo, hi); } }
            asm volatile("" ::: "memory"); }
    }
};
struct EpiChainA {
    const bf16* Gm; const bf16* PB;
    __device__ __forceinline__ void operator()(f32x4 (&acc)[2][2][4][2], const pg8::Unit& u, int wr, int wc, int fr, int fq) const {
#pragma unroll
        for (int ai = 0; ai < 2; ++ai)
#pragma unroll
            for (int mh = 0; mh < 2; ++mh) { v4u g0[2][2], g1[2][2], pl[2][2];
#pragma unroll
                for (int mm = 0; mm < 2; ++mm) { const int m = 2 * mh + mm; const size_t row = EPI_ROW;
#pragma unroll
                    EPI_BJ { g0[mm][bj] = *(const v4u*)(Gm + row * 3072 + EPI_COL8); g1[mm][bj] = *(const v4u*)(Gm + row * 3072 + 1024 + EPI_COL8); pl[mm][bj] = *(const v4u*)(PB + row * 1024 + EPI_COL8); } }
                asm volatile("" ::: "memory");
#pragma unroll
                for (int mm = 0; mm < 2; ++mm) { const int m = 2 * mh + mm;
#pragma unroll
                    EPI_BJ { f32x4 lo = acc[ai][bj][m][0] * bf8_lo(g0[mm][bj]) + bf8_lo(pl[mm][bj]), hi = acc[ai][bj][m][1] * bf8_hi(g0[mm][bj]) + bf8_hi(pl[mm][bj]);
                        const f32x4 gl = bf8_lo(g1[mm][bj]), gh = bf8_hi(g1[mm][bj]);
#pragma unroll
                        for (int e = 0; e < 4; ++e) { lo[e] *= __builtin_amdgcn_rcpf(fmaxf(gl[e], 1e-6f)); hi[e] *= __builtin_amdgcn_rcpf(fmaxf(gh[e], 1e-6f)); }
                        acc[ai][bj][m][0] = lo; acc[ai][bj][m][1] = hi; } }
                asm volatile("" ::: "memory"); }
    }
};
struct EpiChainF {
    const bf16* Gm; bf16* MG;
    __device__ __forceinline__ void operator()(AccRef acc, const pg8::Unit& u, int wr, int wc, int fr, int fq) const {
#pragma unroll
        EPI_BATCH { v4u g1[4][2];
#pragma unroll
            EPI_M { const size_t row = EPI_ROW;
#pragma unroll
                EPI_BJ g1[m][bj] = *(const v4u*)(Gm + row * 3072 + 1024 + EPI_COL8); }
            asm volatile("" ::: "memory");
#pragma unroll
            EPI_M { const size_t row = EPI_ROW;
#pragma unroll
                EPI_BJ { const f32x4 gl = bf8_lo(g1[m][bj]), gh = bf8_hi(g1[m][bj]); f32x4 lo = acc[ai][bj][m][0], hi = acc[ai][bj][m][1];
#pragma unroll
                    for (int e = 0; e < 4; ++e) { lo[e] *= fmaxf(gl[e], 1e-6f); hi[e] *= fmaxf(gh[e], 1e-6f); }
                    st_bf8(MG + row * 1024 + EPI_COL8, lo, hi); } }
            asm volatile("" ::: "memory"); }
    }
};
struct EpiG5 {
    static constexpr bool PERM = true, AFTER_DRAIN = false;
    bf16 *T0, *T1;
    __device__ __forceinline__ void operator()(AccRef acc, const pg8::Unit& u, int wr, int wc, int fr, int fq) const {
        bf16* T = u.z ? T1 : T0;
#pragma unroll
        EPI_ROWS { const size_t row = EPI_ROW;
#pragma unroll
            EPI_BJ st_bf8(T + row * 1024 + EPI_COL8, acc[ai][bj][m][0], acc[ai][bj][m][1]); }
    }
};

enum { K_G1 = 0, K_MERGE, K_S5A, K_S5B, K_DFT1C, K_DFT1L, K_DFT2C, K_DFT2L0, K_DFT2L1, K_GLU, K_FN, K_PC, K_PA, K_PF, K_G5 };
__device__ __forceinline__ int xswz(int L, int n) { return (L & 7) * (n >> 3) + (L >> 3); }
#define PS_W(off) ((const bf16*)(ws + (off)))
struct PhaseSched {
    int sub, c, bid; unsigned char* ws;
    __device__ __forceinline__ void mk(pg8::UDesc& d, const bf16* A, const bf16* Bt, int lda, int ldb, int K, int hB, int kind, int pm, int pn, int z) const {
        d.A = A; d.Bt = Bt; d.lda = lda; d.ldb = ldb; d.K = K; d.hB = hB; d.kind = kind; d.pm = pm; d.pn = pn; d.z = z; d.keep = (kind == K_PF); }
    __device__ __forceinline__ void mk_merge(pg8::UDesc& d, int M, unsigned char* ws) const {
        int pm, pn; if (M < 128) { pm = M >> 2; pn = 8 + (M & 3); } else { pm = (M - 128) >> 3; pn = (M - 128) & 7; }
        mk(d, PS_W(WS_H) + (size_t)pm * 256 * 1024, PS_W(WS_WCAT) + (size_t)(INW + pn * 256) * 1024, 1024, 1024, 1024, 128, K_MERGE, pm, pn, 0); }
    __device__ __forceinline__ bool next(int i, pg8::UDesc& d) const {
        unsigned char* ws = this->ws; asm volatile("" : "+s"(ws));
        if (sub == 1) {
            if (i > 1) return false;
            pg8::StaticOrder so; so.init(T_TOK, INW, GRID, bid); pg8::Unit u;
            if (so.next(i, u)) { mk(d, PS_W(WS_H) + (size_t)u.pm * 256 * 1024, PS_W(WS_WCAT) + (size_t)u.pn * 256 * 1024, 1024, 1024, 1024, 128, K_G1, u.pm, u.pn, 0); return true; }
            if (bid >= 160) { mk_merge(d, xswz(bid - 160, 96), ws); return true; }
            return false;
        }
        if (sub == 2) {
            if (c < 128) return false;
            if (c < 192) { const int L = xswz(c - 128, 64);
                if (i == 0) { const int g = L >> 1, pm = L & 1; mk(d, PS_W(WS_UH) + ((size_t)g * 512 + pm * 256) * 512, PS_W(WS_BTE) + (size_t)g * 256 * 256, 512, 256, 256, 128, K_S5A, pm, 0, g); return true; }
                if (i == 1) { const int pair = L >> 5, gl = (L >> 4) & 1, pn = L & 15; mk(d, PS_W(WS_A1P) + (size_t)gl * 256 * 256, PS_W(WS_UF) + (size_t)pn * 256 * 512 + pair * 256, 256, 512, 256, 128, K_DFT1C, gl, pn, pair); return true; }
                if (i == 2) { mk_merge(d, 96 + xswz(c - 128, 128), ws); return true; }
                return false; }
            const int L = xswz(c - 192, 64);
            if (i == 0) { const int pair = L >> 5, gl = (L >> 4) & 1, r = L & 15, pn2 = (r >> 3) * 16 + (r & 7);
                mk(d, PS_W(WS_A1P) + (size_t)gl * 256 * 256, PS_W(WS_UF) + ((size_t)T_CTX + pn2 * 128) * 512 + pair * 256, 256, 512, 256, 1024, K_DFT1L, gl, pn2, pair); return true; }
            if (i == 1) { mk_merge(d, 96 + xswz(c - 128, 128), ws); return true; }
            return false;
        }
        if (sub == 3) {
            if (c < 64) { if (i > 0) return false; const int half = c >> 5, L = xswz(c & 31, 32), z = L >> 4, pm = (L >> 2) & 3, pn = L & 3;
                mk(d, PS_W(WS_A2L) + ((size_t)z * 1024 + pm * 256) * 2048 + half * 1024, PS_W(WS_VTL) + ((size_t)z * 1024 + pn * 256) * 2048 + half * 1024, 2048, 2048, 1024, 128, half ? K_DFT2L1 : K_DFT2L0, pm, pn, z); return true; }
            if (c < 128) { if (i > 0) return false; const int L = xswz(c - 64, 64), g = L >> 1, pm = L & 1;
                mk(d, PS_W(WS_UH) + ((size_t)g * 512 + pm * 256) * 512, PS_W(WS_BTY) + (size_t)g * 256 * 512, 512, 512, 512, 128, K_S5B, pm, 0, g); return true; }
            if (i == 0) { const int L = xswz(c - 128, 128), pm = L >> 2, pn = L & 3; mk(d, PS_W(WS_Q) + (size_t)pm * 256 * 512, PS_W(WS_WBR) + ((size_t)2 * 1024 + pn * 256) * 512, 512, 512, 512, 128, K_PC, pm, pn, 0); return true; }
            if (i == 1) { if (c < 160) { const int pn = xswz(c - 128, 32); mk(d, PS_W(WS_A2C), PS_W(WS_VTC) + (size_t)pn * 256 * 512, 512, 512, 512, 128, K_DFT2C, 0, pn, 0); return true; }
                mk_merge(d, 224 + xswz(c - 160, 96), ws); return true; }
            return false;
        }
        if (sub == 4) {
            if (i > 0) return false;
            if (c < 128) { const int L = xswz(c, 128), pm = L >> 2, pn = L & 3; mk(d, PS_W(WS_GY) + (size_t)pm * 256 * 512, PS_W(WS_WGLU) + (size_t)pn * 256 * 512, 512, 512, 512, 128, K_GLU, pm, pn, 0); return true; }
            if (c < 160) { const int L = xswz(c - 128, 32), pm = L >> 1, pn = L & 1; mk(d, PS_W(WS_UF) + (size_t)pm * 256 * 512, PS_W(WS_WFN) + (size_t)pn * 256 * 1024, 512, 1024, 512, 128, K_FN, pm, pn, 0); return true; }
            if (c < 192) { const int L = xswz(c - 160, 32), pm = L >> 1, pn = L & 1; mk(d, PS_W(WS_GC) + (size_t)pm * 256 * 1024, PS_W(WS_WFN) + (size_t)pn * 256 * 1024, 1024, 1024, 1024, 128, K_FN, 16 + pm, pn, 0); return true; }
            mk_merge(d, 320 + xswz(c - 192, 64), ws); return true;
        }
        if (sub == 5) {
            if (c >= 128 || i > 1) return false;
            const int t = (c & 7) * 16 + (c >> 3), pm = t >> 2, pn = t & 3;
            if (i == 0) mk(d, PS_W(WS_GA) + (size_t)pm * 256 * 512, PS_W(WS_WBR) + (size_t)pn * 256 * 512, 512, 512, 512, 128, K_PA, pm, pn, 0);
            else mk(d, PS_W(WS_GF) + (size_t)pm * 256 * 512, PS_W(WS_WBR) + ((size_t)1024 + pn * 256) * 512, 512, 512, 512, 128, K_PF, pm, pn, 0);
            return true;
        }
        if (i > 0) return false;
        { const int L = xswz(c, 256), z = L & 1, pm = L >> 3, pn = (L >> 1) & 3; mk(d, PS_W(WS_H) + (size_t)pm * 256 * 1024 + z * 512, PS_W(WS_WOUT) + (size_t)pn * 256 * 1024 + z * 512, 1024, 1024, 512, 128, K_G5, pm, pn, z); return true; }
    }
};
struct EpiAll {
    unsigned char* ws; float* out; const float* const* in; int layer;
    __device__ __forceinline__ bool transform(f32x4 (&acc)[2][2][4][2], const pg8::UDesc& d, int wr, int wc, int fr, int fq) const {
        if (d.kind != K_PA) return false;
        asm volatile("" : "+v"(fr), "+v"(fq), "+s"(wr), "+s"(wc));
        unsigned char* ws = this->ws; asm volatile("" : "+s"(ws));
        EpiChainA{(const bf16*)(ws + WS_G), (const bf16*)(ws + WS_PB)}(acc, pg8::Unit{d.pm, d.pn, d.z}, wr, wc, fr, fq); return true; }
    __device__ __forceinline__ void operator()(AccRef acc, const pg8::UDesc& d, int wr, int wc, int fr, int fq) const {
        asm volatile("" : "+v"(fr), "+v"(fq), "+s"(wr), "+s"(wc));
        const pg8::Unit u{d.pm, d.pn, d.z}; const int kind = d.kind;
        unsigned char* ws = this->ws; float* out = this->out; asm volatile("" : "+s"(ws), "+s"(out));
#define EA_P(off) ((bf16*)(ws + (off)))
        if (kind == K_G1) EpiG1{ws, out, in[I_QG], in[I_KG], layer}(acc, u, wr, wc, fr, fq);
        else if (kind == K_MERGE) EpiMerge{EA_P(WS_G), in[I_MB] + (size_t)layer * 3072}(acc, u, wr, wc, fr, fq);
        else if (kind == K_S5A) EpiS5A{(float*)(ws + WS_SC)}(acc, u, wr, wc, fr, fq);
        else if (kind == K_S5B) EpiS5B{EA_P(WS_GY)}(acc, u, wr, wc, fr, fq);
        else if (kind == K_DFT1C) EpiDFT1C{EA_P(WS_VTC)}(acc, u, wr, wc, fr, fq);
        else if (kind == K_DFT1L) EpiDFT1L{EA_P(WS_VTL)}(acc, u, wr, wc, fr, fq);
        else if (kind == K_DFT2C) EpiDFT2{EA_P(WS_UF), 0, 0}(acc, u, wr, wc, fr, fq);
        else if (kind == K_DFT2L0) EpiDFT2{EA_P(WS_GC), 1, 0}(acc, u, wr, wc, fr, fq);
        else if (kind == K_DFT2L1) EpiDFT2{EA_P(WS_GC), 1, 1}(acc, u, wr, wc, fr, fq);
        else if (kind == K_GLU) EpiGLU{EA_P(WS_GA)}(acc, u, wr, wc, fr, fq);
        else if (kind == K_FN) EpiMul{EA_P(WS_GF)}(acc, u, wr, wc, fr, fq);
        else if (kind == K_PC) EpiG4{EA_P(WS_G), EA_P(WS_PB), EA_P(WS_H), 0}(acc, u, wr, wc, fr, fq);
        else if (kind == K_PF) EpiChainF{EA_P(WS_G), EA_P(WS_H)}(acc, u, wr, wc, fr, fq);
        else EpiG5{EA_P(WS_PB), EA_P(WS_GA)}(acc, u, wr, wc, fr, fq);
#undef EA_P
    }
};

template <class RowMap>
__device__ __forceinline__ void transpose_item(const float* W, int K, int N, bf16* WT, const RowMap& rm, LAS float* scr, int item, int lane, int pitch = 0, int dup = 0) {
    if (pitch == 0) pitch = K;
    const int nblk = N / 32, kb = item / nblk, nb = item % nblk, k0 = 64 * kb, n0 = 32 * nb;
    { f32x4 w[8];
#pragma unroll
      for (int i = 0; i < 8; ++i) w[i] = *(const f32x4*)(W + (size_t)(k0 + 8 * i + (lane >> 3)) * N + n0 + 4 * (lane & 7));
#pragma unroll
      for (int i = 0; i < 8; ++i) { LAS float* d = scr + (8 * i + (lane >> 3)) * 33 + 4 * (lane & 7); d[0] = w[i][0]; d[1] = w[i][1]; d[2] = w[i][2]; d[3] = w[i][3]; } }
    LDS_WAIT(); asm volatile("" ::: "memory");
    const int c = lane & 7;
#pragma unroll
    for (int j = 0; j < 4; ++j) { const int n = (lane >> 3) + 8 * j; const LAS float* s = scr + (8 * c) * 33 + n;
        v4u o; o.x = cvtpk(s[0 * 33], s[1 * 33]); o.y = cvtpk(s[2 * 33], s[3 * 33]); o.z = cvtpk(s[4 * 33], s[5 * 33]); o.w = cvtpk(s[6 * 33], s[7 * 33]);
        bf16* dp = WT + (size_t)rm(n0 + n) * pitch + k0 + 8 * c; *(v4u*)dp = o; if (dup) *(v4u*)(dp + dup) = o; }
    LDS_WAIT(); asm volatile("" ::: "memory");
}
struct RmId { int off; __device__ __forceinline__ int operator()(int n) const { return off + n; } };
struct RmWin { __device__ __forceinline__ int operator()(int n) const {
        if (n < 2048 || n >= 2816) return n; const int t = (n - 2048) >> 8, cl = (n - 2048) & 255, hh = cl >> 6, jl = cl & 63; return 2048 + t * 256 + 128 * (jl >> 5) + 32 * hh + (jl & 31); } };
struct RmGlu { __device__ __forceinline__ int operator()(int c) const { const int half = c >> 9, cc = c & 511; return 256 * (cc >> 7) + 128 * half + (cc & 127); } };

__device__ __forceinline__ void ph_prologue(const Ctx& C) {
    LAS float* sil = (LAS float*)C.lds;
    LAS float* red = sil + 3072;
    for (int item = C.bid; item < 192; item += GRID) {
        const int l = item / 48, ch = item % 48;
        for (int i = C.tid; i < 3072; i += NTHR) { const float x = i < 1024 ? C.in[I_CCTX][i] : C.in[I_C][i - 1024]; sil[i] = x * sigmoidf_(x); }
        __syncthreads();
        const float* W = C.in[I_ADAW] + (size_t)l * 1024 * 3072 + ch * 64 + C.lane;
        float a0 = 0.f, a1 = 0.f, a2 = 0.f;
        for (int i0 = 0; i0 < 128; i0 += 16) { float w[16];
#pragma unroll
            for (int i = 0; i < 16; ++i) w[i] = W[(size_t)(C.wave * 128 + i0 + i) * 3072];
#pragma unroll
            for (int i = 0; i < 16; ++i) { const int k = C.wave * 128 + i0 + i; a0 += w[i] * sil[k]; a1 += w[i] * sil[1024 + k]; a2 += w[i] * sil[2048 + k]; } }
        red[(C.wave * 3 + 0) * 64 + C.lane] = a0; red[(C.wave * 3 + 1) * 64 + C.lane] = a1; red[(C.wave * 3 + 2) * 64 + C.lane] = a2;
        __syncthreads();
        if (C.tid < 192) { const int ci = C.tid >> 6, col = ch * 64 + (C.tid & 63); float s = C.in[I_ADAB][(size_t)l * 3072 + col];
#pragma unroll
            for (int w = 0; w < 8; ++w) s += red[(w * 3 + ci) * 64 + (C.tid & 63)];
            if (col >= 1024 && col < 2048) s = (1.0f + s) * C.in[I_NORMG][l * 1024 + col - 1024];
            C.w<float>(WS_MODF)[((size_t)l * 3 + ci) * 3072 + col] = s; }
        __syncthreads();
    }
    const int gt = C.bid * NTHR + C.tid, ngt = GRID * NTHR;
    constexpr int T_A2L = 2048 * 2048 / 8, T_A2C = 256 * 512 / 8, T_A1P = 512 * 256 / 8;
    for (int t = gt; t < T_A2L + T_A2C + T_A1P; t += ngt) {
        float v[8]; bf16* dst;
        if (t < T_A2L) { const int r = t >> 8, c0 = (t & 255) * 8, kk = 2 * (r & 1023) + (r >> 10); dst = C.w<bf16>(WS_A2L) + (size_t)r * 2048 + c0;
#pragma unroll
            for (int e = 0; e < 8; ++e) { const int col = c0 + e, s = col & 1023, mm = (kk * s) & 2047; float sn, cs; sincospif((float)mm * (1.0f / 1024.0f), &sn, &cs); v[e] = (col < 1024 ? cs : sn) * 0.02209708691207961f; } }
        else if (t < T_A2L + T_A2C) { const int tt = t - T_A2L, k = tt >> 6, c0 = (tt & 63) * 8; dst = C.w<bf16>(WS_A2C) + (size_t)k * 512 + c0;
#pragma unroll
            for (int e = 0; e < 8; ++e) { const int col = c0 + e, s = col & 255, mm = (k * s) & 255; float sn, cs; sincospif((float)mm * (1.0f / 128.0f), &sn, &cs); v[e] = (col < 256 ? cs : sn) * 0.0625f; } }
        else { const int tt = t - T_A2L - T_A2C, r = tt >> 5, c0 = (tt & 31) * 8; dst = C.w<bf16>(WS_A1P) + (size_t)r * 256 + c0; const int gl = r >> 8, reim = (r >> 7) & 1, j = r & 127;
#pragma unroll
            for (int e = 0; e < 8; ++e) { const int col = c0 + e, glc = col >> 7, c = col & 127, mm = (j * c) & 127; float sn, cs; sincospif((float)mm * (1.0f / 64.0f), &sn, &cs);
                v[e] = (glc == gl) ? (reim ? -sn : cs) * 0.08838834764831845f : 0.f; } }
        v4u o; o.x = cvtpk(v[0], v[1]); o.y = cvtpk(v[2], v[3]); o.z = cvtpk(v[4], v[5]); o.w = cvtpk(v[6], v[7]); *(v4u*)dst = o;
    }
    if (gt < 1024) { const int pos = gt >> 4, f = gt & 15; const float inv = powf(10000.0f, -(float)f / 16.0f), ang = (float)pos * inv;
        C.w<float>(WS_ROPE)[gt * 2] = cosf(ang); C.w<float>(WS_ROPE)[gt * 2 + 1] = sinf(ang); }
}

__device__ __forceinline__ void s5_mats_block(const Ctx& C, int l, int g, int part) {
    LAS f32x2* pw = (LAS f32x2*)C.lds;
    LAS f32x2* Bb = pw + 2 * 17 * 64;
    LAS f32x2* Cm = Bb + 2 * 64 * 16;
    LAS float* Kl = (LAS float*)(Cm + 2 * 16 * 64);
    const int tid = C.tid;
    if (tid < 128) {
        const int d = tid >> 6, n = tid & 63; const size_t gi = ((size_t)(l * 2 + d) * 32 + g);
        const float lr = C.in[I_ARE][gi * 64 + n], li = C.in[I_AIM][gi * 64 + n], dt = expf(C.in[I_LDT][gi]);
        for (int tau = 0; tau <= 16; ++tau) { const float mag = expf((float)tau * dt * lr), ang = (float)tau * dt * li; float sn, cs; sincosf(ang, &sn, &cs); pw[(d * 17 + tau) * 64 + n] = (f32x2){mag * cs, mag * sn}; }
        float mag = expf(dt * lr), sn, cs; sincosf(dt * li, &sn, &cs);
        const float x = mag * cs - 1.0f, y = mag * sn, den = 1.0f / (lr * lr + li * li), cr = (x * lr + y * li) * den, cim = (y * lr - x * li) * den;
        const float* br = C.in[I_BRE] + (gi * 64 + n) * 16; const float* bi = C.in[I_BIM] + (gi * 64 + n) * 16;
#pragma unroll
        for (int q = 0; q < 16; ++q) Bb[(d * 64 + n) * 16 + q] = (f32x2){cr * br[q] - cim * bi[q], cr * bi[q] + cim * br[q]};
        if (part == 0) { const float m16 = expf(16.0f * dt * lr); sincosf(16.0f * dt * li, &sn, &cs);
            C.w<float>(WS_A16)[(gi * 64 + n) * 2] = m16 * cs; C.w<float>(WS_A16)[(gi * 64 + n) * 2 + 1] = m16 * sn; }
    }
    for (int idx = tid; idx < 2048; idx += NTHR) { const int d = idx >> 10, p = (idx >> 6) & 15, n = idx & 63; const size_t o = (((size_t)(l * 2 + d) * 32 + g) * 16 + p) * 64 + n;
        Cm[idx] = (f32x2){C.in[I_CRE][o], C.in[I_CIM][o]}; }
    __syncthreads();
    {
        const int d = tid >> 8, p = (tid >> 4) & 15, q = tid & 15; float a0 = 0.f, a1 = 0.f;
        for (int n = 0; n < 64; ++n) { const f32x2 c = Cm[(d * 16 + p) * 64 + n], bq = Bb[(d * 64 + n) * 16 + q]; const float wr = c.x * bq.x - c.y * bq.y, wi = c.x * bq.y + c.y * bq.x;
            const f32x2 p0 = pw[(d * 17 + 2 * part) * 64 + n], p1 = pw[(d * 17 + 2 * part + 1) * 64 + n]; a0 += wr * p0.x - wi * p0.y; a1 += wr * p1.x - wi * p1.y; }
        Kl[(d * 2 + 0) * 256 + p * 16 + q] = a0; Kl[(d * 2 + 1) * 256 + p * 16 + q] = a1;
    }
    __syncthreads();
    bf16* BtE = C.w<bf16>(WS_BTE) + (size_t)g * 256 * 256; bf16* BtY = C.w<bf16>(WS_BTY) + (size_t)g * 256 * 512;
    const float* dsk = C.in[I_SD] + (size_t)l * 512 + g * 16;
    for (int task = tid; task < 2 * 2 * 16 * 32; task += NTHR) {
        const int e = task >> 10, d = (task >> 9) & 1, blk = (task >> 5) & 15, p = (task >> 1) & 15, q0 = (task & 1) * 8, tau = 2 * part + e;
        if (blk >= 16 - tau || (tau == 0 && d == 1)) continue;
        const int t = d == 0 ? blk + tau : blk, j = d == 0 ? blk : blk + tau; float v[8];
#pragma unroll
        for (int k = 0; k < 8; ++k) { float s = Kl[(d * 2 + e) * 256 + p * 16 + q0 + k]; if (tau == 0) { s += Kl[(1 * 2 + e) * 256 + p * 16 + q0 + k]; if (q0 + k == p) s += dsk[p]; } v[k] = s; }
        v4u o; o.x = cvtpk(v[0], v[1]); o.y = cvtpk(v[2], v[3]); o.z = cvtpk(v[4], v[5]); o.w = cvtpk(v[6], v[7]); *(v4u*)(BtY + (size_t)(t * 16 + p) * 512 + j * 16 + q0) = o;
    }
    for (int task = tid; task < 2 * 32 * 32; task += NTHR) {
        const int which = task >> 10, r = 32 * part + ((task >> 5) & 31), c0 = (task & 31) * 8; float v[8]; bf16* dst;
        if (which == 0) { const int d = r >> 7, reim = (r >> 6) & 1, n = r & 63, j = c0 >> 4, q0 = c0 & 15, ex = d == 0 ? 15 - j : j; dst = BtE + (size_t)r * 256 + c0; const f32x2 a = pw[(d * 17 + ex) * 64 + n];
#pragma unroll
            for (int k = 0; k < 8; ++k) { const f32x2 bq = Bb[(d * 64 + n) * 16 + q0 + k]; v[k] = reim ? (a.x * bq.y + a.y * bq.x) : (a.x * bq.x - a.y * bq.y); } }
        else { const int t = r >> 4, p = r & 15, d = c0 >> 7, reim = (c0 >> 6) & 1, n0 = c0 & 63, ex = d == 0 ? t + 1 : 16 - t; dst = BtY + (size_t)r * 512 + 256 + c0;
#pragma unroll
            for (int k = 0; k < 8; ++k) { const f32x2 c = Cm[(d * 16 + p) * 64 + n0 + k], a = pw[(d * 17 + ex) * 64 + n0 + k]; v[k] = reim ? -(c.x * a.y + c.y * a.x) : (c.x * a.x - c.y * a.y); } }
        v4u o; o.x = cvtpk(v[0], v[1]); o.y = cvtpk(v[2], v[3]); o.z = cvtpk(v[4], v[5]); o.w = cvtpk(v[6], v[7]); *(v4u*)dst = o;
    }
    __syncthreads();
}

__device__ __forceinline__ void prep_layer(const Ctx& C, int l, int parts, int blo, int bcnt) {
    if (C.vcu < blo || C.vcu >= blo + bcnt) return;
    const int bi = C.vcu - blo, wi = bi * NWAVES + C.wave, nw = bcnt * NWAVES;
    if (parts & 1) for (int it = bi; it < 256; it += bcnt) s5_mats_block(C, l, it >> 3, it & 7);
    LAS float* scr = (LAS float*)(C.lds + C.wave * 16384);
    constexpr int I_1 = 16 * 104, I_2 = 16 * 96, I_3 = 8 * 32, I_4 = 8 * 16, I_5 = 8 * 32, I_6 = 16 * 32;
    if (parts & 1) {
        for (int it = wi; it < I_1 + I_2 + I_3 + I_4; it += nw) {
            int r = it;
            if (r < I_1) { transpose_item(C.in[I_WIN] + (size_t)l * 1024 * INW, 1024, INW, C.w<bf16>(WS_WCAT), RmWin{}, scr, r, C.lane); continue; } r -= I_1;
            if (r < I_2) { transpose_item(C.in[I_MW] + (size_t)l * 1024 * 3072, 1024, 3072, C.w<bf16>(WS_WCAT), RmId{INW}, scr, r, C.lane); continue; } r -= I_2;
            if (r < I_3) { transpose_item(C.in[I_GLU] + (size_t)l * 512 * 1024, 512, 1024, C.w<bf16>(WS_WGLU), RmGlu{}, scr, r, C.lane); continue; } r -= I_3;
            transpose_item(C.in[I_FN] + (size_t)l * 512 * 512, 512, 512, C.w<bf16>(WS_WFN), RmId{0}, scr, r, C.lane, 1024, 512);
        }
        for (int t = bi * NTHR + C.tid; t < 2 * 2 * 256 * 16; t += bcnt * NTHR) {
            const int kv = t >> 13, r = t & 8191, b = r >> 12, s = (r >> 4) & 255, c0 = (r & 15) * 8;
            const float* src = C.in[kv ? I_CV : I_CK] + (((size_t)b * DEPTH + l) * 256 + s) * KVW + c0;
            const f32x4 a = *(const f32x4*)src, bq = *(const f32x4*)(src + 4);
            v4u o; o.x = cvtpk(a[0], a[1]); o.y = cvtpk(a[2], a[3]); o.z = cvtpk(bq[0], bq[1]); o.w = cvtpk(bq[2], bq[3]);
            *(v4u*)(C.w<bf16>(kv ? WS_VL : WS_KL) + ((size_t)b * LKV + S_LAT + s) * KVW + c0) = o;
        }
    }
    if (parts & 2) for (int it = wi; it < 3 * I_5; it += nw) { const int nb = it / I_5;
        transpose_item(C.in[I_WBR] + ((size_t)l * 3 + nb) * 512 * 1024, 512, 1024, C.w<bf16>(WS_WBR) + (size_t)nb * 1024 * 512, RmId{0}, scr, it - nb * I_5, C.lane); }
    if (parts & 4) for (int it = wi; it < I_6; it += nw) transpose_item(C.in[I_WOUT] + (size_t)l * 1024 * 1024, 1024, 1024, C.w<bf16>(WS_WOUT), RmId{0}, scr, it, C.lane);
}

__device__ __forceinline__ void rows_phase(const Ctx& C, int l, bool last);
__device__ __forceinline__ void ph_l1(const Ctx& C, int l) {
    if (l > 0) prep_layer(C, l, 6, 0, GRID);
    rows_phase(C, l, false);
}

__device__ __forceinline__ void rows_phase(const Ctx& C, int l, bool last) {
    const float* modf = C.w<float>(WS_MODF); float* XR = C.w<float>(WS_XRES);
    const bf16* T0 = C.w<bf16>(WS_PB); const bf16* T1 = C.w<bf16>(WS_GA);
    f32x4 v[4][4];
#pragma unroll
    for (int i = 0; i < 4; ++i) { const int row = C.gw + i * 2048;
        const float* xr = l == 0 ? (i < 2 ? C.in[I_XP] + (size_t)row * 1024 : C.in[I_XS] + (size_t)(row - T_CTX) * 1024) : XR + (size_t)row * 1024;
#pragma unroll
        for (int j = 0; j < 4; ++j) v[i][j] = *(const f32x4*)(xr + C.lane * 4 + 256 * j); }
#pragma unroll
    for (int i = 0; i < 4; ++i) { const int row = C.gw + i * 2048, ci = i < 2 ? 0 : i - 1; float ss = 0.f;
        if (l > 0) {
            const float* gp = modf + ((size_t)(l - 1) * 3 + ci) * 3072 + 2048 + C.lane * 4; u32x2 t0[4], t1[4]; f32x4 gt[4];
#pragma unroll
            for (int j = 0; j < 4; ++j) { t0[j] = *(const u32x2*)(T0 + (size_t)row * 1024 + C.lane * 4 + 256 * j); t1[j] = *(const u32x2*)(T1 + (size_t)row * 1024 + C.lane * 4 + 256 * j); gt[j] = *(const f32x4*)(gp + 256 * j); }
#pragma unroll
            for (int j = 0; j < 4; ++j) v[i][j] += gt[j] * (bf4_to_f(t0[j]) + bf4_to_f(t1[j]));
        }
        if (!last) {
#pragma unroll
            for (int j = 0; j < 4; ++j) *(f32x4*)(XR + (size_t)row * 1024 + C.lane * 4 + 256 * j) = v[i][j];
        }
#pragma unroll
        for (int j = 0; j < 4; ++j) ss += (v[i][j][0] * v[i][j][0] + v[i][j][1] * v[i][j][1]) + (v[i][j][2] * v[i][j][2] + v[i][j][3] * v[i][j][3]);
        const float rstd = rsqrtf(wave_sum(ss, C.lane) * (1.0f / 1024.0f) + RMS_EPS);
        if (last) {
#pragma unroll
            for (int j = 0; j < 4; ++j) *(f32x4*)(C.out + (size_t)row * 1024 + C.lane * 4 + 256 * j) = v[i][j] * rstd * *(const f32x4*)(C.in[I_FG] + C.lane * 4 + 256 * j);
        } else {
            const float* mp = modf + ((size_t)l * 3 + ci) * 3072 + C.lane * 4; bf16* hr = C.w<bf16>(WS_H) + (size_t)row * 1024;
#pragma unroll
            for (int j = 0; j < 4; ++j) { const f32x4 sh = *(const f32x4*)(mp + 256 * j), gs = *(const f32x4*)(mp + 1024 + 256 * j); st_bf4(hr + C.lane * 4 + 256 * j, v[i][j] * rstd * gs + sh); }
        }
    }
}

__device__ __forceinline__ void scan_unit(const Ctx& C, int l, int g, int pm) {
    const float* SC = C.w<float>(WS_SC); bf16* UH = C.w<bf16>(WS_UH); const int lane = C.lane;
    const int nitems = pm ? 4 : 32;
    for (int item = C.wave; item < nitems; item += NWAVES) {
        const int bsel = item >> 1, d = item & 1, nch = pm ? 128 : 16, c0 = pm ? 256 + bsel * 128 : bsel * 16;
        const size_t gi = ((size_t)(l * 2 + d) * 32 + g) * 64 + lane;
        const float ar = C.w<float>(WS_A16)[gi * 2], ai = C.w<float>(WS_A16)[gi * 2 + 1];
        float hr = 0.f, hi = 0.f;
        if (pm) { const float* st = C.in[I_ST] + ((((size_t)bsel * DEPTH + l) * 2 + d) * 32 + g) * 128 + lane * 2; hr = st[0]; hi = st[1]; }
        float sr[16], si[16], tr[16], ti[16];
#pragma unroll
        for (int k = 0; k < 16; ++k) { const int c = d == 0 ? c0 + k : c0 + nch - 1 - k; const size_t o = ((size_t)g * 512 + c) * 256 + d * 128 + lane; sr[k] = SC[o]; si[k] = SC[o + 64]; }
        for (int i0 = 0; i0 < nch; i0 += 16) {
            if (i0 + 16 < nch) {
#pragma unroll
                for (int k = 0; k < 16; ++k) { const int c = d == 0 ? c0 + i0 + 16 + k : c0 + nch - 1 - i0 - 16 - k; const size_t o = ((size_t)g * 512 + c) * 256 + d * 128 + lane; tr[k] = SC[o]; ti[k] = SC[o + 64]; }
            }
#pragma unroll
            for (int k = 0; k < 16; ++k) { const int c = d == 0 ? c0 + i0 + k : c0 + nch - 1 - i0 - k; const size_t oh = ((size_t)g * 512 + c) * 512 + 256 + d * 128 + lane;
                UH[oh] = (bf16)(cvtpk(hr, hr) & 0xffffu); UH[oh + 64] = (bf16)(cvtpk(hi, hi) & 0xffffu);
                const float nr = ar * hr - ai * hi + sr[k], ni = ar * hi + ai * hr + si[k]; hr = nr; hi = ni; }
#pragma unroll
            for (int k = 0; k < 16; ++k) { sr[k] = tr[k]; si[k] = ti[k]; }
        }
        if (!pm) { float* o = C.out + OUT_S + ((((size_t)bsel * DEPTH + l) * 2 + d) * 32 + g) * 128 + lane * 2; o[0] = hr; o[1] = hi; }
    }
}

__device__ __forceinline__ void ph_final(const Ctx& C) { rows_phase(C, DEPTH, true); }

__device__ __forceinline__ void attn_any(const Ctx& C, int uidx) {
    size_t tok0, kvoff; int NT, h;
    if (uidx < 128) { const int b = uidx >> 6, qb = uidx & 7; h = (uidx >> 3) & 7; tok0 = (size_t)T_CTX + b * 2048 + qb * 256; kvoff = (size_t)(WS_KL - WS_KC) / 2 + (size_t)b * LKV * KVW; NT = LKV / 64; }
    else { const int u2 = uidx - 128, b = u2 >> 3; h = u2 & 7; tok0 = (size_t)b * 256; kvoff = tok0 * KVW; NT = 4; }
    kvoff += (h >> 2) * 64;
    const attn_body::bf16* Q = (const attn_body::bf16*)C.w<bf16>(WS_Q) + tok0 * 512 + h * 64;
    const attn_body::bf16* Kp = (const attn_body::bf16*)C.w<bf16>(WS_KC) + kvoff;
    attn_body::attn_unit<8>(Q, Kp, Kp + (WS_VC - WS_KC) / 2, (attn_body::bf16*)Q, (const attn_body::bf16*)C.w<bf16>(WS_GC) + tok0 * 512 + h * 64, 512, KVW, NT, (char*)C.lds, C.tid);
}

#ifndef MK_PER_PHASE
#define MK_PER_PHASE 0
#endif
constexpr int NSUB = 7, N_PHASES = 2 + NSUB * DEPTH;


__global__ void __launch_bounds__(NTHR, 2) fwd_kernel(KArgs args) {
    extern __shared__ __attribute__((aligned(16))) unsigned char lds_raw[];
    Ctx C; C.lds = (LAS unsigned char*)lds_raw; C.tid = threadIdx.x; C.lane = C.tid & 63; C.wave = __builtin_amdgcn_readfirstlane(C.tid >> 6); C.bid = blockIdx.x;
    int wave_s = C.wave;
    C.gw = C.bid * NWAVES + C.wave; C.ngw = GRID * NWAVES; C.in = args.in; C.out = args.out; C.ws = args.ws;
    for (int u = C.tid; u < (LDS_BYTES - LDSCTL_OFF) / 4; u += NTHR) ((LAS unsigned*)(C.lds + LDSCTL_OFF))[u] = 0u;
    __syncthreads();
    volatile LAS unsigned* MISC = (volatile LAS unsigned*)(C.lds + MISC_OFF);
    XcdBarrier bar; bar.bar = (unsigned*)(C.ws + WS_CTL) + CW_BAR; bar.x = 0; bar.st = nullptr;
    const bool multi = args.ph_hi - args.ph_lo > 1;
    if (multi) bar = xcd_barrier_post((unsigned*)(C.ws + WS_CTL) + CW_BAR, MISC + 8, C.tid);

    for (int ph = args.ph_lo; ph < args.ph_hi; ++ph) {
        { int l_; asm volatile("v_mbcnt_lo_u32_b32 %0, -1, 0\n\tv_mbcnt_hi_u32_b32 %0, -1, %0" : "=v"(l_)); asm volatile("" : "+s"(wave_s)); int b_ = blockIdx.x; asm volatile("" : "+s"(b_)); C.bid = b_; C.vcu = b_;   C.lane = l_; C.wave = wave_s; C.tid = wave_s * 64 + l_; C.gw = C.bid * NWAVES + C.wave;
          unsigned char* w_ = args.ws; asm volatile("" : "+s"(w_)); C.ws = w_; float* o_ = args.out; asm volatile("" : "+s"(o_)); C.out = o_; }
        const int c = C.vcu;
        if (ph == 0) { ph_prologue(C); __syncthreads(); prep_layer(C, 0, 7, 0, GRID); }
        else if (ph == N_PHASES - 1) ph_final(C);
        else {
            const int l = (ph - 1) / NSUB, sub = (ph - 1) % NSUB;
            if (sub == 0) ph_l1(C, l);
            else {
                if (sub == 2 && c < 128) for (int i = 0; i < 2; ++i) attn_any(C, c + 128 * i);
                if (sub == 3 && c >= 64 && c < 128) { const int L = xswz(c - 64, 64); scan_unit(C, l, L >> 1, L & 1); VM_WAIT(); }
                __syncthreads();
                { PhaseSched S{sub, c, C.bid, C.ws}; EpiAll E{C.ws, C.out, C.in, l}; int t_ = C.tid; asm volatile("" : "+v"(t_));
                  pg8::gemm_stream<EpiAll, PhaseSched>(C.lds, S, E, t_); }
                if (sub == 5 && l + 1 < DEPTH) { __syncthreads(); prep_layer(C, l + 1, 1, 128, 128); }
            }
        }
        if (ph + 1 < args.ph_hi) xcd_barrier(bar, C.tid);
    }
}

extern "C" void kernel_launch(void* const* d_in, const int* in_sizes, int n_in, void* d_out, int out_size, void* d_ws, size_t ws_size, hipStream_t stream) {
    static int ready = 0;
    if (ready == 0) {
        if (n_in != 28 || out_size != (int)OUT_N || ws_size < WS_END) { fprintf(stderr, "kernel_launch: unexpected problem shape (n_in %d, out %d, ws %zu)\n", n_in, out_size, ws_size); ready = -1; return; }
        int dev = 0, cus = 0;
        if (hipGetDevice(&dev) != hipSuccess || hipDeviceGetAttribute(&cus, hipDeviceAttributeMultiprocessorCount, dev) != hipSuccess) { ready = -1; return; }
        if (hipFuncSetAttribute((const void*)fwd_kernel, hipFuncAttributeMaxDynamicSharedMemorySize, LDS_BYTES) != hipSuccess) { fprintf(stderr, "kernel_launch: hipFuncSetAttribute failed\n"); ready = -1; return; }
        if (cus < GRID) { fprintf(stderr, "kernel_launch: device has %d CUs, this kernel needs %d resident workgroups\n", cus, GRID); ready = -1; return; }
        ready = 1;
    }
    if (ready < 0) return;
    (void)hipMemsetAsync((char*)d_ws + WS_CTL, 0, CTL_ZERO_BYTES, stream);
    KArgs a{};
    for (int i = 0; i < 28; ++i) a.in[i] = (const float*)d_in[i];
    a.out = (float*)d_out; a.ws = (unsigned char*)d_ws;
#if MK_PER_PHASE
    for (int ph = 0; ph < N_PHASES; ++ph) { a.ph_lo = ph; a.ph_hi = ph + 1; hipLaunchKernelGGL(fwd_kernel, dim3(GRID), dim3(NTHR), LDS_BYTES, stream, a); }
#else
    a.ph_lo = 0; a.ph_hi = N_PHASES; hipLaunchKernelGGL(fwd_kernel, dim3(GRID), dim3(NTHR), LDS_BYTES, stream, a);
#endif
}
```

```cpp
#include <hip/hip_runtime.h>
#include <hip/hip_bf16.h>
#include <cstdio>
#include <cstdint>
#include <cmath>
namespace pg8 {
#define PG8_LAS __attribute__((address_space(3)))
typedef unsigned short bf16_t;
typedef short bf16x8 __attribute__((ext_vector_type(8)));
typedef float f32x4 __attribute__((ext_vector_type(4)));
typedef unsigned u32x4 __attribute__((ext_vector_type(4)));
constexpr int BM = 256, BK = 64, HALF = 128, HTB = HALF * BK * 2  , STAGE_BYTES = 8 * HTB, NXCD = 8, WGM = 8;

__host__ __device__ __forceinline__ int lds_byte(int r, int c) { const int st = (r >> 4) * 2 + (c >> 5), rr = r & 15, cc = c & 31, ob = rr * 64 + cc * 2; return st * 1024 + (ob ^ (((ob >> 9) & 1) << 5)); }
__host__ __device__ __forceinline__ void stage_rc(int b, int& R, int& C) { const int st = b / 1024, sb = b % 1024, swz = sb ^ (((sb >> 9) & 1) << 5); R = (st >> 1) * 16 + swz / 64; C = (st & 1) * 32 + (swz % 64) / 2; }
__host__ __device__ __forceinline__ int perm32(int rho) { const int n = rho >> 4, i = rho & 15; return 8 * (i >> 2) + 4 * n + (i & 3); }


struct Unit { int pm, pn, z; };
struct StaticOrder {
    int nM, nN, nwg, G, c;
    __host__ __device__ void init(int M, int N, int G_, int c_) { nM = M / BM; nN = N / BM; nwg = nM * nN; G = G_; c = c_; }
    __host__ __device__ bool next(int i, Unit& u) const {
        const long L = (long)i * G + c; if (L >= nwg) return false;
        int wgid = (int)L; { const int q = nwg / NXCD, r = nwg % NXCD, xcd = wgid % NXCD, off = wgid / NXCD; wgid = (xcd < r ? xcd * (q + 1) : r * (q + 1) + (xcd - r) * q) + off; }
        const int nig = WGM * nN, gid = wgid / nig, fm = gid * WGM, gsz = (nM - fm) < WGM ? (nM - fm) : WGM;
        u.pm = fm + ((wgid % nig) % gsz); u.pn = (wgid % nig) / gsz; return true;
    }
    __device__ __forceinline__ void a_ready(const Unit&) const {}
    __device__ __forceinline__ void done(const Unit&) const {}
};
struct UDesc { const bf16_t* A; const bf16_t* Bt; int lda, ldb, K, hB; int kind, pm, pn, z, keep; };
template <class Epi, class Sched>
__device__ __forceinline__ void gemm_stream(PG8_LAS unsigned char* lds, const Sched& S, const Epi& E, const int tid_in) {
    const int tid = tid_in, wid = __builtin_amdgcn_readfirstlane(tid >> 6), lane = tid & 63, wr = wid >> 2, wc = wid & 3, fr = lane & 15, fq = lane >> 4;
    int RA, RB, CC;
    { int R, C; stage_rc(tid * 16, R, C); RA = R; RB = (R & ~31) + perm32(R & 31); CC = C; }
    const size_t kstep = (size_t)(BK * 2);
    const unsigned ldsw = (unsigned)wid * 1024u;
    const int aoff = lds_byte(wr * 64 + fr, fq * 8), boff = lds_byte(wc * 32 + fr, fq * 8);
#define PG8_SA(b, h) (((b) * 2 + (h)) * HTB)
#define PG8_SB(b, h) ((4 + (b) * 2 + (h)) * HTB)
#define PG8_STAGE_X(bufoff, gbase, RR, ld) do { const unsigned _vo = (unsigned)(RR * (ld) + CC) * 2u; \
        __builtin_amdgcn_global_load_lds((const unsigned*)((const char*)(gbase) + _vo), (PG8_LAS unsigned*)(lds + (bufoff) + ldsw), 16, 0, 0); \
        __builtin_amdgcn_global_load_lds((const unsigned*)((const char*)(gbase) + (size_t)(ld) * 128 + _vo), (PG8_LAS unsigned*)(lds + (bufoff) + ldsw + 8192), 16, 0, 0); } while (0)
#define PG8_STAGE_A(bufoff, gbase, ld) PG8_STAGE_X(bufoff, gbase, RA, ld)
#define PG8_STAGE_B(bufoff, gbase, ld) PG8_STAGE_X(bufoff, gbase, RB, ld)
#define PG8_LDA(dst, b, h) do { _Pragma("unroll") for (int m = 0; m < 4; ++m) _Pragma("unroll") for (int k = 0; k < 2; ++k) dst[m][k] = *(const PG8_LAS bf16x8*)(lds + PG8_SA(b, h) + aoff + m * 2048 + k * 1024); } while (0)
#define PG8_LDB(dst, b, h) do { _Pragma("unroll") for (int n = 0; n < 2; ++n) _Pragma("unroll") for (int k = 0; k < 2; ++k) dst[n][k] = *(const PG8_LAS bf16x8*)(lds + PG8_SB(b, h) + boff + n * 2048 + k * 1024); } while (0)
#define PG8_MMA(ai, bj, At, Bt) do { __builtin_amdgcn_s_setprio(1); _Pragma("unroll") for (int m = 0; m < 4; ++m) _Pragma("unroll") for (int n = 0; n < 2; ++n) _Pragma("unroll") for (int k = 0; k < 2; ++k) \
        acc[ai][bj][m][n] = __builtin_amdgcn_mfma_f32_16x16x32_bf16(Bt[n][k], At[m][k], acc[ai][bj][m][n], 0, 0, 0); __builtin_amdgcn_s_setprio(0); } while (0)
#define PG8_WAIT_V(n) asm volatile("s_waitcnt vmcnt(" #n ")" ::: "memory")
#define PG8_WAIT_L(n) asm volatile("s_waitcnt lgkmcnt(" #n ")" ::: "memory")
#define PG8_BAR __builtin_amdgcn_s_barrier()
#define PG8_SCHED __builtin_amdgcn_sched_barrier(0)
    UDesc cur, nxt; int ui = 0;
    if (!S.next(0, cur)) return;
    f32x4 acc[2][2][4][2];
#pragma unroll
    for (int a = 0; a < 2; ++a)
#pragma unroll
        for (int b = 0; b < 2; ++b)
#pragma unroll
            for (int m = 0; m < 4; ++m)
#pragma unroll
                for (int n = 0; n < 2; ++n) acc[a][b][m][n] = (f32x4){0.f, 0.f, 0.f, 0.f};
    bf16x8 At[4][2], B0[2][2], B1[2][2];
    const char* cA = (const char*)cur.A; const char* cB = (const char*)cur.Bt; int ldaC = cur.lda, ldbC = cur.ldb; unsigned hstepA = (unsigned)HALF * ldaC * 2, hstepB = (unsigned)cur.hB * ldbC * 2;
    PG8_STAGE_B(PG8_SB(0, 0), cB, ldbC); PG8_STAGE_B(PG8_SB(0, 1), cB + hstepB, ldbC); PG8_STAGE_A(PG8_SA(0, 0), cA, ldaC); PG8_STAGE_A(PG8_SA(0, 1), cA + hstepA, ldaC);
    if (wr == 1) PG8_BAR;
    PG8_WAIT_V(2); PG8_BAR;
    PG8_STAGE_B(PG8_SB(1, 0), cB + kstep, ldbC); PG8_STAGE_A(PG8_SA(1, 0), cA + kstep, ldaC); PG8_STAGE_B(PG8_SB(1, 1), cB + hstepB + kstep, ldbC);
    PG8_WAIT_V(6); PG8_BAR;
    for (;;) {
        const bool has_next = S.next(ui + 1, nxt);
        const char* nA = has_next ? (const char*)nxt.A : cA; const char* nB = has_next ? (const char*)nxt.Bt : cB;
        const int ldaN = has_next ? nxt.lda : ldaC, ldbN = has_next ? nxt.ldb : ldbC; const unsigned hstepAN = (unsigned)HALF * ldaN * 2, hstepBN = has_next ? (unsigned)nxt.hB * ldbN * 2 : hstepB;
        const int nt = cur.K / BK;
        for (int t = 0; t < nt; t += 2) {
            const bool last = (t == nt - 2);
            const char* a1 = cA + (size_t)(t + 1) * kstep;
            const char* a2 = last ? nA : cA + (size_t)(t + 2) * kstep; const char* b2 = last ? nB : cB + (size_t)(t + 2) * kstep;
            const char* a3 = a2 + kstep; const char* b3 = b2 + kstep;
            const int lda2 = last ? ldaN : ldaC, ldb2 = last ? ldbN : ldbC; const unsigned hA2 = last ? hstepAN : hstepA, hB2 = last ? hstepBN : hstepB;
            PG8_LDB(B0, 0, 0); PG8_LDB(B1, 0, 1); PG8_SCHED; PG8_LDA(At, 0, 0); PG8_STAGE_A(PG8_SA(1, 1), a1 + hstepA, ldaC);
            PG8_WAIT_V(8); PG8_WAIT_L(0); PG8_BAR; PG8_MMA(0, 0, At, B0); PG8_MMA(0, 1, At, B1); PG8_BAR; PG8_SCHED;
            PG8_LDA(At, 0, 1); PG8_STAGE_B(PG8_SB(0, 0), b2, ldb2); PG8_STAGE_B(PG8_SB(0, 1), b2 + hB2, ldb2); PG8_STAGE_A(PG8_SA(0, 0), a2, lda2);
            PG8_WAIT_V(8); PG8_WAIT_L(0); PG8_BAR; PG8_MMA(1, 0, At, B0); PG8_MMA(1, 1, At, B1); PG8_BAR; PG8_SCHED;
            PG8_LDB(B0, 1, 0); PG8_LDB(B1, 1, 1); PG8_SCHED; PG8_LDA(At, 1, 0); PG8_STAGE_A(PG8_SA(0, 1), a2 + hA2, lda2);
            PG8_WAIT_V(8); PG8_WAIT_L(0); PG8_BAR; PG8_MMA(0, 0, At, B0); PG8_MMA(0, 1, At, B1); PG8_BAR; PG8_SCHED;
            PG8_LDA(At, 1, 1); PG8_STAGE_B(PG8_SB(1, 0), b3, ldb2); PG8_STAGE_B(PG8_SB(1, 1), b3 + hB2, ldb2); PG8_STAGE_A(PG8_SA(1, 0), a3, lda2);
            PG8_WAIT_V(8); PG8_WAIT_L(0); PG8_BAR; PG8_MMA(1, 0, At, B0); PG8_MMA(1, 1, At, B1); PG8_BAR; PG8_SCHED;
        }
        if (wr == 0) PG8_BAR;
        const bool chained = E.transform(acc, cur, wr, wc, fr, fq);
        if (!chained) E(acc, cur, wr, wc, fr, fq);
        if (!has_next) break;
        if (!chained) {
#pragma unroll
        for (int a = 0; a < 2; ++a)
#pragma unroll
            for (int b = 0; b < 2; ++b)
#pragma unroll
                for (int m = 0; m < 4; ++m)
#pragma unroll
                    for (int n = 0; n < 2; ++n) acc[a][b][m][n] = (f32x4){0.f, 0.f, 0.f, 0.f};
        }
        cur = nxt; cA = nA; cB = nB; ldaC = ldaN; ldbC = ldbN; hstepA = hstepAN; hstepB = hstepBN; ++ui;
        if (wr == 1) PG8_BAR;
    }
    PG8_WAIT_V(0);
    PG8_BAR;
#undef PG8_SA
#undef PG8_SB
#undef PG8_STAGE_X
#undef PG8_STAGE_A
#undef PG8_STAGE_B
#undef PG8_LDA
#undef PG8_LDB
#undef PG8_MMA
#undef PG8_WAIT_V
#undef PG8_WAIT_L
#undef PG8_BAR
#undef PG8_SCHED
}
}

#include <hip/hip_bf16.h>
#include <cmath>
namespace attn_body {
using bf16=__hip_bfloat16;
using bf16x8=__attribute__((ext_vector_type(8)))short;
using s16x4=__attribute__((ext_vector_type(4)))short;
using f32x16=__attribute__((ext_vector_type(16)))float;
using u32x4=__attribute__((ext_vector_type(4)))unsigned;
constexpr int D=64;
constexpr int NW=8,QBLK=32,QB=QBLK*NW,KVBLK=64;
__device__ __forceinline__ int crow(int r,int hi){return (r&3)+8*(r>>2)+4*hi;}
#define SBAR() __builtin_amdgcn_sched_barrier(0)
constexpr int NSLOT=3, SLOTB=8192;
constexpr int LDS_K=0, LDS_V=NSLOT*SLOTB, LDS_WS=2*NSLOT*SLOTB, LDS_OST=LDS_WS+NW*64*4, LDS_BYTES=LDS_OST+NW*4096;
constexpr float C2=0.125f*1.4426950408889634f;
__device__ __forceinline__ void glds16(const void*gsrc,unsigned lds_dst){unsigned keep;
  asm volatile("s_mov_b32 %0, m0\n\ts_mov_b32 m0, %2\n\ts_nop 0\n\tglobal_load_lds_dwordx4 %1, off\n\ts_mov_b32 m0, %0":"=&s"(keep):"v"(gsrc),"s"(lds_dst):"memory");}
__device__ __forceinline__ float max3f(float a,float b,float c){float r;asm("v_max3_f32 %0, %1, %2, %3":"=v"(r):"v"(a),"v"(b),"v"(c));return r;}
__device__ __forceinline__ float max2f(float a,float b){float r;asm("v_max_f32_e32 %0, %1, %2":"=v"(r):"v"(a),"v"(b));return r;}
__device__ __forceinline__ float fadd_s(float a,float b){float r;asm("v_add_f32_e32 %0, %1, %2":"=v"(r):"v"(a),"v"(b));return r;}
__device__ __forceinline__ float fsub_s(float a,float b){float r;asm("v_sub_f32_e32 %0, %1, %2":"=v"(r):"v"(a),"v"(b));return r;}
typedef float f32x2_t __attribute__((ext_vector_type(2))); typedef __bf16 bf16x2_t __attribute__((ext_vector_type(2)));
__device__ __forceinline__ unsigned cvtpk_s(float lo,float hi){f32x2_t v={lo,hi};bf16x2_t b=__builtin_convertvector(v,bf16x2_t);return __builtin_bit_cast(unsigned,b);}
#define WAIT_BAR(N) asm volatile("s_waitcnt vmcnt(" #N ") lgkmcnt(0)\n\ts_barrier":::"memory")

__device__ __forceinline__ void qkt(f32x16&p0,f32x16&p1,const char*Kslot,const bf16x8*qr,const f32x16&negm,int r32,int hi){
  const char*kb=Kslot+hi*1024+r32*16;
  #pragma unroll
  for(int d0=0;d0<4;++d0){
    const bf16x8 b0=*reinterpret_cast<const bf16x8*>(kb+d0*2048);
    const bf16x8 b1=*reinterpret_cast<const bf16x8*>(kb+d0*2048+512);
    if(d0==0){p0=__builtin_amdgcn_mfma_f32_32x32x16_bf16(b0,qr[0],negm,0,0,0);p1=__builtin_amdgcn_mfma_f32_32x32x16_bf16(b1,qr[0],negm,0,0,0);}
    else{p0=__builtin_amdgcn_mfma_f32_32x32x16_bf16(b0,qr[d0],p0,0,0,0);p1=__builtin_amdgcn_mfma_f32_32x32x16_bf16(b1,qr[d0],p1,0,0,0);}}
}
typedef __attribute__((address_space(3))) const char* lds_cptr;
typedef short v4i16_t __attribute__((ext_vector_type(4)));
__device__ __forceinline__ void kload8(bf16x8*kf,lds_cptr kp){
  kf[0]=*(const __attribute__((address_space(3))) bf16x8*)(kp);      kf[1]=*(const __attribute__((address_space(3))) bf16x8*)(kp+512);
  kf[2]=*(const __attribute__((address_space(3))) bf16x8*)(kp+2048); kf[3]=*(const __attribute__((address_space(3))) bf16x8*)(kp+2560);
  kf[4]=*(const __attribute__((address_space(3))) bf16x8*)(kp+4096); kf[5]=*(const __attribute__((address_space(3))) bf16x8*)(kp+4608);
  kf[6]=*(const __attribute__((address_space(3))) bf16x8*)(kp+6144); kf[7]=*(const __attribute__((address_space(3))) bf16x8*)(kp+6656);
}
__device__ __forceinline__ void kload2(bf16x8*kf,lds_cptr kp,int j){ kf[2*j]=*(const __attribute__((address_space(3))) bf16x8*)(kp+j*2048); kf[2*j+1]=*(const __attribute__((address_space(3))) bf16x8*)(kp+j*2048+512); }
__device__ __forceinline__ s16x4 vtr(lds_cptr p){ return __builtin_bit_cast(s16x4,__builtin_amdgcn_ds_read_tr16_b64_v4i16((__attribute__((address_space(3))) v4i16_t*)p)); }
__device__ __forceinline__ float rowmax(const f32x16&p0,const f32x16&p1){
  float a=max3f(p0[0],p0[1],p1[0]),b=max3f(p0[2],p0[3],p1[1]);a=max3f(a,p1[2],p1[3]);
  #pragma unroll
  for(int r=4;r<16;r+=4){a=max3f(a,p0[r],p0[r+1]);b=max3f(b,p0[r+2],p0[r+3]);a=max3f(a,p1[r],p1[r+1]);b=max3f(b,p1[r+2],p1[r+3]);}
  const float m=max2f(a,b);
  auto rr=__builtin_amdgcn_permlane32_swap(__float_as_uint(m),__float_as_uint(m),false,false);
  return max2f(__uint_as_float(rr[0]),__uint_as_float(rr[1]));
}
__device__ __forceinline__ void pv(f32x16*o,int vb,bf16x8 pa0,bf16x8 pa1,bf16x8 pa2,bf16x8 pa3){
  #pragma unroll
  for(int d0=0;d0<2;++d0){s16x4 lo[4],hi[4];
    #pragma unroll
    for(int ks=0;ks<4;++ks){
      asm volatile("ds_read_b64_tr_b16 %0,%1 offset:%c2":"=&v"(lo[ks]):"v"(vb),"i"(d0*4096+ks*1024):"memory");
      asm volatile("ds_read_b64_tr_b16 %0,%1 offset:%c2":"=&v"(hi[ks]):"v"(vb),"i"(d0*4096+ks*1024+512):"memory");}
    asm volatile("s_waitcnt lgkmcnt(0)":::"memory");SBAR();
    #define PK(k) (bf16x8){lo[k][0],lo[k][1],lo[k][2],lo[k][3],hi[k][0],hi[k][1],hi[k][2],hi[k][3]}
    o[d0]=__builtin_amdgcn_mfma_f32_32x32x16_bf16(pa0,PK(0),o[d0],0,0,0);
    o[d0]=__builtin_amdgcn_mfma_f32_32x32x16_bf16(pa1,PK(1),o[d0],0,0,0);
    o[d0]=__builtin_amdgcn_mfma_f32_32x32x16_bf16(pa2,PK(2),o[d0],0,0,0);
    o[d0]=__builtin_amdgcn_mfma_f32_32x32x16_bf16(pa3,PK(3),o[d0],0,0,0);
    #undef PK
  }
}

#ifndef ATTN_STORE16
#define ATTN_STORE16(p,v) (*(u32x4*)(p)=(v))
#endif
template<int THRL> __device__ __forceinline__ void attn_unit(const bf16*Qu,const bf16*Kh,const bf16*Vh,bf16*Ou,const bf16*Gu,const int QP,const int KP,const int NT,char*shm,const int tid_in){
  const int tid=tid_in,lane=tid&63,r32=lane&31,hi=lane>>5; const int wid=__builtin_amdgcn_readfirstlane(tid>>6);
  const bf16*Qw=Qu+(long)(wid*QBLK)*QP;
  const unsigned lds0=(unsigned)(uintptr_t)shm;
  float*wsf=(float*)(shm+LDS_WS)+wid*64;
  const bf16*ksrc=Kh+(long)lane*KP+wid*8;
  const bf16*vsrc=Vh+(long)(16*(wid&3)+(lane>>2))*KP+(wid>>2)*32+(lane&3)*8;
  const unsigned kdst=lds0+LDS_K+wid*1024, vdst=lds0+LDS_V+wid*1024;
  #define DMA_K(t,slot) glds16(ksrc+(long)(t)*KVBLK*KP,(unsigned)__builtin_amdgcn_readfirstlane(kdst+(slot)))
  #define DMA_V(t,slot) glds16(vsrc+(long)(t)*KVBLK*KP,(unsigned)__builtin_amdgcn_readfirstlane(vdst+(slot)))
  const int vb0=(int)(lds0+LDS_V)+((lane>>4)&1)*32+(lane&3)*8+(4*hi+((lane&15)>>2))*64;
  const char*Kbase=shm+LDS_K; bf16x8 kf[8];
  const lds_cptr shm3=(lds_cptr)shm; const lds_cptr kp0=shm3+LDS_K+hi*1024+r32*16; const lds_cptr vp0=shm3+LDS_V+((lane>>4)&1)*32+(lane&3)*8+(4*hi+((lane&15)>>2))*64;
  DMA_K(0,0);DMA_V(0,0);DMA_K(1,SLOTB);
  bf16x8 qr[4];
  #pragma unroll
  for(int d0=0;d0<4;++d0)qr[d0]=*reinterpret_cast<const bf16x8*>(&Qw[(long)r32*QP+d0*16+hi*8]);
  float mhat=0.f,l_reg=0.f;f32x16 o[2];o[0]=f32x16{};o[1]=f32x16{};f32x16 negm; {float zf_; asm volatile("v_mov_b32 %0, 0":"=v"(zf_)); _Pragma("unroll") for(int r=0;r<16;++r)negm[r]=zf_;} asm volatile("":"+v"(negm));
  #define CMASK(P0,P1,t) do{}while(0)
  bool resc=false;
  #define START(P0,P1) do{ const float rm=rowmax(P0,P1); resc=false; \
    { const float dl=rm; mhat=fadd_s(mhat,dl); \
      _Pragma("unroll") for(int r=0;r<16;++r){P0[r]=fsub_s(P0[r],dl);P1[r]=fsub_s(P1[r],dl);} \
      _Pragma("unroll") for(int r=0;r<16;++r)negm[r]=-mhat; asm volatile("":"+v"(negm)); } \
    _Pragma("unroll") for(int r=0;r<16;++r)P0[r]=__builtin_amdgcn_exp2f(P0[r]); }while(0)
  #define RESC() do{ if(resc){ asm volatile("s_waitcnt lgkmcnt(0)":::"memory"); \
      _Pragma("unroll") for(int d_=0;d_<2;++d_) _Pragma("unroll") for(int r=0;r<16;++r)o[d_][r]*=wsf[crow(r,hi)]; } }while(0)
  f32x16 pA0,pA1,pB0,pB1;
  int sl_prev=0,sl_cur=0,sl_next=SLOTB;
  #define ROT() do{sl_prev=sl_cur;sl_cur=sl_next;sl_next=(sl_next==(NSLOT-1)*SLOTB)?0:sl_next+SLOTB;}while(0)
  DMA_K(2,2*SLOTB);
  WAIT_BAR(3);
  qkt(pA0,pA1,Kbase,qr,negm,r32,hi);asm volatile("s_nop 15\n\ts_nop 7":"+v"(pA0),"+v"(pA1));CMASK(pA0,pA1,0);
  START(pA0,pA1);
  _Pragma("unroll") for(int r=0;r<16;++r)pA1[r]=__builtin_amdgcn_exp2f(pA1[r]);
  WAIT_BAR(0);
  DMA_K(3,0);DMA_V(1,SLOTB);
  ROT();
  kload8(kf,kp0+sl_cur);
  WAIT_BAR(2);
  s16x4 vlo[8],vhi[8]; u32x4 pw0,pw1,pw2,pw3;
  #define PKW(P,B) cvtpk_s(P[B],P[B+1])
  #define PAF(k) __builtin_bit_cast(bf16x8,pw##k)
  #define VFR(i) (bf16x8){vlo[i][0],vlo[i][1],vlo[i][2],vlo[i][3],vhi[i][0],vhi[i][1],vhi[i][2],vhi[i][3]}
  #define PIN(x) asm volatile("":"+v"(x))
  #define MX3(a,b,c) __builtin_fmaxf(__builtin_fmaxf((a),(b)),(c))
  #define GAPA(MF,A0,A1,A2,A3,W0,W1,PW) do{ MF; sacc+=A0; sacc+=A1; sacc+=A2; sacc+=A3; PIN(sacc); W0; W1; PIN(PW); SBAR(); }while(0)
  #define EX(v) __builtin_amdgcn_exp2f(v)
  #define GAPB(MF,X,B) do{ MF; X[B]=EX(X[B]); X[B+1]=EX(X[B+1]); X[B+2]=EX(X[B+2]); X[B+3]=EX(X[B+3]); PIN(X); SBAR(); }while(0)
  #define VRD(i) do{ vlo[i]=vtr(vp_+(((i)>>2)*4096+((i)&3)*1024)); vhi[i]=vtr(vp_+(((i)>>2)*4096+((i)&3)*1024+512)); }while(0)
  #define KRD(G,j) do{ if(G){ kload2(kf,kp0+sl_next,j); SBAR(); } }while(0)
  #define STEP(C0,C1,P0,P1,t,GK,GV,GL) do{ SBAR(); \
    const lds_cptr vp_=vp0+sl_prev; \
    VRD(0); SBAR(); float sacc=(P0[0]+P0[1]); \
    GAPA(C0=__builtin_amdgcn_mfma_f32_32x32x16_bf16(kf[0],qr[0],negm,0,0,0), P0[2],P0[3],P0[4],P0[5],     pw0[0]=PKW(P0,0), pw0[1]=PKW(P0,2), pw0); \
    VRD(4); SBAR(); GAPA(C1=__builtin_amdgcn_mfma_f32_32x32x16_bf16(kf[1],qr[0],negm,0,0,0), P0[6],P0[7],P0[8],P0[9],     pw0[2]=PKW(P0,4), pw0[3]=PKW(P0,6), pw0); \
    VRD(1); SBAR(); GAPA(C0=__builtin_amdgcn_mfma_f32_32x32x16_bf16(kf[2],qr[1],C0,0,0,0),   P0[10],P0[11],P0[12],P0[13], pw1[0]=PKW(P0,8), pw1[1]=PKW(P0,10), pw1); \
    VRD(5); SBAR(); GAPA(C1=__builtin_amdgcn_mfma_f32_32x32x16_bf16(kf[3],qr[1],C1,0,0,0),   P0[14],P0[15],P1[0],P1[1],   pw1[2]=PKW(P0,12),pw1[3]=PKW(P0,14), pw1); \
    VRD(2); SBAR(); GAPA(C0=__builtin_amdgcn_mfma_f32_32x32x16_bf16(kf[4],qr[2],C0,0,0,0),   P1[2],P1[3],P1[4],P1[5],     pw2[0]=PKW(P1,0), pw2[1]=PKW(P1,2), pw2); \
    VRD(6); SBAR(); GAPA(C1=__builtin_amdgcn_mfma_f32_32x32x16_bf16(kf[5],qr[2],C1,0,0,0),   P1[6],P1[7],P1[8],P1[9],     pw2[2]=PKW(P1,4), pw2[3]=PKW(P1,6), pw2); \
    VRD(3); SBAR(); GAPA(C0=__builtin_amdgcn_mfma_f32_32x32x16_bf16(kf[6],qr[3],C0,0,0,0),   P1[10],P1[11],P1[12],P1[13], pw3[0]=PKW(P1,8), pw3[1]=PKW(P1,10), pw3); \
    VRD(7); SBAR(); GAPA(C1=__builtin_amdgcn_mfma_f32_32x32x16_bf16(kf[7],qr[3],C1,0,0,0),   P1[14],P1[15],0.f,0.f,       pw3[2]=PKW(P1,12),pw3[3]=PKW(P1,14), pw3); \
    l_reg+=sacc; \
    if(GK){DMA_K((t)+3,sl_cur);} if(GV){DMA_V((t)+1,sl_next);} \
    CMASK(C0,C1,t); \
    { float a=MX3(C0[0],C0[1],C1[0]),b=MX3(C0[2],C0[3],C1[1]); a=MX3(a,C1[2],C1[3]); \
      _Pragma("unroll") for(int r=4;r<16;r+=4){a=MX3(a,C0[r],C0[r+1]);b=MX3(b,C0[r+2],C0[r+3]);a=MX3(a,C1[r],C1[r+1]);b=MX3(b,C1[r+2],C1[r+3]);} \
      float rm=__builtin_fmaxf(a,b); { auto rr=__builtin_amdgcn_permlane32_swap(__float_as_uint(rm),__float_as_uint(rm),false,false); rm=__builtin_fmaxf(__uint_as_float(rr[0]),__uint_as_float(rr[1])); } \
      resc=false; \
      if(__builtin_expect(__any(rm>(float)THRL),0)){ const float dl=__builtin_fmaxf(rm,0.f); mhat+=dl; \
        _Pragma("unroll") for(int r=0;r<16;++r){C0[r]-=dl;C1[r]-=dl;} \
        _Pragma("unroll") for(int r=0;r<16;++r)negm[r]=-mhat; asm volatile("":"+v"(negm)); \
        const float f=__builtin_amdgcn_exp2f(-dl); l_reg*=f; if(hi==0)wsf[r32]=f; resc=true; } } \
    SBAR(); \
    GAPB(o[0]=__builtin_amdgcn_mfma_f32_32x32x16_bf16(PAF(0),VFR(0),o[0],0,0,0), C0,0); \
    GAPB(o[1]=__builtin_amdgcn_mfma_f32_32x32x16_bf16(PAF(0),VFR(4),o[1],0,0,0), C0,4); \
    KRD(GL,0); GAPB(o[0]=__builtin_amdgcn_mfma_f32_32x32x16_bf16(PAF(1),VFR(1),o[0],0,0,0), C0,8); \
    KRD(GL,1); GAPB(o[1]=__builtin_amdgcn_mfma_f32_32x32x16_bf16(PAF(1),VFR(5),o[1],0,0,0), C0,12); \
    KRD(GL,2); GAPB(o[0]=__builtin_amdgcn_mfma_f32_32x32x16_bf16(PAF(2),VFR(2),o[0],0,0,0), C1,0); \
    KRD(GL,3); GAPB(o[1]=__builtin_amdgcn_mfma_f32_32x32x16_bf16(PAF(2),VFR(6),o[1],0,0,0), C1,4); \
    GAPB(o[0]=__builtin_amdgcn_mfma_f32_32x32x16_bf16(PAF(3),VFR(3),o[0],0,0,0), C1,8); \
    GAPB(o[1]=__builtin_amdgcn_mfma_f32_32x32x16_bf16(PAF(3),VFR(7),o[1],0,0,0), C1,12); \
    }while(0)
  int t=1;
  #undef CMASK
  #define CMASK(P0,P1,t) do{}while(0)
  for(;t+5<NT;t+=2){
    STEP(pB0,pB1,pA0,pA1,t,true,true,true);     WAIT_BAR(2); RESC(); ROT();
    STEP(pA0,pA1,pB0,pB1,t+1,true,true,true);   WAIT_BAR(2); RESC(); ROT();
  }
  #undef CMASK
  #define CMASK(P0,P1,t) do{}while(0)
  #define ENDW(tt) do{ if((tt)+3<NT){WAIT_BAR(2);} else if((tt)+2<NT){WAIT_BAR(1);} else {WAIT_BAR(0);} }while(0)
  for(;t+1<NT;t+=2){
    STEP(pB0,pB1,pA0,pA1,t,(t+3<NT),(t+1<NT),(t+1<NT));       ENDW(t);   RESC(); ROT();
    STEP(pA0,pA1,pB0,pB1,t+1,(t+4<NT),(t+2<NT),(t+2<NT));     ENDW(t+1); RESC(); ROT();
  }
  STEP(pB0,pB1,pA0,pA1,NT-1,false,false,false); RESC();
  { float sacc=pB0[0]+pB0[1]; _Pragma("unroll") for(int r=2;r<16;++r)sacc+=pB0[r]; _Pragma("unroll") for(int r=0;r<16;++r)sacc+=pB1[r]; l_reg+=sacc;
    pw0=(u32x4){PKW(pB0,0),PKW(pB0,2),PKW(pB0,4),PKW(pB0,6)};pw1=(u32x4){PKW(pB0,8),PKW(pB0,10),PKW(pB0,12),PKW(pB0,14)};pw2=(u32x4){PKW(pB1,0),PKW(pB1,2),PKW(pB1,4),PKW(pB1,6)};pw3=(u32x4){PKW(pB1,8),PKW(pB1,10),PKW(pB1,12),PKW(pB1,14)};
    SBAR(); pv(o,vb0+sl_cur,PAF(0),PAF(1),PAF(2),PAF(3)); }
  #undef PKW
  #undef PAF
  #undef VFR
  #undef PIN
  #undef MX3
  #undef GAPA
  #undef GAPB
  #undef EX
  #undef VRD
  #undef KRD
  #undef STEP
  #undef ENDW
  {auto rr=__builtin_amdgcn_permlane32_swap(__float_as_uint(l_reg),__float_as_uint(l_reg),false,false);l_reg=__uint_as_float(rr[0])+__uint_as_float(rr[1]);}
  if(hi==0)wsf[32+r32]=l_reg;asm volatile("s_waitcnt lgkmcnt(0)":::"memory");
  float rli[16];
  #pragma unroll
  for(int r=0;r<16;++r)rli[r]=__builtin_amdgcn_rcpf(wsf[32+crow(r,hi)]);
  bf16*Ow=Ou+(long)(wid*QBLK)*QP; const bf16*Gw=Gu+(long)(wid*QBLK)*QP;
  { bf16*stg=(bf16*)(shm+LDS_OST)+wid*2048;
    #pragma unroll
    for(int r=0;r<16;++r){const int orow=crow(r,hi);
      #pragma unroll
      for(int d0=0;d0<2;++d0)stg[orow*64+d0*32+r32]=__float2bfloat16(o[d0][r]*rli[r]);}
    asm volatile("s_waitcnt lgkmcnt(0)":::"memory");
    #pragma unroll
    for(int i=0;i<4;++i){const int row=i*8+(lane>>3),ch=lane&7; const u32x4 v=*(const u32x4*)(stg+row*64+ch*8); const u32x4 gv=*(const u32x4*)(Gw+(long)row*QP+ch*8); u32x4 w;
      #pragma unroll
      for(int e=0;e<4;++e){const float a0=__uint_as_float(v[e]<<16)*__uint_as_float(gv[e]<<16),a1=__uint_as_float(v[e]&0xffff0000u)*__uint_as_float(gv[e]&0xffff0000u); w[e]=cvtpk_s(a0,a1);}
      *(u32x4*)(Ow+(long)row*QP+ch*8)=w;} }
  asm volatile("s_waitcnt lgkmcnt(0)\n\ts_barrier":::"memory");
  #undef DMA_K
  #undef DMA_V
  #undef CMASK
  #undef START
  #undef RESC
  #undef ROT
}
constexpr int ATTN_LDS_BYTES=LDS_BYTES;
#undef SBAR
#undef WAIT_BAR
}

#define GAS __attribute__((address_space(1)))
#define LAS __attribute__((address_space(3)))
typedef unsigned short bf16;
typedef unsigned v4u __attribute__((ext_vector_type(4)));
typedef float f32x4 __attribute__((ext_vector_type(4)));
typedef short bf16x8 __attribute__((ext_vector_type(8)));
typedef GAS unsigned gu32;
typedef GAS unsigned long long gu64;
#define RLX_AGENT __ATOMIC_RELAXED, __HIP_MEMORY_SCOPE_AGENT
#define LDS_WAIT() asm volatile("s_waitcnt lgkmcnt(0)" ::: "memory")
#define VM_WAIT() asm volatile("s_waitcnt vmcnt(0)" ::: "memory")
__device__ __forceinline__ unsigned long long rt() { return __builtin_amdgcn_s_memrealtime(); }
__device__ __forceinline__ unsigned f2bf(float f) { unsigned u = __builtin_bit_cast(unsigned, f); return (u + 0x7fffu + ((u >> 16) & 1u)) >> 16; }
__device__ __forceinline__ unsigned pk2(float lo, float hi) { return f2bf(lo) | (f2bf(hi) << 16); }

#define XB_TMO      128
#define XB_XCNT(j)  (256  + 64 * (j))
#define XB_XSUB(j)  (1280 + 64 * (j))
#define XB_XGEN(j)  (2304 + 64 * (j))
#define XB_TOP      3328
#define XB_TOPGEN   3392
#define XCD_BAR_WORDS 3456
#define XB_SPIN_CAP (1u << 18)

__device__ __forceinline__ unsigned xb_ld(unsigned* p)              { return __hip_atomic_load(p, __ATOMIC_RELAXED, __HIP_MEMORY_SCOPE_AGENT); }
__device__ __forceinline__ unsigned xb_add(unsigned* p, unsigned v) { return __hip_atomic_fetch_add(p, v, __ATOMIC_RELAXED, __HIP_MEMORY_SCOPE_AGENT); }
__device__ __forceinline__ unsigned xb_xcc_id() { return (unsigned)__builtin_amdgcn_s_getreg((3 << 11) | 20) & 0xFu; }
#define XB_SPIN(cond, bar) do { unsigned _sp = 0; while (cond) { __builtin_amdgcn_s_sleep(1); \
    if ((++_sp & 255u) == 0u) { if (xb_ld(&(bar)[XB_TMO])) break; if (_sp > XB_SPIN_CAP) { atomicAdd(&(bar)[XB_TMO], 1u); break; } } } } while (0)

struct XcdBarrier {
    unsigned* bar; unsigned x;
    volatile LAS unsigned* st;
};

__device__ __forceinline__ XcdBarrier xcd_barrier_post(unsigned* bar, volatile LAS unsigned* st, const int tid) {
    XcdBarrier b; b.bar = bar; b.x = xb_xcc_id(); b.st = st;
    if (tid == 0) (void)xb_add(&bar[XB_XCNT(b.x)], 1u);
    return b;
}
__device__ __forceinline__ void xcd_barrier_complete(unsigned* bar, unsigned x, unsigned& nloc, unsigned& nx) {
    const unsigned G = gridDim.x * gridDim.y * gridDim.z;
    unsigned sum, cnt, mine, sp = 0u;
    for (;;) {
        sum = 0u; cnt = 0u; mine = 0u;
#pragma unroll
        for (unsigned j = 0; j < 16; ++j) { const unsigned c = xb_ld(&bar[XB_XCNT(j)]); sum += c; cnt += (c > 0u) ? 1u : 0u; mine = (j == x) ? c : mine; }
        if (sum == G) break;
        __builtin_amdgcn_s_sleep(1);
        if ((++sp & 255u) == 0u) { if (xb_ld(&bar[XB_TMO])) break; if (sp > XB_SPIN_CAP) { atomicAdd(&bar[XB_TMO], 1u); break; } }
    }
    nloc = mine > 0u ? mine : 1u; nx = cnt > 0u ? cnt : 1u;
}

__device__ __forceinline__ void xcd_barrier(const XcdBarrier& b, const int tid) {
    asm volatile("s_waitcnt vmcnt(0)" ::: "memory");
    __syncthreads();
    if (tid == 0) {
        unsigned* bar = b.bar; asm volatile("" : "+s"(bar));
        __builtin_amdgcn_s_waitcnt(0);
        unsigned nloc = b.st[0], nx = b.st[1];
        if (nloc == 0u) { unsigned xx = b.x; asm volatile("" : "+s"(xx)); xcd_barrier_complete(bar, xx, nloc, nx); b.st[0] = nloc; b.st[1] = nx; }
        const unsigned old = xb_add(&bar[XB_XSUB(b.x)], 1u);
        const unsigned gen = old / nloc;
        if (old + 1u == (gen + 1u) * nloc) {
            __builtin_amdgcn_fence(__ATOMIC_RELEASE, "agent");
            asm volatile("s_waitcnt vmcnt(0)" ::: "memory");
            const unsigned og = xb_add(&bar[XB_TOP], 1u);
            const unsigned tg = og / nx;
            if (og + 1u == (tg + 1u) * nx) xb_add(&bar[XB_TOPGEN], 1u);
            else XB_SPIN(xb_ld(&bar[XB_TOPGEN]) == tg, bar);
            __builtin_amdgcn_fence(__ATOMIC_ACQUIRE, "agent");
            xb_add(&bar[XB_XGEN(b.x)], 1u);
            asm volatile("s_waitcnt vmcnt(0)" ::: "memory");
        } else {
            XB_SPIN(xb_ld(&bar[XB_XGEN(b.x)]) == gen, bar);
            __builtin_amdgcn_fence(__ATOMIC_ACQUIRE, "agent");
            asm volatile("s_waitcnt vmcnt(0)" ::: "memory");
        }
    }
    __syncthreads();
}


constexpr int NWAVES = 8, NTHR = 512, GRID = 256;
constexpr int T_TOK = 8192, T_CTX = 4096, DMOD = 1024, BW = 512, INW = 3328, NCAT = 6400, DEPTH = 4;
constexpr int S_LAT = 2048, LKV = 2304, KVW = 128;
constexpr float RMS_EPS = 1e-6f;
constexpr float QSCALE = 0.125f * 1.4426950408889634f;
constexpr size_t MiB = 1u << 20;
constexpr size_t WS_CTL = 0, CTL_ZERO_BYTES = MiB;
constexpr size_t WS_MODF = 1 * MiB;
constexpr size_t WS_ROPE = 1 * MiB + 768 * 1024;
constexpr size_t WS_A16 = 1 * MiB + 832 * 1024;
constexpr size_t WS_WCAT = 2 * MiB;
constexpr size_t WS_WGLU = 15 * MiB;
constexpr size_t WS_WFN = 16 * MiB;
constexpr size_t WS_WBR = 17 * MiB;
constexpr size_t WS_WOUT = 20 * MiB;
constexpr size_t WS_BTE = 22 * MiB;
constexpr size_t WS_BTY = 26 * MiB;
constexpr size_t WS_A2L = 34 * MiB;
constexpr size_t WS_GY = 42 * MiB;
constexpr size_t WS_A2C = 50 * MiB;
constexpr size_t WS_A1P = 50 * MiB + 512 * 1024;
constexpr size_t WS_XRES = 51 * MiB;
constexpr size_t WS_G = 83 * MiB;
constexpr size_t WS_H = 131 * MiB;
constexpr size_t WS_VTC = 147 * MiB;
constexpr size_t WS_VTL = 248 * MiB;
constexpr size_t WS_GA = 155 * MiB;
constexpr size_t WS_GF = 163 * MiB;
constexpr size_t WS_Q = 171 * MiB;
constexpr size_t WS_UF = 179 * MiB;
constexpr size_t WS_GC = 187 * MiB;
constexpr size_t WS_KC = 195 * MiB, WS_KL = 196 * MiB;
constexpr size_t WS_VC = WS_KC + 5 * MiB / 2, WS_VL = WS_KL + 5 * MiB / 2;
constexpr size_t WS_PB = 200 * MiB;
constexpr size_t WS_SC = 216 * MiB;
constexpr size_t WS_UH = 232 * MiB;
constexpr size_t WS_END = 256 * MiB;
constexpr int CW_BAR = 4096;
constexpr size_t OUT_K = 8388608, OUT_V = 10485760, OUT_S = 12582912, OUT_N = 13107200;
constexpr int RING_BYTES = 131072, LDSCTL_OFF = RING_BYTES, MISC_OFF = LDSCTL_OFF + 320, LDS_BYTES = 147456;

typedef float f32x2 __attribute__((ext_vector_type(2)));
typedef unsigned u32x2 __attribute__((ext_vector_type(2)));
__device__ __forceinline__ unsigned cvtpk(float lo, float hi) { typedef __bf16 bf16x2_t __attribute__((ext_vector_type(2))); f32x2 v = {lo, hi}; bf16x2_t b = __builtin_convertvector(v, bf16x2_t); return __builtin_bit_cast(unsigned, b); }
__device__ __forceinline__ void st_bf4(bf16* p, f32x4 v) { u32x2 w; w.x = cvtpk(v[0], v[1]); w.y = cvtpk(v[2], v[3]); *(u32x2*)p = w; }
__device__ __forceinline__ f32x4 ld_bf4(const bf16* p) { const u32x2 w = *(const u32x2*)p; f32x4 r; r[0] = __uint_as_float(w.x << 16); r[1] = __uint_as_float(w.x & 0xffff0000u); r[2] = __uint_as_float(w.y << 16); r[3] = __uint_as_float(w.y & 0xffff0000u); return r; }
__device__ __forceinline__ f32x4 bf4_to_f(u32x2 w) { f32x4 r; r[0] = __uint_as_float(w.x << 16); r[1] = __uint_as_float(w.x & 0xffff0000u); r[2] = __uint_as_float(w.y << 16); r[3] = __uint_as_float(w.y & 0xffff0000u); return r; }
__device__ __forceinline__ float bf2f(bf16 h) { return __uint_as_float((unsigned)h << 16); }
__device__ __forceinline__ float sigmoidf_(float x) { return __builtin_amdgcn_rcpf(1.0f + __expf(-x)); }
__device__ __forceinline__ f32x4 sigmoid4(f32x4 v) { f32x4 r; r[0] = sigmoidf_(v[0]); r[1] = sigmoidf_(v[1]); r[2] = sigmoidf_(v[2]); r[3] = sigmoidf_(v[3]); return r; }
__device__ __forceinline__ f32x4 silu4(f32x4 v) { return v * sigmoid4(v); }
__device__ __forceinline__ float gelu_tanh(float x) { const float y = 0.7978845608028654f * (x + 0.044715f * x * x * x); return x * sigmoidf_(2.0f * y); }
__device__ __forceinline__ float shx(float v, int mask, int lane) { return __int_as_float(__builtin_amdgcn_ds_bpermute((lane ^ mask) << 2, __float_as_int(v))); }
__device__ __forceinline__ float wave_sum(float v, int lane) {
#pragma unroll
    for (int o = 1; o < 64; o <<= 1) v += shx(v, o, lane);
    return v;
}

struct KArgs { const float* in[28]; float* out; unsigned char* ws; int ph_lo, ph_hi; };
enum { I_XP = 0, I_XS, I_CK, I_CV, I_ST, I_C, I_CCTX, I_NORMG, I_ADAW, I_ADAB, I_WIN, I_ARE, I_AIM, I_LDT, I_BRE, I_BIM, I_CRE, I_CIM, I_SD, I_GLU, I_FN, I_QG, I_KG, I_WBR, I_MW, I_MB, I_WOUT, I_FG };

struct Ctx {
    LAS unsigned char* lds; int tid, lane, wave, bid, vcu, gw, ngw;
    const float* const* in; float* out; unsigned char* ws;
    template <class Tp> __device__ __forceinline__ Tp* w(size_t off) const { return (Tp*)(ws + off); }
};

__device__ __forceinline__ int epi_opaque(int x) { asm volatile("" : "+v"(x)); return x; }
#define EPI_ROWS for (int ai = 0; ai < 2; ++ai) _Pragma("unroll") for (int m = 0; m < 4; ++m)
#define EPI_BJ for (int bj = 0; bj < 2; ++bj)
#define EPI_ROW epi_opaque(u.pm * 256 + ai * 128 + wr * 64 + m * 16 + fr)
#define EPI_C8 (bj * 128 + wc * 32 + fq * 8)
#define EPI_COL8 (u.pn * 256 + EPI_C8)
typedef const f32x4 (&AccRef)[2][2][4][2];
__device__ __forceinline__ void st_bf8(bf16* p, f32x4 lo, f32x4 hi) { v4u w; w.x = cvtpk(lo[0], lo[1]); w.y = cvtpk(lo[2], lo[3]); w.z = cvtpk(hi[0], hi[1]); w.w = cvtpk(hi[2], hi[3]); *(v4u*)p = w; }
__device__ __forceinline__ f32x4 bf8_lo(v4u w) { f32x4 r; r[0] = __uint_as_float(w.x << 16); r[1] = __uint_as_float(w.x & 0xffff0000u); r[2] = __uint_as_float(w.y << 16); r[3] = __uint_as_float(w.y & 0xffff0000u); return r; }
__device__ __forceinline__ f32x4 bf8_hi(v4u w) { f32x4 r; r[0] = __uint_as_float(w.z << 16); r[1] = __uint_as_float(w.z & 0xffff0000u); r[2] = __uint_as_float(w.w << 16); r[3] = __uint_as_float(w.w & 0xffff0000u); return r; }

struct EpiG1 {
    static constexpr bool PERM = true, AFTER_DRAIN = false;
    unsigned char* ws; float* out; const float *qg, *kg; int layer;
#define EG1_P(name, off) bf16* const name = (bf16*)(ws + (off))
    __device__ __forceinline__ void qkv(AccRef acc, const pg8::Unit& u, int wr, int wc, int fr, int fq) const {
        const int pn = u.pn; const bool isq = pn < 10;
        EG1_P(Q, WS_Q); EG1_P(Kc, WS_KC); EG1_P(Vc, WS_VC); EG1_P(Kl, WS_KL); EG1_P(Vl, WS_VL); float* const outK = out + OUT_K; float* const outV = out + OUT_V; const float* const rope = (const float*)(ws + WS_ROPE);
        const int kind = isq ? 0 : (wc < 2 ? 1 : 2);
        const int head = isq ? (pn - 8) * 4 + wc : (wc & 1);
        f32x4 gv[2][2];
        if (kind == 0) {
#pragma unroll
            EPI_BJ { gv[bj][0] = *(const f32x4*)(qg + layer * 64 + 32 * bj + 8 * fq); gv[bj][1] = *(const f32x4*)(qg + layer * 64 + 32 * bj + 8 * fq + 4); }
        } else {
#pragma unroll
            EPI_BJ { gv[bj][0] = *(const f32x4*)(kg + layer * 64 + 32 * bj + 8 * fq); gv[bj][1] = *(const f32x4*)(kg + layer * 64 + 32 * bj + 8 * fq + 4); }
        }
        const bool lat = u.pm >= 16;
#pragma unroll
        EPI_ROWS {
            const int row = EPI_ROW;
            f32x4 x[2][2];
#pragma unroll
            EPI_BJ { x[bj][0] = acc[ai][bj][m][0]; x[bj][1] = acc[ai][bj][m][1]; }
            if (kind != 2) {
                float ss = 0.f;
#pragma unroll
                EPI_BJ {
#pragma unroll
                    for (int n = 0; n < 2; ++n) { const f32x4 t = x[bj][n]; ss += (t[0] * t[0] + t[1] * t[1]) + (t[2] * t[2] + t[3] * t[3]); } }
                ss += shx(ss, 16, fq * 16 + fr); ss += shx(ss, 32, fq * 16 + fr);
                const float rstd = rsqrtf(ss * (1.0f / 64.0f) + RMS_EPS);
#pragma unroll
                EPI_BJ { x[bj][0] = x[bj][0] * rstd * gv[bj][0]; x[bj][1] = x[bj][1] * rstd * gv[bj][1]; }
            }
            int b, s;
            if (lat) { const int tl = row - T_CTX; b = tl >> 11; s = tl & 2047; } else { b = row >> 8; s = row & 255; }
            if (lat && kind != 2) {
                const int gr = s >> 6, gc = s & 63;
#pragma unroll
                EPI_BJ {
#pragma unroll
                    for (int n = 0; n < 2; ++n) { const int pos = bj ? gc : gr; const f32x4 cs = *(const f32x4*)(rope + (pos * 16 + 4 * fq + 2 * n) * 2); const f32x4 t = x[bj][n];
                        f32x4 r; r[0] = t[0] * cs[0] - t[1] * cs[1]; r[1] = t[0] * cs[1] + t[1] * cs[0]; r[2] = t[2] * cs[2] - t[3] * cs[3]; r[3] = t[2] * cs[3] + t[3] * cs[2]; x[bj][n] = r; } }
            }
#pragma unroll
            EPI_BJ { const int j = 32 * bj + 8 * fq;
                const size_t ol = ((size_t)b * LKV + s) * KVW + head * 64 + j, oc = (size_t)row * KVW + head * 64 + j, oo = (((size_t)b * DEPTH + layer) * 256 + s) * KVW + head * 64 + j;
                if (kind == 0) st_bf8(Q + (size_t)row * 512 + head * 64 + j, x[bj][0] * QSCALE, x[bj][1] * QSCALE);
                else if (kind == 1) { if (lat) st_bf8(Kl + ol, x[bj][0], x[bj][1]); else { st_bf8(Kc + oc, x[bj][0], x[bj][1]); *(f32x4*)(outK + oo) = x[bj][0]; *(f32x4*)(outK + oo + 4) = x[bj][1]; } }
                else { if (lat) st_bf8(Vl + ol, x[bj][0], x[bj][1]); else { st_bf8(Vc + oc, x[bj][0], x[bj][1]); *(f32x4*)(outV + oo) = x[bj][0]; *(f32x4*)(outV + oo + 4) = x[bj][1]; } } }
            asm volatile("" ::: "memory");
        }
    }
    __device__ __forceinline__ void operator()(AccRef acc, const pg8::Unit& u, int wr, int wc, int fr, int fq) const {
        const int pn = u.pn;
        if (pn >= 8 && pn <= 10) { qkv(acc, u, wr, wc, fr, fq); return; }
        EG1_P(UH, WS_UH); EG1_P(GA, WS_GA); EG1_P(UF, WS_UF); EG1_P(GF, WS_GF); EG1_P(GC, WS_GC);
#pragma unroll
        EPI_ROWS { const int row = EPI_ROW;
#pragma unroll
            EPI_BJ { const int col = EPI_COL8; const f32x4 lo = acc[ai][bj][m][0], hi = acc[ai][bj][m][1];
                if (pn < 2) { const int g = col >> 4, q = col & 15; st_bf8(UH + ((size_t)g * 512 + (row >> 4)) * 512 + (row & 15) * 16 + q, lo, hi); }
                else if (pn < 4) st_bf8(GA + (size_t)row * 512 + (col - 512), silu4(lo), silu4(hi));
                else if (pn < 6) st_bf8(UF + (size_t)row * 512 + (col - 1024), lo, hi);
                else if (pn < 8) st_bf8(GF + (size_t)row * 512 + (col - 1536), silu4(lo), silu4(hi));
                else st_bf8(GC + (size_t)row * 512 + (col - 2816), silu4(lo), silu4(hi));
            } }
    }
};
struct EpiMerge {
    static constexpr bool PERM = true, AFTER_DRAIN = false;
    bf16* Gm; const float* mb;
    __device__ __forceinline__ void operator()(AccRef acc, const pg8::Unit& u, int wr, int wc, int fr, int fq) const {
        f32x4 bb[2][2];
#pragma unroll
        EPI_BJ { bb[bj][0] = *(const f32x4*)(mb + EPI_COL8); bb[bj][1] = *(const f32x4*)(mb + EPI_COL8 + 4); }
#pragma unroll
        EPI_ROWS { const size_t row = EPI_ROW;
#pragma unroll
            EPI_BJ st_bf8(Gm + row * 3072 + EPI_COL8, sigmoid4(acc[ai][bj][m][0] + bb[bj][0]), sigmoid4(acc[ai][bj][m][1] + bb[bj][1])); }
    }
};
struct EpiS5A {
    static constexpr bool PERM = true, AFTER_DRAIN = false;
    float* SC;
    __device__ __forceinline__ void operator()(AccRef acc, const pg8::Unit& u, int wr, int wc, int fr, int fq) const {
#pragma unroll
        EPI_ROWS { const int chunk = EPI_ROW;
#pragma unroll
            EPI_BJ { float* p = SC + ((size_t)u.z * 512 + chunk) * 256 + EPI_C8; *(f32x4*)p = acc[ai][bj][m][0]; *(f32x4*)(p + 4) = acc[ai][bj][m][1]; } }
    }
};
__device__ __forceinline__ f32x4 gelu4(f32x4 y) { y[0] = gelu_tanh(y[0]); y[1] = gelu_tanh(y[1]); y[2] = gelu_tanh(y[2]); y[3] = gelu_tanh(y[3]); return y; }
struct EpiS5B {
    static constexpr bool PERM = true, AFTER_DRAIN = false;
    bf16* GY;
    __device__ __forceinline__ void operator()(AccRef acc, const pg8::Unit& u, int wr, int wc, int fr, int fq) const {
#pragma unroll
        EPI_ROWS { const int chunk = EPI_ROW;
#pragma unroll
            EPI_BJ { const int col = EPI_C8, t = col >> 4, p = col & 15; st_bf8(GY + ((size_t)chunk * 16 + t) * 512 + u.z * 16 + p, gelu4(acc[ai][bj][m][0]), gelu4(acc[ai][bj][m][1])); } }
    }
};
struct EpiDFT1C {
    static constexpr bool PERM = true, AFTER_DRAIN = false;
    bf16* VtC;
    __device__ __forceinline__ void operator()(AccRef acc, const pg8::Unit& u, int wr, int wc, int fr, int fq) const {
        const int grp = 2 * u.z + u.pm;
#pragma unroll
        EPI_ROWS { const int j = epi_opaque(wr * 64 + m * 16 + fr), reim = ai;
#pragma unroll
            EPI_BJ { const int tok = EPI_COL8, b = tok >> 8, s = tok & 255; st_bf8(VtC + ((size_t)b * 512 + grp * 128 + j) * 512 + reim * 256 + s, acc[ai][bj][m][0], acc[ai][bj][m][1]); } }
    }
};
struct EpiDFT1L {
    static constexpr bool PERM = true, AFTER_DRAIN = false;
    bf16* VtL;
    __device__ __forceinline__ void operator()(AccRef acc, const pg8::Unit& u, int wr, int wc, int fr, int fq) const {
        const int grp = 2 * u.z + u.pm, b = u.pn >> 4, nn = u.pn & 15;
#pragma unroll
        EPI_ROWS { const int j = epi_opaque(wr * 64 + m * 16 + fr), reim = ai; bf16* dst = VtL + ((size_t)b * 512 + grp * 128 + j) * 2048 + reim * 1024 + nn * 128 + wc * 32 + fq * 8;
            st_bf8(dst, acc[ai][0][m][0] + acc[ai][1][m][0], acc[ai][0][m][1] + acc[ai][1][m][1]);
            st_bf8(dst + (size_t)1024 * 2048, acc[ai][0][m][0] - acc[ai][1][m][0], acc[ai][0][m][1] - acc[ai][1][m][1]); }
    }
};
struct EpiDFT2 {
    static constexpr bool PERM = true, AFTER_DRAIN = false;
    bf16* ZF; int lat, half;
    __device__ __forceinline__ void operator()(AccRef acc, const pg8::Unit& u, int wr, int wc, int fr, int fq) const {
#pragma unroll
        EPI_ROWS { const int k = EPI_ROW;
#pragma unroll
            EPI_BJ { const int col = EPI_COL8, b = col >> 9, ch = col & 511;
                bf16* dst = lat ? ZF + ((size_t)b * 2048 + 2 * k + u.z) * 1024 + half * 512 + ch : ZF + ((size_t)b * 256 + k) * 512 + ch;
                st_bf8(dst, acc[ai][bj][m][0], acc[ai][bj][m][1]); } }
    }
};
#define EPI_BATCH for (int ai = 0; ai < 2; ++ai)
#define EPI_M for (int m = 0; m < 4; ++m)
struct EpiGLU {
    static constexpr bool PERM = true, AFTER_DRAIN = false;
    bf16* GA;
    __device__ __forceinline__ void operator()(AccRef acc, const pg8::Unit& u, int wr, int wc, int fr, int fq) const {
#pragma unroll
        EPI_BATCH { v4u gl[4];
#pragma unroll
            EPI_M { const size_t row = EPI_ROW; gl[m] = *(const v4u*)(GA + row * 512 + u.pn * 128 + wc * 32 + fq * 8); }
            asm volatile("" ::: "memory");
#pragma unroll
            EPI_M { const size_t row = EPI_ROW;
                st_bf8(GA + row * 512 + u.pn * 128 + wc * 32 + fq * 8, acc[ai][0][m][0] * sigmoid4(acc[ai][1][m][0]) * bf8_lo(gl[m]), acc[ai][0][m][1] * sigmoid4(acc[ai][1][m][1]) * bf8_hi(gl[m])); }
            asm volatile("" ::: "memory"); }
    }
};
struct EpiMul {
    static constexpr bool PERM = true, AFTER_DRAIN = false;
    bf16* GF;
    __device__ __forceinline__ void operator()(AccRef acc, const pg8::Unit& u, int wr, int wc, int fr, int fq) const {
#pragma unroll
        EPI_BATCH { v4u gl[4][2];
#pragma unroll
            EPI_M { const size_t row = EPI_ROW;
#pragma unroll
                EPI_BJ gl[m][bj] = *(const v4u*)(GF + row * 512 + EPI_COL8); }
            asm volatile("" ::: "memory");
#pragma unroll
            EPI_M { const size_t row = EPI_ROW;
#pragma unroll
                EPI_BJ st_bf8(GF + row * 512 + EPI_COL8, acc[ai][bj][m][0] * bf8_lo(gl[m][bj]), acc[ai][bj][m][1] * bf8_hi(gl[m][bj])); }
            asm volatile("" ::: "memory"); }
    }
};
struct EpiG4 {
    static constexpr bool PERM = true, AFTER_DRAIN = false;
    const bf16* Gm; bf16* PB; bf16* MG; int mode0;
    __device__ __forceinline__ void operator()(AccRef acc, const pg8::Unit& u, int wr, int wc, int fr, int fq) const {
        const int mode = mode0 + u.z, gsel = mode == 0 ? 2 : mode - 1;
#pragma unroll
        EPI_BATCH { v4u gl[4][2], pl[4][2];
#pragma unroll
            EPI_M { const size_t row = EPI_ROW;
#pragma unroll
                EPI_BJ { gl[m][bj] = *(const v4u*)(Gm + row * 3072 + gsel * 1024 + EPI_COL8); if (mode > 0) pl[m][bj] = *(const v4u*)(PB + row * 1024 + EPI_COL8); } }
            asm volatile("" ::: "memory");
#pragma unroll
            EPI_M { const size_t row = EPI_ROW;
#pragma unroll
                EPI_BJ { f32x4 lo = acc[ai][bj][m][0] * bf8_lo(gl[m][bj]), hi = acc[ai][bj][m][1] * bf8_hi(gl[m][bj]); if (mode > 0) { lo += bf8_lo(pl[m][bj]); hi += bf8_hi(pl[m][bj]); }
                    if (mode < 2) st_bf8(PB + row * 1024 + EPI_COL8, lo, hi); else st_bf8(MG + row * 1024 + EPI_COL8, lo, hi); } }
            asm volatile("" ::: "memory"); }
    }
};
struct EpiChainA {
    const bf16* Gm; const bf16* PB;
    __device__ __forceinline__ void operator()(f32x4 (&acc)[2][2][4][2], const pg8::Unit& u, int wr, int wc, int fr, int fq) const {
#pragma unroll
        for (int ai = 0; ai < 2; ++ai)
#pragma unroll
            for (int mh = 0; mh < 2; ++mh) { v4u g0[2][2], g1[2][2], pl[2][2];
#pragma unroll
                for (int mm = 0; mm < 2; ++mm) { const int m = 2 * mh + mm; const size_t row = EPI_ROW;
#pragma unroll
                    EPI_BJ { g0[mm][bj] = *(const v4u*)(Gm + row * 3072 + EPI_COL8); g1[mm][bj] = *(const v4u*)(Gm + row * 3072 + 1024 + EPI_COL8); pl[mm][bj] = *(const v4u*)(PB + row * 1024 + EPI_COL8); } }
                asm volatile("" ::: "memory");
#pragma unroll
                for (int mm = 0; mm < 2; ++mm) { const int m = 2 * mh + mm;
#pragma unroll
                    EPI_BJ { f32x4 lo = acc[ai][bj][m][0] * bf8_lo(g0[mm][bj]) + bf8_lo(pl[mm][bj]), hi = acc[ai][bj][m][1] * bf8_hi(g0[mm][bj]) + bf8_hi(pl[mm][bj]);
                        const f32x4 gl = bf8_lo(g1[mm][bj]), gh = bf8_hi(g1[mm][bj]);
#pragma unroll
                        for (int e = 0; e < 4; ++e) { lo[e] *= __builtin_amdgcn_rcpf(fmaxf(gl[e], 1e-6f)); hi[e] *= __builtin_amdgcn_rcpf(fmaxf(gh[e], 1e-6f)); }
                        acc[ai][bj][m][0] = lo; acc[ai][bj][m][1] = hi; } }
                asm volatile("" ::: "memory"); }
    }
};
struct EpiChainF {
    const bf16* Gm; bf16* MG;
    __device__ __forceinline__ void operator()(AccRef acc, const pg8::Unit& u, int wr, int wc, int fr, int fq) const {
#pragma unroll
        EPI_BATCH { v4u g1[4][2];
#pragma unroll
            EPI_M { const size_t row = EPI_ROW;
#pragma unroll
                EPI_BJ g1[m][bj] = *(const v4u*)(Gm + row * 3072 + 1024 + EPI_COL8); }
            asm volatile("" ::: "memory");
#pragma unroll
            EPI_M { const size_t row = EPI_ROW;
#pragma unroll
                EPI_BJ { const f32x4 gl = bf8_lo(g1[m][bj]), gh = bf8_hi(g1[m][bj]); f32x4 lo = acc[ai][bj][m][0], hi = acc[ai][bj][m][1];
#pragma unroll
                    for (int e = 0; e < 4; ++e) { lo[e] *= fmaxf(gl[e], 1e-6f); hi[e] *= fmaxf(gh[e], 1e-6f); }
                    st_bf8(MG + row * 1024 + EPI_COL8, lo, hi); } }
            asm volatile("" ::: "memory"); }
    }
};
struct EpiG5 {
    static constexpr bool PERM = true, AFTER_DRAIN = false;
    bf16 *T0, *T1;
    __device__ __forceinline__ void operator()(AccRef acc, const pg8::Unit& u, int wr, int wc, int fr, int fq) const {
        bf16* T = u.z ? T1 : T0;
#pragma unroll
        EPI_ROWS { const size_t row = EPI_ROW;
#pragma unroll
            EPI_BJ st_bf8(T + row * 1024 + EPI_COL8, acc[ai][bj][m][0], acc[ai][bj][m][1]); }
    }
};

enum { K_G1 = 0, K_MERGE, K_S5A, K_S5B, K_DFT1C, K_DFT1L, K_DFT2C, K_DFT2L0, K_DFT2L1, K_GLU, K_FN, K_PC, K_PA, K_PF, K_G5 };
__device__ __forceinline__ int xswz(int L, int n) { return (L & 7) * (n >> 3) + (L >> 3); }
#define PS_W(off) ((const bf16*)(ws + (off)))
struct PhaseSched {
    int sub, c, bid; unsigned char* ws;
    __device__ __forceinline__ void mk(pg8::UDesc& d, const bf16* A, const bf16* Bt, int lda, int ldb, int K, int hB, int kind, int pm, int pn, int z) const {
        d.A = A; d.Bt = Bt; d.lda = lda; d.ldb = ldb; d.K = K; d.hB = hB; d.kind = kind; d.pm = pm; d.pn = pn; d.z = z; d.keep = (kind == K_PF); }
    __device__ __forceinline__ void mk_merge(pg8::UDesc& d, int M, unsigned char* ws) const {
        int pm, pn; if (M < 128) { pm = M >> 2; pn = 8 + (M & 3); } else { pm = (M - 128) >> 3; pn = (M - 128) & 7; }
        mk(d, PS_W(WS_H) + (size_t)pm * 256 * 1024, PS_W(WS_WCAT) + (size_t)(INW + pn * 256) * 1024, 1024, 1024, 1024, 128, K_MERGE, pm, pn, 0); }
    __device__ __forceinline__ bool next(int i, pg8::UDesc& d) const {
        unsigned char* ws = this->ws; asm volatile("" : "+s"(ws));
        if (sub == 1) {
            if (i > 1) return false;
            pg8::StaticOrder so; so.init(T_TOK, INW, GRID, bid); pg8::Unit u;
            if (so.next(i, u)) { mk(d, PS_W(WS_H) + (size_t)u.pm * 256 * 1024, PS_W(WS_WCAT) + (size_t)u.pn * 256 * 1024, 1024, 1024, 1024, 128, K_G1, u.pm, u.pn, 0); return true; }
            if (bid >= 160) { mk_merge(d, xswz(bid - 160, 96), ws); return true; }
            return false;
        }
        if (sub == 2) {
            if (c < 128) return false;
            if (c < 192) { const int L = xswz(c - 128, 64);
                if (i == 0) { const int g = L >> 1, pm = L & 1; mk(d, PS_W(WS_UH) + ((size_t)g * 512 + pm * 256) * 512, PS_W(WS_BTE) + (size_t)g * 256 * 256, 512, 256, 256, 128, K_S5A, pm, 0, g); return true; }
                if (i == 1) { const int pair = L >> 5, gl = (L >> 4) & 1, pn = L & 15; mk(d, PS_W(WS_A1P) + (size_t)gl * 256 * 256, PS_W(WS_UF) + (size_t)pn * 256 * 512 + pair * 256, 256, 512, 256, 128, K_DFT1C, gl, pn, pair); return true; }
                if (i == 2) { mk_merge(d, 96 + xswz(c - 128, 128), ws); return true; }
                return false; }
            const int L = xswz(c - 192, 64);
            if (i == 0) { const int pair = L >> 5, gl = (L >> 4) & 1, r = L & 15, pn2 = (r >> 3) * 16 + (r & 7);
                mk(d, PS_W(WS_A1P) + (size_t)gl * 256 * 256, PS_W(WS_UF) + ((size_t)T_CTX + pn2 * 128) * 512 + pair * 256, 256, 512, 256, 1024, K_DFT1L, gl, pn2, pair); return true; }
            if (i == 1) { mk_merge(d, 96 + xswz(c - 128, 128), ws); return true; }
            return false;
        }
        if (sub == 3) {
            if (c < 64) { if (i > 0) return false; const int half = c >> 5, L = xswz(c & 31, 32), z = L >> 4, pm = (L >> 2) & 3, pn = L & 3;
                mk(d, PS_W(WS_A2L) + ((size_t)z * 1024 + pm * 256) * 2048 + half * 1024, PS_W(WS_VTL) + ((size_t)z * 1024 + pn * 256) * 2048 + half * 1024, 2048, 2048, 1024, 128, half ? K_DFT2L1 : K_DFT2L0, pm, pn, z); return true; }
            if (c < 128) { if (i > 0) return false; const int L = xswz(c - 64, 64), g = L >> 1, pm = L & 1;
                mk(d, PS_W(WS_UH) + ((size_t)g * 512 + pm * 256) * 512, PS_W(WS_BTY) + (size_t)g * 256 * 512, 512, 512, 512, 128, K_S5B, pm, 0, g); return true; }
            if (i == 0) { const int L = xswz(c - 128, 128), pm = L >> 2, pn = L & 3; mk(d, PS_W(WS_Q) + (size_t)pm * 256 * 512, PS_W(WS_WBR) + ((size_t)2 * 1024 + pn * 256) * 512, 512, 512, 512, 128, K_PC, pm, pn, 0); return true; }
            if (i == 1) { if (c < 160) { const int pn = xswz(c - 128, 32); mk(d, PS_W(WS_A2C), PS_W(WS_VTC) + (size_t)pn * 256 * 512, 512, 512, 512, 128, K_DFT2C, 0, pn, 0); return true; }
                mk_merge(d, 224 + xswz(c - 160, 96), ws); return true; }
            return false;
        }
        if (sub == 4) {
            if (i > 0) return false;
            if (c < 128) { const int L = xswz(c, 128), pm = L >> 2, pn = L & 3; mk(d, PS_W(WS_GY) + (size_t)pm * 256 * 512, PS_W(WS_WGLU) + (size_t)pn * 256 * 512, 512, 512, 512, 128, K_GLU, pm, pn, 0); return true; }
            if (c < 160) { const int L = xswz(c - 128, 32), pm = L >> 1, pn = L & 1; mk(d, PS_W(WS_UF) + (size_t)pm * 256 * 512, PS_W(WS_WFN) + (size_t)pn * 256 * 1024, 512, 1024, 512, 128, K_FN, pm, pn, 0); return true; }
            if (c < 192) { const int L = xswz(c - 160, 32), pm = L >> 1, pn = L & 1; mk(d, PS_W(WS_GC) + (size_t)pm * 256 * 1024, PS_W(WS_WFN) + (size_t)pn * 256 * 1024, 1024, 1024, 1024, 128, K_FN, 16 + pm, pn, 0); return true; }
            mk_merge(d, 320 + xswz(c - 192, 64), ws); return true;
        }
        if (sub == 5) {
            if (c >= 128 || i > 1) return false;
            const int t = (c & 7) * 16 + (c >> 3), pm = t >> 2, pn = t & 3;
            if (i == 0) mk(d, PS_W(WS_GA) + (size_t)pm * 256 * 512, PS_W(WS_WBR) + (size_t)pn * 256 * 512, 512, 512, 512, 128, K_PA, pm, pn, 0);
            else mk(d, PS_W(WS_GF) + (size_t)pm * 256 * 512, PS_W(WS_WBR) + ((size_t)1024 + pn * 256) * 512, 512, 512, 512, 128, K_PF, pm, pn, 0);
            return true;
        }
        if (i > 0) return false;
        { const int L = xswz(c, 256), z = L & 1, pm = L >> 3, pn = (L >> 1) & 3; mk(d, PS_W(WS_H) + (size_t)pm * 256 * 1024 + z * 512, PS_W(WS_WOUT) + (size_t)pn * 256 * 1024 + z * 512, 1024, 1024, 512, 128, K_G5, pm, pn, z); return true; }
    }
};
struct EpiAll {
    unsigned char* ws; float* out; const float* const* in; int layer;
    __device__ __forceinline__ bool transform(f32x4 (&acc)[2][2][4][2], const pg8::UDesc& d, int wr, int wc, int fr, int fq) const {
        if (d.kind != K_PA) return false;
        asm volatile("" : "+v"(fr), "+v"(fq), "+s"(wr), "+s"(wc));
        unsigned char* ws = this->ws; asm volatile("" : "+s"(ws));
        EpiChainA{(const bf16*)(ws + WS_G), (const bf16*)(ws + WS_PB)}(acc, pg8::Unit{d.pm, d.pn, d.z}, wr, wc, fr, fq); return true; }
    __device__ __forceinline__ void operator()(AccRef acc, const pg8::UDesc& d, int wr, int wc, int fr, int fq) const {
        asm volatile("" : "+v"(fr), "+v"(fq), "+s"(wr), "+s"(wc));
        const pg8::Unit u{d.pm, d.pn, d.z}; const int kind = d.kind;
        unsigned char* ws = this->ws; float* out = this->out; asm volatile("" : "+s"(ws), "+s"(out));
#define EA_P(off) ((bf16*)(ws + (off)))
        if (kind == K_G1) EpiG1{ws, out, in[I_QG], in[I_KG], layer}(acc, u, wr, wc, fr, fq);
        else if (kind == K_MERGE) EpiMerge{EA_P(WS_G), in[I_MB] + (size_t)layer * 3072}(acc, u, wr, wc, fr, fq);
        else if (kind == K_S5A) EpiS5A{(float*)(ws + WS_SC)}(acc, u, wr, wc, fr, fq);
        else if (kind == K_S5B) EpiS5B{EA_P(WS_GY)}(acc, u, wr, wc, fr, fq);
        else if (kind == K_DFT1C) EpiDFT1C{EA_P(WS_VTC)}(acc, u, wr, wc, fr, fq);
        else if (kind == K_DFT1L) EpiDFT1L{EA_P(WS_VTL)}(acc, u, wr, wc, fr, fq);
        else if (kind == K_DFT2C) EpiDFT2{EA_P(WS_UF), 0, 0}(acc, u, wr, wc, fr, fq);
        else if (kind == K_DFT2L0) EpiDFT2{EA_P(WS_GC), 1, 0}(acc, u, wr, wc, fr, fq);
        else if (kind == K_DFT2L1) EpiDFT2{EA_P(WS_GC), 1, 1}(acc, u, wr, wc, fr, fq);
        else if (kind == K_GLU) EpiGLU{EA_P(WS_GA)}(acc, u, wr, wc, fr, fq);
        else if (kind == K_FN) EpiMul{EA_P(WS_GF)}(acc, u, wr, wc, fr, fq);
        else if (kind == K_PC) EpiG4{EA_P(WS_G), EA_P(WS_PB), EA_P(WS_H), 0}(acc, u, wr, wc, fr, fq);
        else if (kind == K_PF) EpiChainF{EA_P(WS_G), EA_P(WS_H)}(acc, u, wr, wc, fr, fq);
        else EpiG5{EA_P(WS_PB), EA_P(WS_GA)}(acc, u, wr, wc, fr, fq);
#undef EA_P
    }
};

template <class RowMap>
__device__ __forceinline__ void transpose_item(const float* W, int K, int N, bf16* WT, const RowMap& rm, LAS float* scr, int item, int lane, int pitch = 0, int dup = 0) {
    if (pitch == 0) pitch = K;
    const int nblk = N / 32, kb = item / nblk, nb = item % nblk, k0 = 64 * kb, n0 = 32 * nb;
    { f32x4 w[8];
#pragma unroll
      for (int i = 0; i < 8; ++i) w[i] = *(const f32x4*)(W + (size_t)(k0 + 8 * i + (lane >> 3)) * N + n0 + 4 * (lane & 7));
#pragma unroll
      for (int i = 0; i < 8; ++i) { LAS float* d = scr + (8 * i + (lane >> 3)) * 33 + 4 * (lane & 7); d[0] = w[i][0]; d[1] = w[i][1]; d[2] = w[i][2]; d[3] = w[i][3]; } }
    LDS_WAIT(); asm volatile("" ::: "memory");
    const int c = lane & 7;
#pragma unroll
    for (int j = 0; j < 4; ++j) { const int n = (lane >> 3) + 8 * j; const LAS float* s = scr + (8 * c) * 33 + n;
        v4u o; o.x = cvtpk(s[0 * 33], s[1 * 33]); o.y = cvtpk(s[2 * 33], s[3 * 33]); o.z = cvtpk(s[4 * 33], s[5 * 33]); o.w = cvtpk(s[6 * 33], s[7 * 33]);
        bf16* dp = WT + (size_t)rm(n0 + n) * pitch + k0 + 8 * c; *(v4u*)dp = o; if (dup) *(v4u*)(dp + dup) = o; }
    LDS_WAIT(); asm volatile("" ::: "memory");
}
struct RmId { int off; __device__ __forceinline__ int operator()(int n) const { return off + n; } };
struct RmWin { __device__ __forceinline__ int operator()(int n) const {
        if (n < 2048 || n >= 2816) return n; const int t = (n - 2048) >> 8, cl = (n - 2048) & 255, hh = cl >> 6, jl = cl & 63; return 2048 + t * 256 + 128 * (jl >> 5) + 32 * hh + (jl & 31); } };
struct RmGlu { __device__ __forceinline__ int operator()(int c) const { const int half = c >> 9, cc = c & 511; return 256 * (cc >> 7) + 128 * half + (cc & 127); } };

__device__ __forceinline__ void ph_prologue(const Ctx& C) {
    LAS float* sil = (LAS float*)C.lds;
    LAS float* red = sil + 3072;
    for (int item = C.bid; item < 192; item += GRID) {
        const int l = item / 48, ch = item % 48;
        for (int i = C.tid; i < 3072; i += NTHR) { const float x = i < 1024 ? C.in[I_CCTX][i] : C.in[I_C][i - 1024]; sil[i] = x * sigmoidf_(x); }
        __syncthreads();
        const float* W = C.in[I_ADAW] + (size_t)l * 1024 * 3072 + ch * 64 + C.lane;
        float a0 = 0.f, a1 = 0.f, a2 = 0.f;
        for (int i0 = 0; i0 < 128; i0 += 32) { float w[32];
#pragma unroll
            for (int i = 0; i < 32; ++i) w[i] = W[(size_t)(C.wave * 128 + i0 + i) * 3072];
#pragma unroll
            for (int i = 0; i < 32; ++i) { const int k = C.wave * 128 + i0 + i; a0 += w[i] * sil[k]; a1 += w[i] * sil[1024 + k]; a2 += w[i] * sil[2048 + k]; } }
        red[(C.wave * 3 + 0) * 64 + C.lane] = a0; red[(C.wave * 3 + 1) * 64 + C.lane] = a1; red[(C.wave * 3 + 2) * 64 + C.lane] = a2;
        __syncthreads();
        if (C.tid < 192) { const int ci = C.tid >> 6, col = ch * 64 + (C.tid & 63); float s = C.in[I_ADAB][(size_t)l * 3072 + col];
#pragma unroll
            for (int w = 0; w < 8; ++w) s += red[(w * 3 + ci) * 64 + (C.tid & 63)];
            if (col >= 1024 && col < 2048) s = (1.0f + s) * C.in[I_NORMG][l * 1024 + col - 1024];
            C.w<float>(WS_MODF)[((size_t)l * 3 + ci) * 3072 + col] = s; }
        __syncthreads();
    }
    const int gt = C.bid * NTHR + C.tid, ngt = GRID * NTHR;
    constexpr int T_A2L = 2048 * 2048 / 8, T_A2C = 256 * 512 / 8, T_A1P = 512 * 256 / 8;
    for (int t = gt; t < T_A2L + T_A2C + T_A1P; t += ngt) {
        float v[8]; bf16* dst;
        if (t < T_A2L) { const int r = t >> 8, c0 = (t & 255) * 8, kk = 2 * (r & 1023) + (r >> 10); dst = C.w<bf16>(WS_A2L) + (size_t)r * 2048 + c0;
#pragma unroll
            for (int e = 0; e < 8; ++e) { const int col = c0 + e, s = col & 1023, mm = (kk * s) & 2047; float sn, cs; sincospif((float)mm * (1.0f / 1024.0f), &sn, &cs); v[e] = (col < 1024 ? cs : sn) * 0.02209708691207961f; } }
        else if (t < T_A2L + T_A2C) { const int tt = t - T_A2L, k = tt >> 6, c0 = (tt & 63) * 8; dst = C.w<bf16>(WS_A2C) + (size_t)k * 512 + c0;
#pragma unroll
            for (int e = 0; e < 8; ++e) { const int col = c0 + e, s = col & 255, mm = (k * s) & 255; float sn, cs; sincospif((float)mm * (1.0f / 128.0f), &sn, &cs); v[e] = (col < 256 ? cs : sn) * 0.0625f; } }
        else { const int tt = t - T_A2L - T_A2C, r = tt >> 5, c0 = (tt & 31) * 8; dst = C.w<bf16>(WS_A1P) + (size_t)r * 256 + c0; const int gl = r >> 8, reim = (r >> 7) & 1, j = r & 127;
#pragma unroll
            for (int e = 0; e < 8; ++e) { const int col = c0 + e, glc = col >> 7, c = col & 127, mm = (j * c) & 127; float sn, cs; sincospif((float)mm * (1.0f / 64.0f), &sn, &cs);
                v[e] = (glc == gl) ? (reim ? -sn : cs) * 0.08838834764831845f : 0.f; } }
        v4u o; o.x = cvtpk(v[0], v[1]); o.y = cvtpk(v[2], v[3]); o.z = cvtpk(v[4], v[5]); o.w = cvtpk(v[6], v[7]); *(v4u*)dst = o;
    }
    if (gt < 1024) { const int pos = gt >> 4, f = gt & 15; const float inv = powf(10000.0f, -(float)f / 16.0f), ang = (float)pos * inv;
        C.w<float>(WS_ROPE)[gt * 2] = cosf(ang); C.w<float>(WS_ROPE)[gt * 2 + 1] = sinf(ang); }
}

__device__ __forceinline__ void s5_mats_block(const Ctx& C, int l, int g, int part) {
    LAS f32x2* pw = (LAS f32x2*)C.lds;
    LAS f32x2* Bb = pw + 2 * 17 * 64;
    LAS f32x2* Cm = Bb + 2 * 64 * 16;
    LAS float* Kl = (LAS float*)(Cm + 2 * 16 * 64);
    const int tid = C.tid;
    if (tid < 128) {
        const int d = tid >> 6, n = tid & 63; const size_t gi = ((size_t)(l * 2 + d) * 32 + g);
        const float lr = C.in[I_ARE][gi * 64 + n], li = C.in[I_AIM][gi * 64 + n], dt = expf(C.in[I_LDT][gi]);
        for (int tau = 0; tau <= 16; ++tau) { const float mag = expf((float)tau * dt * lr), ang = (float)tau * dt * li; float sn, cs; sincosf(ang, &sn, &cs); pw[(d * 17 + tau) * 64 + n] = (f32x2){mag * cs, mag * sn}; }
        float mag = expf(dt * lr), sn, cs; sincosf(dt * li, &sn, &cs);
        const float x = mag * cs - 1.0f, y = mag * sn, den = 1.0f / (lr * lr + li * li), cr = (x * lr + y * li) * den, cim = (y * lr - x * li) * den;
        const float* br = C.in[I_BRE] + (gi * 64 + n) * 16; const float* bi = C.in[I_BIM] + (gi * 64 + n) * 16;
#pragma unroll
        for (int q = 0; q < 16; ++q) Bb[(d * 64 + n) * 16 + q] = (f32x2){cr * br[q] - cim * bi[q], cr * bi[q] + cim * br[q]};
        if (part == 0) { const float m16 = expf(16.0f * dt * lr); sincosf(16.0f * dt * li, &sn, &cs);
            C.w<float>(WS_A16)[(gi * 64 + n) * 2] = m16 * cs; C.w<float>(WS_A16)[(gi * 64 + n) * 2 + 1] = m16 * sn; }
    }
    for (int idx = tid; idx < 2048; idx += NTHR) { const int d = idx >> 10, p = (idx >> 6) & 15, n = idx & 63; const size_t o = (((size_t)(l * 2 + d) * 32 + g) * 16 + p) * 64 + n;
        Cm[idx] = (f32x2){C.in[I_CRE][o], C.in[I_CIM][o]}; }
    __syncthreads();
    {
        const int d = tid >> 8, p = (tid >> 4) & 15, q = tid & 15; float a0 = 0.f, a1 = 0.f;
        for (int n = 0; n < 64; ++n) { const f32x2 c = Cm[(d * 16 + p) * 64 + n], bq = Bb[(d * 64 + n) * 16 + q]; const float wr = c.x * bq.x - c.y * bq.y, wi = c.x * bq.y + c.y * bq.x;
            const f32x2 p0 = pw[(d * 17 + 2 * part) * 64 + n], p1 = pw[(d * 17 + 2 * part + 1) * 64 + n]; a0 += wr * p0.x - wi * p0.y; a1 += wr * p1.x - wi * p1.y; }
        Kl[(d * 2 + 0) * 256 + p * 16 + q] = a0; Kl[(d * 2 + 1) * 256 + p * 16 + q] = a1;
    }
    __syncthreads();
    bf16* BtE = C.w<bf16>(WS_BTE) + (size_t)g * 256 * 256; bf16* BtY = C.w<bf16>(WS_BTY) + (size_t)g * 256 * 512;
    const float* dsk = C.in[I_SD] + (size_t)l * 512 + g * 16;
    for (int task = tid; task < 2 * 2 * 16 * 32; task += NTHR) {
        const int e = task >> 10, d = (task >> 9) & 1, blk = (task >> 5) & 15, p = (task >> 1) & 15, q0 = (task & 1) * 8, tau = 2 * part + e;
        if (blk >= 16 - tau || (tau == 0 && d == 1)) continue;
        const int t = d == 0 ? blk + tau : blk, j = d == 0 ? blk : blk + tau; float v[8];
#pragma unroll
        for (int k = 0; k < 8; ++k) { float s = Kl[(d * 2 + e) * 256 + p * 16 + q0 + k]; if (tau == 0) { s += Kl[(1 * 2 + e) * 256 + p * 16 + q0 + k]; if (q0 + k == p) s += dsk[p]; } v[k] = s; }
        v4u o; o.x = cvtpk(v[0], v[1]); o.y = cvtpk(v[2], v[3]); o.z = cvtpk(v[4], v[5]); o.w = cvtpk(v[6], v[7]); *(v4u*)(BtY + (size_t)(t * 16 + p) * 512 + j * 16 + q0) = o;
    }
    for (int task = tid; task < 2 * 32 * 32; task += NTHR) {
        const int which = task >> 10, r = 32 * part + ((task >> 5) & 31), c0 = (task & 31) * 8; float v[8]; bf16* dst;
        if (which == 0) { const int d = r >> 7, reim = (r >> 6) & 1, n = r & 63, j = c0 >> 4, q0 = c0 & 15, ex = d == 0 ? 15 - j : j; dst = BtE + (size_t)r * 256 + c0; const f32x2 a = pw[(d * 17 + ex) * 64 + n];
#pragma unroll
            for (int k = 0; k < 8; ++k) { const f32x2 bq = Bb[(d * 64 + n) * 16 + q0 + k]; v[k] = reim ? (a.x * bq.y + a.y * bq.x) : (a.x * bq.x - a.y * bq.y); } }
        else { const int t = r >> 4, p = r & 15, d = c0 >> 7, reim = (c0 >> 6) & 1, n0 = c0 & 63, ex = d == 0 ? t + 1 : 16 - t; dst = BtY + (size_t)r * 512 + 256 + c0;
#pragma unroll
            for (int k = 0; k < 8; ++k) { const f32x2 c = Cm[(d * 16 + p) * 64 + n0 + k], a = pw[(d * 17 + ex) * 64 + n0 + k]; v[k] = reim ? -(c.x * a.y + c.y * a.x) : (c.x * a.x - c.y * a.y); } }
        v4u o; o.x = cvtpk(v[0], v[1]); o.y = cvtpk(v[2], v[3]); o.z = cvtpk(v[4], v[5]); o.w = cvtpk(v[6], v[7]); *(v4u*)dst = o;
    }
    __syncthreads();
}

__device__ __forceinline__ void prep_layer(const Ctx& C, int l, int parts, int blo, int bcnt) {
    if (C.vcu < blo || C.vcu >= blo + bcnt) return;
    const int bi = C.vcu - blo, wi = bi * NWAVES + C.wave, nw = bcnt * NWAVES;
    if (parts & 1) for (int it = bi; it < 256; it += bcnt) s5_mats_block(C, l, it >> 3, it & 7);
    LAS float* scr = (LAS float*)(C.lds + C.wave * 16384);
    constexpr int I_1 = 16 * 104, I_2 = 16 * 96, I_3 = 8 * 32, I_4 = 8 * 16, I_5 = 8 * 32, I_6 = 16 * 32;
    if (parts & 1) {
        for (int it = wi; it < I_1 + I_2 + I_3 + I_4; it += nw) {
            int r = it;
            if (r < I_1) { transpose_item(C.in[I_WIN] + (size_t)l * 1024 * INW, 1024, INW, C.w<bf16>(WS_WCAT), RmWin{}, scr, r, C.lane); continue; } r -= I_1;
            if (r < I_2) { transpose_item(C.in[I_MW] + (size_t)l * 1024 * 3072, 1024, 3072, C.w<bf16>(WS_WCAT), RmId{INW}, scr, r, C.lane); continue; } r -= I_2;
            if (r < I_3) { transpose_item(C.in[I_GLU] + (size_t)l * 512 * 1024, 512, 1024, C.w<bf16>(WS_WGLU), RmGlu{}, scr, r, C.lane); continue; } r -= I_3;
            transpose_item(C.in[I_FN] + (size_t)l * 512 * 512, 512, 512, C.w<bf16>(WS_WFN), RmId{0}, scr, r, C.lane, 1024, 512);
        }
        for (int t = bi * NTHR + C.tid; t < 2 * 2 * 256 * 16; t += bcnt * NTHR) {
            const int kv = t >> 13, r = t & 8191, b = r >> 12, s = (r >> 4) & 255, c0 = (r & 15) * 8;
            const float* src = C.in[kv ? I_CV : I_CK] + (((size_t)b * DEPTH + l) * 256 + s) * KVW + c0;
            const f32x4 a = *(const f32x4*)src, bq = *(const f32x4*)(src + 4);
            v4u o; o.x = cvtpk(a[0], a[1]); o.y = cvtpk(a[2], a[3]); o.z = cvtpk(bq[0], bq[1]); o.w = cvtpk(bq[2], bq[3]);
            *(v4u*)(C.w<bf16>(kv ? WS_VL : WS_KL) + ((size_t)b * LKV + S_LAT + s) * KVW + c0) = o;
        }
    }
    if (parts & 2) for (int it = wi; it < 3 * I_5; it += nw) { const int nb = it / I_5;
        transpose_item(C.in[I_WBR] + ((size_t)l * 3 + nb) * 512 * 1024, 512, 1024, C.w<bf16>(WS_WBR) + (size_t)nb * 1024 * 512, RmId{0}, scr, it - nb * I_5, C.lane); }
    if (parts & 4) for (int it = wi; it < I_6; it += nw) transpose_item(C.in[I_WOUT] + (size_t)l * 1024 * 1024, 1024, 1024, C.w<bf16>(WS_WOUT), RmId{0}, scr, it, C.lane);
}

__device__ __forceinline__ void rows_phase(const Ctx& C, int l, bool last);
__device__ __forceinline__ void ph_l1(const Ctx& C, int l) {
    if (l > 0) prep_layer(C, l, 6, 0, GRID);
    rows_phase(C, l, false);
}

__device__ __forceinline__ void rows_phase(const Ctx& C, int l, bool last) {
    const float* modf = C.w<float>(WS_MODF); float* XR = C.w<float>(WS_XRES);
    const bf16* T0 = C.w<bf16>(WS_PB); const bf16* T1 = C.w<bf16>(WS_GA);
    f32x4 v[4][4];
#pragma unroll
    for (int i = 0; i < 4; ++i) { const int row = C.gw + i * 2048;
        const float* xr = l == 0 ? (i < 2 ? C.in[I_XP] + (size_t)row * 1024 : C.in[I_XS] + (size_t)(row - T_CTX) * 1024) : XR + (size_t)row * 1024;
#pragma unroll
        for (int j = 0; j < 4; ++j) v[i][j] = *(const f32x4*)(xr + C.lane * 4 + 256 * j); }
#pragma unroll
    for (int i = 0; i < 4; ++i) { const int row = C.gw + i * 2048, ci = i < 2 ? 0 : i - 1; float ss = 0.f;
        if (l > 0) {
            const float* gp = modf + ((size_t)(l - 1) * 3 + ci) * 3072 + 2048 + C.lane * 4; u32x2 t0[4], t1[4]; f32x4 gt[4];
#pragma unroll
            for (int j = 0; j < 4; ++j) { t0[j] = *(const u32x2*)(T0 + (size_t)row * 1024 + C.lane * 4 + 256 * j); t1[j] = *(const u32x2*)(T1 + (size_t)row * 1024 + C.lane * 4 + 256 * j); gt[j] = *(const f32x4*)(gp + 256 * j); }
#pragma unroll
            for (int j = 0; j < 4; ++j) v[i][j] += gt[j] * (bf4_to_f(t0[j]) + bf4_to_f(t1[j]));
        }
        if (!last) {
#pragma unroll
            for (int j = 0; j < 4; ++j) *(f32x4*)(XR + (size_t)row * 1024 + C.lane * 4 + 256 * j) = v[i][j];
        }
#pragma unroll
        for (int j = 0; j < 4; ++j) ss += (v[i][j][0] * v[i][j][0] + v[i][j][1] * v[i][j][1]) + (v[i][j][2] * v[i][j][2] + v[i][j][3] * v[i][j][3]);
        const float rstd = rsqrtf(wave_sum(ss, C.lane) * (1.0f / 1024.0f) + RMS_EPS);
        if (last) {
#pragma unroll
            for (int j = 0; j < 4; ++j) *(f32x4*)(C.out + (size_t)row * 1024 + C.lane * 4 + 256 * j) = v[i][j] * rstd * *(const f32x4*)(C.in[I_FG] + C.lane * 4 + 256 * j);
        } else {
            const float* mp = modf + ((size_t)l * 3 + ci) * 3072 + C.lane * 4; bf16* hr = C.w<bf16>(WS_H) + (size_t)row * 1024;
#pragma unroll
            for (int j = 0; j < 4; ++j) { const f32x4 sh = *(const f32x4*)(mp + 256 * j), gs = *(const f32x4*)(mp + 1024 + 256 * j); st_bf4(hr + C.lane * 4 + 256 * j, v[i][j] * rstd * gs + sh); }
        }
    }
}

__device__ __forceinline__ void scan_unit(const Ctx& C, int l, int g, int pm) {
    const float* SC = C.w<float>(WS_SC); bf16* UH = C.w<bf16>(WS_UH); const int lane = C.lane;
    const int nitems = pm ? 4 : 32;
    for (int item = C.wave; item < nitems; item += NWAVES) {
        const int bsel = item >> 1, d = item & 1, nch = pm ? 128 : 16, c0 = pm ? 256 + bsel * 128 : bsel * 16;
        const size_t gi = ((size_t)(l * 2 + d) * 32 + g) * 64 + lane;
        const float ar = C.w<float>(WS_A16)[gi * 2], ai = C.w<float>(WS_A16)[gi * 2 + 1];
        float hr = 0.f, hi = 0.f;
        if (pm) { const float* st = C.in[I_ST] + ((((size_t)bsel * DEPTH + l) * 2 + d) * 32 + g) * 128 + lane * 2; hr = st[0]; hi = st[1]; }
        float sr[16], si[16], tr[16], ti[16];
#pragma unroll
        for (int k = 0; k < 16; ++k) { const int c = d == 0 ? c0 + k : c0 + nch - 1 - k; const size_t o = ((size_t)g * 512 + c) * 256 + d * 128 + lane; sr[k] = SC[o]; si[k] = SC[o + 64]; }
        for (int i0 = 0; i0 < nch; i0 += 16) {
            if (i0 + 16 < nch) {
#pragma unroll
                for (int k = 0; k < 16; ++k) { const int c = d == 0 ? c0 + i0 + 16 + k : c0 + nch - 1 - i0 - 16 - k; const size_t o = ((size_t)g * 512 + c) * 256 + d * 128 + lane; tr[k] = SC[o]; ti[k] = SC[o + 64]; }
            }
#pragma unroll
            for (int k = 0; k < 16; ++k) { const int c = d == 0 ? c0 + i0 + k : c0 + nch - 1 - i0 - k; const size_t oh = ((size_t)g * 512 + c) * 512 + 256 + d * 128 + lane;
                UH[oh] = (bf16)(cvtpk(hr, hr) & 0xffffu); UH[oh + 64] = (bf16)(cvtpk(hi, hi) & 0xffffu);
                const float nr = ar * hr - ai * hi + sr[k], ni = ar * hi + ai * hr + si[k]; hr = nr; hi = ni; }
#pragma unroll
            for (int k = 0; k < 16; ++k) { sr[k] = tr[k]; si[k] = ti[k]; }
        }
        if (!pm) { float* o = C.out + OUT_S + ((((size_t)bsel * DEPTH + l) * 2 + d) * 32 + g) * 128 + lane * 2; o[0] = hr; o[1] = hi; }
    }
}

__device__ __forceinline__ void ph_final(const Ctx& C) { rows_phase(C, DEPTH, true); }

__device__ __forceinline__ void attn_any(const Ctx& C, int uidx) {
    size_t tok0, kvoff; int NT, h;
    if (uidx < 128) { const int b = uidx >> 6, qb = uidx & 7; h = (uidx >> 3) & 7; tok0 = (size_t)T_CTX + b * 2048 + qb * 256; kvoff = (size_t)(WS_KL - WS_KC) / 2 + (size_t)b * LKV * KVW; NT = LKV / 64; }
    else { const int u2 = uidx - 128, b = u2 >> 3; h = u2 & 7; tok0 = (size_t)b * 256; kvoff = tok0 * KVW; NT = 4; }
    kvoff += (h >> 2) * 64;
    const attn_body::bf16* Q = (const attn_body::bf16*)C.w<bf16>(WS_Q) + tok0 * 512 + h * 64;
    const attn_body::bf16* Kp = (const attn_body::bf16*)C.w<bf16>(WS_KC) + kvoff;
    attn_body::attn_unit<8>(Q, Kp, Kp + (WS_VC - WS_KC) / 2, (attn_body::bf16*)Q, (const attn_body::bf16*)C.w<bf16>(WS_GC) + tok0 * 512 + h * 64, 512, KVW, NT, (char*)C.lds, C.tid);
}

#ifndef MK_PER_PHASE
#define MK_PER_PHASE 0
#endif
constexpr int NSUB = 7, N_PHASES = 2 + NSUB * DEPTH;


__global__ void __launch_bounds__(NTHR, 2) fwd_kernel(KArgs args) {
    extern __shared__ __attribute__((aligned(16))) unsigned char lds_raw[];
    Ctx C; C.lds = (LAS unsigned char*)lds_raw; C.tid = threadIdx.x; C.lane = C.tid & 63; C.wave = __builtin_amdgcn_readfirstlane(C.tid >> 6); C.bid = blockIdx.x;
    int wave_s = C.wave;
    C.gw = C.bid * NWAVES + C.wave; C.ngw = GRID * NWAVES; C.in = args.in; C.out = args.out; C.ws = args.ws;
    for (int u = C.tid; u < (LDS_BYTES - LDSCTL_OFF) / 4; u += NTHR) ((LAS unsigned*)(C.lds + LDSCTL_OFF))[u] = 0u;
    __syncthreads();
    volatile LAS unsigned* MISC = (volatile LAS unsigned*)(C.lds + MISC_OFF);
    XcdBarrier bar; bar.bar = (unsigned*)(C.ws + WS_CTL) + CW_BAR; bar.x = 0; bar.st = nullptr;
    const bool multi = args.ph_hi - args.ph_lo > 1;
    if (multi) bar = xcd_barrier_post((unsigned*)(C.ws + WS_CTL) + CW_BAR, MISC + 8, C.tid);

    for (int ph = args.ph_lo; ph < args.ph_hi; ++ph) {
        { int l_; asm volatile("v_mbcnt_lo_u32_b32 %0, -1, 0\n\tv_mbcnt_hi_u32_b32 %0, -1, %0" : "=v"(l_)); asm volatile("" : "+s"(wave_s)); int b_ = blockIdx.x; asm volatile("" : "+s"(b_)); C.bid = b_; C.vcu = b_;   C.lane = l_; C.wave = wave_s; C.tid = wave_s * 64 + l_; C.gw = C.bid * NWAVES + C.wave;
          unsigned char* w_ = args.ws; asm volatile("" : "+s"(w_)); C.ws = w_; float* o_ = args.out; asm volatile("" : "+s"(o_)); C.out = o_; }
        const int c = C.vcu;
        if (ph == 0) { ph_prologue(C); __syncthreads(); prep_layer(C, 0, 7, 0, GRID); }
        else if (ph == N_PHASES - 1) ph_final(C);
        else {
            const int l = (ph - 1) / NSUB, sub = (ph - 1) % NSUB;
            if (sub == 0) ph_l1(C, l);
            else {
                if (sub == 2 && c < 128) for (int i = 0; i < 2; ++i) attn_any(C, c + 128 * i);
                if (sub == 3 && c >= 64 && c < 128) { const int L = xswz(c - 64, 64); scan_unit(C, l, L >> 1, L & 1); VM_WAIT(); }
                __syncthreads();
                { PhaseSched S{sub, c, C.bid, C.ws}; EpiAll E{C.ws, C.out, C.in, l}; int t_ = C.tid; asm volatile("" : "+v"(t_));
                  pg8::gemm_stream<EpiAll, PhaseSched>(C.lds, S, E, t_); }
                if (sub == 5 && l + 1 < DEPTH) { __syncthreads(); prep_layer(C, l + 1, 1, 128, 128); }
            }
        }
        if (ph + 1 < args.ph_hi) xcd_barrier(bar, C.tid);
    }
}

extern "C" void kernel_launch(void* const* d_in, const int* in_sizes, int n_in, void* d_out, int out_size, void* d_ws, size_t ws_size, hipStream_t stream) {
    static int ready = 0;
    if (ready == 0) {
        if (n_in != 28 || out_size != (int)OUT_N || ws_size < WS_END) { fprintf(stderr, "kernel_launch: unexpected problem shape (n_in %d, out %d, ws %zu)\n", n_in, out_size, ws_size); ready = -1; return; }
        int dev = 0, cus = 0;
        if (hipGetDevice(&dev) != hipSuccess || hipDeviceGetAttribute(&cus, hipDeviceAttributeMultiprocessorCount, dev) != hipSuccess) { ready = -1; return; }
        if (hipFuncSetAttribute((const void*)fwd_kernel, hipFuncAttributeMaxDynamicSharedMemorySize, LDS_BYTES) != hipSuccess) { fprintf(stderr, "kernel_launch: hipFuncSetAttribute failed\n"); ready = -1; return; }
        if (cus < GRID) { fprintf(stderr, "kernel_launch: device has %d CUs, this kernel needs %d resident workgroups\n", cus, GRID); ready = -1; return; }
        ready = 1;
    }
    if (ready < 0) return;
    (void)hipMemsetAsync((char*)d_ws + WS_CTL, 0, CTL_ZERO_BYTES, stream);
    KArgs a{};
    for (int i = 0; i < 28; ++i) a.in[i] = (const float*)d_in[i];
    a.out = (float*)d_out; a.ws = (unsigned char*)d_ws;
#if MK_PER_PHASE
    for (int ph = 0; ph < N_PHASES; ++ph) { a.ph_lo = ph; a.ph_hi = ph + 1; hipLaunchKernelGGL(fwd_kernel, dim3(GRID), dim3(NTHR), LDS_BYTES, stream, a); }
#else
    a.ph_lo = 0; a.ph_hi = N_PHASES; hipLaunchKernelGGL(fwd_kernel, dim3(GRID), dim3(NTHR), LDS_BYTES, stream, a);
#endif
}
```

```cpp
#include <hip/hip_runtime.h>
#include <hip/hip_bf16.h>
#include <cstdio>
#include <cstdint>
#include <cmath>
namespace pg8 {
#define PG8_LAS __attribute__((address_space(3)))
typedef unsigned short bf16_t;
typedef short bf16x8 __attribute__((ext_vector_type(8)));
typedef float f32x4 __attribute__((ext_vector_type(4)));
typedef unsigned u32x4 __attribute__((ext_vector_type(4)));
constexpr int BM = 256, BK = 64, HALF = 128, HTB = HALF * BK * 2  , STAGE_BYTES = 8 * HTB, NXCD = 8, WGM = 8;

__host__ __device__ __forceinline__ int lds_byte(int r, int c) { const int st = (r >> 4) * 2 + (c >> 5), rr = r & 15, cc = c & 31, ob = rr * 64 + cc * 2; return st * 1024 + (ob ^ (((ob >> 9) & 1) << 5)); }
__host__ __device__ __forceinline__ void stage_rc(int b, int& R, int& C) { const int st = b / 1024, sb = b % 1024, swz = sb ^ (((sb >> 9) & 1) << 5); R = (st >> 1) * 16 + swz / 64; C = (st & 1) * 32 + (swz % 64) / 2; }
__host__ __device__ __forceinline__ int perm32(int rho) { const int n = rho >> 4, i = rho & 15; return 8 * (i >> 2) + 4 * n + (i & 3); }


struct Unit { int pm, pn, z; };
struct StaticOrder {
    int nM, nN, nwg, G, c;
    __host__ __device__ void init(int M, int N, int G_, int c_) { nM = M / BM; nN = N / BM; nwg = nM * nN; G = G_; c = c_; }
    __host__ __device__ bool next(int i, Unit& u) const {
        const long L = (long)i * G + c; if (L >= nwg) return false;
        int wgid = (int)L; { const int q = nwg / NXCD, r = nwg % NXCD, xcd = wgid % NXCD, off = wgid / NXCD; wgid = (xcd < r ? xcd * (q + 1) : r * (q + 1) + (xcd - r) * q) + off; }
        const int nig = WGM * nN, gid = wgid / nig, fm = gid * WGM, gsz = (nM - fm) < WGM ? (nM - fm) : WGM;
        u.pm = fm + ((wgid % nig) % gsz); u.pn = (wgid % nig) / gsz; return true;
    }
    __device__ __forceinline__ void a_ready(const Unit&) const {}
    __device__ __forceinline__ void done(const Unit&) const {}
};
struct UDesc { const bf16_t* A; const bf16_t* Bt; int lda, ldb, K, hB; int kind, pm, pn, z, keep; };
template <class Epi, class Sched>
__device__ __forceinline__ void gemm_stream(PG8_LAS unsigned char* lds, const Sched& S, const Epi& E, const int tid_in) {
    const int tid = tid_in, wid = __builtin_amdgcn_readfirstlane(tid >> 6), lane = tid & 63, wr = wid >> 2, wc = wid & 3, fr = lane & 15, fq = lane >> 4;
    int RA, RB, CC;
    { int R, C; stage_rc(tid * 16, R, C); RA = R; RB = (R & ~31) + perm32(R & 31); CC = C; }
    const size_t kstep = (size_t)(BK * 2);
    const unsigned ldsw = (unsigned)wid * 1024u;
    const int aoff = lds_byte(wr * 64 + fr, fq * 8), boff = lds_byte(wc * 32 + fr, fq * 8);
#define PG8_SA(b, h) (((b) * 2 + (h)) * HTB)
#define PG8_SB(b, h) ((4 + (b) * 2 + (h)) * HTB)
#define PG8_STAGE_X(bufoff, gbase, RR, ld) do { const unsigned _vo = (unsigned)(RR * (ld) + CC) * 2u; \
        __builtin_amdgcn_global_load_lds((const unsigned*)((const char*)(gbase) + _vo), (PG8_LAS unsigned*)(lds + (bufoff) + ldsw), 16, 0, 0); \
        __builtin_amdgcn_global_load_lds((const unsigned*)((const char*)(gbase) + (size_t)(ld) * 128 + _vo), (PG8_LAS unsigned*)(lds + (bufoff) + ldsw + 8192), 16, 0, 0); } while (0)
#define PG8_STAGE_A(bufoff, gbase, ld) PG8_STAGE_X(bufoff, gbase, RA, ld)
#define PG8_STAGE_B(bufoff, gbase, ld) PG8_STAGE_X(bufoff, gbase, RB, ld)
#define PG8_LDA(dst, b, h) do { _Pragma("unroll") for (int m = 0; m < 4; ++m) _Pragma("unroll") for (int k = 0; k < 2; ++k) dst[m][k] = *(const PG8_LAS bf16x8*)(lds + PG8_SA(b, h) + aoff + m * 2048 + k * 1024); } while (0)
#define PG8_LDB(dst, b, h) do { _Pragma("unroll") for (int n = 0; n < 2; ++n) _Pragma("unroll") for (int k = 0; k < 2; ++k) dst[n][k] = *(const PG8_LAS bf16x8*)(lds + PG8_SB(b, h) + boff + n * 2048 + k * 1024); } while (0)
#define PG8_MMA(ai, bj, At, Bt) do { __builtin_amdgcn_s_setprio(1); _Pragma("unroll") for (int m = 0; m < 4; ++m) _Pragma("unroll") for (int n = 0; n < 2; ++n) _Pragma("unroll") for (int k = 0; k < 2; ++k) \
        acc[ai][bj][m][n] = __builtin_amdgcn_mfma_f32_16x16x32_bf16(Bt[n][k], At[m][k], acc[ai][bj][m][n], 0, 0, 0); __builtin_amdgcn_s_setprio(0); } while (0)
#define PG8_WAIT_V(n) asm volatile("s_waitcnt vmcnt(" #n ")" ::: "memory")
#define PG8_WAIT_L(n) asm volatile("s_waitcnt lgkmcnt(" #n ")" ::: "memory")
#define PG8_BAR __builtin_amdgcn_s_barrier()
#define PG8_SCHED __builtin_amdgcn_sched_barrier(0)
    UDesc cur, nxt; int ui = 0;
    if (!S.next(0, cur)) return;
    f32x4 acc[2][2][4][2];
#pragma unroll
    for (int a = 0; a < 2; ++a)
#pragma unroll
        for (int b = 0; b < 2; ++b)
#pragma unroll
            for (int m = 0; m < 4; ++m)
#pragma unroll
                for (int n = 0; n < 2; ++n) acc[a][b][m][n] = (f32x4){0.f, 0.f, 0.f, 0.f};
    bf16x8 At[4][2], B0[2][2], B1[2][2];
    const char* cA = (const char*)cur.A; const char* cB = (const char*)cur.Bt; int ldaC = cur.lda, ldbC = cur.ldb; unsigned hstepA = (unsigned)HALF * ldaC * 2, hstepB = (unsigned)cur.hB * ldbC * 2;
    PG8_STAGE_B(PG8_SB(0, 0), cB, ldbC); PG8_STAGE_B(PG8_SB(0, 1), cB + hstepB, ldbC); PG8_STAGE_A(PG8_SA(0, 0), cA, ldaC); PG8_STAGE_A(PG8_SA(0, 1), cA + hstepA, ldaC);
    if (wr == 1) PG8_BAR;
    PG8_WAIT_V(2); PG8_BAR;
    PG8_STAGE_B(PG8_SB(1, 0), cB + kstep, ldbC); PG8_STAGE_A(PG8_SA(1, 0), cA + kstep, ldaC); PG8_STAGE_B(PG8_SB(1, 1), cB + hstepB + kstep, ldbC);
    PG8_WAIT_V(6); PG8_BAR;
    for (;;) {
        const bool has_next = S.next(ui + 1, nxt);
        const char* nA = has_next ? (const char*)nxt.A : cA; const char* nB = has_next ? (const char*)nxt.Bt : cB;
        const int ldaN = has_next ? nxt.lda : ldaC, ldbN = has_next ? nxt.ldb : ldbC; const unsigned hstepAN = (unsigned)HALF * ldaN * 2, hstepBN = has_next ? (unsigned)nxt.hB * ldbN * 2 : hstepB;
        const int nt = cur.K / BK;
        for (int t = 0; t < nt; t += 2) {
            const bool last = (t == nt - 2);
            const char* a1 = cA + (size_t)(t + 1) * kstep;
            const char* a2 = last ? nA : cA + (size_t)(t + 2) * kstep; const char* b2 = last ? nB : cB + (size_t)(t + 2) * kstep;
            const char* a3 = a2 + kstep; const char* b3 = b2 + kstep;
            const int lda2 = last ? ldaN : ldaC, ldb2 = last ? ldbN : ldbC; const unsigned hA2 = last ? hstepAN : hstepA, hB2 = last ? hstepBN : hstepB;
            PG8_LDB(B0, 0, 0); PG8_LDB(B1, 0, 1); PG8_SCHED; PG8_LDA(At, 0, 0); PG8_STAGE_A(PG8_SA(1, 1), a1 + hstepA, ldaC);
            PG8_WAIT_V(8); PG8_WAIT_L(0); PG8_BAR; PG8_MMA(0, 0, At, B0); PG8_MMA(0, 1, At, B1); PG8_BAR; PG8_SCHED;
            PG8_LDA(At, 0, 1); PG8_STAGE_B(PG8_SB(0, 0), b2, ldb2); PG8_STAGE_B(PG8_SB(0, 1), b2 + hB2, ldb2); PG8_STAGE_A(PG8_SA(0, 0), a2, lda2);
            PG8_WAIT_V(8); PG8_WAIT_L(0); PG8_BAR; PG8_MMA(1, 0, At, B0); PG8_MMA(1, 1, At, B1); PG8_BAR; PG8_SCHED;
            PG8_LDB(B0, 1, 0); PG8_LDB(B1, 1, 1); PG8_SCHED; PG8_LDA(At, 1, 0); PG8_STAGE_A(PG8_SA(0, 1), a2 + hA2, lda2);
            PG8_WAIT_V(8); PG8_WAIT_L(0); PG8_BAR; PG8_MMA(0, 0, At, B0); PG8_MMA(0, 1, At, B1); PG8_BAR; PG8_SCHED;
            PG8_LDA(At, 1, 1); PG8_STAGE_B(PG8_SB(1, 0), b3, ldb2); PG8_STAGE_B(PG8_SB(1, 1), b3 + hB2, ldb2); PG8_STAGE_A(PG8_SA(1, 0), a3, lda2);
            PG8_WAIT_V(8); PG8_WAIT_L(0); PG8_BAR; PG8_MMA(1, 0, At, B0); PG8_MMA(1, 1, At, B1); PG8_BAR; PG8_SCHED;
        }
        if (wr == 0) PG8_BAR;
        const bool chained = E.transform(acc, cur, wr, wc, fr, fq);
        if (!chained) E(acc, cur, wr, wc, fr, fq);
        if (!has_next) break;
        if (!chained) {
#pragma unroll
        for (int a = 0; a < 2; ++a)
#pragma unroll
            for (int b = 0; b < 2; ++b)
#pragma unroll
                for (int m = 0; m < 4; ++m)
#pragma unroll
                    for (int n = 0; n < 2; ++n) acc[a][b][m][n] = (f32x4){0.f, 0.f, 0.f, 0.f};
        }
        cur = nxt; cA = nA; cB = nB; ldaC = ldaN; ldbC = ldbN; hstepA = hstepAN; hstepB = hstepBN; ++ui;
        if (wr == 1) PG8_BAR;
    }
    PG8_WAIT_V(0);
    PG8_BAR;
#undef PG8_SA
#undef PG8_SB
#undef PG8_STAGE_X
#undef PG8_STAGE_A
#undef PG8_STAGE_B
#undef PG8_LDA
#undef PG8_LDB
#undef PG8_MMA
#undef PG8_WAIT_V
#undef PG8_WAIT_L
#undef PG8_BAR
#undef PG8_SCHED
}
}

#include <hip/hip_bf16.h>
#include <cmath>
namespace attn_body {
using bf16=__hip_bfloat16;
using bf16x8=__attribute__((ext_vector_type(8)))short;
using s16x4=__attribute__((ext_vector_type(4)))short;
using f32x16=__attribute__((ext_vector_type(16)))float;
using u32x4=__attribute__((ext_vector_type(4)))unsigned;
constexpr int D=64;
constexpr int NW=8,QBLK=32,QB=QBLK*NW,KVBLK=64;
__device__ __forceinline__ int crow(int r,int hi){return (r&3)+8*(r>>2)+4*hi;}
#define SBAR() __builtin_amdgcn_sched_barrier(0)
constexpr int NSLOT=3, SLOTB=8192;
constexpr int LDS_K=0, LDS_V=NSLOT*SLOTB, LDS_WS=2*NSLOT*SLOTB, LDS_OST=LDS_WS+NW*64*4, LDS_BYTES=LDS_OST+NW*4096;
constexpr float C2=0.125f*1.4426950408889634f;
__device__ __forceinline__ void glds16(const void*gsrc,unsigned lds_dst){unsigned keep;
  asm volatile("s_mov_b32 %0, m0\n\ts_mov_b32 m0, %2\n\ts_nop 0\n\tglobal_load_lds_dwordx4 %1, off\n\ts_mov_b32 m0, %0":"=&s"(keep):"v"(gsrc),"s"(lds_dst):"memory");}
__device__ __forceinline__ float max3f(float a,float b,float c){float r;asm("v_max3_f32 %0, %1, %2, %3":"=v"(r):"v"(a),"v"(b),"v"(c));return r;}
__device__ __forceinline__ float max2f(float a,float b){float r;asm("v_max_f32_e32 %0, %1, %2":"=v"(r):"v"(a),"v"(b));return r;}
__device__ __forceinline__ float fadd_s(float a,float b){float r;asm("v_add_f32_e32 %0, %1, %2":"=v"(r):"v"(a),"v"(b));return r;}
__device__ __forceinline__ float fsub_s(float a,float b){float r;asm("v_sub_f32_e32 %0, %1, %2":"=v"(r):"v"(a),"v"(b));return r;}
typedef float f32x2_t __attribute__((ext_vector_type(2))); typedef __bf16 bf16x2_t __attribute__((ext_vector_type(2)));
__device__ __forceinline__ unsigned cvtpk_s(float lo,float hi){f32x2_t v={lo,hi};bf16x2_t b=__builtin_convertvector(v,bf16x2_t);return __builtin_bit_cast(unsigned,b);}
#define WAIT_BAR(N) asm volatile("s_waitcnt vmcnt(" #N ") lgkmcnt(0)\n\ts_barrier":::"memory")

__device__ __forceinline__ void qkt(f32x16&p0,f32x16&p1,const char*Kslot,const bf16x8*qr,const f32x16&negm,int r32,int hi){
  const char*kb=Kslot+hi*1024+r32*16;
  #pragma unroll
  for(int d0=0;d0<4;++d0){
    const bf16x8 b0=*reinterpret_cast<const bf16x8*>(kb+d0*2048);
    const bf16x8 b1=*reinterpret_cast<const bf16x8*>(kb+d0*2048+512);
    if(d0==0){p0=__builtin_amdgcn_mfma_f32_32x32x16_bf16(b0,qr[0],negm,0,0,0);p1=__builtin_amdgcn_mfma_f32_32x32x16_bf16(b1,qr[0],negm,0,0,0);}
    else{p0=__builtin_amdgcn_mfma_f32_32x32x16_bf16(b0,qr[d0],p0,0,0,0);p1=__builtin_amdgcn_mfma_f32_32x32x16_bf16(b1,qr[d0],p1,0,0,0);}}
}
typedef __attribute__((address_space(3))) const char* lds_cptr;
typedef short v4i16_t __attribute__((ext_vector_type(4)));
__device__ __forceinline__ void kload8(bf16x8*kf,lds_cptr kp){
  kf[0]=*(const __attribute__((address_space(3))) bf16x8*)(kp);      kf[1]=*(const __attribute__((address_space(3))) bf16x8*)(kp+512);
  kf[2]=*(const __attribute__((address_space(3))) bf16x8*)(kp+2048); kf[3]=*(const __attribute__((address_space(3))) bf16x8*)(kp+2560);
  kf[4]=*(const __attribute__((address_space(3))) bf16x8*)(kp+4096); kf[5]=*(const __attribute__((address_space(3))) bf16x8*)(kp+4608);
  kf[6]=*(const __attribute__((address_space(3))) bf16x8*)(kp+6144); kf[7]=*(const __attribute__((address_space(3))) bf16x8*)(kp+6656);
}
__device__ __forceinline__ void kload2(bf16x8*kf,lds_cptr kp,int j){ kf[2*j]=*(const __attribute__((address_space(3))) bf16x8*)(kp+j*2048); kf[2*j+1]=*(const __attribute__((address_space(3))) bf16x8*)(kp+j*2048+512); }
__device__ __forceinline__ s16x4 vtr(lds_cptr p){ return __builtin_bit_cast(s16x4,__builtin_amdgcn_ds_read_tr16_b64_v4i16((__attribute__((address_space(3))) v4i16_t*)p)); }
__device__ __forceinline__ float rowmax(const f32x16&p0,const f32x16&p1){
  float a=max3f(p0[0],p0[1],p1[0]),b=max3f(p0[2],p0[3],p1[1]);a=max3f(a,p1[2],p1[3]);
  #pragma unroll
  for(int r=4;r<16;r+=4){a=max3f(a,p0[r],p0[r+1]);b=max3f(b,p0[r+2],p0[r+3]);a=max3f(a,p1[r],p1[r+1]);b=max3f(b,p1[r+2],p1[r+3]);}
  const float m=max2f(a,b);
  auto rr=__builtin_amdgcn_permlane32_swap(__float_as_uint(m),__float_as_uint(m),false,false);
  return max2f(__uint_as_float(rr[0]),__uint_as_float(rr[1]));
}
__device__ __forceinline__ void pv(f32x16*o,int vb,bf16x8 pa0,bf16x8 pa1,bf16x8 pa2,bf16x8 pa3){
  #pragma unroll
  for(int d0=0;d0<2;++d0){s16x4 lo[4],hi[4];
    #pragma unroll
    for(int ks=0;ks<4;++ks){
      asm volatile("ds_read_b64_tr_b16 %0,%1 offset:%c2":"=&v"(lo[ks]):"v"(vb),"i"(d0*4096+ks*1024):"memory");
      asm volatile("ds_read_b64_tr_b16 %0,%1 offset:%c2":"=&v"(hi[ks]):"v"(vb),"i"(d0*4096+ks*1024+512):"memory");}
    asm volatile("s_waitcnt lgkmcnt(0)":::"memory");SBAR();
    #define PK(k) (bf16x8){lo[k][0],lo[k][1],lo[k][2],lo[k][3],hi[k][0],hi[k][1],hi[k][2],hi[k][3]}
    o[d0]=__builtin_amdgcn_mfma_f32_32x32x16_bf16(pa0,PK(0),o[d0],0,0,0);
    o[d0]=__builtin_amdgcn_mfma_f32_32x32x16_bf16(pa1,PK(1),o[d0],0,0,0);
    o[d0]=__builtin_amdgcn_mfma_f32_32x32x16_bf16(pa2,PK(2),o[d0],0,0,0);
    o[d0]=__builtin_amdgcn_mfma_f32_32x32x16_bf16(pa3,PK(3),o[d0],0,0,0);
    #undef PK
  }
}

#ifndef ATTN_STORE16
#define ATTN_STORE16(p,v) (*(u32x4*)(p)=(v))
#endif
template<int THRL> __device__ __forceinline__ void attn_unit(const bf16*Qu,const bf16*Kh,const bf16*Vh,bf16*Ou,const bf16*Gu,const int QP,const int KP,const int NT,char*shm,const int tid_in){
  const int tid=tid_in,lane=tid&63,r32=lane&31,hi=lane>>5; const int wid=__builtin_amdgcn_readfirstlane(tid>>6);
  const bf16*Qw=Qu+(long)(wid*QBLK)*QP;
  const unsigned lds0=(unsigned)(uintptr_t)shm;
  float*wsf=(float*)(shm+LDS_WS)+wid*64;
  const bf16*ksrc=Kh+(long)lane*KP+wid*8;
  const bf16*vsrc=Vh+(long)(16*(wid&3)+(lane>>2))*KP+(wid>>2)*32+(lane&3)*8;
  const unsigned kdst=lds0+LDS_K+wid*1024, vdst=lds0+LDS_V+wid*1024;
  #define DMA_K(t,slot) glds16(ksrc+(long)(t)*KVBLK*KP,(unsigned)__builtin_amdgcn_readfirstlane(kdst+(slot)))
  #define DMA_V(t,slot) glds16(vsrc+(long)(t)*KVBLK*KP,(unsigned)__builtin_amdgcn_readfirstlane(vdst+(slot)))
  const int vb0=(int)(lds0+LDS_V)+((lane>>4)&1)*32+(lane&3)*8+(4*hi+((lane&15)>>2))*64;
  const char*Kbase=shm+LDS_K; bf16x8 kf[8];
  const lds_cptr shm3=(lds_cptr)shm; const lds_cptr kp0=shm3+LDS_K+hi*1024+r32*16; const lds_cptr vp0=shm3+LDS_V+((lane>>4)&1)*32+(lane&3)*8+(4*hi+((lane&15)>>2))*64;
  DMA_K(0,0);DMA_V(0,0);DMA_K(1,SLOTB);
  bf16x8 qr[4];
  #pragma unroll
  for(int d0=0;d0<4;++d0)qr[d0]=*reinterpret_cast<const bf16x8*>(&Qw[(long)r32*QP+d0*16+hi*8]);
  float mhat=0.f,l_reg=0.f;f32x16 o[2];o[0]=f32x16{};o[1]=f32x16{};f32x16 negm; {float zf_; asm volatile("v_mov_b32 %0, 0":"=v"(zf_)); _Pragma("unroll") for(int r=0;r<16;++r)negm[r]=zf_;} asm volatile("":"+v"(negm));
  #define CMASK(P0,P1,t) do{}while(0)
  bool resc=false;
  #define START(P0,P1) do{ const float rm=rowmax(P0,P1); resc=false; \
    { const float dl=rm; mhat=fadd_s(mhat,dl); \
      _Pragma("unroll") for(int r=0;r<16;++r){P0[r]=fsub_s(P0[r],dl);P1[r]=fsub_s(P1[r],dl);} \
      _Pragma("unroll") for(int r=0;r<16;++r)negm[r]=-mhat; asm volatile("":"+v"(negm)); } \
    _Pragma("unroll") for(int r=0;r<16;++r)P0[r]=__builtin_amdgcn_exp2f(P0[r]); }while(0)
  #define RESC() do{ if(resc){ asm volatile("s_waitcnt lgkmcnt(0)":::"memory"); \
      _Pragma("unroll") for(int d_=0;d_<2;++d_) _Pragma("unroll") for(int r=0;r<16;++r)o[d_][r]*=wsf[crow(r,hi)]; } }while(0)
  f32x16 pA0,pA1,pB0,pB1;
  int sl_prev=0,sl_cur=0,sl_next=SLOTB;
  #define ROT() do{sl_prev=sl_cur;sl_cur=sl_next;sl_next=(sl_next==(NSLOT-1)*SLOTB)?0:sl_next+SLOTB;}while(0)
  DMA_K(2,2*SLOTB);
  WAIT_BAR(3);
  qkt(pA0,pA1,Kbase,qr,negm,r32,hi);asm volatile("s_nop 15\n\ts_nop 7":"+v"(pA0),"+v"(pA1));CMASK(pA0,pA1,0);
  START(pA0,pA1);
  _Pragma("unroll") for(int r=0;r<16;++r)pA1[r]=__builtin_amdgcn_exp2f(pA1[r]);
  WAIT_BAR(0);
  DMA_K(3,0);DMA_V(1,SLOTB);
  ROT();
  kload8(kf,kp0+sl_cur);
  WAIT_BAR(2);
  s16x4 vlo[8],vhi[8]; u32x4 pw0,pw1,pw2,pw3;
  #define PKW(P,B) cvtpk_s(P[B],P[B+1])
  #define PAF(k) __builtin_bit_cast(bf16x8,pw##k)
  #define VFR(i) (bf16x8){vlo[i][0],vlo[i][1],vlo[i][2],vlo[i][3],vhi[i][0],vhi[i][1],vhi[i][2],vhi[i][3]}
  #define PIN(x) asm volatile("":"+v"(x))
  #define MX3(a,b,c) __builtin_fmaxf(__builtin_fmaxf((a),(b)),(c))
  #define GAPA(MF,A0,A1,A2,A3,W0,W1,PW) do{ MF; sacc+=A0; sacc+=A1; sacc+=A2; sacc+=A3; PIN(sacc); W0; W1; PIN(PW); SBAR(); }while(0)
  #define EX(v) __builtin_amdgcn_exp2f(v)
  #define GAPB(MF,X,B) do{ MF; X[B]=EX(X[B]); X[B+1]=EX(X[B+1]); X[B+2]=EX(X[B+2]); X[B+3]=EX(X[B+3]); PIN(X); SBAR(); }while(0)
  #define VRD(i) do{ vlo[i]=vtr(vp_+(((i)>>2)*4096+((i)&3)*1024)); vhi[i]=vtr(vp_+(((i)>>2)*4096+((i)&3)*1024+512)); }while(0)
  #define KRD(G,j) do{ if(G){ kload2(kf,kp0+sl_next,j); SBAR(); } }while(0)
  #define STEP(C0,C1,P0,P1,t,GK,GV,GL) do{ SBAR(); \
    const lds_cptr vp_=vp0+sl_prev; \
    VRD(0); SBAR(); float sacc=(P0[0]+P0[1]); \
    GAPA(C0=__builtin_amdgcn_mfma_f32_32x32x16_bf16(kf[0],qr[0],negm,0,0,0), P0[2],P0[3],P0[4],P0[5],     pw0[0]=PKW(P0,0), pw0[1]=PKW(P0,2), pw0); \
    VRD(4); SBAR(); GAPA(C1=__builtin_amdgcn_mfma_f32_32x32x16_bf16(kf[1],qr[0],negm,0,0,0), P0[6],P0[7],P0[8],P0[9],     pw0[2]=PKW(P0,4), pw0[3]=PKW(P0,6), pw0); \
    VRD(1); SBAR(); GAPA(C0=__builtin_amdgcn_mfma_f32_32x32x16_bf16(kf[2],qr[1],C0,0,0,0),   P0[10],P0[11],P0[12],P0[13], pw1[0]=PKW(P0,8), pw1[1]=PKW(P0,10), pw1); \
    VRD(5); SBAR(); GAPA(C1=__builtin_amdgcn_mfma_f32_32x32x16_bf16(kf[3],qr[1],C1,0,0,0),   P0[14],P0[15],P1[0],P1[1],   pw1[2]=PKW(P0,12),pw1[3]=PKW(P0,14), pw1); \
    VRD(2); SBAR(); GAPA(C0=__builtin_amdgcn_mfma_f32_32x32x16_bf16(kf[4],qr[2],C0,0,0,0),   P1[2],P1[3],P1[4],P1[5],     pw2[0]=PKW(P1,0), pw2[1]=PKW(P1,2), pw2); \
    VRD(6); SBAR(); GAPA(C1=__builtin_amdgcn_mfma_f32_32x32x16_bf16(kf[5],qr[2],C1,0,0,0),   P1[6],P1[7],P1[8],P1[9],     pw2[2]=PKW(P1,4), pw2[3]=PKW(P1,6), pw2); \
    VRD(3); SBAR(); GAPA(C0=__builtin_amdgcn_mfma_f32_32x32x16_bf16(kf[6],qr[3],C0,0,0,0),   P1[10],P1[11],P1[12],P1[13], pw3[0]=PKW(P1,8), pw3[1]=PKW(P1,10), pw3); \
    VRD(7); SBAR(); GAPA(C1=__builtin_amdgcn_mfma_f32_32x32x16_bf16(kf[7],qr[3],C1,0,0,0),   P1[14],P1[15],0.f,0.f,       pw3[2]=PKW(P1,12),pw3[3]=PKW(P1,14), pw3); \
    l_reg+=sacc; \
    if(GK){DMA_K((t)+3,sl_cur);} if(GV){DMA_V((t)+1,sl_next);} \
    CMASK(C0,C1,t); \
    { float a=MX3(C0[0],C0[1],C1[0]),b=MX3(C0[2],C0[3],C1[1]); a=MX3(a,C1[2],C1[3]); \
      _Pragma("unroll") for(int r=4;r<16;r+=4){a=MX3(a,C0[r],C0[r+1]);b=MX3(b,C0[r+2],C0[r+3]);a=MX3(a,C1[r],C1[r+1]);b=MX3(b,C1[r+2],C1[r+3]);} \
      float rm=__builtin_fmaxf(a,b); { auto rr=__builtin_amdgcn_permlane32_swap(__float_as_uint(rm),__float_as_uint(rm),false,false); rm=__builtin_fmaxf(__uint_as_float(rr[0]),__uint_as_float(rr[1])); } \
      resc=false; \
      if(__builtin_expect(__any(rm>(float)THRL),0)){ const float dl=__builtin_fmaxf(rm,0.f); mhat+=dl; \
        _Pragma("unroll") for(int r=0;r<16;++r){C0[r]-=dl;C1[r]-=dl;} \
        _Pragma("unroll") for(int r=0;r<16;++r)negm[r]=-mhat; asm volatile("":"+v"(negm)); \
        const float f=__builtin_amdgcn_exp2f(-dl); l_reg*=f; if(hi==0)wsf[r32]=f; resc=true; } } \
    SBAR(); \
    GAPB(o[0]=__builtin_amdgcn_mfma_f32_32x32x16_bf16(PAF(0),VFR(0),o[0],0,0,0), C0,0); \
    GAPB(o[1]=__builtin_amdgcn_mfma_f32_32x32x16_bf16(PAF(0),VFR(4),o[1],0,0,0), C0,4); \
    KRD(GL,0); GAPB(o[0]=__builtin_amdgcn_mfma_f32_32x32x16_bf16(PAF(1),VFR(1),o[0],0,0,0), C0,8); \
    KRD(GL,1); GAPB(o[1]=__builtin_amdgcn_mfma_f32_32x32x16_bf16(PAF(1),VFR(5),o[1],0,0,0), C0,12); \
    KRD(GL,2); GAPB(o[0]=__builtin_amdgcn_mfma_f32_32x32x16_bf16(PAF(2),VFR(2),o[0],0,0,0), C1,0); \
    KRD(GL,3); GAPB(o[1]=__builtin_amdgcn_mfma_f32_32x32x16_bf16(PAF(2),VFR(6),o[1],0,0,0), C1,4); \
    GAPB(o[0]=__builtin_amdgcn_mfma_f32_32x32x16_bf16(PAF(3),VFR(3),o[0],0,0,0), C1,8); \
    GAPB(o[1]=__builtin_amdgcn_mfma_f32_32x32x16_bf16(PAF(3),VFR(7),o[1],0,0,0), C1,12); \
    }while(0)
  int t=1;
  #undef CMASK
  #define CMASK(P0,P1,t) do{}while(0)
  for(;t+5<NT;t+=2){
    STEP(pB0,pB1,pA0,pA1,t,true,true,true);     WAIT_BAR(2); RESC(); ROT();
    STEP(pA0,pA1,pB0,pB1,t+1,true,true,true);   WAIT_BAR(2); RESC(); ROT();
  }
  #undef CMASK
  #define CMASK(P0,P1,t) do{}while(0)
  #define ENDW(tt) do{ if((tt)+3<NT){WAIT_BAR(2);} else if((tt)+2<NT){WAIT_BAR(1);} else {WAIT_BAR(0);} }while(0)
  for(;t+1<NT;t+=2){
    STEP(pB0,pB1,pA0,pA1,t,(t+3<NT),(t+1<NT),(t+1<NT));       ENDW(t);   RESC(); ROT();
    STEP(pA0,pA1,pB0,pB1,t+1,(t+4<NT),(t+2<NT),(t+2<NT));     ENDW(t+1); RESC(); ROT();
  }
  STEP(pB0,pB1,pA0,pA1,NT-1,false,false,false); RESC();
  { float sacc=pB0[0]+pB0[1]; _Pragma("unroll") for(int r=2;r<16;++r)sacc+=pB0[r]; _Pragma("unroll") for(int r=0;r<16;++r)sacc+=pB1[r]; l_reg+=sacc;
    pw0=(u32x4){PKW(pB0,0),PKW(pB0,2),PKW(pB0,4),PKW(pB0,6)};pw1=(u32x4){PKW(pB0,8),PKW(pB0,10),PKW(pB0,12),PKW(pB0,14)};pw2=(u32x4){PKW(pB1,0),PKW(pB1,2),PKW(pB1,4),PKW(pB1,6)};pw3=(u32x4){PKW(pB1,8),PKW(pB1,10),PKW(pB1,12),PKW(pB1,14)};
    SBAR(); pv(o,vb0+sl_cur,PAF(0),PAF(1),PAF(2),PAF(3)); }
  #undef PKW
  #undef PAF
  #undef VFR
  #undef PIN
  #undef MX3
  #undef GAPA
  #undef GAPB
  #undef EX
  #undef VRD
  #undef KRD
  #undef STEP
  #undef ENDW
  {auto rr=__builtin_amdgcn_permlane32_swap(__float_as_uint(l_reg),__float_as_uint(l_reg),false,false);l_reg=__uint_as_float(rr[0])+__uint_as_float(rr[1]);}
  if(hi==0)wsf[32+r32]=l_reg;asm volatile("s_waitcnt lgkmcnt(0)":::"memory");
  float rli[16];
  #pragma unroll
  for(int r=0;r<16;++r)rli[r]=__builtin_amdgcn_rcpf(wsf[32+crow(r,hi)]);
  bf16*Ow=Ou+(long)(wid*QBLK)*QP; const bf16*Gw=Gu+(long)(wid*QBLK)*QP;
  { bf16*stg=(bf16*)(shm+LDS_OST)+wid*2048;
    #pragma unroll
    for(int r=0;r<16;++r){const int orow=crow(r,hi);
      #pragma unroll
      for(int d0=0;d0<2;++d0)stg[orow*64+d0*32+r32]=__float2bfloat16(o[d0][r]*rli[r]);}
    asm volatile("s_waitcnt lgkmcnt(0)":::"memory");
    #pragma unroll
    for(int i=0;i<4;++i){const int row=i*8+(lane>>3),ch=lane&7; const u32x4 v=*(const u32x4*)(stg+row*64+ch*8); const u32x4 gv=*(const u32x4*)(Gw+(long)row*QP+ch*8); u32x4 w;
      #pragma unroll
      for(int e=0;e<4;++e){const float a0=__uint_as_float(v[e]<<16)*__uint_as_float(gv[e]<<16),a1=__uint_as_float(v[e]&0xffff0000u)*__uint_as_float(gv[e]&0xffff0000u); w[e]=cvtpk_s(a0,a1);}
      *(u32x4*)(Ow+(long)row*QP+ch*8)=w;} }
  asm volatile("s_waitcnt lgkmcnt(0)\n\ts_barrier":::"memory");
  #undef DMA_K
  #undef DMA_V
  #undef CMASK
  #undef START
  #undef RESC
  #undef ROT
}
constexpr int ATTN_LDS_BYTES=LDS_BYTES;
#undef SBAR
#undef WAIT_BAR
}

#define GAS __attribute__((address_space(1)))
#define LAS __attribute__((address_space(3)))
typedef unsigned short bf16;
typedef unsigned v4u __attribute__((ext_vector_type(4)));
typedef float f32x4 __attribute__((ext_vector_type(4)));
typedef short bf16x8 __attribute__((ext_vector_type(8)));
typedef GAS unsigned gu32;
typedef GAS unsigned long long gu64;
#define RLX_AGENT __ATOMIC_RELAXED, __HIP_MEMORY_SCOPE_AGENT
#define LDS_WAIT() asm volatile("s_waitcnt lgkmcnt(0)" ::: "memory")
#define VM_WAIT() asm volatile("s_waitcnt vmcnt(0)" ::: "memory")
__device__ __forceinline__ unsigned long long rt() { return __builtin_amdgcn_s_memrealtime(); }
__device__ __forceinline__ unsigned f2bf(float f) { unsigned u = __builtin_bit_cast(unsigned, f); return (u + 0x7fffu + ((u >> 16) & 1u)) >> 16; }
__device__ __forceinline__ unsigned pk2(float lo, float hi) { return f2bf(lo) | (f2bf(hi) << 16); }

#define XB_TMO      128
#define XB_XCNT(j)  (256  + 64 * (j))
#define XB_XSUB(j)  (1280 + 64 * (j))
#define XB_XGEN(j)  (2304 + 64 * (j))
#define XB_TOP      3328
#define XB_TOPGEN   3392
#define XCD_BAR_WORDS 3456
#define XB_SPIN_CAP (1u << 18)

__device__ __forceinline__ unsigned xb_ld(unsigned* p)              { return __hip_atomic_load(p, __ATOMIC_RELAXED, __HIP_MEMORY_SCOPE_AGENT); }
__device__ __forceinline__ unsigned xb_add(unsigned* p, unsigned v) { return __hip_atomic_fetch_add(p, v, __ATOMIC_RELAXED, __HIP_MEMORY_SCOPE_AGENT); }
__device__ __forceinline__ unsigned xb_xcc_id() { return (unsigned)__builtin_amdgcn_s_getreg((3 << 11) | 20) & 0xFu; }
#define XB_SPIN(cond, bar) do { unsigned _sp = 0; while (cond) { __builtin_amdgcn_s_sleep(1); \
    if ((++_sp & 255u) == 0u) { if (xb_ld(&(bar)[XB_TMO])) break; if (_sp > XB_SPIN_CAP) { atomicAdd(&(bar)[XB_TMO], 1u); break; } } } } while (0)

struct XcdBarrier {
    unsigned* bar; unsigned x;
    volatile LAS unsigned* st;
};

__device__ __forceinline__ XcdBarrier xcd_barrier_post(unsigned* bar, volatile LAS unsigned* st, const int tid) {
    XcdBarrier b; b.bar = bar; b.x = xb_xcc_id(); b.st = st;
    if (tid == 0) (void)xb_add(&bar[XB_XCNT(b.x)], 1u);
    return b;
}
__device__ __forceinline__ void xcd_barrier_complete(unsigned* bar, unsigned x, unsigned& nloc, unsigned& nx) {
    const unsigned G = gridDim.x * gridDim.y * gridDim.z;
    unsigned sum, cnt, mine, sp = 0u;
    for (;;) {
        sum = 0u; cnt = 0u; mine = 0u;
#pragma unroll
        for (unsigned j = 0; j < 16; ++j) { const unsigned c = xb_ld(&bar[XB_XCNT(j)]); sum += c; cnt += (c > 0u) ? 1u : 0u; mine = (j == x) ? c : mine; }
        if (sum == G) break;
        __builtin_amdgcn_s_sleep(1);
        if ((++sp & 255u) == 0u) { if (xb_ld(&bar[XB_TMO])) break; if (sp > XB_SPIN_CAP) { atomicAdd(&bar[XB_TMO], 1u); break; } }
    }
    nloc = mine > 0u ? mine : 1u; nx = cnt > 0u ? cnt : 1u;
}

__device__ __forceinline__ void xcd_barrier(const XcdBarrier& b, const int tid) {
    asm volatile("s_waitcnt vmcnt(0)" ::: "memory");
    __syncthreads();
    if (tid == 0) {
        unsigned* bar = b.bar; asm volatile("" : "+s"(bar));
        __builtin_amdgcn_s_waitcnt(0);
        unsigned nloc = b.st[0], nx = b.st[1];
        if (nloc == 0u) { unsigned xx = b.x; asm volatile("" : "+s"(xx)); xcd_barrier_complete(bar, xx, nloc, nx); b.st[0] = nloc; b.st[1] = nx; }
        const unsigned old = xb_add(&bar[XB_XSUB(b.x)], 1u);
        const unsigned gen = old / nloc;
        if (old + 1u == (gen + 1u) * nloc) {
            __builtin_amdgcn_fence(__ATOMIC_RELEASE, "agent");
            asm volatile("s_waitcnt vmcnt(0)" ::: "memory");
            const unsigned og = xb_add(&bar[XB_TOP], 1u);
            const unsigned tg = og / nx;
            if (og + 1u == (tg + 1u) * nx) xb_add(&bar[XB_TOPGEN], 1u);
            else XB_SPIN(xb_ld(&bar[XB_TOPGEN]) == tg, bar);
            __builtin_amdgcn_fence(__ATOMIC_ACQUIRE, "agent");
            xb_add(&bar[XB_XGEN(b.x)], 1u);
            asm volatile("s_waitcnt vmcnt(0)" ::: "memory");
        } else {
            XB_SPIN(xb_ld(&bar[XB_XGEN(b.x)]) == gen, bar);
            __builtin_amdgcn_fence(__ATOMIC_ACQUIRE, "agent");
            asm volatile("s_waitcnt vmcnt(0)" ::: "memory");
        }
    }
    __syncthreads();
}


constexpr int NWAVES = 8, NTHR = 512, GRID = 256;
constexpr int T_TOK = 8192, T_CTX = 4096, DMOD = 1024, BW = 512, INW = 3328, NCAT = 6400, DEPTH = 4;
constexpr int S_LAT = 2048, LKV = 2304, KVW = 128;
constexpr float RMS_EPS = 1e-6f;
constexpr float QSCALE = 0.125f * 1.4426950408889634f;
constexpr size_t MiB = 1u << 20;
constexpr size_t WS_CTL = 0, CTL_ZERO_BYTES = MiB;
constexpr size_t WS_MODF = 1 * MiB;
constexpr size_t WS_ROPE = 1 * MiB + 768 * 1024;
constexpr size_t WS_A16 = 1 * MiB + 832 * 1024;
constexpr size_t WS_WCAT = 2 * MiB;
constexpr size_t WS_WGLU = 15 * MiB;
constexpr size_t WS_WFN = 16 * MiB;
constexpr size_t WS_WBR = 17 * MiB;
constexpr size_t WS_WOUT = 20 * MiB;
constexpr size_t WS_BTE = 22 * MiB;
constexpr size_t WS_BTY = 26 * MiB;
constexpr size_t WS_A2L = 34 * MiB;
constexpr size_t WS_GY = 42 * MiB;
constexpr size_t WS_A2C = 50 * MiB;
constexpr size_t WS_A1P = 50 * MiB + 512 * 1024;
constexpr size_t WS_XRES = 51 * MiB;
constexpr size_t WS_G = 83 * MiB;
constexpr size_t WS_H = 131 * MiB;
constexpr size_t WS_VTC = 147 * MiB;
constexpr size_t WS_VTL = 248 * MiB;
constexpr size_t WS_GA = 155 * MiB;
constexpr size_t WS_GF = 163 * MiB;
constexpr size_t WS_Q = 171 * MiB;
constexpr size_t WS_UF = 179 * MiB;
constexpr size_t WS_GC = 187 * MiB;
constexpr size_t WS_KC = 195 * MiB, WS_KL = 196 * MiB;
constexpr size_t WS_VC = WS_KC + 5 * MiB / 2, WS_VL = WS_KL + 5 * MiB / 2;
constexpr size_t WS_PB = 200 * MiB;
constexpr size_t WS_SC = 216 * MiB;
constexpr size_t WS_UH = 232 * MiB;
constexpr size_t WS_END = 256 * MiB;
constexpr int CW_BAR = 4096;
constexpr size_t OUT_K = 8388608, OUT_V = 10485760, OUT_S = 12582912, OUT_N = 13107200;
constexpr int RING_BYTES = 131072, LDSCTL_OFF = RING_BYTES, MISC_OFF = LDSCTL_OFF + 320, LDS_BYTES = 147456;

typedef float f32x2 __attribute__((ext_vector_type(2)));
typedef unsigned u32x2 __attribute__((ext_vector_type(2)));
__device__ __forceinline__ unsigned cvtpk(float lo, float hi) { typedef __bf16 bf16x2_t __attribute__((ext_vector_type(2))); f32x2 v = {lo, hi}; bf16x2_t b = __builtin_convertvector(v, bf16x2_t); return __builtin_bit_cast(unsigned, b); }
__device__ __forceinline__ void st_bf4(bf16* p, f32x4 v) { u32x2 w; w.x = cvtpk(v[0], v[1]); w.y = cvtpk(v[2], v[3]); *(u32x2*)p = w; }
__device__ __forceinline__ f32x4 ld_bf4(const bf16* p) { const u32x2 w = *(const u32x2*)p; f32x4 r; r[0] = __uint_as_float(w.x << 16); r[1] = __uint_as_float(w.x & 0xffff0000u); r[2] = __uint_as_float(w.y << 16); r[3] = __uint_as_float(w.y & 0xffff0000u); return r; }
__device__ __forceinline__ f32x4 bf4_to_f(u32x2 w) { f32x4 r; r[0] = __uint_as_float(w.x << 16); r[1] = __uint_as_float(w.x & 0xffff0000u); r[2] = __uint_as_float(w.y << 16); r[3] = __uint_as_float(w.y & 0xffff0000u); return r; }
__device__ __forceinline__ float bf2f(bf16 h) { return __uint_as_float((unsigned)h << 16); }
__device__ __forceinline__ float sigmoidf_(float x) { return __builtin_amdgcn_rcpf(1.0f + __expf(-x)); }
__device__ __forceinline__ f32x4 sigmoid4(f32x4 v) { f32x4 r; r[0] = sigmoidf_(v[0]); r[1] = sigmoidf_(v[1]); r[2] = sigmoidf_(v[2]); r[3] = sigmoidf_(v[3]); return r; }
__device__ __forceinline__ f32x4 silu4(f32x4 v) { return v * sigmoid4(v); }
__device__ __forceinline__ float gelu_tanh(float x) { const float y = 0.7978845608028654f * (x + 0.044715f * x * x * x); return x * sigmoidf_(2.0f * y); }
__device__ __forceinline__ float shx(float v, int mask, int lane) { return __int_as_float(__builtin_amdgcn_ds_bpermute((lane ^ mask) << 2, __float_as_int(v))); }
__device__ __forceinline__ float wave_sum(float v, int lane) {
#pragma unroll
    for (int o = 1; o < 64; o <<= 1) v += shx(v, o, lane);
    return v;
}

struct KArgs { const float* in[28]; float* out; unsigned char* ws; int ph_lo, ph_hi; };
enum { I_XP = 0, I_XS, I_CK, I_CV, I_ST, I_C, I_CCTX, I_NORMG, I_ADAW, I_ADAB, I_WIN, I_ARE, I_AIM, I_LDT, I_BRE, I_BIM, I_CRE, I_CIM, I_SD, I_GLU, I_FN, I_QG, I_KG, I_WBR, I_MW, I_MB, I_WOUT, I_FG };

struct Ctx {
    LAS unsigned char* lds; int tid, lane, wave, bid, vcu, gw, ngw;
    const float* const* in; float* out; unsigned char* ws;
    template <class Tp> __device__ __forceinline__ Tp* w(size_t off) const { return (Tp*)(ws + off); }
};

__device__ __forceinline__ int epi_opaque(int x) { asm volatile("" : "+v"(x)); return x; }
#define EPI_ROWS for (int ai = 0; ai < 2; ++ai) _Pragma("unroll") for (int m = 0; m < 4; ++m)
#define EPI_BJ for (int bj = 0; bj < 2; ++bj)
#define EPI_ROW epi_opaque(u.pm * 256 + ai * 128 + wr * 64 + m * 16 + fr)
#define EPI_C8 (bj * 128 + wc * 32 + fq * 8)
#define EPI_COL8 (u.pn * 256 + EPI_C8)
typedef const f32x4 (&AccRef)[2][2][4][2];
__device__ __forceinline__ void st_bf8(bf16* p, f32x4 lo, f32x4 hi) { v4u w; w.x = cvtpk(lo[0], lo[1]); w.y = cvtpk(lo[2], lo[3]); w.z = cvtpk(hi[0], hi[1]); w.w = cvtpk(hi[2], hi[3]); *(v4u*)p = w; }
__device__ __forceinline__ f32x4 bf8_lo(v4u w) { f32x4 r; r[0] = __uint_as_float(w.x << 16); r[1] = __uint_as_float(w.x & 0xffff0000u); r[2] = __uint_as_float(w.y << 16); r[3] = __uint_as_float(w.y & 0xffff0000u); return r; }
__device__ __forceinline__ f32x4 bf8_hi(v4u w) { f32x4 r; r[0] = __uint_as_float(w.z << 16); r[1] = __uint_as_float(w.z & 0xffff0000u); r[2] = __uint_as_float(w.w << 16); r[3] = __uint_as_float(w.w & 0xffff0000u); return r; }

struct EpiG1 {
    static constexpr bool PERM = true, AFTER_DRAIN = false;
    unsigned char* ws; float* out; const float *qg, *kg; int layer;
#define EG1_P(name, off) bf16* const name = (bf16*)(ws + (off))
    __device__ __forceinline__ void qkv(AccRef acc, const pg8::Unit& u, int wr, int wc, int fr, int fq) const {
        const int pn = u.pn; const bool isq = pn < 10;
        EG1_P(Q, WS_Q); EG1_P(Kc, WS_KC); EG1_P(Vc, WS_VC); EG1_P(Kl, WS_KL); EG1_P(Vl, WS_VL); float* const outK = out + OUT_K; float* const outV = out + OUT_V; const float* const rope = (const float*)(ws + WS_ROPE);
        const int kind = isq ? 0 : (wc < 2 ? 1 : 2);
        const int head = isq ? (pn - 8) * 4 + wc : (wc & 1);
        f32x4 gv[2][2];
        if (kind == 0) {
#pragma unroll
            EPI_BJ { gv[bj][0] = *(const f32x4*)(qg + layer * 64 + 32 * bj + 8 * fq); gv[bj][1] = *(const f32x4*)(qg + layer * 64 + 32 * bj + 8 * fq + 4); }
        } else {
#pragma unroll
            EPI_BJ { gv[bj][0] = *(const f32x4*)(kg + layer * 64 + 32 * bj + 8 * fq); gv[bj][1] = *(const f32x4*)(kg + layer * 64 + 32 * bj + 8 * fq + 4); }
        }
        const bool lat = u.pm >= 16;
#pragma unroll
        EPI_ROWS {
            const int row = EPI_ROW;
            f32x4 x[2][2];
#pragma unroll
            EPI_BJ { x[bj][0] = acc[ai][bj][m][0]; x[bj][1] = acc[ai][bj][m][1]; }
            if (kind != 2) {
                float ss = 0.f;
#pragma unroll
                EPI_BJ {
#pragma unroll
                    for (int n = 0; n < 2; ++n) { const f32x4 t = x[bj][n]; ss += (t[0] * t[0] + t[1] * t[1]) + (t[2] * t[2] + t[3] * t[3]); } }
                ss += shx(ss, 16, fq * 16 + fr); ss += shx(ss, 32, fq * 16 + fr);
                const float rstd = rsqrtf(ss * (1.0f / 64.0f) + RMS_EPS);
#pragma unroll
                EPI_BJ { x[bj][0] = x[bj][0] * rstd * gv[bj][0]; x[bj][1] = x[bj][1] * rstd * gv[bj][1]; }
            }
            int b, s;
            if (lat) { const int tl = row - T_CTX; b = tl >> 11; s = tl & 2047; } else { b = row >> 8; s = row & 255; }
            if (lat && kind != 2) {
                const int gr = s >> 6, gc = s & 63;
#pragma unroll
                EPI_BJ {
#pragma unroll
                    for (int n = 0; n < 2; ++n) { const int pos = bj ? gc : gr; const f32x4 cs = *(const f32x4*)(rope + (pos * 16 + 4 * fq + 2 * n) * 2); const f32x4 t = x[bj][n];
                        f32x4 r; r[0] = t[0] * cs[0] - t[1] * cs[1]; r[1] = t[0] * cs[1] + t[1] * cs[0]; r[2] = t[2] * cs[2] - t[3] * cs[3]; r[3] = t[2] * cs[3] + t[3] * cs[2]; x[bj][n] = r; } }
            }
#pragma unroll
            EPI_BJ { const int j = 32 * bj + 8 * fq;
                const size_t ol = ((size_t)b * LKV + s) * KVW + head * 64 + j, oc = (size_t)row * KVW + head * 64 + j, oo = (((size_t)b * DEPTH + layer) * 256 + s) * KVW + head * 64 + j;
                if (kind == 0) st_bf8(Q + (size_t)row * 512 + head * 64 + j, x[bj][0] * QSCALE, x[bj][1] * QSCALE);
                else if (kind == 1) { if (lat) st_bf8(Kl + ol, x[bj][0], x[bj][1]); else { st_bf8(Kc + oc, x[bj][0], x[bj][1]); *(f32x4*)(outK + oo) = x[bj][0]; *(f32x4*)(outK + oo + 4) = x[bj][1]; } }
                else { if (lat) st_bf8(Vl + ol, x[bj][0], x[bj][1]); else { st_bf8(Vc + oc, x[bj][0], x[bj][1]); *(f32x4*)(outV + oo) = x[bj][0]; *(f32x4*)(outV + oo + 4) = x[bj][1]; } } }
            asm volatile("" ::: "memory");
        }
    }
    __device__ __forceinline__ void operator()(AccRef acc, const pg8::Unit& u, int wr, int wc, int fr, int fq) const {
        const int pn = u.pn;
        if (pn >= 8 && pn <= 10) { qkv(acc, u, wr, wc, fr, fq); return; }
        EG1_P(UH, WS_UH); EG1_P(GA, WS_GA); EG1_P(UF, WS_UF); EG1_P(GF, WS_GF); EG1_P(GC, WS_GC);
#pragma unroll
        EPI_ROWS { const int row = EPI_ROW;
#pragma unroll
            EPI_BJ { const int col = EPI_COL8; const f32x4 lo = acc[ai][bj][m][0], hi = acc[ai][bj][m][1];
                if (pn < 2) { const int g = col >> 4, q = col & 15; st_bf8(UH + ((size_t)g * 512 + (row >> 4)) * 512 + (row & 15) * 16 + q, lo, hi); }
                else if (pn < 4) st_bf8(GA + (size_t)row * 512 + (col - 512), silu4(lo), silu4(hi));
                else if (pn < 6) st_bf8(UF + (size_t)row * 512 + (col - 1024), lo, hi);
                else if (pn < 8) st_bf8(GF + (size_t)row * 512 + (col - 1536), silu4(lo), silu4(hi));
                else st_bf8(GC + (size_t)row * 512 + (col - 2816), silu4(lo), silu4(hi));
            } }
    }
};
struct EpiMerge {
    static constexpr bool PERM = true, AFTER_DRAIN = false;
    bf16* Gm; const float* mb;
    __device__ __forceinline__ void operator()(AccRef acc, const pg8::Unit& u, int wr, int wc, int fr, int fq) const {
        f32x4 bb[2][2];
#pragma unroll
        EPI_BJ { bb[bj][0] = *(const f32x4*)(mb + EPI_COL8); bb[bj][1] = *(const f32x4*)(mb + EPI_COL8 + 4); }
#pragma unroll
        EPI_ROWS { const size_t row = EPI_ROW;
#pragma unroll
            EPI_BJ st_bf8(Gm + row * 3072 + EPI_COL8, sigmoid4(acc[ai][bj][m][0] + bb[bj][0]), sigmoid4(acc[ai][bj][m][1] + bb[bj][1])); }
    }
};
struct EpiS5A {
    static constexpr bool PERM = true, AFTER_DRAIN = false;
    float* SC;
    __device__ __forceinline__ void operator()(AccRef acc, const pg8::Unit& u, int wr, int wc, int fr, int fq) const {
#pragma unroll
        EPI_ROWS { const int chunk = EPI_ROW;
#pragma unroll
            EPI_BJ { float* p = SC + ((size_t)u.z * 512 + chunk) * 256 + EPI_C8; *(f32x4*)p = acc[ai][bj][m][0]; *(f32x4*)(p + 4) = acc[ai][bj][m][1]; } }
    }
};
__device__ __forceinline__ f32x4 gelu4(f32x4 y) { y[0] = gelu_tanh(y[0]); y[1] = gelu_tanh(y[1]); y[2] = gelu_tanh(y[2]); y[3] = gelu_tanh(y[3]); return y; }
struct EpiS5B {
    static constexpr bool PERM = true, AFTER_DRAIN = false;
    bf16* GY;
    __device__ __forceinline__ void operator()(AccRef acc, const pg8::Unit& u, int wr, int wc, int fr, int fq) const {
#pragma unroll
        EPI_ROWS { const int chunk = EPI_ROW;
#pragma unroll
            EPI_BJ { const int col = EPI_C8, t = col >> 4, p = col & 15; st_bf8(GY + ((size_t)chunk * 16 + t) * 512 + u.z * 16 + p, gelu4(acc[ai][bj][m][0]), gelu4(acc[ai][bj][m][1])); } }
    }
};
struct EpiDFT1C {
    static constexpr bool PERM = true, AFTER_DRAIN = false;
    bf16* VtC;
    __device__ __forceinline__ void operator()(AccRef acc, const pg8::Unit& u, int wr, int wc, int fr, int fq) const {
        const int grp = 2 * u.z + u.pm;
#pragma unroll
        EPI_ROWS { const int j = epi_opaque(wr * 64 + m * 16 + fr), reim = ai;
#pragma unroll
            EPI_BJ { const int tok = EPI_COL8, b = tok >> 8, s = tok & 255; st_bf8(VtC + ((size_t)b * 512 + grp * 128 + j) * 512 + reim * 256 + s, acc[ai][bj][m][0], acc[ai][bj][m][1]); } }
    }
};
struct EpiDFT1L {
    static constexpr bool PERM = true, AFTER_DRAIN = false;
    bf16* VtL;
    __device__ __forceinline__ void operator()(AccRef acc, const pg8::Unit& u, int wr, int wc, int fr, int fq) const {
        const int grp = 2 * u.z + u.pm, b = u.pn >> 4, nn = u.pn & 15;
#pragma unroll
        EPI_ROWS { const int j = epi_opaque(wr * 64 + m * 16 + fr), reim = ai; bf16* dst = VtL + ((size_t)b * 512 + grp * 128 + j) * 2048 + reim * 1024 + nn * 128 + wc * 32 + fq * 8;
            st_bf8(dst, acc[ai][0][m][0] + acc[ai][1][m][0], acc[ai][0][m][1] + acc[ai][1][m][1]);
            st_bf8(dst + (size_t)1024 * 2048, acc[ai][0][m][0] - acc[ai][1][m][0], acc[ai][0][m][1] - acc[ai][1][m][1]); }
    }
};
struct EpiDFT2 {
    static constexpr bool PERM = true, AFTER_DRAIN = false;
    bf16* ZF; int lat, half;
    __device__ __forceinline__ void operator()(AccRef acc, const pg8::Unit& u, int wr, int wc, int fr, int fq) const {
#pragma unroll
        EPI_ROWS { const int k = EPI_ROW;
#pragma unroll
            EPI_BJ { const int col = EPI_COL8, b = col >> 9, ch = col & 511;
                bf16* dst = lat ? ZF + ((size_t)b * 2048 + 2 * k + u.z) * 1024 + half * 512 + ch : ZF + ((size_t)b * 256 + k) * 512 + ch;
                st_bf8(dst, acc[ai][bj][m][0], acc[ai][bj][m][1]); } }
    }
};
#define EPI_BATCH for (int ai = 0; ai < 2; ++ai)
#define EPI_M for (int m = 0; m < 4; ++m)
struct EpiGLU {
    static constexpr bool PERM = true, AFTER_DRAIN = false;
    bf16* GA;
    __device__ __forceinline__ void operator()(AccRef acc, const pg8::Unit& u, int wr, int wc, int fr, int fq) const {
#pragma unroll
        EPI_BATCH { v4u gl[4];
#pragma unroll
            EPI_M { const size_t row = EPI_ROW; gl[m] = *(const v4u*)(GA + row * 512 + u.pn * 128 + wc * 32 + fq * 8); }
            asm volatile("" ::: "memory");
#pragma unroll
            EPI_M { const size_t row = EPI_ROW;
                st_bf8(GA + row * 512 + u.pn * 128 + wc * 32 + fq * 8, acc[ai][0][m][0] * sigmoid4(acc[ai][1][m][0]) * bf8_lo(gl[m]), acc[ai][0][m][1] * sigmoid4(acc[ai][1][m][1]) * bf8_hi(gl[m])); }
            asm volatile("" ::: "memory"); }
    }
};
struct EpiMul {
    static constexpr bool PERM = true, AFTER_DRAIN = false;
    bf16* GF;
    __device__ __forceinline__ void operator()(AccRef acc, const pg8::Unit& u, int wr, int wc, int fr, int fq) const {
#pragma unroll
        EPI_BATCH { v4u gl[4][2];
#pragma unroll
            EPI_M { const size_t row = EPI_ROW;
#pragma unroll
                EPI_BJ gl[m][bj] = *(const v4u*)(GF + row * 512 + EPI_COL8); }
            asm volatile("" ::: "memory");
#pragma unroll
            EPI_M { const size_t row = EPI_ROW;
#pragma unroll
                EPI_BJ st_bf8(GF + row * 512 + EPI_COL8, acc[ai][bj][m][0] * bf8_lo(gl[m][bj]), acc[ai][bj][m][1] * bf8_hi(gl[m][bj])); }
            asm volatile("" ::: "memory"); }
    }
};
struct EpiG4 {
    static constexpr bool PERM = true, AFTER_DRAIN = false;
    const bf16* Gm; bf16* PB; bf16* MG; int mode0;
    __device__ __forceinline__ void operator()(AccRef acc, const pg8::Unit& u, int wr, int wc, int fr, int fq) const {
        const int mode = mode0 + u.z, gsel = mode == 0 ? 2 : mode - 1;
#pragma unroll
        EPI_BATCH { v4u gl[4][2], pl[4][2];
#pragma unroll
            EPI_M { const size_t row = EPI_ROW;
#pragma unroll
                EPI_BJ { gl[m][bj] = *(const v4u*)(Gm + row * 3072 + gsel * 1024 + EPI_COL8); if (mode > 0) pl[m][bj] = *(const v4u*)(PB + row * 1024 + EPI_COL8); } }
            asm volatile("" ::: "memory");
#pragma unroll
            EPI_M { const size_t row = EPI_ROW;
#pragma unroll
                EPI_BJ { f32x4 lo = acc[ai][bj][m][0] * bf8_lo(gl[m][bj]), hi = acc[ai][bj][m][1] * bf8_hi(gl[m][bj]); if (mode > 0) { lo += bf8_lo(pl[m][bj]); hi += bf8_hi(pl[m][bj]); }
                    if (mode < 2) st_bf8(PB + row * 1024 + EPI_COL8, lo, hi); else st_bf8(MG + row * 1024 + EPI_COL8, lo, hi); } }
            asm volatile("" ::: "memory"); }
    }
};
struct EpiChainA {
    const bf16* Gm; const bf16* PB;
    __device__ __forceinline__ void operator()(f32x4 (&acc)[2][2][4][2], const pg8::Unit& u, int wr, int wc, int fr, int fq) const {
#pragma unroll
        for (int ai = 0; ai < 2; ++ai)
#pragma unroll
            for (int mh = 0; mh < 2; ++mh) { v4u g0[2][2], g1[2][2], pl[2][2];
#pragma unroll
                for (int mm = 0; mm < 2; ++mm) { const int m = 2 * mh + mm; const size_t row = EPI_ROW;
#pragma unroll
                    EPI_BJ { g0[mm][bj] = *(const v4u*)(Gm + row * 3072 + EPI_COL8); g1[mm][bj] = *(const v4u*)(Gm + row * 3072 + 1024 + EPI_COL8); pl[mm][bj] = *(const v4u*)(PB + row * 1024 + EPI_COL8); } }
                asm volatile("" ::: "memory");
#pragma unroll
                for (int mm = 0; mm < 2; ++mm) { const int m = 2 * mh + mm;
#pragma unroll
                    EPI_BJ { f32x4 lo = acc[ai][bj][m][0] * bf8_lo(g0[mm][bj]) + bf8_lo(pl[mm][bj]), hi = acc[ai][bj][m][1] * bf8_hi(g0[mm][bj]) + bf8_hi(pl[mm][bj]);
                        const f32x4 gl = bf8_lo(g1[mm][bj]), gh = bf8_hi(g1[mm][bj]);
#pragma unroll
                        for (int e = 0; e < 4; ++e) { lo[e] *= __builtin_amdgcn_rcpf(fmaxf(gl[e], 1e-6f)); hi[e] *= __builtin_amdgcn_rcpf(fmaxf(gh[e], 1e-6f)); }
                        acc[ai][bj][m][0] = lo; acc[ai][bj][m][1] = hi; } }
                asm volatile("" ::: "memory"); }
    }
};
struct EpiChainF {
    const bf16* Gm; bf16* MG;
    __device__ __forceinline__ void operator()(AccRef acc, const pg8::Unit& u, int wr, int wc, int fr, int fq) const {
#pragma unroll
        EPI_BATCH { v4u g1[4][2];
#pragma unroll
            EPI_M { const size_t row = EPI_ROW;
#pragma unroll
                EPI_BJ g1[m][bj] = *(const v4u*)(Gm + row * 3072 + 1024 + EPI_COL8); }
            asm volatile("" ::: "memory");
#pragma unroll
            EPI_M { const size_t row = EPI_ROW;
#pragma unroll
                EPI_BJ { const f32x4 gl = bf8_lo(g1[m][bj]), gh = bf8_hi(g1[m][bj]); f32x4 lo = acc[ai][bj][m][0], hi = acc[ai][bj][m][1];
#pragma unroll
                    for (int e = 0; e < 4; ++e) { lo[e] *= fmaxf(gl[e], 1e-6f); hi[e] *= fmaxf(gh[e], 1e-6f); }
                    st_bf8(MG + row * 1024 + EPI_COL8, lo, hi); } }
            asm volatile("" ::: "memory"); }
    }
};
struct EpiG5 {
    static constexpr bool PERM = true, AFTER_DRAIN = false;
    bf16 *T0, *T1;
    __device__ __forceinline__ void operator()(AccRef acc, const pg8::Unit& u, int wr, int wc, int fr, int fq) const {
        bf16* T = u.z ? T1 : T0;
#pragma unroll
        EPI_ROWS { const size_t row = EPI_ROW;
#pragma unroll
            EPI_BJ st_bf8(T + row * 1024 + EPI_COL8, acc[ai][bj][m][0], acc[ai][bj][m][1]); }
    }
};

enum { K_G1 = 0, K_MERGE, K_S5A, K_S5B, K_DFT1C, K_DFT1L, K_DFT2C, K_DFT2L0, K_DFT2L1, K_GLU, K_FN, K_PC, K_PA, K_PF, K_G5 };
__device__ __forceinline__ int xswz(int L, int n) { return (L & 7) * (n >> 3) + (L >> 3); }
#define PS_W(off) ((const bf16*)(ws + (off)))
struct PhaseSched {
    int sub, c, bid; unsigned char* ws;
    __device__ __forceinline__ void mk(pg8::UDesc& d, const bf16* A, const bf16* Bt, int lda, int ldb, int K, int hB, int kind, int pm, int pn, int z) const {
        d.A = A; d.Bt = Bt; d.lda = lda; d.ldb = ldb; d.K = K; d.hB = hB; d.kind = kind; d.pm = pm; d.pn = pn; d.z = z; d.keep = (kind == K_PF); }
    __device__ __forceinline__ void mk_merge(pg8::UDesc& d, int M, unsigned char* ws) const {
        int pm, pn; if (M < 128) { pm = M >> 2; pn = 8 + (M & 3); } else { pm = (M - 128) >> 3; pn = (M - 128) & 7; }
        mk(d, PS_W(WS_H) + (size_t)pm * 256 * 1024, PS_W(WS_WCAT) + (size_t)(INW + pn * 256) * 1024, 1024, 1024, 1024, 128, K_MERGE, pm, pn, 0); }
    __device__ __forceinline__ bool next(int i, pg8::UDesc& d) const {
        unsigned char* ws = this->ws; asm volatile("" : "+s"(ws));
        if (sub == 1) {
            if (i > 1) return false;
            pg8::StaticOrder so; so.init(T_TOK, INW, GRID, bid); pg8::Unit u;
            if (so.next(i, u)) { mk(d, PS_W(WS_H) + (size_t)u.pm * 256 * 1024, PS_W(WS_WCAT) + (size_t)u.pn * 256 * 1024, 1024, 1024, 1024, 128, K_G1, u.pm, u.pn, 0); return true; }
            if (bid >= 160) { mk_merge(d, xswz(bid - 160, 96), ws); return true; }
            return false;
        }
        if (sub == 2) {
            if (c < 128) return false;
            if (c < 192) { const int L = xswz(c - 128, 64);
                if (i == 0) { const int g = L >> 1, pm = L & 1; mk(d, PS_W(WS_UH) + ((size_t)g * 512 + pm * 256) * 512, PS_W(WS_BTE) + (size_t)g * 256 * 256, 512, 256, 256, 128, K_S5A, pm, 0, g); return true; }
                if (i == 1) { const int pair = L >> 5, gl = (L >> 4) & 1, pn = L & 15; mk(d, PS_W(WS_A1P) + (size_t)gl * 256 * 256, PS_W(WS_UF) + (size_t)pn * 256 * 512 + pair * 256, 256, 512, 256, 128, K_DFT1C, gl, pn, pair); return true; }
                if (i == 2) { mk_merge(d, 96 + xswz(c - 128, 128), ws); return true; }
                return false; }
            const int L = xswz(c - 192, 64);
            if (i == 0) { const int pair = L >> 5, gl = (L >> 4) & 1, r = L & 15, pn2 = (r >> 3) * 16 + (r & 7);
                mk(d, PS_W(WS_A1P) + (size_t)gl * 256 * 256, PS_W(WS_UF) + ((size_t)T_CTX + pn2 * 128) * 512 + pair * 256, 256, 512, 256, 1024, K_DFT1L, gl, pn2, pair); return true; }
            if (i == 1) { mk_merge(d, 96 + xswz(c - 128, 128), ws); return true; }
            return false;
        }
        if (sub == 3) {
            if (c < 64) { if (i > 0) return false; const int half = c >> 5, L = xswz(c & 31, 32), z = L >> 4, pm = (L >> 2) & 3, pn = L & 3;
                mk(d, PS_W(WS_A2L) + ((size_t)z * 1024 + pm * 256) * 2048 + half * 1024, PS_W(WS_VTL) + ((size_t)z * 1024 + pn * 256) * 2048 + half * 1024, 2048, 2048, 1024, 128, half ? K_DFT2L1 : K_DFT2L0, pm, pn, z); return true; }
            if (c < 128) { if (i > 0) return false; const int L = xswz(c - 64, 64), g = L >> 1, pm = L & 1;
                mk(d, PS_W(WS_UH) + ((size_t)g * 512 + pm * 256) * 512, PS_W(WS_BTY) + (size_t)g * 256 * 512, 512, 512, 512, 128, K_S5B, pm, 0, g); return true; }
            if (i == 0) { const int L = xswz(c - 128, 128), pm = L >> 2, pn = L & 3; mk(d, PS_W(WS_Q) + (size_t)pm * 256 * 512, PS_W(WS_WBR) + ((size_t)2 * 1024 + pn * 256) * 512, 512, 512, 512, 128, K_PC, pm, pn, 0); return true; }
            if (i == 1) { if (c < 160) { const int pn = xswz(c - 128, 32); mk(d, PS_W(WS_A2C), PS_W(WS_VTC) + (size_t)pn * 256 * 512, 512, 512, 512, 128, K_DFT2C, 0, pn, 0); return true; }
                mk_merge(d, 224 + xswz(c - 160, 96), ws); return true; }
            return false;
        }
        if (sub == 4) {
            if (i > 0) return false;
            if (c < 128) { const int L = xswz(c, 128), pm = L >> 2, pn = L & 3; mk(d, PS_W(WS_GY) + (size_t)pm * 256 * 512, PS_W(WS_WGLU) + (size_t)pn * 256 * 512, 512, 512, 512, 128, K_GLU, pm, pn, 0); return true; }
            if (c < 160) { const int L = xswz(c - 128, 32), pm = L >> 1, pn = L & 1; mk(d, PS_W(WS_UF) + (size_t)pm * 256 * 512, PS_W(WS_WFN) + (size_t)pn * 256 * 1024, 512, 1024, 512, 128, K_FN, pm, pn, 0); return true; }
            if (c < 192) { const int L = xswz(c - 160, 32), pm = L >> 1, pn = L & 1; mk(d, PS_W(WS_GC) + (size_t)pm * 256 * 1024, PS_W(WS_WFN) + (size_t)pn * 256 * 1024, 1024, 1024, 1024, 128, K_FN, 16 + pm, pn, 0); return true; }
            mk_merge(d, 320 + xswz(c - 192, 64), ws); return true;
        }
        if (sub == 5) {
            if (c >= 128 || i > 1) return false;
            const int t = (c & 7) * 16 + (c >> 3), pm = t >> 2, pn = t & 3;
            if (i == 0) mk(d, PS_W(WS_GA) + (size_t)pm * 256 * 512, PS_W(WS_WBR) + (size_t)pn * 256 * 512, 512, 512, 512, 128, K_PA, pm, pn, 0);
            else mk(d, PS_W(WS_GF) + (size_t)pm * 256 * 512, PS_W(WS_WBR) + ((size_t)1024 + pn * 256) * 512, 512, 512, 512, 128, K_PF, pm, pn, 0);
            return true;
        }
        if (i > 0) return false;
        { const int L = xswz(c, 256), z = L & 1, pm = L >> 3, pn = (L >> 1) & 3; mk(d, PS_W(WS_H) + (size_t)pm * 256 * 1024 + z * 512, PS_W(WS_WOUT) + (size_t)pn * 256 * 1024 + z * 512, 1024, 1024, 512, 128, K_G5, pm, pn, z); return true; }
    }
};
struct EpiAll {
    unsigned char* ws; float* out; const float* const* in; int layer;
    __device__ __forceinline__ bool transform(f32x4 (&acc)[2][2][4][2], const pg8::UDesc& d, int wr, int wc, int fr, int fq) const {
        if (d.kind != K_PA) return false;
        asm volatile("" : "+v"(fr), "+v"(fq), "+s"(wr), "+s"(wc));
        unsigned char* ws = this->ws; asm volatile("" : "+s"(ws));
        EpiChainA{(const bf16*)(ws + WS_G), (const bf16*)(ws + WS_PB)}(acc, pg8::Unit{d.pm, d.pn, d.z}, wr, wc, fr, fq); return true; }
    __device__ __forceinline__ void operator()(AccRef acc, const pg8::UDesc& d, int wr, int wc, int fr, int fq) const {
        asm volatile("" : "+v"(fr), "+v"(fq), "+s"(wr), "+s"(wc));
        const pg8::Unit u{d.pm, d.pn, d.z}; const int kind = d.kind;
        unsigned char* ws = this->ws; float* out = this->out; asm volatile("" : "+s"(ws), "+s"(out));
#define EA_P(off) ((bf16*)(ws + (off)))
        if (kind == K_G1) EpiG1{ws, out, in[I_QG], in[I_KG], layer}(acc, u, wr, wc, fr, fq);
        else if (kind == K_MERGE) EpiMerge{EA_P(WS_G), in[I_MB] + (size_t)layer * 3072}(acc, u, wr, wc, fr, fq);
        else if (kind == K_S5A) EpiS5A{(float*)(ws + WS_SC)}(acc, u, wr, wc, fr, fq);
        else if (kind == K_S5B) EpiS5B{EA_P(WS_GY)}(acc, u, wr, wc, fr, fq);
        else if (kind == K_DFT1C) EpiDFT1C{EA_P(WS_VTC)}(acc, u, wr, wc, fr, fq);
        else if (kind == K_DFT1L) EpiDFT1L{EA_P(WS_VTL)}(acc, u, wr, wc, fr, fq);
        else if (kind == K_DFT2C) EpiDFT2{EA_P(WS_UF), 0, 0}(acc, u, wr, wc, fr, fq);
        else if (kind == K_DFT2L0) EpiDFT2{EA_P(WS_GC), 1, 0}(acc, u, wr, wc, fr, fq);
        else if (kind == K_DFT2L1) EpiDFT2{EA_P(WS_GC), 1, 1}(acc, u, wr, wc, fr, fq);
        else if (kind == K_GLU) EpiGLU{EA_P(WS_GA)}(acc, u, wr, wc, fr, fq);
        else if (kind == K_FN) EpiMul{EA_P(WS_GF)}(acc, u, wr, wc, fr, fq);
        else if (kind == K_PC) EpiG4{EA_P(WS_G), EA_P(WS_PB), EA_P(WS_H), 0}(acc, u, wr, wc, fr, fq);
        else if (kind == K_PF) EpiChainF{EA_P(WS_G), EA_P(WS_H)}(acc, u, wr, wc, fr, fq);
        else EpiG5{EA_P(WS_PB), EA_P(WS_GA)}(acc, u, wr, wc, fr, fq);
#undef EA_P
    }
};

template <class RowMap>
__device__ __forceinline__ void transpose_item(const float* W, int K, int N, bf16* WT, const RowMap& rm, LAS float* scr, int item, int lane, int pitch = 0, int dup = 0) {
    if (pitch == 0) pitch = K;
    const int nblk = N / 32, kb = item / nblk, nb = item % nblk, k0 = 64 * kb, n0 = 32 * nb;
    { f32x4 w[8];
#pragma unroll
      for (int i = 0; i < 8; ++i) w[i] = *(const f32x4*)(W + (size_t)(k0 + 8 * i + (lane >> 3)) * N + n0 + 4 * (lane & 7));
#pragma unroll
      for (int i = 0; i < 8; ++i) { LAS float* d = scr + (8 * i + (lane >> 3)) * 33 + 4 * (lane & 7); d[0] = w[i][0]; d[1] = w[i][1]; d[2] = w[i][2]; d[3] = w[i][3]; } }
    LDS_WAIT(); asm volatile("" ::: "memory");
    const int c = lane & 7;
#pragma unroll
    for (int j = 0; j < 4; ++j) { const int n = (lane >> 3) + 8 * j; const LAS float* s = scr + (8 * c) * 33 + n;
        v4u o; o.x = cvtpk(s[0 * 33], s[1 * 33]); o.y = cvtpk(s[2 * 33], s[3 * 33]); o.z = cvtpk(s[4 * 33], s[5 * 33]); o.w = cvtpk(s[6 * 33], s[7 * 33]);
        bf16* dp = WT + (size_t)rm(n0 + n) * pitch + k0 + 8 * c; *(v4u*)dp = o; if (dup) *(v4u*)(dp + dup) = o; }
    LDS_WAIT(); asm volatile("" ::: "memory");
}
struct RmId { int off; __device__ __forceinline__ int operator()(int n) const { return off + n; } };
struct RmWin { __device__ __forceinline__ int operator()(int n) const {
        if (n < 2048 || n >= 2816) return n; const int t = (n - 2048) >> 8, cl = (n - 2048) & 255, hh = cl >> 6, jl = cl & 63; return 2048 + t * 256 + 128 * (jl >> 5) + 32 * hh + (jl & 31); } };
struct RmGlu { __device__ __forceinline__ int operator()(int c) const { const int half = c >> 9, cc = c & 511; return 256 * (cc >> 7) + 128 * half + (cc & 127); } };

__device__ __forceinline__ void ph_prologue(const Ctx& C) {
    LAS float* sil = (LAS float*)C.lds;
    LAS float* red = sil + 3072;
    for (int item = C.bid; item < 192; item += GRID) {
        const int l = item / 48, ch = item % 48;
        for (int i = C.tid; i < 3072; i += NTHR) { const float x = i < 1024 ? C.in[I_CCTX][i] : C.in[I_C][i - 1024]; sil[i] = x * sigmoidf_(x); }
        __syncthreads();
        const float* W = C.in[I_ADAW] + (size_t)l * 1024 * 3072 + ch * 64 + C.lane;
        float a0 = 0.f, a1 = 0.f, a2 = 0.f;
        for (int i0 = 0; i0 < 128; i0 += 32) { float w[32];
#pragma unroll
            for (int i = 0; i < 32; ++i) w[i] = W[(size_t)(C.wave * 128 + i0 + i) * 3072];
#pragma unroll
            for (int i = 0; i < 32; ++i) { const int k = C.wave * 128 + i0 + i; a0 += w[i] * sil[k]; a1 += w[i] * sil[1024 + k]; a2 += w[i] * sil[2048 + k]; } }
        red[(C.wave * 3 + 0) * 64 + C.lane] = a0; red[(C.wave * 3 + 1) * 64 + C.lane] = a1; red[(C.wave * 3 + 2) * 64 + C.lane] = a2;
        __syncthreads();
        if (C.tid < 192) { const int ci = C.tid >> 6, col = ch * 64 + (C.tid & 63); float s = C.in[I_ADAB][(size_t)l * 3072 + col];
#pragma unroll
            for (int w = 0; w < 8; ++w) s += red[(w * 3 + ci) * 64 + (C.tid & 63)];
            if (col >= 1024 && col < 2048) s = (1.0f + s) * C.in[I_NORMG][l * 1024 + col - 1024];
            C.w<float>(WS_MODF)[((size_t)l * 3 + ci) * 3072 + col] = s; }
        __syncthreads();
    }
    const int gt = C.bid * NTHR + C.tid, ngt = GRID * NTHR;
    constexpr int T_A2L = 2048 * 2048 / 8, T_A2C = 256 * 512 / 8, T_A1P = 512 * 256 / 8;
    for (int t = gt; t < T_A2L + T_A2C + T_A1P; t += ngt) {
        float v[8]; bf16* dst;
        if (t < T_A2L) { const int r = t >> 8, c0 = (t & 255) * 8, kk = 2 * (r & 1023) + (r >> 10); dst = C.w<bf16>(WS_A2L) + (size_t)r * 2048 + c0;
#pragma unroll
            for (int e = 0; e < 8; ++e) { const int col = c0 + e, s = col & 1023, mm = (kk * s) & 2047; float sn, cs; sincospif((float)mm * (1.0f / 1024.0f), &sn, &cs); v[e] = (col < 1024 ? cs : sn) * 0.02209708691207961f; } }
        else if (t < T_A2L + T_A2C) { const int tt = t - T_A2L, k = tt >> 6, c0 = (tt & 63) * 8; dst = C.w<bf16>(WS_A2C) + (size_t)k * 512 + c0;
#pragma unroll
            for (int e = 0; e < 8; ++e) { const int col = c0 + e, s = col & 255, mm = (k * s) & 255; float sn, cs; sincospif((float)mm * (1.0f / 128.0f), &sn, &cs); v[e] = (col < 256 ? cs : sn) * 0.0625f; } }
        else { const int tt = t - T_A2L - T_A2C, r = tt >> 5, c0 = (tt & 31) * 8; dst = C.w<bf16>(WS_A1P) + (size_t)r * 256 + c0; const int gl = r >> 8, reim = (r >> 7) & 1, j = r & 127;
#pragma unroll
            for (int e = 0; e < 8; ++e) { const int col = c0 + e, glc = col >> 7, c = col & 127, mm = (j * c) & 127; float sn, cs; sincospif((float)mm * (1.0f / 64.0f), &sn, &cs);
                v[e] = (glc == gl) ? (reim ? -sn : cs) * 0.08838834764831845f : 0.f; } }
        v4u o; o.x = cvtpk(v[0], v[1]); o.y = cvtpk(v[2], v[3]); o.z = cvtpk(v[4], v[5]); o.w = cvtpk(v[6], v[7]); *(v4u*)dst = o;
    }
    if (gt < 1024) { const int pos = gt >> 4, f = gt & 15; const float inv = powf(10000.0f, -(float)f / 16.0f), ang = (float)pos * inv;
        C.w<float>(WS_ROPE)[gt * 2] = cosf(ang); C.w<float>(WS_ROPE)[gt * 2 + 1] = sinf(ang); }
}

__device__ __forceinline__ void s5_mats_block(const Ctx& C, int l, int g, int part) {
    LAS f32x2* pw = (LAS f32x2*)C.lds;
    LAS f32x2* Bb = pw + 2 * 17 * 64;
    LAS f32x2* Cm = Bb + 2 * 64 * 16;
    LAS float* Kl = (LAS float*)(Cm + 2 * 16 * 64);
    const int tid = C.tid;
    if (tid < 128) {
        const int d = tid >> 6, n = tid & 63; const size_t gi = ((size_t)(l * 2 + d) * 32 + g);
        const float lr = C.in[I_ARE][gi * 64 + n], li = C.in[I_AIM][gi * 64 + n], dt = expf(C.in[I_LDT][gi]);
        float mag = expf(dt * lr), sn, cs; sincosf(dt * li, &sn, &cs);
        { const float are = mag * cs, aim = mag * sn; float pr = 1.0f, pi = 0.0f;
          for (int tau = 0; tau <= 16; ++tau) { pw[(d * 17 + tau) * 64 + n] = (f32x2){pr, pi}; const float nr = pr * are - pi * aim, ni = pr * aim + pi * are; pr = nr; pi = ni; } }
        const float x = mag * cs - 1.0f, y = mag * sn, den = 1.0f / (lr * lr + li * li), cr = (x * lr + y * li) * den, cim = (y * lr - x * li) * den;
        const float* br = C.in[I_BRE] + (gi * 64 + n) * 16; const float* bi = C.in[I_BIM] + (gi * 64 + n) * 16;
#pragma unroll
        for (int q = 0; q < 16; ++q) Bb[(d * 64 + n) * 16 + q] = (f32x2){cr * br[q] - cim * bi[q], cr * bi[q] + cim * br[q]};
        if (part == 0) { const f32x2 p16 = pw[(d * 17 + 16) * 64 + n]; C.w<float>(WS_A16)[(gi * 64 + n) * 2] = p16.x; C.w<float>(WS_A16)[(gi * 64 + n) * 2 + 1] = p16.y; }
    }
    for (int idx = tid; idx < 2048; idx += NTHR) { const int d = idx >> 10, p = (idx >> 6) & 15, n = idx & 63; const size_t o = (((size_t)(l * 2 + d) * 32 + g) * 16 + p) * 64 + n;
        Cm[idx] = (f32x2){C.in[I_CRE][o], C.in[I_CIM][o]}; }
    __syncthreads();
    {
        const int d = tid >> 8, p = (tid >> 4) & 15, q = tid & 15; float a0 = 0.f, a1 = 0.f;
        for (int n = 0; n < 64; ++n) { const f32x2 c = Cm[(d * 16 + p) * 64 + n], bq = Bb[(d * 64 + n) * 16 + q]; const float wr = c.x * bq.x - c.y * bq.y, wi = c.x * bq.y + c.y * bq.x;
            const f32x2 p0 = pw[(d * 17 + 2 * part) * 64 + n], p1 = pw[(d * 17 + 2 * part + 1) * 64 + n]; a0 += wr * p0.x - wi * p0.y; a1 += wr * p1.x - wi * p1.y; }
        Kl[(d * 2 + 0) * 256 + p * 16 + q] = a0; Kl[(d * 2 + 1) * 256 + p * 16 + q] = a1;
    }
    __syncthreads();
    bf16* BtE = C.w<bf16>(WS_BTE) + (size_t)g * 256 * 256; bf16* BtY = C.w<bf16>(WS_BTY) + (size_t)g * 256 * 512;
    const float* dsk = C.in[I_SD] + (size_t)l * 512 + g * 16;
    for (int task = tid; task < 2 * 2 * 16 * 32; task += NTHR) {
        const int e = task >> 10, d = (task >> 9) & 1, blk = (task >> 5) & 15, p = (task >> 1) & 15, q0 = (task & 1) * 8, tau = 2 * part + e;
        if (blk >= 16 - tau || (tau == 0 && d == 1)) continue;
        const int t = d == 0 ? blk + tau : blk, j = d == 0 ? blk : blk + tau; float v[8];
#pragma unroll
        for (int k = 0; k < 8; ++k) { float s = Kl[(d * 2 + e) * 256 + p * 16 + q0 + k]; if (tau == 0) { s += Kl[(1 * 2 + e) * 256 + p * 16 + q0 + k]; if (q0 + k == p) s += dsk[p]; } v[k] = s; }
        v4u o; o.x = cvtpk(v[0], v[1]); o.y = cvtpk(v[2], v[3]); o.z = cvtpk(v[4], v[5]); o.w = cvtpk(v[6], v[7]); *(v4u*)(BtY + (size_t)(t * 16 + p) * 512 + j * 16 + q0) = o;
    }
    for (int task = tid; task < 2 * 32 * 32; task += NTHR) {
        const int which = task >> 10, r = 32 * part + ((task >> 5) & 31), c0 = (task & 31) * 8; float v[8]; bf16* dst;
        if (which == 0) { const int d = r >> 7, reim = (r >> 6) & 1, n = r & 63, j = c0 >> 4, q0 = c0 & 15, ex = d == 0 ? 15 - j : j; dst = BtE + (size_t)r * 256 + c0; const f32x2 a = pw[(d * 17 + ex) * 64 + n];
#pragma unroll
            for (int k = 0; k < 8; ++k) { const f32x2 bq = Bb[(d * 64 + n) * 16 + q0 + k]; v[k] = reim ? (a.x * bq.y + a.y * bq.x) : (a.x * bq.x - a.y * bq.y); } }
        else { const int t = r >> 4, p = r & 15, d = c0 >> 7, reim = (c0 >> 6) & 1, n0 = c0 & 63, ex = d == 0 ? t + 1 : 16 - t; dst = BtY + (size_t)r * 512 + 256 + c0;
#pragma unroll
            for (int k = 0; k < 8; ++k) { const f32x2 c = Cm[(d * 16 + p) * 64 + n0 + k], a = pw[(d * 17 + ex) * 64 + n0 + k]; v[k] = reim ? -(c.x * a.y + c.y * a.x) : (c.x * a.x - c.y * a.y); } }
        v4u o; o.x = cvtpk(v[0], v[1]); o.y = cvtpk(v[2], v[3]); o.z = cvtpk(v[4], v[5]); o.w = cvtpk(v[6], v[7]); *(v4u*)dst = o;
    }
    __syncthreads();
}

__device__ __forceinline__ void prep_layer(const Ctx& C, int l, int parts, int blo, int bcnt) {
    if (C.vcu < blo || C.vcu >= blo + bcnt) return;
    const int bi = C.vcu - blo, wi = bi * NWAVES + C.wave, nw = bcnt * NWAVES;
    if (parts & 1) for (int it = bi; it < 256; it += bcnt) s5_mats_block(C, l, it >> 3, it & 7);
    LAS float* scr = (LAS float*)(C.lds + C.wave * 16384);
    constexpr int I_1 = 16 * 104, I_2 = 16 * 96, I_3 = 8 * 32, I_4 = 8 * 16, I_5 = 8 * 32, I_6 = 16 * 32;
    if (parts & 1) {
        for (int it = wi; it < I_1 + I_2 + I_3 + I_4; it += nw) {
            int r = it;
            if (r < I_1) { transpose_item(C.in[I_WIN] + (size_t)l * 1024 * INW, 1024, INW, C.w<bf16>(WS_WCAT), RmWin{}, scr, r, C.lane); continue; } r -= I_1;
            if (r < I_2) { transpose_item(C.in[I_MW] + (size_t)l * 1024 * 3072, 1024, 3072, C.w<bf16>(WS_WCAT), RmId{INW}, scr, r, C.lane); continue; } r -= I_2;
            if (r < I_3) { transpose_item(C.in[I_GLU] + (size_t)l * 512 * 1024, 512, 1024, C.w<bf16>(WS_WGLU), RmGlu{}, scr, r, C.lane); continue; } r -= I_3;
            transpose_item(C.in[I_FN] + (size_t)l * 512 * 512, 512, 512, C.w<bf16>(WS_WFN), RmId{0}, scr, r, C.lane, 1024, 512);
        }
        for (int t = bi * NTHR + C.tid; t < 2 * 2 * 256 * 16; t += bcnt * NTHR) {
            const int kv = t >> 13, r = t & 8191, b = r >> 12, s = (r >> 4) & 255, c0 = (r & 15) * 8;
            const float* src = C.in[kv ? I_CV : I_CK] + (((size_t)b * DEPTH + l) * 256 + s) * KVW + c0;
            const f32x4 a = *(const f32x4*)src, bq = *(const f32x4*)(src + 4);
            v4u o; o.x = cvtpk(a[0], a[1]); o.y = cvtpk(a[2], a[3]); o.z = cvtpk(bq[0], bq[1]); o.w = cvtpk(bq[2], bq[3]);
            *(v4u*)(C.w<bf16>(kv ? WS_VL : WS_KL) + ((size_t)b * LKV + S_LAT + s) * KVW + c0) = o;
        }
    }
    if (parts & 2) for (int it = wi; it < 3 * I_5; it += nw) { const int nb = it / I_5;
        transpose_item(C.in[I_WBR] + ((size_t)l * 3 + nb) * 512 * 1024, 512, 1024, C.w<bf16>(WS_WBR) + (size_t)nb * 1024 * 512, RmId{0}, scr, it - nb * I_5, C.lane); }
    if (parts & 4) for (int it = wi; it < I_6; it += nw) transpose_item(C.in[I_WOUT] + (size_t)l * 1024 * 1024, 1024, 1024, C.w<bf16>(WS_WOUT), RmId{0}, scr, it, C.lane);
}

__device__ __forceinline__ void rows_phase(const Ctx& C, int l, bool last);
__device__ __forceinline__ void ph_l1(const Ctx& C, int l) {
    if (l > 0) prep_layer(C, l, 6, 0, GRID);
    rows_phase(C, l, false);
}

__device__ __forceinline__ void rows_phase(const Ctx& C, int l, bool last) {
    const float* modf = C.w<float>(WS_MODF); float* XR = C.w<float>(WS_XRES);
    const bf16* T0 = C.w<bf16>(WS_PB); const bf16* T1 = C.w<bf16>(WS_GA);
    f32x4 v[4][4];
#pragma unroll
    for (int i = 0; i < 4; ++i) { const int row = C.gw + i * 2048;
        const float* xr = l == 0 ? (i < 2 ? C.in[I_XP] + (size_t)row * 1024 : C.in[I_XS] + (size_t)(row - T_CTX) * 1024) : XR + (size_t)row * 1024;
#pragma unroll
        for (int j = 0; j < 4; ++j) v[i][j] = *(const f32x4*)(xr + C.lane * 4 + 256 * j); }
#pragma unroll
    for (int i = 0; i < 4; ++i) { const int row = C.gw + i * 2048, ci = i < 2 ? 0 : i - 1; float ss = 0.f;
        if (l > 0) {
            const float* gp = modf + ((size_t)(l - 1) * 3 + ci) * 3072 + 2048 + C.lane * 4; u32x2 t0[4], t1[4]; f32x4 gt[4];
#pragma unroll
            for (int j = 0; j < 4; ++j) { t0[j] = *(const u32x2*)(T0 + (size_t)row * 1024 + C.lane * 4 + 256 * j); t1[j] = *(const u32x2*)(T1 + (size_t)row * 1024 + C.lane * 4 + 256 * j); gt[j] = *(const f32x4*)(gp + 256 * j); }
#pragma unroll
            for (int j = 0; j < 4; ++j) v[i][j] += gt[j] * (bf4_to_f(t0[j]) + bf4_to_f(t1[j]));
        }
        if (!last) {
#pragma unroll
            for (int j = 0; j < 4; ++j) *(f32x4*)(XR + (size_t)row * 1024 + C.lane * 4 + 256 * j) = v[i][j];
        }
#pragma unroll
        for (int j = 0; j < 4; ++j) ss += (v[i][j][0] * v[i][j][0] + v[i][j][1] * v[i][j][1]) + (v[i][j][2] * v[i][j][2] + v[i][j][3] * v[i][j][3]);
        const float rstd = rsqrtf(wave_sum(ss, C.lane) * (1.0f / 1024.0f) + RMS_EPS);
        if (last) {
#pragma unroll
            for (int j = 0; j < 4; ++j) *(f32x4*)(C.out + (size_t)row * 1024 + C.lane * 4 + 256 * j) = v[i][j] * rstd * *(const f32x4*)(C.in[I_FG] + C.lane * 4 + 256 * j);
        } else {
            const float* mp = modf + ((size_t)l * 3 + ci) * 3072 + C.lane * 4; bf16* hr = C.w<bf16>(WS_H) + (size_t)row * 1024;
#pragma unroll
            for (int j = 0; j < 4; ++j) { const f32x4 sh = *(const f32x4*)(mp + 256 * j), gs = *(const f32x4*)(mp + 1024 + 256 * j); st_bf4(hr + C.lane * 4 + 256 * j, v[i][j] * rstd * gs + sh); }
        }
    }
}

__device__ __forceinline__ void scan_unit(const Ctx& C, int l, int g, int pm) {
    const float* SC = C.w<float>(WS_SC); bf16* UH = C.w<bf16>(WS_UH); const int lane = C.lane;
    const int nitems = pm ? 4 : 32;
    for (int item = C.wave; item < nitems; item += NWAVES) {
        const int bsel = item >> 1, d = item & 1, nch = pm ? 128 : 16, c0 = pm ? 256 + bsel * 128 : bsel * 16;
        const size_t gi = ((size_t)(l * 2 + d) * 32 + g) * 64 + lane;
        const float ar = C.w<float>(WS_A16)[gi * 2], ai = C.w<float>(WS_A16)[gi * 2 + 1];
        float hr = 0.f, hi = 0.f;
        if (pm) { const float* st = C.in[I_ST] + ((((size_t)bsel * DEPTH + l) * 2 + d) * 32 + g) * 128 + lane * 2; hr = st[0]; hi = st[1]; }
        float sr[16], si[16], tr[16], ti[16];
#pragma unroll
        for (int k = 0; k < 16; ++k) { const int c = d == 0 ? c0 + k : c0 + nch - 1 - k; const size_t o = ((size_t)g * 512 + c) * 256 + d * 128 + lane; sr[k] = SC[o]; si[k] = SC[o + 64]; }
        for (int i0 = 0; i0 < nch; i0 += 16) {
            if (i0 + 16 < nch) {
#pragma unroll
                for (int k = 0; k < 16; ++k) { const int c = d == 0 ? c0 + i0 + 16 + k : c0 + nch - 1 - i0 - 16 - k; const size_t o = ((size_t)g * 512 + c) * 256 + d * 128 + lane; tr[k] = SC[o]; ti[k] = SC[o + 64]; }
            }
#pragma unroll
            for (int k = 0; k < 16; ++k) { const int c = d == 0 ? c0 + i0 + k : c0 + nch - 1 - i0 - k; const size_t oh = ((size_t)g * 512 + c) * 512 + 256 + d * 128 + lane;
                UH[oh] = (bf16)(cvtpk(hr, hr) & 0xffffu); UH[oh + 64] = (bf16)(cvtpk(hi, hi) & 0xffffu);
                const float nr = ar * hr - ai * hi + sr[k], ni = ar * hi + ai * hr + si[k]; hr = nr; hi = ni; }
#pragma unroll
            for (int k = 0; k < 16; ++k) { sr[k] = tr[k]; si[k] = ti[k]; }
        }
        if (!pm) { float* o = C.out + OUT_S + ((((size_t)bsel * DEPTH + l) * 2 + d) * 32 + g) * 128 + lane * 2; o[0] = hr; o[1] = hi; }
    }
}

__device__ __forceinline__ void ph_final(const Ctx& C) { rows_phase(C, DEPTH, true); }

__device__ __forceinline__ void attn_any(const Ctx& C, int uidx) {
    size_t tok0, kvoff; int NT, h;
    if (uidx < 128) { const int b = uidx >> 6, qb = uidx & 7; h = (uidx >> 3) & 7; tok0 = (size_t)T_CTX + b * 2048 + qb * 256; kvoff = (size_t)(WS_KL - WS_KC) / 2 + (size_t)b * LKV * KVW; NT = LKV / 64; }
    else { const int u2 = uidx - 128, b = u2 >> 3; h = u2 & 7; tok0 = (size_t)b * 256; kvoff = tok0 * KVW; NT = 4; }
    kvoff += (h >> 2) * 64;
    const attn_body::bf16* Q = (const attn_body::bf16*)C.w<bf16>(WS_Q) + tok0 * 512 + h * 64;
    const attn_body::bf16* Kp = (const attn_body::bf16*)C.w<bf16>(WS_KC) + kvoff;
    attn_body::attn_unit<8>(Q, Kp, Kp + (WS_VC - WS_KC) / 2, (attn_body::bf16*)Q, (const attn_body::bf16*)C.w<bf16>(WS_GC) + tok0 * 512 + h * 64, 512, KVW, NT, (char*)C.lds, C.tid);
}

#ifndef MK_PER_PHASE
#define MK_PER_PHASE 0
#endif
constexpr int NSUB = 7, N_PHASES = 2 + NSUB * DEPTH;


__global__ void __launch_bounds__(NTHR, 2) fwd_kernel(KArgs args) {
    extern __shared__ __attribute__((aligned(16))) unsigned char lds_raw[];
    Ctx C; C.lds = (LAS unsigned char*)lds_raw; C.tid = threadIdx.x; C.lane = C.tid & 63; C.wave = __builtin_amdgcn_readfirstlane(C.tid >> 6); C.bid = blockIdx.x;
    int wave_s = C.wave;
    C.gw = C.bid * NWAVES + C.wave; C.ngw = GRID * NWAVES; C.in = args.in; C.out = args.out; C.ws = args.ws;
    for (int u = C.tid; u < (LDS_BYTES - LDSCTL_OFF) / 4; u += NTHR) ((LAS unsigned*)(C.lds + LDSCTL_OFF))[u] = 0u;
    __syncthreads();
    volatile LAS unsigned* MISC = (volatile LAS unsigned*)(C.lds + MISC_OFF);
    XcdBarrier bar; bar.bar = (unsigned*)(C.ws + WS_CTL) + CW_BAR; bar.x = 0; bar.st = nullptr;
    const bool multi = args.ph_hi - args.ph_lo > 1;
    if (multi) bar = xcd_barrier_post((unsigned*)(C.ws + WS_CTL) + CW_BAR, MISC + 8, C.tid);

    for (int ph = args.ph_lo; ph < args.ph_hi; ++ph) {
        { int l_; asm volatile("v_mbcnt_lo_u32_b32 %0, -1, 0\n\tv_mbcnt_hi_u32_b32 %0, -1, %0" : "=v"(l_)); asm volatile("" : "+s"(wave_s)); int b_ = blockIdx.x; asm volatile("" : "+s"(b_)); C.bid = b_; C.vcu = b_;   C.lane = l_; C.wave = wave_s; C.tid = wave_s * 64 + l_; C.gw = C.bid * NWAVES + C.wave;
          unsigned char* w_ = args.ws; asm volatile("" : "+s"(w_)); C.ws = w_; float* o_ = args.out; asm volatile("" : "+s"(o_)); C.out = o_; }
        const int c = C.vcu;
        if (ph == 0) { ph_prologue(C); __syncthreads(); prep_layer(C, 0, 7, 0, GRID); }
        else if (ph == N_PHASES - 1) ph_final(C);
        else {
            const int l = (ph - 1) / NSUB, sub = (ph - 1) % NSUB;
            if (sub == 0) ph_l1(C, l);
            else {
                if (sub == 2 && c < 128) for (int i = 0; i < 2; ++i) attn_any(C, c + 128 * i);
                if (sub == 3 && c >= 64 && c < 128) { const int L = xswz(c - 64, 64); scan_unit(C, l, L >> 1, L & 1); VM_WAIT(); }
                __syncthreads();
                { PhaseSched S{sub, c, C.bid, C.ws}; EpiAll E{C.ws, C.out, C.in, l}; int t_ = C.tid; asm volatile("" : "+v"(t_));
                  pg8::gemm_stream<EpiAll, PhaseSched>(C.lds, S, E, t_); }
                if (sub == 5 && l + 1 < DEPTH) { __syncthreads(); prep_layer(C, l + 1, 1, 128, 128); }
            }
        }
        if (ph + 1 < args.ph_hi) xcd_barrier(bar, C.tid);
    }
}

extern "C" void kernel_launch(void* const* d_in, const int* in_sizes, int n_in, void* d_out, int out_size, void* d_ws, size_t ws_size, hipStream_t stream) {
    static int ready = 0;
    if (ready == 0) {
        if (n_in != 28 || out_size != (int)OUT_N || ws_size < WS_END) { fprintf(stderr, "kernel_launch: unexpected problem shape (n_in %d, out %d, ws %zu)\n", n_in, out_size, ws_size); ready = -1; return; }
        int dev = 0, cus = 0;
        if (hipGetDevice(&dev) != hipSuccess || hipDeviceGetAttribute(&cus, hipDeviceAttributeMultiprocessorCount, dev) != hipSuccess) { ready = -1; return; }
        if (hipFuncSetAttribute((const void*)fwd_kernel, hipFuncAttributeMaxDynamicSharedMemorySize, LDS_BYTES) != hipSuccess) { fprintf(stderr, "kernel_launch: hipFuncSetAttribute failed\n"); ready = -1; return; }
        if (cus < GRID) { fprintf(stderr, "kernel_launch: device has %d CUs, this kernel needs %d resident workgroups\n", cus, GRID); ready = -1; return; }
        ready = 1;
    }
    if (ready < 0) return;
    (void)hipMemsetAsync((char*)d_ws + WS_CTL, 0, CTL_ZERO_BYTES, stream);
    KArgs a{};
    for (int i = 0; i < 28; ++i) a.in[i] = (const float*)d_in[i];
    a.out = (float*)d_out; a.ws = (unsigned char*)d_ws;
#if MK_PER_PHASE
    for (int ph = 0; ph < N_PHASES; ++ph) { a.ph_lo = ph; a.ph_hi = ph + 1; hipLaunchKernelGGL(fwd_kernel, dim3(GRID), dim3(NTHR), LDS_BYTES, stream, a); }
#else
    a.ph_lo = 0; a.ph_hi = N_PHASES; hipLaunchKernelGGL(fwd_kernel, dim3(GRID), dim3(NTHR), LDS_BYTES, stream, a);
#endif
}
```

```cpp
#include <hip/hip_runtime.h>
#include <hip/hip_bf16.h>
#include <cstdio>
#include <cstdint>
#include <cmath>
namespace pg8 {
#define PG8_LAS __attribute__((address_space(3)))
typedef unsigned short bf16_t;
typedef short bf16x8 __attribute__((ext_vector_type(8)));
typedef float f32x4 __attribute__((ext_vector_type(4)));
typedef unsigned u32x4 __attribute__((ext_vector_type(4)));
constexpr int BM = 256, BK = 64, HALF = 128, HTB = HALF * BK * 2  , STAGE_BYTES = 8 * HTB, NXCD = 8, WGM = 8;

__host__ __device__ __forceinline__ int lds_byte(int r, int c) { const int st = (r >> 4) * 2 + (c >> 5), rr = r & 15, cc = c & 31, ob = rr * 64 + cc * 2; return st * 1024 + (ob ^ (((ob >> 9) & 1) << 5)); }
__host__ __device__ __forceinline__ void stage_rc(int b, int& R, int& C) { const int st = b / 1024, sb = b % 1024, swz = sb ^ (((sb >> 9) & 1) << 5); R = (st >> 1) * 16 + swz / 64; C = (st & 1) * 32 + (swz % 64) / 2; }
__host__ __device__ __forceinline__ int perm32(int rho) { const int n = rho >> 4, i = rho & 15; return 8 * (i >> 2) + 4 * n + (i & 3); }


struct Unit { int pm, pn, z; };
struct StaticOrder {
    int nM, nN, nwg, G, c;
    __host__ __device__ void init(int M, int N, int G_, int c_) { nM = M / BM; nN = N / BM; nwg = nM * nN; G = G_; c = c_; }
    __host__ __device__ bool next(int i, Unit& u) const {
        const long L = (long)i * G + c; if (L >= nwg) return false;
        int wgid = (int)L; { const int q = nwg / NXCD, r = nwg % NXCD, xcd = wgid % NXCD, off = wgid / NXCD; wgid = (xcd < r ? xcd * (q + 1) : r * (q + 1) + (xcd - r) * q) + off; }
        const int nig = WGM * nN, gid = wgid / nig, fm = gid * WGM, gsz = (nM - fm) < WGM ? (nM - fm) : WGM;
        u.pm = fm + ((wgid % nig) % gsz); u.pn = (wgid % nig) / gsz; return true;
    }
    __device__ __forceinline__ void a_ready(const Unit&) const {}
    __device__ __forceinline__ void done(const Unit&) const {}
};
struct UDesc { const bf16_t* A; const bf16_t* Bt; int lda, ldb, K, hB; int kind, pm, pn, z, keep; };
template <class Epi, class Sched>
__device__ __forceinline__ void gemm_stream(PG8_LAS unsigned char* lds, const Sched& S, const Epi& E, const int tid_in) {
    const int tid = tid_in, wid = __builtin_amdgcn_readfirstlane(tid >> 6), lane = tid & 63, wr = wid >> 2, wc = wid & 3, fr = lane & 15, fq = lane >> 4;
    int RA, RB, CC;
    { int R, C; stage_rc(tid * 16, R, C); RA = R; RB = (R & ~31) + perm32(R & 31); CC = C; }
    const size_t kstep = (size_t)(BK * 2);
    const unsigned ldsw = (unsigned)wid * 1024u;
    const int aoff = lds_byte(wr * 64 + fr, fq * 8), boff = lds_byte(wc * 32 + fr, fq * 8);
#define PG8_SA(b, h) (((b) * 2 + (h)) * HTB)
#define PG8_SB(b, h) ((4 + (b) * 2 + (h)) * HTB)
#define PG8_STAGE_X(bufoff, gbase, RR, ld) do { const unsigned _vo = (unsigned)(RR * (ld) + CC) * 2u; \
        __builtin_amdgcn_global_load_lds((const unsigned*)((const char*)(gbase) + _vo), (PG8_LAS unsigned*)(lds + (bufoff) + ldsw), 16, 0, 0); \
        __builtin_amdgcn_global_load_lds((const unsigned*)((const char*)(gbase) + (size_t)(ld) * 128 + _vo), (PG8_LAS unsigned*)(lds + (bufoff) + ldsw + 8192), 16, 0, 0); } while (0)
#define PG8_STAGE_A(bufoff, gbase, ld) PG8_STAGE_X(bufoff, gbase, RA, ld)
#define PG8_STAGE_B(bufoff, gbase, ld) PG8_STAGE_X(bufoff, gbase, RB, ld)
#define PG8_LDA(dst, b, h) do { _Pragma("unroll") for (int m = 0; m < 4; ++m) _Pragma("unroll") for (int k = 0; k < 2; ++k) dst[m][k] = *(const PG8_LAS bf16x8*)(lds + PG8_SA(b, h) + aoff + m * 2048 + k * 1024); } while (0)
#define PG8_LDB(dst, b, h) do { _Pragma("unroll") for (int n = 0; n < 2; ++n) _Pragma("unroll") for (int k = 0; k < 2; ++k) dst[n][k] = *(const PG8_LAS bf16x8*)(lds + PG8_SB(b, h) + boff + n * 2048 + k * 1024); } while (0)
#define PG8_MMA(ai, bj, At, Bt) do { __builtin_amdgcn_s_setprio(1); _Pragma("unroll") for (int m = 0; m < 4; ++m) _Pragma("unroll") for (int n = 0; n < 2; ++n) _Pragma("unroll") for (int k = 0; k < 2; ++k) \
        acc[ai][bj][m][n] = __builtin_amdgcn_mfma_f32_16x16x32_bf16(Bt[n][k], At[m][k], acc[ai][bj][m][n], 0, 0, 0); __builtin_amdgcn_s_setprio(0); } while (0)
#define PG8_WAIT_V(n) asm volatile("s_waitcnt vmcnt(" #n ")" ::: "memory")
#define PG8_WAIT_L(n) asm volatile("s_waitcnt lgkmcnt(" #n ")" ::: "memory")
#define PG8_BAR __builtin_amdgcn_s_barrier()
#define PG8_SCHED __builtin_amdgcn_sched_barrier(0)
    UDesc cur, nxt; int ui = 0;
    if (!S.next(0, cur)) return;
    f32x4 acc[2][2][4][2];
#pragma unroll
    for (int a = 0; a < 2; ++a)
#pragma unroll
        for (int b = 0; b < 2; ++b)
#pragma unroll
            for (int m = 0; m < 4; ++m)
#pragma unroll
                for (int n = 0; n < 2; ++n) acc[a][b][m][n] = (f32x4){0.f, 0.f, 0.f, 0.f};
    bf16x8 At[4][2], B0[2][2], B1[2][2];
    const char* cA = (const char*)cur.A; const char* cB = (const char*)cur.Bt; int ldaC = cur.lda, ldbC = cur.ldb; unsigned hstepA = (unsigned)HALF * ldaC * 2, hstepB = (unsigned)cur.hB * ldbC * 2;
    PG8_STAGE_B(PG8_SB(0, 0), cB, ldbC); PG8_STAGE_B(PG8_SB(0, 1), cB + hstepB, ldbC); PG8_STAGE_A(PG8_SA(0, 0), cA, ldaC); PG8_STAGE_A(PG8_SA(0, 1), cA + hstepA, ldaC);
    if (wr == 1) PG8_BAR;
    PG8_WAIT_V(2); PG8_BAR;
    PG8_STAGE_B(PG8_SB(1, 0), cB + kstep, ldbC); PG8_STAGE_A(PG8_SA(1, 0), cA + kstep, ldaC); PG8_STAGE_B(PG8_SB(1, 1), cB + hstepB + kstep, ldbC);
    PG8_WAIT_V(6); PG8_BAR;
    for (;;) {
        const bool has_next = S.next(ui + 1, nxt);
        const char* nA = has_next ? (const char*)nxt.A : cA; const char* nB = has_next ? (const char*)nxt.Bt : cB;
        const int ldaN = has_next ? nxt.lda : ldaC, ldbN = has_next ? nxt.ldb : ldbC; const unsigned hstepAN = (unsigned)HALF * ldaN * 2, hstepBN = has_next ? (unsigned)nxt.hB * ldbN * 2 : hstepB;
        const int nt = cur.K / BK;
        for (int t = 0; t < nt; t += 2) {
            const bool last = (t == nt - 2);
            const char* a1 = cA + (size_t)(t + 1) * kstep;
            const char* a2 = last ? nA : cA + (size_t)(t + 2) * kstep; const char* b2 = last ? nB : cB + (size_t)(t + 2) * kstep;
            const char* a3 = a2 + kstep; const char* b3 = b2 + kstep;
            const int lda2 = last ? ldaN : ldaC, ldb2 = last ? ldbN : ldbC; const unsigned hA2 = last ? hstepAN : hstepA, hB2 = last ? hstepBN : hstepB;
            PG8_LDB(B0, 0, 0); PG8_LDB(B1, 0, 1); PG8_SCHED; PG8_LDA(At, 0, 0); PG8_STAGE_A(PG8_SA(1, 1), a1 + hstepA, ldaC);
            PG8_WAIT_V(8); PG8_WAIT_L(0); PG8_BAR; PG8_MMA(0, 0, At, B0); PG8_MMA(0, 1, At, B1); PG8_BAR; PG8_SCHED;
            PG8_LDA(At, 0, 1); PG8_STAGE_B(PG8_SB(0, 0), b2, ldb2); PG8_STAGE_B(PG8_SB(0, 1), b2 + hB2, ldb2); PG8_STAGE_A(PG8_SA(0, 0), a2, lda2);
            PG8_WAIT_V(8); PG8_WAIT_L(0); PG8_BAR; PG8_MMA(1, 0, At, B0); PG8_MMA(1, 1, At, B1); PG8_BAR; PG8_SCHED;
            PG8_LDB(B0, 1, 0); PG8_LDB(B1, 1, 1); PG8_SCHED; PG8_LDA(At, 1, 0); PG8_STAGE_A(PG8_SA(0, 1), a2 + hA2, lda2);
            PG8_WAIT_V(8); PG8_WAIT_L(0); PG8_BAR; PG8_MMA(0, 0, At, B0); PG8_MMA(0, 1, At, B1); PG8_BAR; PG8_SCHED;
            PG8_LDA(At, 1, 1); PG8_STAGE_B(PG8_SB(1, 0), b3, ldb2); PG8_STAGE_B(PG8_SB(1, 1), b3 + hB2, ldb2); PG8_STAGE_A(PG8_SA(1, 0), a3, lda2);
            PG8_WAIT_V(8); PG8_WAIT_L(0); PG8_BAR; PG8_MMA(1, 0, At, B0); PG8_MMA(1, 1, At, B1); PG8_BAR; PG8_SCHED;
        }
        if (wr == 0) PG8_BAR;
        const bool chained = E.transform(acc, cur, wr, wc, fr, fq);
        if (!chained) E(acc, cur, wr, wc, fr, fq);
        if (!has_next) break;
        if (!chained) {
#pragma unroll
        for (int a = 0; a < 2; ++a)
#pragma unroll
            for (int b = 0; b < 2; ++b)
#pragma unroll
                for (int m = 0; m < 4; ++m)
#pragma unroll
                    for (int n = 0; n < 2; ++n) acc[a][b][m][n] = (f32x4){0.f, 0.f, 0.f, 0.f};
        }
        cur = nxt; cA = nA; cB = nB; ldaC = ldaN; ldbC = ldbN; hstepA = hstepAN; hstepB = hstepBN; ++ui;
        if (wr == 1) PG8_BAR;
    }
    PG8_WAIT_V(0);
    PG8_BAR;
#undef PG8_SA
#undef PG8_SB
#undef PG8_STAGE_X
#undef PG8_STAGE_A
#undef PG8_STAGE_B
#undef PG8_LDA
#undef PG8_LDB
#undef PG8_MMA
#undef PG8_WAIT_V
#undef PG8_WAIT_L
#undef PG8_BAR
#undef PG8_SCHED
}
}

#include <hip/hip_bf16.h>
#include <cmath>
namespace attn_body {
using bf16=__hip_bfloat16;
using bf16x8=__attribute__((ext_vector_type(8)))short;
using s16x4=__attribute__((ext_vector_type(4)))short;
using f32x16=__attribute__((ext_vector_type(16)))float;
using u32x4=__attribute__((ext_vector_type(4)))unsigned;
constexpr int D=64;
constexpr int NW=8,QBLK=32,QB=QBLK*NW,KVBLK=64;
__device__ __forceinline__ int crow(int r,int hi){return (r&3)+8*(r>>2)+4*hi;}
#define SBAR() __builtin_amdgcn_sched_barrier(0)
constexpr int NSLOT=3, SLOTB=8192;
constexpr int LDS_K=0, LDS_V=NSLOT*SLOTB, LDS_WS=2*NSLOT*SLOTB, LDS_OST=LDS_WS+NW*64*4, LDS_BYTES=LDS_OST+NW*4096;
constexpr float C2=0.125f*1.4426950408889634f;
__device__ __forceinline__ void glds16(const void*gsrc,unsigned lds_dst){unsigned keep;
  asm volatile("s_mov_b32 %0, m0\n\ts_mov_b32 m0, %2\n\ts_nop 0\n\tglobal_load_lds_dwordx4 %1, off\n\ts_mov_b32 m0, %0":"=&s"(keep):"v"(gsrc),"s"(lds_dst):"memory");}
__device__ __forceinline__ float max3f(float a,float b,float c){float r;asm("v_max3_f32 %0, %1, %2, %3":"=v"(r):"v"(a),"v"(b),"v"(c));return r;}
__device__ __forceinline__ float max2f(float a,float b){float r;asm("v_max_f32_e32 %0, %1, %2":"=v"(r):"v"(a),"v"(b));return r;}
__device__ __forceinline__ float fadd_s(float a,float b){float r;asm("v_add_f32_e32 %0, %1, %2":"=v"(r):"v"(a),"v"(b));return r;}
__device__ __forceinline__ float fsub_s(float a,float b){float r;asm("v_sub_f32_e32 %0, %1, %2":"=v"(r):"v"(a),"v"(b));return r;}
typedef float f32x2_t __attribute__((ext_vector_type(2))); typedef __bf16 bf16x2_t __attribute__((ext_vector_type(2)));
__device__ __forceinline__ unsigned cvtpk_s(float lo,float hi){f32x2_t v={lo,hi};bf16x2_t b=__builtin_convertvector(v,bf16x2_t);return __builtin_bit_cast(unsigned,b);}
#define WAIT_BAR(N) asm volatile("s_waitcnt vmcnt(" #N ") lgkmcnt(0)\n\ts_barrier":::"memory")

__device__ __forceinline__ void qkt(f32x16&p0,f32x16&p1,const char*Kslot,const bf16x8*qr,const f32x16&negm,int r32,int hi){
  const char*kb=Kslot+hi*1024+r32*16;
  #pragma unroll
  for(int d0=0;d0<4;++d0){
    const bf16x8 b0=*reinterpret_cast<const bf16x8*>(kb+d0*2048);
    const bf16x8 b1=*reinterpret_cast<const bf16x8*>(kb+d0*2048+512);
    if(d0==0){p0=__builtin_amdgcn_mfma_f32_32x32x16_bf16(b0,qr[0],negm,0,0,0);p1=__builtin_amdgcn_mfma_f32_32x32x16_bf16(b1,qr[0],negm,0,0,0);}
    else{p0=__builtin_amdgcn_mfma_f32_32x32x16_bf16(b0,qr[d0],p0,0,0,0);p1=__builtin_amdgcn_mfma_f32_32x32x16_bf16(b1,qr[d0],p1,0,0,0);}}
}
typedef __attribute__((address_space(3))) const char* lds_cptr;
typedef short v4i16_t __attribute__((ext_vector_type(4)));
__device__ __forceinline__ void kload8(bf16x8*kf,lds_cptr kp){
  kf[0]=*(const __attribute__((address_space(3))) bf16x8*)(kp);      kf[1]=*(const __attribute__((address_space(3))) bf16x8*)(kp+512);
  kf[2]=*(const __attribute__((address_space(3))) bf16x8*)(kp+2048); kf[3]=*(const __attribute__((address_space(3))) bf16x8*)(kp+2560);
  kf[4]=*(const __attribute__((address_space(3))) bf16x8*)(kp+4096); kf[5]=*(const __attribute__((address_space(3))) bf16x8*)(kp+4608);
  kf[6]=*(const __attribute__((address_space(3))) bf16x8*)(kp+6144); kf[7]=*(const __attribute__((address_space(3))) bf16x8*)(kp+6656);
}
__device__ __forceinline__ void kload2(bf16x8*kf,lds_cptr kp,int j){ kf[2*j]=*(const __attribute__((address_space(3))) bf16x8*)(kp+j*2048); kf[2*j+1]=*(const __attribute__((address_space(3))) bf16x8*)(kp+j*2048+512); }
__device__ __forceinline__ s16x4 vtr(lds_cptr p){ return __builtin_bit_cast(s16x4,__builtin_amdgcn_ds_read_tr16_b64_v4i16((__attribute__((address_space(3))) v4i16_t*)p)); }
__device__ __forceinline__ float rowmax(const f32x16&p0,const f32x16&p1){
  float a=max3f(p0[0],p0[1],p1[0]),b=max3f(p0[2],p0[3],p1[1]);a=max3f(a,p1[2],p1[3]);
  #pragma unroll
  for(int r=4;r<16;r+=4){a=max3f(a,p0[r],p0[r+1]);b=max3f(b,p0[r+2],p0[r+3]);a=max3f(a,p1[r],p1[r+1]);b=max3f(b,p1[r+2],p1[r+3]);}
  const float m=max2f(a,b);
  auto rr=__builtin_amdgcn_permlane32_swap(__float_as_uint(m),__float_as_uint(m),false,false);
  return max2f(__uint_as_float(rr[0]),__uint_as_float(rr[1]));
}
__device__ __forceinline__ void pv(f32x16*o,int vb,bf16x8 pa0,bf16x8 pa1,bf16x8 pa2,bf16x8 pa3){
  #pragma unroll
  for(int d0=0;d0<2;++d0){s16x4 lo[4],hi[4];
    #pragma unroll
    for(int ks=0;ks<4;++ks){
      asm volatile("ds_read_b64_tr_b16 %0,%1 offset:%c2":"=&v"(lo[ks]):"v"(vb),"i"(d0*4096+ks*1024):"memory");
      asm volatile("ds_read_b64_tr_b16 %0,%1 offset:%c2":"=&v"(hi[ks]):"v"(vb),"i"(d0*4096+ks*1024+512):"memory");}
    asm volatile("s_waitcnt lgkmcnt(0)":::"memory");SBAR();
    #define PK(k) (bf16x8){lo[k][0],lo[k][1],lo[k][2],lo[k][3],hi[k][0],hi[k][1],hi[k][2],hi[k][3]}
    o[d0]=__builtin_amdgcn_mfma_f32_32x32x16_bf16(pa0,PK(0),o[d0],0,0,0);
    o[d0]=__builtin_amdgcn_mfma_f32_32x32x16_bf16(pa1,PK(1),o[d0],0,0,0);
    o[d0]=__builtin_amdgcn_mfma_f32_32x32x16_bf16(pa2,PK(2),o[d0],0,0,0);
    o[d0]=__builtin_amdgcn_mfma_f32_32x32x16_bf16(pa3,PK(3),o[d0],0,0,0);
    #undef PK
  }
}

#ifndef ATTN_STORE16
#define ATTN_STORE16(p,v) (*(u32x4*)(p)=(v))
#endif
template<int THRL> __device__ __forceinline__ void attn_unit(const bf16*Qu,const bf16*Kh,const bf16*Vh,bf16*Ou,const bf16*Gu,const int QP,const int KP,const int NT,char*shm,const int tid_in){
  const int tid=tid_in,lane=tid&63,r32=lane&31,hi=lane>>5; const int wid=__builtin_amdgcn_readfirstlane(tid>>6);
  const bf16*Qw=Qu+(long)(wid*QBLK)*QP;
  const unsigned lds0=(unsigned)(uintptr_t)shm;
  float*wsf=(float*)(shm+LDS_WS)+wid*64;
  const bf16*ksrc=Kh+(long)lane*KP+wid*8;
  const bf16*vsrc=Vh+(long)(16*(wid&3)+(lane>>2))*KP+(wid>>2)*32+(lane&3)*8;
  const unsigned kdst=lds0+LDS_K+wid*1024, vdst=lds0+LDS_V+wid*1024;
  #define DMA_K(t,slot) glds16(ksrc+(long)(t)*KVBLK*KP,(unsigned)__builtin_amdgcn_readfirstlane(kdst+(slot)))
  #define DMA_V(t,slot) glds16(vsrc+(long)(t)*KVBLK*KP,(unsigned)__builtin_amdgcn_readfirstlane(vdst+(slot)))
  const int vb0=(int)(lds0+LDS_V)+((lane>>4)&1)*32+(lane&3)*8+(4*hi+((lane&15)>>2))*64;
  const char*Kbase=shm+LDS_K; bf16x8 kf[8];
  const lds_cptr shm3=(lds_cptr)shm; const lds_cptr kp0=shm3+LDS_K+hi*1024+r32*16; const lds_cptr vp0=shm3+LDS_V+((lane>>4)&1)*32+(lane&3)*8+(4*hi+((lane&15)>>2))*64;
  DMA_K(0,0);DMA_V(0,0);DMA_K(1,SLOTB);
  bf16x8 qr[4];
  #pragma unroll
  for(int d0=0;d0<4;++d0)qr[d0]=*reinterpret_cast<const bf16x8*>(&Qw[(long)r32*QP+d0*16+hi*8]);
  float mhat=0.f,l_reg=0.f;f32x16 o[2];o[0]=f32x16{};o[1]=f32x16{};f32x16 negm; {float zf_; asm volatile("v_mov_b32 %0, 0":"=v"(zf_)); _Pragma("unroll") for(int r=0;r<16;++r)negm[r]=zf_;} asm volatile("":"+v"(negm));
  #define CMASK(P0,P1,t) do{}while(0)
  bool resc=false;
  #define START(P0,P1) do{ const float rm=rowmax(P0,P1); resc=false; \
    { const float dl=rm; mhat=fadd_s(mhat,dl); \
      _Pragma("unroll") for(int r=0;r<16;++r){P0[r]=fsub_s(P0[r],dl);P1[r]=fsub_s(P1[r],dl);} \
      _Pragma("unroll") for(int r=0;r<16;++r)negm[r]=-mhat; asm volatile("":"+v"(negm)); } \
    _Pragma("unroll") for(int r=0;r<16;++r)P0[r]=__builtin_amdgcn_exp2f(P0[r]); }while(0)
  #define RESC() do{ if(resc){ asm volatile("s_waitcnt lgkmcnt(0)":::"memory"); \
      _Pragma("unroll") for(int d_=0;d_<2;++d_) _Pragma("unroll") for(int r=0;r<16;++r)o[d_][r]*=wsf[crow(r,hi)]; } }while(0)
  f32x16 pA0,pA1,pB0,pB1;
  int sl_prev=0,sl_cur=0,sl_next=SLOTB;
  #define ROT() do{sl_prev=sl_cur;sl_cur=sl_next;sl_next=(sl_next==(NSLOT-1)*SLOTB)?0:sl_next+SLOTB;}while(0)
  DMA_K(2,2*SLOTB);
  WAIT_BAR(3);
  qkt(pA0,pA1,Kbase,qr,negm,r32,hi);asm volatile("s_nop 15\n\ts_nop 7":"+v"(pA0),"+v"(pA1));CMASK(pA0,pA1,0);
  START(pA0,pA1);
  _Pragma("unroll") for(int r=0;r<16;++r)pA1[r]=__builtin_amdgcn_exp2f(pA1[r]);
  WAIT_BAR(0);
  DMA_K(3,0);DMA_V(1,SLOTB);
  ROT();
  kload8(kf,kp0+sl_cur);
  WAIT_BAR(2);
  s16x4 vlo[8],vhi[8]; u32x4 pw0,pw1,pw2,pw3;
  #define PKW(P,B) cvtpk_s(P[B],P[B+1])
  #define PAF(k) __builtin_bit_cast(bf16x8,pw##k)
  #define VFR(i) (bf16x8){vlo[i][0],vlo[i][1],vlo[i][2],vlo[i][3],vhi[i][0],vhi[i][1],vhi[i][2],vhi[i][3]}
  #define PIN(x) asm volatile("":"+v"(x))
  #define MX3(a,b,c) __builtin_fmaxf(__builtin_fmaxf((a),(b)),(c))
  #define GAPA(MF,A0,A1,A2,A3,W0,W1,PW) do{ MF; sacc+=A0; sacc+=A1; sacc+=A2; sacc+=A3; PIN(sacc); W0; W1; PIN(PW); SBAR(); }while(0)
  #define EX(v) __builtin_amdgcn_exp2f(v)
  #define GAPB(MF,X,B) do{ MF; X[B]=EX(X[B]); X[B+1]=EX(X[B+1]); X[B+2]=EX(X[B+2]); X[B+3]=EX(X[B+3]); PIN(X); SBAR(); }while(0)
  #define VRD(i) do{ vlo[i]=vtr(vp_+(((i)>>2)*4096+((i)&3)*1024)); vhi[i]=vtr(vp_+(((i)>>2)*4096+((i)&3)*1024+512)); }while(0)
  #define KRD(G,j) do{ if(G){ kload2(kf,kp0+sl_next,j); SBAR(); } }while(0)
  #define STEP(C0,C1,P0,P1,t,GK,GV,GL) do{ SBAR(); \
    const lds_cptr vp_=vp0+sl_prev; \
    VRD(0); SBAR(); float sacc=(P0[0]+P0[1]); \
    GAPA(C0=__builtin_amdgcn_mfma_f32_32x32x16_bf16(kf[0],qr[0],negm,0,0,0), P0[2],P0[3],P0[4],P0[5],     pw0[0]=PKW(P0,0), pw0[1]=PKW(P0,2), pw0); \
    VRD(4); SBAR(); GAPA(C1=__builtin_amdgcn_mfma_f32_32x32x16_bf16(kf[1],qr[0],negm,0,0,0), P0[6],P0[7],P0[8],P0[9],     pw0[2]=PKW(P0,4), pw0[3]=PKW(P0,6), pw0); \
    VRD(1); SBAR(); GAPA(C0=__builtin_amdgcn_mfma_f32_32x32x16_bf16(kf[2],qr[1],C0,0,0,0),   P0[10],P0[11],P0[12],P0[13], pw1[0]=PKW(P0,8), pw1[1]=PKW(P0,10), pw1); \
    VRD(5); SBAR(); GAPA(C1=__builtin_amdgcn_mfma_f32_32x32x16_bf16(kf[3],qr[1],C1,0,0,0),   P0[14],P0[15],P1[0],P1[1],   pw1[2]=PKW(P0,12),pw1[3]=PKW(P0,14), pw1); \
    VRD(2); SBAR(); GAPA(C0=__builtin_amdgcn_mfma_f32_32x32x16_bf16(kf[4],qr[2],C0,0,0,0),   P1[2],P1[3],P1[4],P1[5],     pw2[0]=PKW(P1,0), pw2[1]=PKW(P1,2), pw2); \
    VRD(6); SBAR(); GAPA(C1=__builtin_amdgcn_mfma_f32_32x32x16_bf16(kf[5],qr[2],C1,0,0,0),   P1[6],P1[7],P1[8],P1[9],     pw2[2]=PKW(P1,4), pw2[3]=PKW(P1,6), pw2); \
    VRD(3); SBAR(); GAPA(C0=__builtin_amdgcn_mfma_f32_32x32x16_bf16(kf[6],qr[3],C0,0,0,0),   P1[10],P1[11],P1[12],P1[13], pw3[0]=PKW(P1,8), pw3[1]=PKW(P1,10), pw3); \
    VRD(7); SBAR(); GAPA(C1=__builtin_amdgcn_mfma_f32_32x32x16_bf16(kf[7],qr[3],C1,0,0,0),   P1[14],P1[15],0.f,0.f,       pw3[2]=PKW(P1,12),pw3[3]=PKW(P1,14), pw3); \
    l_reg+=sacc; \
    if(GK){DMA_K((t)+3,sl_cur);} if(GV){DMA_V((t)+1,sl_next);} \
    CMASK(C0,C1,t); \
    { float a=MX3(C0[0],C0[1],C1[0]),b=MX3(C0[2],C0[3],C1[1]); a=MX3(a,C1[2],C1[3]); \
      _Pragma("unroll") for(int r=4;r<16;r+=4){a=MX3(a,C0[r],C0[r+1]);b=MX3(b,C0[r+2],C0[r+3]);a=MX3(a,C1[r],C1[r+1]);b=MX3(b,C1[r+2],C1[r+3]);} \
      float rm=__builtin_fmaxf(a,b); { auto rr=__builtin_amdgcn_permlane32_swap(__float_as_uint(rm),__float_as_uint(rm),false,false); rm=__builtin_fmaxf(__uint_as_float(rr[0]),__uint_as_float(rr[1])); } \
      resc=false; \
      if(__builtin_expect(__any(rm>(float)THRL),0)){ const float dl=__builtin_fmaxf(rm,0.f); mhat+=dl; \
        _Pragma("unroll") for(int r=0;r<16;++r){C0[r]-=dl;C1[r]-=dl;} \
        _Pragma("unroll") for(int r=0;r<16;++r)negm[r]=-mhat; asm volatile("":"+v"(negm)); \
        const float f=__builtin_amdgcn_exp2f(-dl); l_reg*=f; if(hi==0)wsf[r32]=f; resc=true; } } \
    SBAR(); \
    GAPB(o[0]=__builtin_amdgcn_mfma_f32_32x32x16_bf16(PAF(0),VFR(0),o[0],0,0,0), C0,0); \
    GAPB(o[1]=__builtin_amdgcn_mfma_f32_32x32x16_bf16(PAF(0),VFR(4),o[1],0,0,0), C0,4); \
    KRD(GL,0); GAPB(o[0]=__builtin_amdgcn_mfma_f32_32x32x16_bf16(PAF(1),VFR(1),o[0],0,0,0), C0,8); \
    KRD(GL,1); GAPB(o[1]=__builtin_amdgcn_mfma_f32_32x32x16_bf16(PAF(1),VFR(5),o[1],0,0,0), C0,12); \
    KRD(GL,2); GAPB(o[0]=__builtin_amdgcn_mfma_f32_32x32x16_bf16(PAF(2),VFR(2),o[0],0,0,0), C1,0); \
    KRD(GL,3); GAPB(o[1]=__builtin_amdgcn_mfma_f32_32x32x16_bf16(PAF(2),VFR(6),o[1],0,0,0), C1,4); \
    GAPB(o[0]=__builtin_amdgcn_mfma_f32_32x32x16_bf16(PAF(3),VFR(3),o[0],0,0,0), C1,8); \
    GAPB(o[1]=__builtin_amdgcn_mfma_f32_32x32x16_bf16(PAF(3),VFR(7),o[1],0,0,0), C1,12); \
    }while(0)
  int t=1;
  #undef CMASK
  #define CMASK(P0,P1,t) do{}while(0)
  for(;t+5<NT;t+=2){
    STEP(pB0,pB1,pA0,pA1,t,true,true,true);     WAIT_BAR(2); RESC(); ROT();
    STEP(pA0,pA1,pB0,pB1,t+1,true,true,true);   WAIT_BAR(2); RESC(); ROT();
  }
  #undef CMASK
  #define CMASK(P0,P1,t) do{}while(0)
  #define ENDW(tt) do{ if((tt)+3<NT){WAIT_BAR(2);} else if((tt)+2<NT){WAIT_BAR(1);} else {WAIT_BAR(0);} }while(0)
  for(;t+1<NT;t+=2){
    STEP(pB0,pB1,pA0,pA1,t,(t+3<NT),(t+1<NT),(t+1<NT));       ENDW(t);   RESC(); ROT();
    STEP(pA0,pA1,pB0,pB1,t+1,(t+4<NT),(t+2<NT),(t+2<NT));     ENDW(t+1); RESC(); ROT();
  }
  STEP(pB0,pB1,pA0,pA1,NT-1,false,false,false); RESC();
  { float sacc=pB0[0]+pB0[1]; _Pragma("unroll") for(int r=2;r<16;++r)sacc+=pB0[r]; _Pragma("unroll") for(int r=0;r<16;++r)sacc+=pB1[r]; l_reg+=sacc;
    pw0=(u32x4){PKW(pB0,0),PKW(pB0,2),PKW(pB0,4),PKW(pB0,6)};pw1=(u32x4){PKW(pB0,8),PKW(pB0,10),PKW(pB0,12),PKW(pB0,14)};pw2=(u32x4){PKW(pB1,0),PKW(pB1,2),PKW(pB1,4),PKW(pB1,6)};pw3=(u32x4){PKW(pB1,8),PKW(pB1,10),PKW(pB1,12),PKW(pB1,14)};
    SBAR(); pv(o,vb0+sl_cur,PAF(0),PAF(1),PAF(2),PAF(3)); }
  #undef PKW
  #undef PAF
  #undef VFR
  #undef PIN
  #undef MX3
  #undef GAPA
  #undef GAPB
  #undef EX
  #undef VRD
  #undef KRD
  #undef STEP
  #undef ENDW
  {auto rr=__builtin_amdgcn_permlane32_swap(__float_as_uint(l_reg),__float_as_uint(l_reg),false,false);l_reg=__uint_as_float(rr[0])+__uint_as_float(rr[1]);}
  if(hi==0)wsf[32+r32]=l_reg;asm volatile("s_waitcnt lgkmcnt(0)":::"memory");
  float rli[16];
  #pragma unroll
  for(int r=0;r<16;++r)rli[r]=__builtin_amdgcn_rcpf(wsf[32+crow(r,hi)]);
  bf16*Ow=Ou+(long)(wid*QBLK)*QP; const bf16*Gw=Gu+(long)(wid*QBLK)*QP;
  { bf16*stg=(bf16*)(shm+LDS_OST)+wid*2048;
    #pragma unroll
    for(int r=0;r<16;++r){const int orow=crow(r,hi);
      #pragma unroll
      for(int d0=0;d0<2;++d0)stg[orow*64+d0*32+r32]=__float2bfloat16(o[d0][r]*rli[r]);}
    asm volatile("s_waitcnt lgkmcnt(0)":::"memory");
    #pragma unroll
    for(int i=0;i<4;++i){const int row=i*8+(lane>>3),ch=lane&7; const u32x4 v=*(const u32x4*)(stg+row*64+ch*8); const u32x4 gv=*(const u32x4*)(Gw+(long)row*QP+ch*8); u32x4 w;
      #pragma unroll
      for(int e=0;e<4;++e){const float a0=__uint_as_float(v[e]<<16)*__uint_as_float(gv[e]<<16),a1=__uint_as_float(v[e]&0xffff0000u)*__uint_as_float(gv[e]&0xffff0000u); w[e]=cvtpk_s(a0,a1);}
      *(u32x4*)(Ow+(long)row*QP+ch*8)=w;} }
  asm volatile("s_waitcnt lgkmcnt(0)\n\ts_barrier":::"memory");
  #undef DMA_K
  #undef DMA_V
  #undef CMASK
  #undef START
  #undef RESC
  #undef ROT
}
constexpr int ATTN_LDS_BYTES=LDS_BYTES;
#undef SBAR
#undef WAIT_BAR
}

#define GAS __attribute__((address_space(1)))
#define LAS __attribute__((address_space(3)))
typedef unsigned short bf16;
typedef unsigned v4u __attribute__((ext_vector_type(4)));
typedef float f32x4 __attribute__((ext_vector_type(4)));
typedef short bf16x8 __attribute__((ext_vector_type(8)));
typedef GAS unsigned gu32;
typedef GAS unsigned long long gu64;
#define RLX_AGENT __ATOMIC_RELAXED, __HIP_MEMORY_SCOPE_AGENT
#define LDS_WAIT() asm volatile("s_waitcnt lgkmcnt(0)" ::: "memory")
#define VM_WAIT() asm volatile("s_waitcnt vmcnt(0)" ::: "memory")
__device__ __forceinline__ unsigned long long rt() { return __builtin_amdgcn_s_memrealtime(); }
__device__ __forceinline__ unsigned f2bf(float f) { unsigned u = __builtin_bit_cast(unsigned, f); return (u + 0x7fffu + ((u >> 16) & 1u)) >> 16; }
__device__ __forceinline__ unsigned pk2(float lo, float hi) { return f2bf(lo) | (f2bf(hi) << 16); }

#define XB_TMO      128
#define XB_XCNT(j)  (256  + 64 * (j))
#define XB_XSUB(j)  (1280 + 64 * (j))
#define XB_XGEN(j)  (2304 + 64 * (j))
#define XB_TOP      3328
#define XB_TOPGEN   3392
#define XCD_BAR_WORDS 3456
#define XB_SPIN_CAP (1u << 18)

__device__ __forceinline__ unsigned xb_ld(unsigned* p)              { return __hip_atomic_load(p, __ATOMIC_RELAXED, __HIP_MEMORY_SCOPE_AGENT); }
__device__ __forceinline__ unsigned xb_add(unsigned* p, unsigned v) { return __hip_atomic_fetch_add(p, v, __ATOMIC_RELAXED, __HIP_MEMORY_SCOPE_AGENT); }
__device__ __forceinline__ unsigned xb_xcc_id() { return (unsigned)__builtin_amdgcn_s_getreg((3 << 11) | 20) & 0xFu; }
#define XB_SPIN(cond, bar) do { unsigned _sp = 0; while (cond) { __builtin_amdgcn_s_sleep(1); \
    if ((++_sp & 255u) == 0u) { if (xb_ld(&(bar)[XB_TMO])) break; if (_sp > XB_SPIN_CAP) { atomicAdd(&(bar)[XB_TMO], 1u); break; } } } } while (0)

struct XcdBarrier {
    unsigned* bar; unsigned x;
    volatile LAS unsigned* st;
};

__device__ __forceinline__ XcdBarrier xcd_barrier_post(unsigned* bar, volatile LAS unsigned* st, const int tid) {
    XcdBarrier b; b.bar = bar; b.x = xb_xcc_id(); b.st = st;
    if (tid == 0) (void)xb_add(&bar[XB_XCNT(b.x)], 1u);
    return b;
}
__device__ __forceinline__ void xcd_barrier_complete(unsigned* bar, unsigned x, unsigned& nloc, unsigned& nx) {
    const unsigned G = gridDim.x * gridDim.y * gridDim.z;
    unsigned sum, cnt, mine, sp = 0u;
    for (;;) {
        sum = 0u; cnt = 0u; mine = 0u;
#pragma unroll
        for (unsigned j = 0; j < 16; ++j) { const unsigned c = xb_ld(&bar[XB_XCNT(j)]); sum += c; cnt += (c > 0u) ? 1u : 0u; mine = (j == x) ? c : mine; }
        if (sum == G) break;
        __builtin_amdgcn_s_sleep(1);
        if ((++sp & 255u) == 0u) { if (xb_ld(&bar[XB_TMO])) break; if (sp > XB_SPIN_CAP) { atomicAdd(&bar[XB_TMO], 1u); break; } }
    }
    nloc = mine > 0u ? mine : 1u; nx = cnt > 0u ? cnt : 1u;
}

__device__ __forceinline__ void xcd_barrier(const XcdBarrier& b, const int tid) {
    asm volatile("s_waitcnt vmcnt(0)" ::: "memory");
    __syncthreads();
    if (tid == 0) {
        unsigned* bar = b.bar; asm volatile("" : "+s"(bar));
        __builtin_amdgcn_s_waitcnt(0);
        unsigned nloc = b.st[0], nx = b.st[1];
        if (nloc == 0u) { unsigned xx = b.x; asm volatile("" : "+s"(xx)); xcd_barrier_complete(bar, xx, nloc, nx); b.st[0] = nloc; b.st[1] = nx; }
        const unsigned old = xb_add(&bar[XB_XSUB(b.x)], 1u);
        const unsigned gen = old / nloc;
        if (old + 1u == (gen + 1u) * nloc) {
            __builtin_amdgcn_fence(__ATOMIC_RELEASE, "agent");
            asm volatile("s_waitcnt vmcnt(0)" ::: "memory");
            const unsigned og = xb_add(&bar[XB_TOP], 1u);
            const unsigned tg = og / nx;
            if (og + 1u == (tg + 1u) * nx) xb_add(&bar[XB_TOPGEN], 1u);
            else XB_SPIN(xb_ld(&bar[XB_TOPGEN]) == tg, bar);
            __builtin_amdgcn_fence(__ATOMIC_ACQUIRE, "agent");
            xb_add(&bar[XB_XGEN(b.x)], 1u);
            asm volatile("s_waitcnt vmcnt(0)" ::: "memory");
        } else {
            XB_SPIN(xb_ld(&bar[XB_XGEN(b.x)]) == gen, bar);
            __builtin_amdgcn_fence(__ATOMIC_ACQUIRE, "agent");
            asm volatile("s_waitcnt vmcnt(0)" ::: "memory");
        }
    }
    __syncthreads();
}


constexpr int NWAVES = 8, NTHR = 512, GRID = 256;
constexpr int T_TOK = 8192, T_CTX = 4096, DMOD = 1024, BW = 512, INW = 3328, NCAT = 6400, DEPTH = 4;
constexpr int S_LAT = 2048, LKV = 2304, KVW = 128;
constexpr float RMS_EPS = 1e-6f;
constexpr float QSCALE = 0.125f * 1.4426950408889634f;
constexpr size_t MiB = 1u << 20;
constexpr size_t WS_CTL = 0, CTL_ZERO_BYTES = MiB;
constexpr size_t WS_MODF = 1 * MiB;
constexpr size_t WS_ROPE = 1 * MiB + 768 * 1024;
constexpr size_t WS_A16 = 1 * MiB + 832 * 1024;
constexpr size_t WS_WCAT = 2 * MiB;
constexpr size_t WS_WGLU = 15 * MiB;
constexpr size_t WS_WFN = 16 * MiB;
constexpr size_t WS_WBR = 17 * MiB;
constexpr size_t WS_WOUT = 20 * MiB;
constexpr size_t WS_BTE = 22 * MiB;
constexpr size_t WS_BTY = 26 * MiB;
constexpr size_t WS_A2L = 34 * MiB;
constexpr size_t WS_GY = 42 * MiB;
constexpr size_t WS_A2C = 50 * MiB;
constexpr size_t WS_A1P = 50 * MiB + 512 * 1024;
constexpr size_t WS_XRES = 51 * MiB;
constexpr size_t WS_G = 83 * MiB;
constexpr size_t WS_H = 131 * MiB;
constexpr size_t WS_VTC = 147 * MiB;
constexpr size_t WS_VTL = 248 * MiB;
constexpr size_t WS_GA = 155 * MiB;
constexpr size_t WS_GF = 163 * MiB;
constexpr size_t WS_Q = 171 * MiB;
constexpr size_t WS_UF = 179 * MiB;
constexpr size_t WS_GC = 187 * MiB;
constexpr size_t WS_KC = 195 * MiB, WS_KL = 196 * MiB;
constexpr size_t WS_VC = WS_KC + 5 * MiB / 2, WS_VL = WS_KL + 5 * MiB / 2;
constexpr size_t WS_PB = 200 * MiB;
constexpr size_t WS_SC = 216 * MiB;
constexpr size_t WS_UH = 232 * MiB;
constexpr size_t WS_END = 256 * MiB;
constexpr int CW_BAR = 4096;
constexpr size_t OUT_K = 8388608, OUT_V = 10485760, OUT_S = 12582912, OUT_N = 13107200;
constexpr int RING_BYTES = 131072, LDSCTL_OFF = RING_BYTES, MISC_OFF = LDSCTL_OFF + 320, LDS_BYTES = 147456;

typedef float f32x2 __attribute__((ext_vector_type(2)));
typedef unsigned u32x2 __attribute__((ext_vector_type(2)));
__device__ __forceinline__ unsigned cvtpk(float lo, float hi) { typedef __bf16 bf16x2_t __attribute__((ext_vector_type(2))); f32x2 v = {lo, hi}; bf16x2_t b = __builtin_convertvector(v, bf16x2_t); return __builtin_bit_cast(unsigned, b); }
__device__ __forceinline__ void st_bf4(bf16* p, f32x4 v) { u32x2 w; w.x = cvtpk(v[0], v[1]); w.y = cvtpk(v[2], v[3]); *(u32x2*)p = w; }
__device__ __forceinline__ f32x4 ld_bf4(const bf16* p) { const u32x2 w = *(const u32x2*)p; f32x4 r; r[0] = __uint_as_float(w.x << 16); r[1] = __uint_as_float(w.x & 0xffff0000u); r[2] = __uint_as_float(w.y << 16); r[3] = __uint_as_float(w.y & 0xffff0000u); return r; }
__device__ __forceinline__ f32x4 bf4_to_f(u32x2 w) { f32x4 r; r[0] = __uint_as_float(w.x << 16); r[1] = __uint_as_float(w.x & 0xffff0000u); r[2] = __uint_as_float(w.y << 16); r[3] = __uint_as_float(w.y & 0xffff0000u); return r; }
__device__ __forceinline__ float bf2f(bf16 h) { return __uint_as_float((unsigned)h << 16); }
__device__ __forceinline__ float sigmoidf_(float x) { return __builtin_amdgcn_rcpf(1.0f + __expf(-x)); }
__device__ __forceinline__ f32x4 sigmoid4(f32x4 v) { f32x4 r; r[0] = sigmoidf_(v[0]); r[1] = sigmoidf_(v[1]); r[2] = sigmoidf_(v[2]); r[3] = sigmoidf_(v[3]); return r; }
__device__ __forceinline__ f32x4 silu4(f32x4 v) { return v * sigmoid4(v); }
__device__ __forceinline__ float gelu_tanh(float x) { const float y = 0.7978845608028654f * (x + 0.044715f * x * x * x); return x * sigmoidf_(2.0f * y); }
__device__ __forceinline__ float shx(float v, int mask, int lane) { return __int_as_float(__builtin_amdgcn_ds_bpermute((lane ^ mask) << 2, __float_as_int(v))); }
__device__ __forceinline__ float wave_sum(float v, int lane) {
#pragma unroll
    for (int o = 1; o < 64; o <<= 1) v += shx(v, o, lane);
    return v;
}

struct KArgs { const float* in[28]; float* out; unsigned char* ws; int ph_lo, ph_hi; };
enum { I_XP = 0, I_XS, I_CK, I_CV, I_ST, I_C, I_CCTX, I_NORMG, I_ADAW, I_ADAB, I_WIN, I_ARE, I_AIM, I_LDT, I_BRE, I_BIM, I_CRE, I_CIM, I_SD, I_GLU, I_FN, I_QG, I_KG, I_WBR, I_MW, I_MB, I_WOUT, I_FG };

struct Ctx {
    LAS unsigned char* lds; int tid, lane, wave, bid, vcu, gw, ngw;
    const float* const* in; float* out; unsigned char* ws;
    template <class Tp> __device__ __forceinline__ Tp* w(size_t off) const { return (Tp*)(ws + off); }
};

__device__ __forceinline__ int epi_opaque(int x) { asm volatile("" : "+v"(x)); return x; }
#define EPI_ROWS for (int ai = 0; ai < 2; ++ai) _Pragma("unroll") for (int m = 0; m < 4; ++m)
#define EPI_BJ for (int bj = 0; bj < 2; ++bj)
#define EPI_ROW epi_opaque(u.pm * 256 + ai * 128 + wr * 64 + m * 16 + fr)
#define EPI_C8 (bj * 128 + wc * 32 + fq * 8)
#define EPI_COL8 (u.pn * 256 + EPI_C8)
typedef const f32x4 (&AccRef)[2][2][4][2];
__device__ __forceinline__ void st_bf8(bf16* p, f32x4 lo, f32x4 hi) { v4u w; w.x = cvtpk(lo[0], lo[1]); w.y = cvtpk(lo[2], lo[3]); w.z = cvtpk(hi[0], hi[1]); w.w = cvtpk(hi[2], hi[3]); *(v4u*)p = w; }
__device__ __forceinline__ f32x4 bf8_lo(v4u w) { f32x4 r; r[0] = __uint_as_float(w.x << 16); r[1] = __uint_as_float(w.x & 0xffff0000u); r[2] = __uint_as_float(w.y << 16); r[3] = __uint_as_float(w.y & 0xffff0000u); return r; }
__device__ __forceinline__ f32x4 bf8_hi(v4u w) { f32x4 r; r[0] = __uint_as_float(w.z << 16); r[1] = __uint_as_float(w.z & 0xffff0000u); r[2] = __uint_as_float(w.w << 16); r[3] = __uint_as_float(w.w & 0xffff0000u); return r; }

struct EpiG1 {
    static constexpr bool PERM = true, AFTER_DRAIN = false;
    unsigned char* ws; float* out; const float *qg, *kg; int layer;
#define EG1_P(name, off) bf16* const name = (bf16*)(ws + (off))
    __device__ __forceinline__ void qkv(AccRef acc, const pg8::Unit& u, int wr, int wc, int fr, int fq) const {
        const int pn = u.pn; const bool isq = pn < 10;
        EG1_P(Q, WS_Q); EG1_P(Kc, WS_KC); EG1_P(Vc, WS_VC); EG1_P(Kl, WS_KL); EG1_P(Vl, WS_VL); float* const outK = out + OUT_K; float* const outV = out + OUT_V; const float* const rope = (const float*)(ws + WS_ROPE);
        const int kind = isq ? 0 : (wc < 2 ? 1 : 2);
        const int head = isq ? (pn - 8) * 4 + wc : (wc & 1);
        f32x4 gv[2][2];
        if (kind == 0) {
#pragma unroll
            EPI_BJ { gv[bj][0] = *(const f32x4*)(qg + layer * 64 + 32 * bj + 8 * fq); gv[bj][1] = *(const f32x4*)(qg + layer * 64 + 32 * bj + 8 * fq + 4); }
        } else {
#pragma unroll
            EPI_BJ { gv[bj][0] = *(const f32x4*)(kg + layer * 64 + 32 * bj + 8 * fq); gv[bj][1] = *(const f32x4*)(kg + layer * 64 + 32 * bj + 8 * fq + 4); }
        }
        const bool lat = u.pm >= 16;
#pragma unroll
        EPI_ROWS {
            const int row = EPI_ROW;
            f32x4 x[2][2];
#pragma unroll
            EPI_BJ { x[bj][0] = acc[ai][bj][m][0]; x[bj][1] = acc[ai][bj][m][1]; }
            if (kind != 2) {
                float ss = 0.f;
#pragma unroll
                EPI_BJ {
#pragma unroll
                    for (int n = 0; n < 2; ++n) { const f32x4 t = x[bj][n]; ss += (t[0] * t[0] + t[1] * t[1]) + (t[2] * t[2] + t[3] * t[3]); } }
                ss += shx(ss, 16, fq * 16 + fr); ss += shx(ss, 32, fq * 16 + fr);
                const float rstd = rsqrtf(ss * (1.0f / 64.0f) + RMS_EPS);
#pragma unroll
                EPI_BJ { x[bj][0] = x[bj][0] * rstd * gv[bj][0]; x[bj][1] = x[bj][1] * rstd * gv[bj][1]; }
            }
            int b, s;
            if (lat) { const int tl = row - T_CTX; b = tl >> 11; s = tl & 2047; } else { b = row >> 8; s = row & 255; }
            if (lat && kind != 2) {
                const int gr = s >> 6, gc = s & 63;
#pragma unroll
                EPI_BJ {
#pragma unroll
                    for (int n = 0; n < 2; ++n) { const int pos = bj ? gc : gr; const f32x4 cs = *(const f32x4*)(rope + (pos * 16 + 4 * fq + 2 * n) * 2); const f32x4 t = x[bj][n];
                        f32x4 r; r[0] = t[0] * cs[0] - t[1] * cs[1]; r[1] = t[0] * cs[1] + t[1] * cs[0]; r[2] = t[2] * cs[2] - t[3] * cs[3]; r[3] = t[2] * cs[3] + t[3] * cs[2]; x[bj][n] = r; } }
            }
#pragma unroll
            EPI_BJ { const int j = 32 * bj + 8 * fq;
                const size_t ol = ((size_t)b * LKV + s) * KVW + head * 64 + j, oc = (size_t)row * KVW + head * 64 + j, oo = (((size_t)b * DEPTH + layer) * 256 + s) * KVW + head * 64 + j;
                if (kind == 0) st_bf8(Q + (size_t)row * 512 + head * 64 + j, x[bj][0] * QSCALE, x[bj][1] * QSCALE);
                else if (kind == 1) { if (lat) st_bf8(Kl + ol, x[bj][0], x[bj][1]); else { st_bf8(Kc + oc, x[bj][0], x[bj][1]); *(f32x4*)(outK + oo) = x[bj][0]; *(f32x4*)(outK + oo + 4) = x[bj][1]; } }
                else { if (lat) st_bf8(Vl + ol, x[bj][0], x[bj][1]); else { st_bf8(Vc + oc, x[bj][0], x[bj][1]); *(f32x4*)(outV + oo) = x[bj][0]; *(f32x4*)(outV + oo + 4) = x[bj][1]; } } }
            asm volatile("" ::: "memory");
        }
    }
    __device__ __forceinline__ void operator()(AccRef acc, const pg8::Unit& u, int wr, int wc, int fr, int fq) const {
        const int pn = u.pn;
        if (pn >= 8 && pn <= 10) { qkv(acc, u, wr, wc, fr, fq); return; }
        EG1_P(UH, WS_UH); EG1_P(GA, WS_GA); EG1_P(UF, WS_UF); EG1_P(GF, WS_GF); EG1_P(GC, WS_GC);
#pragma unroll
        EPI_ROWS { const int row = EPI_ROW;
#pragma unroll
            EPI_BJ { const int col = EPI_COL8; const f32x4 lo = acc[ai][bj][m][0], hi = acc[ai][bj][m][1];
                if (pn < 2) { const int g = col >> 4, q = col & 15; st_bf8(UH + ((size_t)g * 512 + (row >> 4)) * 512 + (row & 15) * 16 + q, lo, hi); }
                else if (pn < 4) st_bf8(GA + (size_t)row * 512 + (col - 512), silu4(lo), silu4(hi));
                else if (pn < 6) st_bf8(UF + (size_t)row * 512 + (col - 1024), lo, hi);
                else if (pn < 8) st_bf8(GF + (size_t)row * 512 + (col - 1536), silu4(lo), silu4(hi));
                else st_bf8(GC + (size_t)row * 512 + (col - 2816), silu4(lo), silu4(hi));
            } }
    }
};
struct EpiMerge {
    static constexpr bool PERM = true, AFTER_DRAIN = false;
    bf16* Gm; const float* mb;
    __device__ __forceinline__ void operator()(AccRef acc, const pg8::Unit& u, int wr, int wc, int fr, int fq) const {
        f32x4 bb[2][2];
#pragma unroll
        EPI_BJ { bb[bj][0] = *(const f32x4*)(mb + EPI_COL8); bb[bj][1] = *(const f32x4*)(mb + EPI_COL8 + 4); }
#pragma unroll
        EPI_ROWS { const size_t row = EPI_ROW;
#pragma unroll
            EPI_BJ st_bf8(Gm + row * 3072 + EPI_COL8, sigmoid4(acc[ai][bj][m][0] + bb[bj][0]), sigmoid4(acc[ai][bj][m][1] + bb[bj][1])); }
    }
};
struct EpiS5A {
    static constexpr bool PERM = true, AFTER_DRAIN = false;
    float* SC;
    __device__ __forceinline__ void operator()(AccRef acc, const pg8::Unit& u, int wr, int wc, int fr, int fq) const {
#pragma unroll
        EPI_ROWS { const int chunk = EPI_ROW;
#pragma unroll
            EPI_BJ { float* p = SC + ((size_t)u.z * 512 + chunk) * 256 + EPI_C8; *(f32x4*)p = acc[ai][bj][m][0]; *(f32x4*)(p + 4) = acc[ai][bj][m][1]; } }
    }
};
__device__ __forceinline__ f32x4 gelu4(f32x4 y) { y[0] = gelu_tanh(y[0]); y[1] = gelu_tanh(y[1]); y[2] = gelu_tanh(y[2]); y[3] = gelu_tanh(y[3]); return y; }
struct EpiS5B {
    static constexpr bool PERM = true, AFTER_DRAIN = false;
    bf16* GY;
    __device__ __forceinline__ void operator()(AccRef acc, const pg8::Unit& u, int wr, int wc, int fr, int fq) const {
#pragma unroll
        EPI_ROWS { const int chunk = EPI_ROW;
#pragma unroll
            EPI_BJ { const int col = EPI_C8, t = col >> 4, p = col & 15; st_bf8(GY + ((size_t)chunk * 16 + t) * 512 + u.z * 16 + p, gelu4(acc[ai][bj][m][0]), gelu4(acc[ai][bj][m][1])); } }
    }
};
struct EpiDFT1C {
    static constexpr bool PERM = true, AFTER_DRAIN = false;
    bf16* VtC;
    __device__ __forceinline__ void operator()(AccRef acc, const pg8::Unit& u, int wr, int wc, int fr, int fq) const {
        const int grp = 2 * u.z + u.pm;
#pragma unroll
        EPI_ROWS { const int j = epi_opaque(wr * 64 + m * 16 + fr), reim = ai;
#pragma unroll
            EPI_BJ { const int tok = EPI_COL8, b = tok >> 8, s = tok & 255; st_bf8(VtC + ((size_t)b * 512 + grp * 128 + j) * 512 + reim * 256 + s, acc[ai][bj][m][0], acc[ai][bj][m][1]); } }
    }
};
struct EpiDFT1L {
    static constexpr bool PERM = true, AFTER_DRAIN = false;
    bf16* VtL;
    __device__ __forceinline__ void operator()(AccRef acc, const pg8::Unit& u, int wr, int wc, int fr, int fq) const {
        const int grp = 2 * u.z + u.pm, b = u.pn >> 4, nn = u.pn & 15;
#pragma unroll
        EPI_ROWS { const int j = epi_opaque(wr * 64 + m * 16 + fr), reim = ai; bf16* dst = VtL + ((size_t)b * 512 + grp * 128 + j) * 2048 + reim * 1024 + nn * 128 + wc * 32 + fq * 8;
            st_bf8(dst, acc[ai][0][m][0] + acc[ai][1][m][0], acc[ai][0][m][1] + acc[ai][1][m][1]);
            st_bf8(dst + (size_t)1024 * 2048, acc[ai][0][m][0] - acc[ai][1][m][0], acc[ai][0][m][1] - acc[ai][1][m][1]); }
    }
};
struct EpiDFT2 {
    static constexpr bool PERM = true, AFTER_DRAIN = false;
    bf16* ZF; int lat, half;
    __device__ __forceinline__ void operator()(AccRef acc, const pg8::Unit& u, int wr, int wc, int fr, int fq) const {
#pragma unroll
        EPI_ROWS { const int k = EPI_ROW;
#pragma unroll
            EPI_BJ { const int col = EPI_COL8, b = col >> 9, ch = col & 511;
                bf16* dst = lat ? ZF + ((size_t)b * 2048 + 2 * k + u.z) * 1024 + half * 512 + ch : ZF + ((size_t)b * 256 + k) * 512 + ch;
                st_bf8(dst, acc[ai][bj][m][0], acc[ai][bj][m][1]); } }
    }
};
#define EPI_BATCH for (int ai = 0; ai < 2; ++ai)
#define EPI_M for (int m = 0; m < 4; ++m)
struct EpiGLU {
    static constexpr bool PERM = true, AFTER_DRAIN = false;
    bf16* GA;
    __device__ __forceinline__ void operator()(AccRef acc, const pg8::Unit& u, int wr, int wc, int fr, int fq) const {
#pragma unroll
        EPI_BATCH { v4u gl[4];
#pragma unroll
            EPI_M { const size_t row = EPI_ROW; gl[m] = *(const v4u*)(GA + row * 512 + u.pn * 128 + wc * 32 + fq * 8); }
            asm volatile("" ::: "memory");
#pragma unroll
            EPI_M { const size_t row = EPI_ROW;
                st_bf8(GA + row * 512 + u.pn * 128 + wc * 32 + fq * 8, acc[ai][0][m][0] * sigmoid4(acc[ai][1][m][0]) * bf8_lo(gl[m]), acc[ai][0][m][1] * sigmoid4(acc[ai][1][m][1]) * bf8_hi(gl[m])); }
            asm volatile("" ::: "memory"); }
    }
};
struct EpiMul {
    static constexpr bool PERM = true, AFTER_DRAIN = false;
    bf16* GF;
    __device__ __forceinline__ void operator()(AccRef acc, const pg8::Unit& u, int wr, int wc, int fr, int fq) const {
#pragma unroll
        EPI_BATCH { v4u gl[4][2];
#pragma unroll
            EPI_M { const size_t row = EPI_ROW;
#pragma unroll
                EPI_BJ gl[m][bj] = *(const v4u*)(GF + row * 512 + EPI_COL8); }
            asm volatile("" ::: "memory");
#pragma unroll
            EPI_M { const size_t row = EPI_ROW;
#pragma unroll
                EPI_BJ st_bf8(GF + row * 512 + EPI_COL8, acc[ai][bj][m][0] * bf8_lo(gl[m][bj]), acc[ai][bj][m][1] * bf8_hi(gl[m][bj])); }
            asm volatile("" ::: "memory"); }
    }
};
struct EpiG4 {
    static constexpr bool PERM = true, AFTER_DRAIN = false;
    const bf16* Gm; bf16* PB; bf16* MG; int mode0;
    __device__ __forceinline__ void operator()(AccRef acc, const pg8::Unit& u, int wr, int wc, int fr, int fq) const {
        const int mode = mode0 + u.z, gsel = mode == 0 ? 2 : mode - 1;
#pragma unroll
        EPI_BATCH { v4u gl[4][2], pl[4][2];
#pragma unroll
            EPI_M { const size_t row = EPI_ROW;
#pragma unroll
                EPI_BJ { gl[m][bj] = *(const v4u*)(Gm + row * 3072 + gsel * 1024 + EPI_COL8); if (mode > 0) pl[m][bj] = *(const v4u*)(PB + row * 1024 + EPI_COL8); } }
            asm volatile("" ::: "memory");
#pragma unroll
            EPI_M { const size_t row = EPI_ROW;
#pragma unroll
                EPI_BJ { f32x4 lo = acc[ai][bj][m][0] * bf8_lo(gl[m][bj]), hi = acc[ai][bj][m][1] * bf8_hi(gl[m][bj]); if (mode > 0) { lo += bf8_lo(pl[m][bj]); hi += bf8_hi(pl[m][bj]); }
                    if (mode < 2) st_bf8(PB + row * 1024 + EPI_COL8, lo, hi); else st_bf8(MG + row * 1024 + EPI_COL8, lo, hi); } }
            asm volatile("" ::: "memory"); }
    }
};
struct EpiChainA {
    const bf16* Gm; const bf16* PB;
    __device__ __forceinline__ void operator()(f32x4 (&acc)[2][2][4][2], const pg8::Unit& u, int wr, int wc, int fr, int fq) const {
#pragma unroll
        for (int ai = 0; ai < 2; ++ai)
#pragma unroll
            for (int mh = 0; mh < 2; ++mh) { v4u g0[2][2], g1[2][2], pl[2][2];
#pragma unroll
                for (int mm = 0; mm < 2; ++mm) { const int m = 2 * mh + mm; const size_t row = EPI_ROW;
#pragma unroll
                    EPI_BJ { g0[mm][bj] = *(const v4u*)(Gm + row * 3072 + EPI_COL8); g1[mm][bj] = *(const v4u*)(Gm + row * 3072 + 1024 + EPI_COL8); pl[mm][bj] = *(const v4u*)(PB + row * 1024 + EPI_COL8); } }
                asm volatile("" ::: "memory");
#pragma unroll
                for (int mm = 0; mm < 2; ++mm) { const int m = 2 * mh + mm;
#pragma unroll
                    EPI_BJ { f32x4 lo = acc[ai][bj][m][0] * bf8_lo(g0[mm][bj]) + bf8_lo(pl[mm][bj]), hi = acc[ai][bj][m][1] * bf8_hi(g0[mm][bj]) + bf8_hi(pl[mm][bj]);
                        const f32x4 gl = bf8_lo(g1[mm][bj]), gh = bf8_hi(g1[mm][bj]);
#pragma unroll
                        for (int e = 0; e < 4; ++e) { lo[e] *= __builtin_amdgcn_rcpf(fmaxf(gl[e], 1e-6f)); hi[e] *= __builtin_amdgcn_rcpf(fmaxf(gh[e], 1e-6f)); }
                        acc[ai][bj][m][0] = lo; acc[ai][bj][m][1] = hi; } }
                asm volatile("" ::: "memory"); }
    }
};
struct EpiChainF {
    const bf16* Gm; bf16* MG;
    __device__ __forceinline__ void operator()(AccRef acc, const pg8::Unit& u, int wr, int wc, int fr, int fq) const {
#pragma unroll
        EPI_BATCH { v4u g1[4][2];
#pragma unroll
            EPI_M { const size_t row = EPI_ROW;
#pragma unroll
                EPI_BJ g1[m][bj] = *(const v4u*)(Gm + row * 3072 + 1024 + EPI_COL8); }
            asm volatile("" ::: "memory");
#pragma unroll
            EPI_M { const size_t row = EPI_ROW;
#pragma unroll
                EPI_BJ { const f32x4 gl = bf8_lo(g1[m][bj]), gh = bf8_hi(g1[m][bj]); f32x4 lo = acc[ai][bj][m][0], hi = acc[ai][bj][m][1];
#pragma unroll
                    for (int e = 0; e < 4; ++e) { lo[e] *= fmaxf(gl[e], 1e-6f); hi[e] *= fmaxf(gh[e], 1e-6f); }
                    st_bf8(MG + row * 1024 + EPI_COL8, lo, hi); } }
            asm volatile("" ::: "memory"); }
    }
};
struct EpiG5 {
    static constexpr bool PERM = true, AFTER_DRAIN = false;
    bf16 *T0, *T1;
    __device__ __forceinline__ void operator()(AccRef acc, const pg8::Unit& u, int wr, int wc, int fr, int fq) const {
        bf16* T = u.z ? T1 : T0;
#pragma unroll
        EPI_ROWS { const size_t row = EPI_ROW;
#pragma unroll
            EPI_BJ st_bf8(T + row * 1024 + EPI_COL8, acc[ai][bj][m][0], acc[ai][bj][m][1]); }
    }
};

enum { K_G1 = 0, K_MERGE, K_S5A, K_S5B, K_DFT1C, K_DFT1L, K_DFT2C, K_DFT2L0, K_DFT2L1, K_GLU, K_FN, K_PC, K_PA, K_PF, K_G5 };
__device__ __forceinline__ int xswz(int L, int n) { return (L & 7) * (n >> 3) + (L >> 3); }
#define PS_W(off) ((const bf16*)(ws + (off)))
struct PhaseSched {
    int sub, c, bid; unsigned char* ws;
    __device__ __forceinline__ void mk(pg8::UDesc& d, const bf16* A, const bf16* Bt, int lda, int ldb, int K, int hB, int kind, int pm, int pn, int z) const {
        d.A = A; d.Bt = Bt; d.lda = lda; d.ldb = ldb; d.K = K; d.hB = hB; d.kind = kind; d.pm = pm; d.pn = pn; d.z = z; d.keep = (kind == K_PF); }
    __device__ __forceinline__ void mk_merge(pg8::UDesc& d, int M, unsigned char* ws) const {
        int pm, pn; if (M < 128) { pm = M >> 2; pn = 8 + (M & 3); } else { pm = (M - 128) >> 3; pn = (M - 128) & 7; }
        mk(d, PS_W(WS_H) + (size_t)pm * 256 * 1024, PS_W(WS_WCAT) + (size_t)(INW + pn * 256) * 1024, 1024, 1024, 1024, 128, K_MERGE, pm, pn, 0); }
    __device__ __forceinline__ bool next(int i, pg8::UDesc& d) const {
        unsigned char* ws = this->ws; asm volatile("" : "+s"(ws));
        if (sub == 1) {
            if (i > 1) return false;
            pg8::StaticOrder so; so.init(T_TOK, INW, GRID, bid); pg8::Unit u;
            if (so.next(i, u)) { mk(d, PS_W(WS_H) + (size_t)u.pm * 256 * 1024, PS_W(WS_WCAT) + (size_t)u.pn * 256 * 1024, 1024, 1024, 1024, 128, K_G1, u.pm, u.pn, 0); return true; }
            if (bid >= 160) { mk_merge(d, xswz(bid - 160, 96), ws); return true; }
            return false;
        }
        if (sub == 2) {
            if (c < 128) return false;
            if (c < 192) { const int L = xswz(c - 128, 64);
                if (i == 0) { const int g = L >> 1, pm = L & 1; mk(d, PS_W(WS_UH) + ((size_t)g * 512 + pm * 256) * 512, PS_W(WS_BTE) + (size_t)g * 256 * 256, 512, 256, 256, 128, K_S5A, pm, 0, g); return true; }
                if (i == 1) { const int pair = L >> 5, gl = (L >> 4) & 1, pn = L & 15; mk(d, PS_W(WS_A1P) + (size_t)gl * 256 * 256, PS_W(WS_UF) + (size_t)pn * 256 * 512 + pair * 256, 256, 512, 256, 128, K_DFT1C, gl, pn, pair); return true; }
                if (i == 2) { mk_merge(d, 96 + xswz(c - 128, 128), ws); return true; }
                return false; }
            const int L = xswz(c - 192, 64);
            if (i == 0) { const int pair = L >> 5, gl = (L >> 4) & 1, r = L & 15, pn2 = (r >> 3) * 16 + (r & 7);
                mk(d, PS_W(WS_A1P) + (size_t)gl * 256 * 256, PS_W(WS_UF) + ((size_t)T_CTX + pn2 * 128) * 512 + pair * 256, 256, 512, 256, 1024, K_DFT1L, gl, pn2, pair); return true; }
            if (i == 1) { mk_merge(d, 96 + xswz(c - 128, 128), ws); return true; }
            return false;
        }
        if (sub == 3) {
            if (c < 64) { if (i > 0) return false; const int half = c >> 5, L = xswz(c & 31, 32), z = L >> 4, pm = (L >> 2) & 3, pn = L & 3;
                mk(d, PS_W(WS_A2L) + ((size_t)z * 1024 + pm * 256) * 2048 + half * 1024, PS_W(WS_VTL) + ((size_t)z * 1024 + pn * 256) * 2048 + half * 1024, 2048, 2048, 1024, 128, half ? K_DFT2L1 : K_DFT2L0, pm, pn, z); return true; }
            if (c < 128) { if (i > 0) return false; const int L = xswz(c - 64, 64), g = L >> 1, pm = L & 1;
                mk(d, PS_W(WS_UH) + ((size_t)g * 512 + pm * 256) * 512, PS_W(WS_BTY) + (size_t)g * 256 * 512, 512, 512, 512, 128, K_S5B, pm, 0, g); return true; }
            if (i == 0) { const int L = xswz(c - 128, 128), pm = L >> 2, pn = L & 3; mk(d, PS_W(WS_Q) + (size_t)pm * 256 * 512, PS_W(WS_WBR) + ((size_t)2 * 1024 + pn * 256) * 512, 512, 512, 512, 128, K_PC, pm, pn, 0); return true; }
            if (i == 1) { if (c < 160) { const int pn = xswz(c - 128, 32); mk(d, PS_W(WS_A2C), PS_W(WS_VTC) + (size_t)pn * 256 * 512, 512, 512, 512, 128, K_DFT2C, 0, pn, 0); return true; }
                mk_merge(d, 224 + xswz(c - 160, 96), ws); return true; }
            return false;
        }
        if (sub == 4) {
            if (i > 0) return false;
            if (c < 128) { const int L = xswz(c, 128), pm = L >> 2, pn = L & 3; mk(d, PS_W(WS_GY) + (size_t)pm * 256 * 512, PS_W(WS_WGLU) + (size_t)pn * 256 * 512, 512, 512, 512, 128, K_GLU, pm, pn, 0); return true; }
            if (c < 160) { const int L = xswz(c - 128, 32), pm = L >> 1, pn = L & 1; mk(d, PS_W(WS_UF) + (size_t)pm * 256 * 512, PS_W(WS_WFN) + (size_t)pn * 256 * 1024, 512, 1024, 512, 128, K_FN, pm, pn, 0); return true; }
            if (c < 192) { const int L = xswz(c - 160, 32), pm = L >> 1, pn = L & 1; mk(d, PS_W(WS_GC) + (size_t)pm * 256 * 1024, PS_W(WS_WFN) + (size_t)pn * 256 * 1024, 1024, 1024, 1024, 128, K_FN, 16 + pm, pn, 0); return true; }
            mk_merge(d, 320 + xswz(c - 192, 64), ws); return true;
        }
        if (sub == 5) {
            if (c >= 128 || i > 1) return false;
            const int t = (c & 7) * 16 + (c >> 3), pm = t >> 2, pn = t & 3;
            if (i == 0) mk(d, PS_W(WS_GA) + (size_t)pm * 256 * 512, PS_W(WS_WBR) + (size_t)pn * 256 * 512, 512, 512, 512, 128, K_PA, pm, pn, 0);
            else mk(d, PS_W(WS_GF) + (size_t)pm * 256 * 512, PS_W(WS_WBR) + ((size_t)1024 + pn * 256) * 512, 512, 512, 512, 128, K_PF, pm, pn, 0);
            return true;
        }
        if (i > 0) return false;
        { const int L = xswz(c, 256), z = L & 1, pm = L >> 3, pn = (L >> 1) & 3; mk(d, PS_W(WS_H) + (size_t)pm * 256 * 1024 + z * 512, PS_W(WS_WOUT) + (size_t)pn * 256 * 1024 + z * 512, 1024, 1024, 512, 128, K_G5, pm, pn, z); return true; }
    }
};
struct EpiAll {
    unsigned char* ws; float* out; const float* const* in; int layer;
    __device__ __forceinline__ bool transform(f32x4 (&acc)[2][2][4][2], const pg8::UDesc& d, int wr, int wc, int fr, int fq) const {
        if (d.kind != K_PA) return false;
        asm volatile("" : "+v"(fr), "+v"(fq), "+s"(wr), "+s"(wc));
        unsigned char* ws = this->ws; asm volatile("" : "+s"(ws));
        EpiChainA{(const bf16*)(ws + WS_G), (const bf16*)(ws + WS_PB)}(acc, pg8::Unit{d.pm, d.pn, d.z}, wr, wc, fr, fq); return true; }
    __device__ __forceinline__ void operator()(AccRef acc, const pg8::UDesc& d, int wr, int wc, int fr, int fq) const {
        asm volatile("" : "+v"(fr), "+v"(fq), "+s"(wr), "+s"(wc));
        const pg8::Unit u{d.pm, d.pn, d.z}; const int kind = d.kind;
        unsigned char* ws = this->ws; float* out = this->out; asm volatile("" : "+s"(ws), "+s"(out));
#define EA_P(off) ((bf16*)(ws + (off)))
        if (kind == K_G1) EpiG1{ws, out, in[I_QG], in[I_KG], layer}(acc, u, wr, wc, fr, fq);
        else if (kind == K_MERGE) EpiMerge{EA_P(WS_G), in[I_MB] + (size_t)layer * 3072}(acc, u, wr, wc, fr, fq);
        else if (kind == K_S5A) EpiS5A{(float*)(ws + WS_SC)}(acc, u, wr, wc, fr, fq);
        else if (kind == K_S5B) EpiS5B{EA_P(WS_GY)}(acc, u, wr, wc, fr, fq);
        else if (kind == K_DFT1C) EpiDFT1C{EA_P(WS_VTC)}(acc, u, wr, wc, fr, fq);
        else if (kind == K_DFT1L) EpiDFT1L{EA_P(WS_VTL)}(acc, u, wr, wc, fr, fq);
        else if (kind == K_DFT2C) EpiDFT2{EA_P(WS_UF), 0, 0}(acc, u, wr, wc, fr, fq);
        else if (kind == K_DFT2L0) EpiDFT2{EA_P(WS_GC), 1, 0}(acc, u, wr, wc, fr, fq);
        else if (kind == K_DFT2L1) EpiDFT2{EA_P(WS_GC), 1, 1}(acc, u, wr, wc, fr, fq);
        else if (kind == K_GLU) EpiGLU{EA_P(WS_GA)}(acc, u, wr, wc, fr, fq);
        else if (kind == K_FN) EpiMul{EA_P(WS_GF)}(acc, u, wr, wc, fr, fq);
        else if (kind == K_PC) EpiG4{EA_P(WS_G), EA_P(WS_PB), EA_P(WS_H), 0}(acc, u, wr, wc, fr, fq);
        else if (kind == K_PF) EpiChainF{EA_P(WS_G), EA_P(WS_H)}(acc, u, wr, wc, fr, fq);
        else EpiG5{EA_P(WS_PB), EA_P(WS_GA)}(acc, u, wr, wc, fr, fq);
#undef EA_P
    }
};

template <class RowMap>
__device__ __forceinline__ void transpose_item(const float* W, int K, int N, bf16* WT, const RowMap& rm, LAS float* scr, int item, int lane, int pitch = 0, int dup = 0) {
    if (pitch == 0) pitch = K;
    const int nblk = N / 32, kb = item / nblk, nb = item % nblk, k0 = 64 * kb, n0 = 32 * nb;
    { f32x4 w[8];
#pragma unroll
      for (int i = 0; i < 8; ++i) w[i] = *(const f32x4*)(W + (size_t)(k0 + 8 * i + (lane >> 3)) * N + n0 + 4 * (lane & 7));
#pragma unroll
      for (int i = 0; i < 8; ++i) { LAS float* d = scr + (8 * i + (lane >> 3)) * 33 + 4 * (lane & 7); d[0] = w[i][0]; d[1] = w[i][1]; d[2] = w[i][2]; d[3] = w[i][3]; } }
    LDS_WAIT(); asm volatile("" ::: "memory");
    const int c = lane & 7;
#pragma unroll
    for (int j = 0; j < 4; ++j) { const int n = (lane >> 3) + 8 * j; const LAS float* s = scr + (8 * c) * 33 + n;
        v4u o; o.x = cvtpk(s[0 * 33], s[1 * 33]); o.y = cvtpk(s[2 * 33], s[3 * 33]); o.z = cvtpk(s[4 * 33], s[5 * 33]); o.w = cvtpk(s[6 * 33], s[7 * 33]);
        bf16* dp = WT + (size_t)rm(n0 + n) * pitch + k0 + 8 * c; *(v4u*)dp = o; if (dup) *(v4u*)(dp + dup) = o; }
    LDS_WAIT(); asm volatile("" ::: "memory");
}
struct RmId { int off; __device__ __forceinline__ int operator()(int n) const { return off + n; } };
struct RmWin { __device__ __forceinline__ int operator()(int n) const {
        if (n < 2048 || n >= 2816) return n; const int t = (n - 2048) >> 8, cl = (n - 2048) & 255, hh = cl >> 6, jl = cl & 63; return 2048 + t * 256 + 128 * (jl >> 5) + 32 * hh + (jl & 31); } };
struct RmGlu { __device__ __forceinline__ int operator()(int c) const { const int half = c >> 9, cc = c & 511; return 256 * (cc >> 7) + 128 * half + (cc & 127); } };

__device__ __forceinline__ void ph_prologue(const Ctx& C) {
    LAS float* sil = (LAS float*)C.lds;
    LAS float* red = sil + 3072;
    for (int item = C.bid; item < 192; item += GRID) {
        const int l = item / 48, ch = item % 48;
        for (int i = C.tid; i < 3072; i += NTHR) { const float x = i < 1024 ? C.in[I_CCTX][i] : C.in[I_C][i - 1024]; sil[i] = x * sigmoidf_(x); }
        __syncthreads();
        const float* W = C.in[I_ADAW] + (size_t)l * 1024 * 3072 + ch * 64 + C.lane;
        float a0 = 0.f, a1 = 0.f, a2 = 0.f;
        for (int i0 = 0; i0 < 128; i0 += 32) { float w[32];
#pragma unroll
            for (int i = 0; i < 32; ++i) w[i] = W[(size_t)(C.wave * 128 + i0 + i) * 3072];
#pragma unroll
            for (int i = 0; i < 32; ++i) { const int k = C.wave * 128 + i0 + i; a0 += w[i] * sil[k]; a1 += w[i] * sil[1024 + k]; a2 += w[i] * sil[2048 + k]; } }
        red[(C.wave * 3 + 0) * 64 + C.lane] = a0; red[(C.wave * 3 + 1) * 64 + C.lane] = a1; red[(C.wave * 3 + 2) * 64 + C.lane] = a2;
        __syncthreads();
        if (C.tid < 192) { const int ci = C.tid >> 6, col = ch * 64 + (C.tid & 63); float s = C.in[I_ADAB][(size_t)l * 3072 + col];
#pragma unroll
            for (int w = 0; w < 8; ++w) s += red[(w * 3 + ci) * 64 + (C.tid & 63)];
            if (col >= 1024 && col < 2048) s = (1.0f + s) * C.in[I_NORMG][l * 1024 + col - 1024];
            C.w<float>(WS_MODF)[((size_t)l * 3 + ci) * 3072 + col] = s; }
        __syncthreads();
    }
    const int gt = C.bid * NTHR + C.tid, ngt = GRID * NTHR;
    constexpr int T_A2L = 2048 * 2048 / 8, T_A2C = 256 * 512 / 8, T_A1P = 512 * 256 / 8;
    for (int t = gt; t < T_A2L + T_A2C + T_A1P; t += ngt) {
        float v[8]; bf16* dst;
        if (t < T_A2L) { const int r = t >> 8, c0 = (t & 255) * 8, kk = 2 * (r & 1023) + (r >> 10); dst = C.w<bf16>(WS_A2L) + (size_t)r * 2048 + c0;
#pragma unroll
            for (int e = 0; e < 8; ++e) { const int col = c0 + e, s = col & 1023, mm = (kk * s) & 2047; float sn, cs; sincospif((float)mm * (1.0f / 1024.0f), &sn, &cs); v[e] = (col < 1024 ? cs : sn) * 0.02209708691207961f; } }
        else if (t < T_A2L + T_A2C) { const int tt = t - T_A2L, k = tt >> 6, c0 = (tt & 63) * 8; dst = C.w<bf16>(WS_A2C) + (size_t)k * 512 + c0;
#pragma unroll
            for (int e = 0; e < 8; ++e) { const int col = c0 + e, s = col & 255, mm = (k * s) & 255; float sn, cs; sincospif((float)mm * (1.0f / 128.0f), &sn, &cs); v[e] = (col < 256 ? cs : sn) * 0.0625f; } }
        else { const int tt = t - T_A2L - T_A2C, r = tt >> 5, c0 = (tt & 31) * 8; dst = C.w<bf16>(WS_A1P) + (size_t)r * 256 + c0; const int gl = r >> 8, reim = (r >> 7) & 1, j = r & 127;
#pragma unroll
            for (int e = 0; e < 8; ++e) { const int col = c0 + e, glc = col >> 7, c = col & 127, mm = (j * c) & 127; float sn, cs; sincospif((float)mm * (1.0f / 64.0f), &sn, &cs);
                v[e] = (glc == gl) ? (reim ? -sn : cs) * 0.08838834764831845f : 0.f; } }
        v4u o; o.x = cvtpk(v[0], v[1]); o.y = cvtpk(v[2], v[3]); o.z = cvtpk(v[4], v[5]); o.w = cvtpk(v[6], v[7]); *(v4u*)dst = o;
    }
    if (gt < 1024) { const int pos = gt >> 4, f = gt & 15; const float inv = powf(10000.0f, -(float)f / 16.0f), ang = (float)pos * inv;
        C.w<float>(WS_ROPE)[gt * 2] = cosf(ang); C.w<float>(WS_ROPE)[gt * 2 + 1] = sinf(ang); }
}

__device__ __forceinline__ void s5_mats_block(const Ctx& C, int l, int g, int part) {
    LAS f32x2* pw = (LAS f32x2*)C.lds;
    LAS f32x2* Bb = pw + 2 * 17 * 64;
    LAS f32x2* Cm = Bb + 2 * 64 * 16;
    LAS float* Kl = (LAS float*)(Cm + 2 * 16 * 64);
    const int tid = C.tid;
    if (tid < 128) {
        const int d = tid >> 6, n = tid & 63; const size_t gi = ((size_t)(l * 2 + d) * 32 + g);
        const float lr = C.in[I_ARE][gi * 64 + n], li = C.in[I_AIM][gi * 64 + n], dt = expf(C.in[I_LDT][gi]);
        float mag = expf(dt * lr), sn, cs; sincosf(dt * li, &sn, &cs);
        { const float are = mag * cs, aim = mag * sn; float pr = 1.0f, pi = 0.0f;
          for (int tau = 0; tau <= 16; ++tau) { pw[(d * 17 + tau) * 64 + n] = (f32x2){pr, pi}; const float nr = pr * are - pi * aim, ni = pr * aim + pi * are; pr = nr; pi = ni; } }
        const float x = mag * cs - 1.0f, y = mag * sn, den = 1.0f / (lr * lr + li * li), cr = (x * lr + y * li) * den, cim = (y * lr - x * li) * den;
        const float* br = C.in[I_BRE] + (gi * 64 + n) * 16; const float* bi = C.in[I_BIM] + (gi * 64 + n) * 16;
#pragma unroll
        for (int q = 0; q < 16; ++q) Bb[(d * 64 + n) * 16 + q] = (f32x2){cr * br[q] - cim * bi[q], cr * bi[q] + cim * br[q]};
        if (part == 0) { const f32x2 p16 = pw[(d * 17 + 16) * 64 + n]; C.w<float>(WS_A16)[(gi * 64 + n) * 2] = p16.x; C.w<float>(WS_A16)[(gi * 64 + n) * 2 + 1] = p16.y; }
    }
    for (int idx = tid; idx < 2048; idx += NTHR) { const int d = idx >> 10, p = (idx >> 6) & 15, n = idx & 63; const size_t o = (((size_t)(l * 2 + d) * 32 + g) * 16 + p) * 64 + n;
        Cm[idx] = (f32x2){C.in[I_CRE][o], C.in[I_CIM][o]}; }
    __syncthreads();
    {
        const int d = tid >> 8, p = (tid >> 4) & 15, q = tid & 15; float a0 = 0.f, a1 = 0.f;
        for (int n = 0; n < 64; ++n) { const f32x2 c = Cm[(d * 16 + p) * 64 + n], bq = Bb[(d * 64 + n) * 16 + q]; const float wr = c.x * bq.x - c.y * bq.y, wi = c.x * bq.y + c.y * bq.x;
            const f32x2 p0 = pw[(d * 17 + 2 * part) * 64 + n], p1 = pw[(d * 17 + 2 * part + 1) * 64 + n]; a0 += wr * p0.x - wi * p0.y; a1 += wr * p1.x - wi * p1.y; }
        Kl[(d * 2 + 0) * 256 + p * 16 + q] = a0; Kl[(d * 2 + 1) * 256 + p * 16 + q] = a1;
    }
    __syncthreads();
    bf16* BtE = C.w<bf16>(WS_BTE) + (size_t)g * 256 * 256; bf16* BtY = C.w<bf16>(WS_BTY) + (size_t)g * 256 * 512;
    const float* dsk = C.in[I_SD] + (size_t)l * 512 + g * 16;
    for (int task = tid; task < 2 * 2 * 16 * 32; task += NTHR) {
        const int e = task >> 10, d = (task >> 9) & 1, blk = (task >> 5) & 15, p = (task >> 1) & 15, q0 = (task & 1) * 8, tau = 2 * part + e;
        if (blk >= 16 - tau || (tau == 0 && d == 1)) continue;
        const int t = d == 0 ? blk + tau : blk, j = d == 0 ? blk : blk + tau; float v[8];
#pragma unroll
        for (int k = 0; k < 8; ++k) { float s = Kl[(d * 2 + e) * 256 + p * 16 + q0 + k]; if (tau == 0) { s += Kl[(1 * 2 + e) * 256 + p * 16 + q0 + k]; if (q0 + k == p) s += dsk[p]; } v[k] = s; }
        v4u o; o.x = cvtpk(v[0], v[1]); o.y = cvtpk(v[2], v[3]); o.z = cvtpk(v[4], v[5]); o.w = cvtpk(v[6], v[7]); *(v4u*)(BtY + (size_t)(t * 16 + p) * 512 + j * 16 + q0) = o;
    }
    for (int task = tid; task < 2 * 32 * 32; task += NTHR) {
        const int which = task >> 10, r = 32 * part + ((task >> 5) & 31), c0 = (task & 31) * 8; float v[8]; bf16* dst;
        if (which == 0) { const int d = r >> 7, reim = (r >> 6) & 1, n = r & 63, j = c0 >> 4, q0 = c0 & 15, ex = d == 0 ? 15 - j : j; dst = BtE + (size_t)r * 256 + c0; const f32x2 a = pw[(d * 17 + ex) * 64 + n];
#pragma unroll
            for (int k = 0; k < 8; ++k) { const f32x2 bq = Bb[(d * 64 + n) * 16 + q0 + k]; v[k] = reim ? (a.x * bq.y + a.y * bq.x) : (a.x * bq.x - a.y * bq.y); } }
        else { const int t = r >> 4, p = r & 15, d = c0 >> 7, reim = (c0 >> 6) & 1, n0 = c0 & 63, ex = d == 0 ? t + 1 : 16 - t; dst = BtY + (size_t)r * 512 + 256 + c0;
#pragma unroll
            for (int k = 0; k < 8; ++k) { const f32x2 c = Cm[(d * 16 + p) * 64 + n0 + k], a = pw[(d * 17 + ex) * 64 + n0 + k]; v[k] = reim ? -(c.x * a.y + c.y * a.x) : (c.x * a.x - c.y * a.y); } }
        v4u o; o.x = cvtpk(v[0], v[1]); o.y = cvtpk(v[2], v[3]); o.z = cvtpk(v[4], v[5]); o.w = cvtpk(v[6], v[7]); *(v4u*)dst = o;
    }
    __syncthreads();
}

__device__ __forceinline__ void prep_layer(const Ctx& C, int l, int parts, int blo, int bcnt) {
    if (C.vcu < blo || C.vcu >= blo + bcnt) return;
    const int bi = C.vcu - blo, wi = bi * NWAVES + C.wave, nw = bcnt * NWAVES;
    if (parts & 1) for (int it = bi; it < 256; it += bcnt) s5_mats_block(C, l, it >> 3, it & 7);
    LAS float* scr = (LAS float*)(C.lds + C.wave * 16384);
    constexpr int I_1 = 16 * 104, I_2 = 16 * 96, I_3 = 8 * 32, I_4 = 8 * 16, I_5 = 8 * 32, I_6 = 16 * 32;
    if (parts & 1) {
        for (int it = wi; it < I_1 + I_2 + I_3 + I_4; it += nw) {
            int r = it;
            if (r < I_1) { transpose_item(C.in[I_WIN] + (size_t)l * 1024 * INW, 1024, INW, C.w<bf16>(WS_WCAT), RmWin{}, scr, r, C.lane); continue; } r -= I_1;
            if (r < I_2) { transpose_item(C.in[I_MW] + (size_t)l * 1024 * 3072, 1024, 3072, C.w<bf16>(WS_WCAT), RmId{INW}, scr, r, C.lane); continue; } r -= I_2;
            if (r < I_3) { transpose_item(C.in[I_GLU] + (size_t)l * 512 * 1024, 512, 1024, C.w<bf16>(WS_WGLU), RmGlu{}, scr, r, C.lane); continue; } r -= I_3;
            transpose_item(C.in[I_FN] + (size_t)l * 512 * 512, 512, 512, C.w<bf16>(WS_WFN), RmId{0}, scr, r, C.lane, 1024, 512);
        }
        for (int t = bi * NTHR + C.tid; t < 2 * 2 * 256 * 16; t += bcnt * NTHR) {
            const int kv = t >> 13, r = t & 8191, b = r >> 12, s = (r >> 4) & 255, c0 = (r & 15) * 8;
            const float* src = C.in[kv ? I_CV : I_CK] + (((size_t)b * DEPTH + l) * 256 + s) * KVW + c0;
            const f32x4 a = *(const f32x4*)src, bq = *(const f32x4*)(src + 4);
            v4u o; o.x = cvtpk(a[0], a[1]); o.y = cvtpk(a[2], a[3]); o.z = cvtpk(bq[0], bq[1]); o.w = cvtpk(bq[2], bq[3]);
            *(v4u*)(C.w<bf16>(kv ? WS_VL : WS_KL) + ((size_t)b * LKV + S_LAT + s) * KVW + c0) = o;
        }
    }
    if (parts & 2) for (int it = wi; it < 3 * I_5; it += nw) { const int nb = it / I_5;
        transpose_item(C.in[I_WBR] + ((size_t)l * 3 + nb) * 512 * 1024, 512, 1024, C.w<bf16>(WS_WBR) + (size_t)nb * 1024 * 512, RmId{0}, scr, it - nb * I_5, C.lane); }
    if (parts & 4) for (int it = wi; it < I_6; it += nw) transpose_item(C.in[I_WOUT] + (size_t)l * 1024 * 1024, 1024, 1024, C.w<bf16>(WS_WOUT), RmId{0}, scr, it, C.lane);
}

__device__ __forceinline__ void rows_phase(const Ctx& C, int l, bool last);
__device__ __forceinline__ void ph_l1(const Ctx& C, int l) {
    if (l > 0) prep_layer(C, l, 6, 0, GRID);
    rows_phase(C, l, false);
}

__device__ __forceinline__ void rows_phase(const Ctx& C, int l, bool last) {
    const float* modf = C.w<float>(WS_MODF); bf16* XR = C.w<bf16>(WS_XRES);
    const bf16* T0 = C.w<bf16>(WS_PB); const bf16* T1 = C.w<bf16>(WS_GA);
    f32x4 v[4][4];
#pragma unroll
    for (int i = 0; i < 4; ++i) { const int row = C.gw + i * 2048;
        if (l == 0) { const float* xr = i < 2 ? C.in[I_XP] + (size_t)row * 1024 : C.in[I_XS] + (size_t)(row - T_CTX) * 1024;
#pragma unroll
            for (int j = 0; j < 4; ++j) v[i][j] = *(const f32x4*)(xr + C.lane * 4 + 256 * j);
        } else {
#pragma unroll
            for (int j = 0; j < 4; ++j) v[i][j] = bf4_to_f(*(const u32x2*)(XR + (size_t)row * 1024 + C.lane * 4 + 256 * j)); } }
#pragma unroll
    for (int i = 0; i < 4; ++i) { const int row = C.gw + i * 2048, ci = i < 2 ? 0 : i - 1; float ss = 0.f;
        if (l > 0) {
            const float* gp = modf + ((size_t)(l - 1) * 3 + ci) * 3072 + 2048 + C.lane * 4; u32x2 t0[4], t1[4]; f32x4 gt[4];
#pragma unroll
            for (int j = 0; j < 4; ++j) { t0[j] = *(const u32x2*)(T0 + (size_t)row * 1024 + C.lane * 4 + 256 * j); t1[j] = *(const u32x2*)(T1 + (size_t)row * 1024 + C.lane * 4 + 256 * j); gt[j] = *(const f32x4*)(gp + 256 * j); }
#pragma unroll
            for (int j = 0; j < 4; ++j) v[i][j] += gt[j] * (bf4_to_f(t0[j]) + bf4_to_f(t1[j]));
        }
        if (!last) {
#pragma unroll
            for (int j = 0; j < 4; ++j) st_bf4(XR + (size_t)row * 1024 + C.lane * 4 + 256 * j, v[i][j]);
        }
#pragma unroll
        for (int j = 0; j < 4; ++j) ss += (v[i][j][0] * v[i][j][0] + v[i][j][1] * v[i][j][1]) + (v[i][j][2] * v[i][j][2] + v[i][j][3] * v[i][j][3]);
        const float rstd = rsqrtf(wave_sum(ss, C.lane) * (1.0f / 1024.0f) + RMS_EPS);
        if (last) {
#pragma unroll
            for (int j = 0; j < 4; ++j) *(f32x4*)(C.out + (size_t)row * 1024 + C.lane * 4 + 256 * j) = v[i][j] * rstd * *(const f32x4*)(C.in[I_FG] + C.lane * 4 + 256 * j);
        } else {
            const float* mp = modf + ((size_t)l * 3 + ci) * 3072 + C.lane * 4; bf16* hr = C.w<bf16>(WS_H) + (size_t)row * 1024;
#pragma unroll
            for (int j = 0; j < 4; ++j) { const f32x4 sh = *(const f32x4*)(mp + 256 * j), gs = *(const f32x4*)(mp + 1024 + 256 * j); st_bf4(hr + C.lane * 4 + 256 * j, v[i][j] * rstd * gs + sh); }
        }
    }
}

__device__ __forceinline__ void scan_unit(const Ctx& C, int l, int g, int pm) {
    const float* SC = C.w<float>(WS_SC); bf16* UH = C.w<bf16>(WS_UH); const int lane = C.lane;
    const int nitems = pm ? 4 : 32;
    for (int item = C.wave; item < nitems; item += NWAVES) {
        const int bsel = item >> 1, d = item & 1, nch = pm ? 128 : 16, c0 = pm ? 256 + bsel * 128 : bsel * 16;
        const size_t gi = ((size_t)(l * 2 + d) * 32 + g) * 64 + lane;
        const float ar = C.w<float>(WS_A16)[gi * 2], ai = C.w<float>(WS_A16)[gi * 2 + 1];
        float hr = 0.f, hi = 0.f;
        if (pm) { const float* st = C.in[I_ST] + ((((size_t)bsel * DEPTH + l) * 2 + d) * 32 + g) * 128 + lane * 2; hr = st[0]; hi = st[1]; }
        float sr[16], si[16], tr[16], ti[16];
#pragma unroll
        for (int k = 0; k < 16; ++k) { const int c = d == 0 ? c0 + k : c0 + nch - 1 - k; const size_t o = ((size_t)g * 512 + c) * 256 + d * 128 + lane; sr[k] = SC[o]; si[k] = SC[o + 64]; }
        for (int i0 = 0; i0 < nch; i0 += 16) {
            if (i0 + 16 < nch) {
#pragma unroll
                for (int k = 0; k < 16; ++k) { const int c = d == 0 ? c0 + i0 + 16 + k : c0 + nch - 1 - i0 - 16 - k; const size_t o = ((size_t)g * 512 + c) * 256 + d * 128 + lane; tr[k] = SC[o]; ti[k] = SC[o + 64]; }
            }
#pragma unroll
            for (int k = 0; k < 16; ++k) { const int c = d == 0 ? c0 + i0 + k : c0 + nch - 1 - i0 - k; const size_t oh = ((size_t)g * 512 + c) * 512 + 256 + d * 128 + lane;
                UH[oh] = (bf16)(cvtpk(hr, hr) & 0xffffu); UH[oh + 64] = (bf16)(cvtpk(hi, hi) & 0xffffu);
                const float nr = ar * hr - ai * hi + sr[k], ni = ar * hi + ai * hr + si[k]; hr = nr; hi = ni; }
#pragma unroll
            for (int k = 0; k < 16; ++k) { sr[k] = tr[k]; si[k] = ti[k]; }
        }
        if (!pm) { float* o = C.out + OUT_S + ((((size_t)bsel * DEPTH + l) * 2 + d) * 32 + g) * 128 + lane * 2; o[0] = hr; o[1] = hi; }
    }
}

__device__ __forceinline__ void ph_final(const Ctx& C) { rows_phase(C, DEPTH, true); }

__device__ __forceinline__ void attn_any(const Ctx& C, int uidx) {
    size_t tok0, kvoff; int NT, h;
    if (uidx < 128) { const int b = uidx >> 6, qb = uidx & 7; h = (uidx >> 3) & 7; tok0 = (size_t)T_CTX + b * 2048 + qb * 256; kvoff = (size_t)(WS_KL - WS_KC) / 2 + (size_t)b * LKV * KVW; NT = LKV / 64; }
    else { const int u2 = uidx - 128, b = u2 >> 3; h = u2 & 7; tok0 = (size_t)b * 256; kvoff = tok0 * KVW; NT = 4; }
    kvoff += (h >> 2) * 64;
    const attn_body::bf16* Q = (const attn_body::bf16*)C.w<bf16>(WS_Q) + tok0 * 512 + h * 64;
    const attn_body::bf16* Kp = (const attn_body::bf16*)C.w<bf16>(WS_KC) + kvoff;
    attn_body::attn_unit<8>(Q, Kp, Kp + (WS_VC - WS_KC) / 2, (attn_body::bf16*)Q, (const attn_body::bf16*)C.w<bf16>(WS_GC) + tok0 * 512 + h * 64, 512, KVW, NT, (char*)C.lds, C.tid);
}

#ifndef MK_PER_PHASE
#define MK_PER_PHASE 0
#endif
constexpr int NSUB = 7, N_PHASES = 2 + NSUB * DEPTH;


__global__ void __launch_bounds__(NTHR, 2) fwd_kernel(KArgs args) {
    extern __shared__ __attribute__((aligned(16))) unsigned char lds_raw[];
    Ctx C; C.lds = (LAS unsigned char*)lds_raw; C.tid = threadIdx.x; C.lane = C.tid & 63; C.wave = __builtin_amdgcn_readfirstlane(C.tid >> 6); C.bid = blockIdx.x;
    int wave_s = C.wave;
    C.gw = C.bid * NWAVES + C.wave; C.ngw = GRID * NWAVES; C.in = args.in; C.out = args.out; C.ws = args.ws;
    for (int u = C.tid; u < (LDS_BYTES - LDSCTL_OFF) / 4; u += NTHR) ((LAS unsigned*)(C.lds + LDSCTL_OFF))[u] = 0u;
    __syncthreads();
    volatile LAS unsigned* MISC = (volatile LAS unsigned*)(C.lds + MISC_OFF);
    XcdBarrier bar; bar.bar = (unsigned*)(C.ws + WS_CTL) + CW_BAR; bar.x = 0; bar.st = nullptr;
    const bool multi = args.ph_hi - args.ph_lo > 1;
    if (multi) bar = xcd_barrier_post((unsigned*)(C.ws + WS_CTL) + CW_BAR, MISC + 8, C.tid);

    for (int ph = args.ph_lo; ph < args.ph_hi; ++ph) {
        { int l_; asm volatile("v_mbcnt_lo_u32_b32 %0, -1, 0\n\tv_mbcnt_hi_u32_b32 %0, -1, %0" : "=v"(l_)); asm volatile("" : "+s"(wave_s)); int b_ = blockIdx.x; asm volatile("" : "+s"(b_)); C.bid = b_; C.vcu = b_;   C.lane = l_; C.wave = wave_s; C.tid = wave_s * 64 + l_; C.gw = C.bid * NWAVES + C.wave;
          unsigned char* w_ = args.ws; asm volatile("" : "+s"(w_)); C.ws = w_; float* o_ = args.out; asm volatile("" : "+s"(o_)); C.out = o_; }
        const int c = C.vcu;
        if (ph == 0) { ph_prologue(C); __syncthreads(); prep_layer(C, 0, 7, 0, GRID); }
        else if (ph == N_PHASES - 1) ph_final(C);
        else {
            const int l = (ph - 1) / NSUB, sub = (ph - 1) % NSUB;
            if (sub == 0) ph_l1(C, l);
            else {
                if (sub == 2 && c < 128) for (int i = 0; i < 2; ++i) attn_any(C, c + 128 * i);
                if (sub == 3 && c >= 64 && c < 128) { const int L = xswz(c - 64, 64); scan_unit(C, l, L >> 1, L & 1); VM_WAIT(); }
                __syncthreads();
                { PhaseSched S{sub, c, C.bid, C.ws}; EpiAll E{C.ws, C.out, C.in, l}; int t_ = C.tid; asm volatile("" : "+v"(t_));
                  pg8::gemm_stream<EpiAll, PhaseSched>(C.lds, S, E, t_); }
                if (sub == 5 && l + 1 < DEPTH) { __syncthreads(); prep_layer(C, l + 1, 1, 128, 128); }
            }
        }
        if (ph + 1 < args.ph_hi) xcd_barrier(bar, C.tid);
    }
}

extern "C" void kernel_launch(void* const* d_in, const int* in_sizes, int n_in, void* d_out, int out_size, void* d_ws, size_t ws_size, hipStream_t stream) {
    static int ready = 0;
    if (ready == 0) {
        if (n_in != 28 || out_size != (int)OUT_N || ws_size < WS_END) { fprintf(stderr, "kernel_launch: unexpected problem shape (n_in %d, out %d, ws %zu)\n", n_in, out_size, ws_size); ready = -1; return; }
        int dev = 0, cus = 0;
        if (hipGetDevice(&dev) != hipSuccess || hipDeviceGetAttribute(&cus, hipDeviceAttributeMultiprocessorCount, dev) != hipSuccess) { ready = -1; return; }
        if (hipFuncSetAttribute((const void*)fwd_kernel, hipFuncAttributeMaxDynamicSharedMemorySize, LDS_BYTES) != hipSuccess) { fprintf(stderr, "kernel_launch: hipFuncSetAttribute failed\n"); ready = -1; return; }
        if (cus < GRID) { fprintf(stderr, "kernel_launch: device has %d CUs, this kernel needs %d resident workgroups\n", cus, GRID); ready = -1; return; }
        ready = 1;
    }
    if (ready < 0) return;
    (void)hipMemsetAsync((char*)d_ws + WS_CTL, 0, CTL_ZERO_BYTES, stream);
    KArgs a{};
    for (int i = 0; i < 28; ++i) a.in[i] = (const float*)d_in[i];
    a.out = (float*)d_out; a.ws = (unsigned char*)d_ws;
#if MK_PER_PHASE
    for (int ph = 0; ph < N_PHASES; ++ph) { a.ph_lo = ph; a.ph_hi = ph + 1; hipLaunchKernelGGL(fwd_kernel, dim3(GRID), dim3(NTHR), LDS_BYTES, stream, a); }
#else
    a.ph_lo = 0; a.ph_hi = N_PHASES; hipLaunchKernelGGL(fwd_kernel, dim3(GRID), dim3(NTHR), LDS_BYTES, stream, a);
#endif
}
```

```cpp
#include <hip/hip_runtime.h>
#include <hip/hip_bf16.h>
#include <cstdio>
#include <cstdint>
#include <cmath>
namespace pg8 {
#define PG8_LAS __attribute__((address_space(3)))
typedef unsigned short bf16_t;
typedef short bf16x8 __attribute__((ext_vector_type(8)));
typedef float f32x4 __attribute__((ext_vector_type(4)));
typedef unsigned u32x4 __attribute__((ext_vector_type(4)));
constexpr int BM = 256, BK = 64, HALF = 128, HTB = HALF * BK * 2  , STAGE_BYTES = 8 * HTB, NXCD = 8, WGM = 8;

__host__ __device__ __forceinline__ int lds_byte(int r, int c) { const int st = (r >> 4) * 2 + (c >> 5), rr = r & 15, cc = c & 31, ob = rr * 64 + cc * 2; return st * 1024 + (ob ^ (((ob >> 9) & 1) << 5)); }
__host__ __device__ __forceinline__ void stage_rc(int b, int& R, int& C) { const int st = b / 1024, sb = b % 1024, swz = sb ^ (((sb >> 9) & 1) << 5); R = (st >> 1) * 16 + swz / 64; C = (st & 1) * 32 + (swz % 64) / 2; }
__host__ __device__ __forceinline__ int perm32(int rho) { const int n = rho >> 4, i = rho & 15; return 8 * (i >> 2) + 4 * n + (i & 3); }


struct Unit { int pm, pn, z; };
struct StaticOrder {
    int nM, nN, nwg, G, c;
    __host__ __device__ void init(int M, int N, int G_, int c_) { nM = M / BM; nN = N / BM; nwg = nM * nN; G = G_; c = c_; }
    __host__ __device__ bool next(int i, Unit& u) const {
        const long L = (long)i * G + c; if (L >= nwg) return false;
        int wgid = (int)L; { const int q = nwg / NXCD, r = nwg % NXCD, xcd = wgid % NXCD, off = wgid / NXCD; wgid = (xcd < r ? xcd * (q + 1) : r * (q + 1) + (xcd - r) * q) + off; }
        const int nig = WGM * nN, gid = wgid / nig, fm = gid * WGM, gsz = (nM - fm) < WGM ? (nM - fm) : WGM;
        u.pm = fm + ((wgid % nig) % gsz); u.pn = (wgid % nig) / gsz; return true;
    }
    __device__ __forceinline__ void a_ready(const Unit&) const {}
    __device__ __forceinline__ void done(const Unit&) const {}
};
struct UDesc { const bf16_t* A; const bf16_t* Bt; int lda, ldb, K, hB; int kind, pm, pn, z, keep; };
template <class Epi, class Sched>
__device__ __forceinline__ void gemm_stream(PG8_LAS unsigned char* lds, const Sched& S, const Epi& E, const int tid_in) {
    const int tid = tid_in, wid = __builtin_amdgcn_readfirstlane(tid >> 6), lane = tid & 63, wr = wid >> 2, wc = wid & 3, fr = lane & 15, fq = lane >> 4;
    int RA, RB, CC;
    { int R, C; stage_rc(tid * 16, R, C); RA = R; RB = (R & ~31) + perm32(R & 31); CC = C; }
    const size_t kstep = (size_t)(BK * 2);
    const unsigned ldsw = (unsigned)wid * 1024u;
    const int aoff = lds_byte(wr * 64 + fr, fq * 8), boff = lds_byte(wc * 32 + fr, fq * 8);
#define PG8_SA(b, h) (((b) * 2 + (h)) * HTB)
#define PG8_SB(b, h) ((4 + (b) * 2 + (h)) * HTB)
#define PG8_STAGE_X(bufoff, gbase, RR, ld) do { const unsigned _vo = (unsigned)(RR * (ld) + CC) * 2u; \
        __builtin_amdgcn_global_load_lds((const unsigned*)((const char*)(gbase) + _vo), (PG8_LAS unsigned*)(lds + (bufoff) + ldsw), 16, 0, 0); \
        __builtin_amdgcn_global_load_lds((const unsigned*)((const char*)(gbase) + (size_t)(ld) * 128 + _vo), (PG8_LAS unsigned*)(lds + (bufoff) + ldsw + 8192), 16, 0, 0); } while (0)
#define PG8_STAGE_A(bufoff, gbase, ld) PG8_STAGE_X(bufoff, gbase, RA, ld)
#define PG8_STAGE_B(bufoff, gbase, ld) PG8_STAGE_X(bufoff, gbase, RB, ld)
#define PG8_LDA(dst, b, h) do { _Pragma("unroll") for (int m = 0; m < 4; ++m) _Pragma("unroll") for (int k = 0; k < 2; ++k) dst[m][k] = *(const PG8_LAS bf16x8*)(lds + PG8_SA(b, h) + aoff + m * 2048 + k * 1024); } while (0)
#define PG8_LDB(dst, b, h) do { _Pragma("unroll") for (int n = 0; n < 2; ++n) _Pragma("unroll") for (int k = 0; k < 2; ++k) dst[n][k] = *(const PG8_LAS bf16x8*)(lds + PG8_SB(b, h) + boff + n * 2048 + k * 1024); } while (0)
#define PG8_MMA(ai, bj, At, Bt) do { __builtin_amdgcn_s_setprio(1); _Pragma("unroll") for (int m = 0; m < 4; ++m) _Pragma("unroll") for (int n = 0; n < 2; ++n) _Pragma("unroll") for (int k = 0; k < 2; ++k) \
        acc[ai][bj][m][n] = __builtin_amdgcn_mfma_f32_16x16x32_bf16(Bt[n][k], At[m][k], acc[ai][bj][m][n], 0, 0, 0); __builtin_amdgcn_s_setprio(0); } while (0)
#define PG8_WAIT_V(n) asm volatile("s_waitcnt vmcnt(" #n ")" ::: "memory")
#define PG8_WAIT_L(n) asm volatile("s_waitcnt lgkmcnt(" #n ")" ::: "memory")
#define PG8_BAR __builtin_amdgcn_s_barrier()
#define PG8_SCHED __builtin_amdgcn_sched_barrier(0)
    UDesc cur, nxt; int ui = 0;
    if (!S.next(0, cur)) return;
    f32x4 acc[2][2][4][2];
#pragma unroll
    for (int a = 0; a < 2; ++a)
#pragma unroll
        for (int b = 0; b < 2; ++b)
#pragma unroll
            for (int m = 0; m < 4; ++m)
#pragma unroll
                for (int n = 0; n < 2; ++n) acc[a][b][m][n] = (f32x4){0.f, 0.f, 0.f, 0.f};
    bf16x8 At[4][2], B0[2][2], B1[2][2];
    const char* cA = (const char*)cur.A; const char* cB = (const char*)cur.Bt; int ldaC = cur.lda, ldbC = cur.ldb; unsigned hstepA = (unsigned)HALF * ldaC * 2, hstepB = (unsigned)cur.hB * ldbC * 2;
    PG8_STAGE_B(PG8_SB(0, 0), cB, ldbC); PG8_STAGE_B(PG8_SB(0, 1), cB + hstepB, ldbC); PG8_STAGE_A(PG8_SA(0, 0), cA, ldaC); PG8_STAGE_A(PG8_SA(0, 1), cA + hstepA, ldaC);
    if (wr == 1) PG8_BAR;
    PG8_WAIT_V(2); PG8_BAR;
    PG8_STAGE_B(PG8_SB(1, 0), cB + kstep, ldbC); PG8_STAGE_A(PG8_SA(1, 0), cA + kstep, ldaC); PG8_STAGE_B(PG8_SB(1, 1), cB + hstepB + kstep, ldbC);
    PG8_WAIT_V(6); PG8_BAR;
    for (;;) {
        const bool has_next = S.next(ui + 1, nxt);
        const char* nA = has_next ? (const char*)nxt.A : cA; const char* nB = has_next ? (const char*)nxt.Bt : cB;
        const int ldaN = has_next ? nxt.lda : ldaC, ldbN = has_next ? nxt.ldb : ldbC; const unsigned hstepAN = (unsigned)HALF * ldaN * 2, hstepBN = has_next ? (unsigned)nxt.hB * ldbN * 2 : hstepB;
        const int nt = cur.K / BK;
        for (int t = 0; t < nt; t += 2) {
            const bool last = (t == nt - 2);
            const char* a1 = cA + (size_t)(t + 1) * kstep;
            const char* a2 = last ? nA : cA + (size_t)(t + 2) * kstep; const char* b2 = last ? nB : cB + (size_t)(t + 2) * kstep;
            const char* a3 = a2 + kstep; const char* b3 = b2 + kstep;
            const int lda2 = last ? ldaN : ldaC, ldb2 = last ? ldbN : ldbC; const unsigned hA2 = last ? hstepAN : hstepA, hB2 = last ? hstepBN : hstepB;
            PG8_LDB(B0, 0, 0); PG8_LDB(B1, 0, 1); PG8_SCHED; PG8_LDA(At, 0, 0); PG8_STAGE_A(PG8_SA(1, 1), a1 + hstepA, ldaC);
            PG8_WAIT_V(8); PG8_WAIT_L(0); PG8_BAR; PG8_MMA(0, 0, At, B0); PG8_MMA(0, 1, At, B1); PG8_BAR; PG8_SCHED;
            PG8_LDA(At, 0, 1); PG8_STAGE_B(PG8_SB(0, 0), b2, ldb2); PG8_STAGE_B(PG8_SB(0, 1), b2 + hB2, ldb2); PG8_STAGE_A(PG8_SA(0, 0), a2, lda2);
            PG8_WAIT_V(8); PG8_WAIT_L(0); PG8_BAR; PG8_MMA(1, 0, At, B0); PG8_MMA(1, 1, At, B1); PG8_BAR; PG8_SCHED;
            PG8_LDB(B0, 1, 0); PG8_LDB(B1, 1, 1); PG8_SCHED; PG8_LDA(At, 1, 0); PG8_STAGE_A(PG8_SA(0, 1), a2 + hA2, lda2);
            PG8_WAIT_V(8); PG8_WAIT_L(0); PG8_BAR; PG8_MMA(0, 0, At, B0); PG8_MMA(0, 1, At, B1); PG8_BAR; PG8_SCHED;
            PG8_LDA(At, 1, 1); PG8_STAGE_B(PG8_SB(1, 0), b3, ldb2); PG8_STAGE_B(PG8_SB(1, 1), b3 + hB2, ldb2); PG8_STAGE_A(PG8_SA(1, 0), a3, lda2);
            PG8_WAIT_V(8); PG8_WAIT_L(0); PG8_BAR; PG8_MMA(1, 0, At, B0); PG8_MMA(1, 1, At, B1); PG8_BAR; PG8_SCHED;
        }
        if (wr == 0) PG8_BAR;
        const bool chained = E.transform(acc, cur, wr, wc, fr, fq);
        if (!chained) E(acc, cur, wr, wc, fr, fq);
        if (!has_next) break;
        if (!chained) {
#pragma unroll
        for (int a = 0; a < 2; ++a)
#pragma unroll
            for (int b = 0; b < 2; ++b)
#pragma unroll
                for (int m = 0; m < 4; ++m)
#pragma unroll
                    for (int n = 0; n < 2; ++n) acc[a][b][m][n] = (f32x4){0.f, 0.f, 0.f, 0.f};
        }
        cur = nxt; cA = nA; cB = nB; ldaC = ldaN; ldbC = ldbN; hstepA = hstepAN; hstepB = hstepBN; ++ui;
        if (wr == 1) PG8_BAR;
    }
    PG8_WAIT_V(0);
    PG8_BAR;
#undef PG8_SA
#undef PG8_SB
#undef PG8_STAGE_X
#undef PG8_STAGE_A
#undef PG8_STAGE_B
#undef PG8_LDA
#undef PG8_LDB
#undef PG8_MMA
#undef PG8_WAIT_V
#undef PG8_WAIT_L
#undef PG8_BAR
#undef PG8_SCHED
}
}

#include <hip/hip_bf16.h>
#include <cmath>
namespace attn_body {
using bf16=__hip_bfloat16;
using bf16x8=__attribute__((ext_vector_type(8)))short;
using s16x4=__attribute__((ext_vector_type(4)))short;
using f32x16=__attribute__((ext_vector_type(16)))float;
using u32x4=__attribute__((ext_vector_type(4)))unsigned;
constexpr int D=64;
constexpr int NW=8,QBLK=32,QB=QBLK*NW,KVBLK=64;
__device__ __forceinline__ int crow(int r,int hi){return (r&3)+8*(r>>2)+4*hi;}
#define SBAR() __builtin_amdgcn_sched_barrier(0)
constexpr int NSLOT=3, SLOTB=8192;
constexpr int LDS_K=0, LDS_V=NSLOT*SLOTB, LDS_WS=2*NSLOT*SLOTB, LDS_OST=LDS_WS+NW*64*4, LDS_BYTES=LDS_OST+NW*4096;
constexpr float C2=0.125f*1.4426950408889634f;
__device__ __forceinline__ void glds16(const void*gsrc,unsigned lds_dst){unsigned keep;
  asm volatile("s_mov_b32 %0, m0\n\ts_mov_b32 m0, %2\n\ts_nop 0\n\tglobal_load_lds_dwordx4 %1, off\n\ts_mov_b32 m0, %0":"=&s"(keep):"v"(gsrc),"s"(lds_dst):"memory");}
__device__ __forceinline__ float max3f(float a,float b,float c){float r;asm("v_max3_f32 %0, %1, %2, %3":"=v"(r):"v"(a),"v"(b),"v"(c));return r;}
__device__ __forceinline__ float max2f(float a,float b){float r;asm("v_max_f32_e32 %0, %1, %2":"=v"(r):"v"(a),"v"(b));return r;}
__device__ __forceinline__ float fadd_s(float a,float b){float r;asm("v_add_f32_e32 %0, %1, %2":"=v"(r):"v"(a),"v"(b));return r;}
__device__ __forceinline__ float fsub_s(float a,float b){float r;asm("v_sub_f32_e32 %0, %1, %2":"=v"(r):"v"(a),"v"(b));return r;}
typedef float f32x2_t __attribute__((ext_vector_type(2))); typedef __bf16 bf16x2_t __attribute__((ext_vector_type(2)));
__device__ __forceinline__ unsigned cvtpk_s(float lo,float hi){f32x2_t v={lo,hi};bf16x2_t b=__builtin_convertvector(v,bf16x2_t);return __builtin_bit_cast(unsigned,b);}
#define WAIT_BAR(N) asm volatile("s_waitcnt vmcnt(" #N ") lgkmcnt(0)\n\ts_barrier":::"memory")

__device__ __forceinline__ void qkt(f32x16&p0,f32x16&p1,const char*Kslot,const bf16x8*qr,const f32x16&negm,int r32,int hi){
  const char*kb=Kslot+hi*1024+r32*16;
  #pragma unroll
  for(int d0=0;d0<4;++d0){
    const bf16x8 b0=*reinterpret_cast<const bf16x8*>(kb+d0*2048);
    const bf16x8 b1=*reinterpret_cast<const bf16x8*>(kb+d0*2048+512);
    if(d0==0){p0=__builtin_amdgcn_mfma_f32_32x32x16_bf16(b0,qr[0],negm,0,0,0);p1=__builtin_amdgcn_mfma_f32_32x32x16_bf16(b1,qr[0],negm,0,0,0);}
    else{p0=__builtin_amdgcn_mfma_f32_32x32x16_bf16(b0,qr[d0],p0,0,0,0);p1=__builtin_amdgcn_mfma_f32_32x32x16_bf16(b1,qr[d0],p1,0,0,0);}}
}
typedef __attribute__((address_space(3))) const char* lds_cptr;
typedef short v4i16_t __attribute__((ext_vector_type(4)));
__device__ __forceinline__ void kload8(bf16x8*kf,lds_cptr kp){
  kf[0]=*(const __attribute__((address_space(3))) bf16x8*)(kp);      kf[1]=*(const __attribute__((address_space(3))) bf16x8*)(kp+512);
  kf[2]=*(const __attribute__((address_space(3))) bf16x8*)(kp+2048); kf[3]=*(const __attribute__((address_space(3))) bf16x8*)(kp+2560);
  kf[4]=*(const __attribute__((address_space(3))) bf16x8*)(kp+4096); kf[5]=*(const __attribute__((address_space(3))) bf16x8*)(kp+4608);
  kf[6]=*(const __attribute__((address_space(3))) bf16x8*)(kp+6144); kf[7]=*(const __attribute__((address_space(3))) bf16x8*)(kp+6656);
}
__device__ __forceinline__ void kload2(bf16x8*kf,lds_cptr kp,int j){ kf[2*j]=*(const __attribute__((address_space(3))) bf16x8*)(kp+j*2048); kf[2*j+1]=*(const __attribute__((address_space(3))) bf16x8*)(kp+j*2048+512); }
__device__ __forceinline__ s16x4 vtr(lds_cptr p){ return __builtin_bit_cast(s16x4,__builtin_amdgcn_ds_read_tr16_b64_v4i16((__attribute__((address_space(3))) v4i16_t*)p)); }
__device__ __forceinline__ float rowmax(const f32x16&p0,const f32x16&p1){
  float a=max3f(p0[0],p0[1],p1[0]),b=max3f(p0[2],p0[3],p1[1]);a=max3f(a,p1[2],p1[3]);
  #pragma unroll
  for(int r=4;r<16;r+=4){a=max3f(a,p0[r],p0[r+1]);b=max3f(b,p0[r+2],p0[r+3]);a=max3f(a,p1[r],p1[r+1]);b=max3f(b,p1[r+2],p1[r+3]);}
  const float m=max2f(a,b);
  auto rr=__builtin_amdgcn_permlane32_swap(__float_as_uint(m),__float_as_uint(m),false,false);
  return max2f(__uint_as_float(rr[0]),__uint_as_float(rr[1]));
}
__device__ __forceinline__ void pv(f32x16*o,int vb,bf16x8 pa0,bf16x8 pa1,bf16x8 pa2,bf16x8 pa3){
  #pragma unroll
  for(int d0=0;d0<2;++d0){s16x4 lo[4],hi[4];
    #pragma unroll
    for(int ks=0;ks<4;++ks){
      asm volatile("ds_read_b64_tr_b16 %0,%1 offset:%c2":"=&v"(lo[ks]):"v"(vb),"i"(d0*4096+ks*1024):"memory");
      asm volatile("ds_read_b64_tr_b16 %0,%1 offset:%c2":"=&v"(hi[ks]):"v"(vb),"i"(d0*4096+ks*1024+512):"memory");}
    asm volatile("s_waitcnt lgkmcnt(0)":::"memory");SBAR();
    #define PK(k) (bf16x8){lo[k][0],lo[k][1],lo[k][2],lo[k][3],hi[k][0],hi[k][1],hi[k][2],hi[k][3]}
    o[d0]=__builtin_amdgcn_mfma_f32_32x32x16_bf16(pa0,PK(0),o[d0],0,0,0);
    o[d0]=__builtin_amdgcn_mfma_f32_32x32x16_bf16(pa1,PK(1),o[d0],0,0,0);
    o[d0]=__builtin_amdgcn_mfma_f32_32x32x16_bf16(pa2,PK(2),o[d0],0,0,0);
    o[d0]=__builtin_amdgcn_mfma_f32_32x32x16_bf16(pa3,PK(3),o[d0],0,0,0);
    #undef PK
  }
}

#ifndef ATTN_STORE16
#define ATTN_STORE16(p,v) (*(u32x4*)(p)=(v))
#endif
template<int THRL> __device__ __forceinline__ void attn_unit(const bf16*Qu,const bf16*Kh,const bf16*Vh,bf16*Ou,const bf16*Gu,const int QP,const int KP,const int NT,char*shm,const int tid_in){
  const int tid=tid_in,lane=tid&63,r32=lane&31,hi=lane>>5; const int wid=__builtin_amdgcn_readfirstlane(tid>>6);
  const bf16*Qw=Qu+(long)(wid*QBLK)*QP;
  const unsigned lds0=(unsigned)(uintptr_t)shm;
  float*wsf=(float*)(shm+LDS_WS)+wid*64;
  const bf16*ksrc=Kh+(long)lane*KP+wid*8;
  const bf16*vsrc=Vh+(long)(16*(wid&3)+(lane>>2))*KP+(wid>>2)*32+(lane&3)*8;
  const unsigned kdst=lds0+LDS_K+wid*1024, vdst=lds0+LDS_V+wid*1024;
  #define DMA_K(t,slot) glds16(ksrc+(long)(t)*KVBLK*KP,(unsigned)__builtin_amdgcn_readfirstlane(kdst+(slot)))
  #define DMA_V(t,slot) glds16(vsrc+(long)(t)*KVBLK*KP,(unsigned)__builtin_amdgcn_readfirstlane(vdst+(slot)))
  const int vb0=(int)(lds0+LDS_V)+((lane>>4)&1)*32+(lane&3)*8+(4*hi+((lane&15)>>2))*64;
  const char*Kbase=shm+LDS_K; bf16x8 kf[8];
  const lds_cptr shm3=(lds_cptr)shm; const lds_cptr kp0=shm3+LDS_K+hi*1024+r32*16; const lds_cptr vp0=shm3+LDS_V+((lane>>4)&1)*32+(lane&3)*8+(4*hi+((lane&15)>>2))*64;
  DMA_K(0,0);DMA_V(0,0);DMA_K(1,SLOTB);
  bf16x8 qr[4];
  #pragma unroll
  for(int d0=0;d0<4;++d0)qr[d0]=*reinterpret_cast<const bf16x8*>(&Qw[(long)r32*QP+d0*16+hi*8]);
  float mhat=0.f,l_reg=0.f;f32x16 o[2];o[0]=f32x16{};o[1]=f32x16{};f32x16 negm; {float zf_; asm volatile("v_mov_b32 %0, 0":"=v"(zf_)); _Pragma("unroll") for(int r=0;r<16;++r)negm[r]=zf_;} asm volatile("":"+v"(negm));
  #define CMASK(P0,P1,t) do{}while(0)
  bool resc=false;
  #define START(P0,P1) do{ const float rm=rowmax(P0,P1); resc=false; \
    { const float dl=rm; mhat=fadd_s(mhat,dl); \
      _Pragma("unroll") for(int r=0;r<16;++r){P0[r]=fsub_s(P0[r],dl);P1[r]=fsub_s(P1[r],dl);} \
      _Pragma("unroll") for(int r=0;r<16;++r)negm[r]=-mhat; asm volatile("":"+v"(negm)); } \
    _Pragma("unroll") for(int r=0;r<16;++r)P0[r]=__builtin_amdgcn_exp2f(P0[r]); }while(0)
  #define RESC() do{ if(resc){ asm volatile("s_waitcnt lgkmcnt(0)":::"memory"); \
      _Pragma("unroll") for(int d_=0;d_<2;++d_) _Pragma("unroll") for(int r=0;r<16;++r)o[d_][r]*=wsf[crow(r,hi)]; } }while(0)
  f32x16 pA0,pA1,pB0,pB1;
  int sl_prev=0,sl_cur=0,sl_next=SLOTB;
  #define ROT() do{sl_prev=sl_cur;sl_cur=sl_next;sl_next=(sl_next==(NSLOT-1)*SLOTB)?0:sl_next+SLOTB;}while(0)
  DMA_K(2,2*SLOTB);
  WAIT_BAR(3);
  qkt(pA0,pA1,Kbase,qr,negm,r32,hi);asm volatile("s_nop 15\n\ts_nop 7":"+v"(pA0),"+v"(pA1));CMASK(pA0,pA1,0);
  START(pA0,pA1);
  _Pragma("unroll") for(int r=0;r<16;++r)pA1[r]=__builtin_amdgcn_exp2f(pA1[r]);
  WAIT_BAR(0);
  DMA_K(3,0);DMA_V(1,SLOTB);
  ROT();
  kload8(kf,kp0+sl_cur);
  WAIT_BAR(2);
  s16x4 vlo[8],vhi[8]; u32x4 pw0,pw1,pw2,pw3;
  #define PKW(P,B) cvtpk_s(P[B],P[B+1])
  #define PAF(k) __builtin_bit_cast(bf16x8,pw##k)
  #define VFR(i) (bf16x8){vlo[i][0],vlo[i][1],vlo[i][2],vlo[i][3],vhi[i][0],vhi[i][1],vhi[i][2],vhi[i][3]}
  #define PIN(x) asm volatile("":"+v"(x))
  #define MX3(a,b,c) __builtin_fmaxf(__builtin_fmaxf((a),(b)),(c))
  #define GAPA(MF,A0,A1,A2,A3,W0,W1,PW) do{ MF; sacc+=A0; sacc+=A1; sacc+=A2; sacc+=A3; PIN(sacc); W0; W1; PIN(PW); SBAR(); }while(0)
  #define EX(v) __builtin_amdgcn_exp2f(v)
  #define GAPB(MF,X,B) do{ MF; X[B]=EX(X[B]); X[B+1]=EX(X[B+1]); X[B+2]=EX(X[B+2]); X[B+3]=EX(X[B+3]); PIN(X); SBAR(); }while(0)
  #define VRD(i) do{ vlo[i]=vtr(vp_+(((i)>>2)*4096+((i)&3)*1024)); vhi[i]=vtr(vp_+(((i)>>2)*4096+((i)&3)*1024+512)); }while(0)
  #define KRD(G,j) do{ if(G){ kload2(kf,kp0+sl_next,j); SBAR(); } }while(0)
  #define STEP(C0,C1,P0,P1,t,GK,GV,GL) do{ SBAR(); \
    const lds_cptr vp_=vp0+sl_prev; \
    VRD(0); SBAR(); float sacc=(P0[0]+P0[1]); \
    GAPA(C0=__builtin_amdgcn_mfma_f32_32x32x16_bf16(kf[0],qr[0],negm,0,0,0), P0[2],P0[3],P0[4],P0[5],     pw0[0]=PKW(P0,0), pw0[1]=PKW(P0,2), pw0); \
    VRD(4); SBAR(); GAPA(C1=__builtin_amdgcn_mfma_f32_32x32x16_bf16(kf[1],qr[0],negm,0,0,0), P0[6],P0[7],P0[8],P0[9],     pw0[2]=PKW(P0,4), pw0[3]=PKW(P0,6), pw0); \
    VRD(1); SBAR(); GAPA(C0=__builtin_amdgcn_mfma_f32_32x32x16_bf16(kf[2],qr[1],C0,0,0,0),   P0[10],P0[11],P0[12],P0[13], pw1[0]=PKW(P0,8), pw1[1]=PKW(P0,10), pw1); \
    VRD(5); SBAR(); GAPA(C1=__builtin_amdgcn_mfma_f32_32x32x16_bf16(kf[3],qr[1],C1,0,0,0),   P0[14],P0[15],P1[0],P1[1],   pw1[2]=PKW(P0,12),pw1[3]=PKW(P0,14), pw1); \
    VRD(2); SBAR(); GAPA(C0=__builtin_amdgcn_mfma_f32_32x32x16_bf16(kf[4],qr[2],C0,0,0,0),   P1[2],P1[3],P1[4],P1[5],     pw2[0]=PKW(P1,0), pw2[1]=PKW(P1,2), pw2); \
    VRD(6); SBAR(); GAPA(C1=__builtin_amdgcn_mfma_f32_32x32x16_bf16(kf[5],qr[2],C1,0,0,0),   P1[6],P1[7],P1[8],P1[9],     pw2[2]=PKW(P1,4), pw2[3]=PKW(P1,6), pw2); \
    VRD(3); SBAR(); GAPA(C0=__builtin_amdgcn_mfma_f32_32x32x16_bf16(kf[6],qr[3],C0,0,0,0),   P1[10],P1[11],P1[12],P1[13], pw3[0]=PKW(P1,8), pw3[1]=PKW(P1,10), pw3); \
    VRD(7); SBAR(); GAPA(C1=__builtin_amdgcn_mfma_f32_32x32x16_bf16(kf[7],qr[3],C1,0,0,0),   P1[14],P1[15],0.f,0.f,       pw3[2]=PKW(P1,12),pw3[3]=PKW(P1,14), pw3); \
    l_reg+=sacc; \
    if(GK){DMA_K((t)+3,sl_cur);} if(GV){DMA_V((t)+1,sl_next);} \
    CMASK(C0,C1,t); \
    { float a=MX3(C0[0],C0[1],C1[0]),b=MX3(C0[2],C0[3],C1[1]); a=MX3(a,C1[2],C1[3]); \
      _Pragma("unroll") for(int r=4;r<16;r+=4){a=MX3(a,C0[r],C0[r+1]);b=MX3(b,C0[r+2],C0[r+3]);a=MX3(a,C1[r],C1[r+1]);b=MX3(b,C1[r+2],C1[r+3]);} \
      float rm=__builtin_fmaxf(a,b); { auto rr=__builtin_amdgcn_permlane32_swap(__float_as_uint(rm),__float_as_uint(rm),false,false); rm=__builtin_fmaxf(__uint_as_float(rr[0]),__uint_as_float(rr[1])); } \
      resc=false; \
      if(__builtin_expect(__any(rm>(float)THRL),0)){ const float dl=__builtin_fmaxf(rm,0.f); mhat+=dl; \
        _Pragma("unroll") for(int r=0;r<16;++r){C0[r]-=dl;C1[r]-=dl;} \
        _Pragma("unroll") for(int r=0;r<16;++r)negm[r]=-mhat; asm volatile("":"+v"(negm)); \
        const float f=__builtin_amdgcn_exp2f(-dl); l_reg*=f; if(hi==0)wsf[r32]=f; resc=true; } } \
    SBAR(); \
    GAPB(o[0]=__builtin_amdgcn_mfma_f32_32x32x16_bf16(PAF(0),VFR(0),o[0],0,0,0), C0,0); \
    GAPB(o[1]=__builtin_amdgcn_mfma_f32_32x32x16_bf16(PAF(0),VFR(4),o[1],0,0,0), C0,4); \
    KRD(GL,0); GAPB(o[0]=__builtin_amdgcn_mfma_f32_32x32x16_bf16(PAF(1),VFR(1),o[0],0,0,0), C0,8); \
    KRD(GL,1); GAPB(o[1]=__builtin_amdgcn_mfma_f32_32x32x16_bf16(PAF(1),VFR(5),o[1],0,0,0), C0,12); \
    KRD(GL,2); GAPB(o[0]=__builtin_amdgcn_mfma_f32_32x32x16_bf16(PAF(2),VFR(2),o[0],0,0,0), C1,0); \
    KRD(GL,3); GAPB(o[1]=__builtin_amdgcn_mfma_f32_32x32x16_bf16(PAF(2),VFR(6),o[1],0,0,0), C1,4); \
    GAPB(o[0]=__builtin_amdgcn_mfma_f32_32x32x16_bf16(PAF(3),VFR(3),o[0],0,0,0), C1,8); \
    GAPB(o[1]=__builtin_amdgcn_mfma_f32_32x32x16_bf16(PAF(3),VFR(7),o[1],0,0,0), C1,12); \
    }while(0)
  int t=1;
  #undef CMASK
  #define CMASK(P0,P1,t) do{}while(0)
  for(;t+5<NT;t+=2){
    STEP(pB0,pB1,pA0,pA1,t,true,true,true);     WAIT_BAR(2); RESC(); ROT();
    STEP(pA0,pA1,pB0,pB1,t+1,true,true,true);   WAIT_BAR(2); RESC(); ROT();
  }
  #undef CMASK
  #define CMASK(P0,P1,t) do{}while(0)
  #define ENDW(tt) do{ if((tt)+3<NT){WAIT_BAR(2);} else if((tt)+2<NT){WAIT_BAR(1);} else {WAIT_BAR(0);} }while(0)
  for(;t+1<NT;t+=2){
    STEP(pB0,pB1,pA0,pA1,t,(t+3<NT),(t+1<NT),(t+1<NT));       ENDW(t);   RESC(); ROT();
    STEP(pA0,pA1,pB0,pB1,t+1,(t+4<NT),(t+2<NT),(t+2<NT));     ENDW(t+1); RESC(); ROT();
  }
  STEP(pB0,pB1,pA0,pA1,NT-1,false,false,false); RESC();
  { float sacc=pB0[0]+pB0[1]; _Pragma("unroll") for(int r=2;r<16;++r)sacc+=pB0[r]; _Pragma("unroll") for(int r=0;r<16;++r)sacc+=pB1[r]; l_reg+=sacc;
    pw0=(u32x4){PKW(pB0,0),PKW(pB0,2),PKW(pB0,4),PKW(pB0,6)};pw1=(u32x4){PKW(pB0,8),PKW(pB0,10),PKW(pB0,12),PKW(pB0,14)};pw2=(u32x4){PKW(pB1,0),PKW(pB1,2),PKW(pB1,4),PKW(pB1,6)};pw3=(u32x4){PKW(pB1,8),PKW(pB1,10),PKW(pB1,12),PKW(pB1,14)};
    SBAR(); pv(o,vb0+sl_cur,PAF(0),PAF(1),PAF(2),PAF(3)); }
  #undef PKW
  #undef PAF
  #undef VFR
  #undef PIN
  #undef MX3
  #undef GAPA
  #undef GAPB
  #undef EX
  #undef VRD
  #undef KRD
  #undef STEP
  #undef ENDW
  {auto rr=__builtin_amdgcn_permlane32_swap(__float_as_uint(l_reg),__float_as_uint(l_reg),false,false);l_reg=__uint_as_float(rr[0])+__uint_as_float(rr[1]);}
  if(hi==0)wsf[32+r32]=l_reg;asm volatile("s_waitcnt lgkmcnt(0)":::"memory");
  float rli[16];
  #pragma unroll
  for(int r=0;r<16;++r)rli[r]=__builtin_amdgcn_rcpf(wsf[32+crow(r,hi)]);
  bf16*Ow=Ou+(long)(wid*QBLK)*QP; const bf16*Gw=Gu+(long)(wid*QBLK)*QP;
  { bf16*stg=(bf16*)(shm+LDS_OST)+wid*2048;
    #pragma unroll
    for(int r=0;r<16;++r){const int orow=crow(r,hi);
      #pragma unroll
      for(int d0=0;d0<2;++d0)stg[orow*64+d0*32+r32]=__float2bfloat16(o[d0][r]*rli[r]);}
    asm volatile("s_waitcnt lgkmcnt(0)":::"memory");
    #pragma unroll
    for(int i=0;i<4;++i){const int row=i*8+(lane>>3),ch=lane&7; const u32x4 v=*(const u32x4*)(stg+row*64+ch*8); const u32x4 gv=*(const u32x4*)(Gw+(long)row*QP+ch*8); u32x4 w;
      #pragma unroll
      for(int e=0;e<4;++e){const float a0=__uint_as_float(v[e]<<16)*__uint_as_float(gv[e]<<16),a1=__uint_as_float(v[e]&0xffff0000u)*__uint_as_float(gv[e]&0xffff0000u); w[e]=cvtpk_s(a0,a1);}
      *(u32x4*)(Ow+(long)row*QP+ch*8)=w;} }
  asm volatile("s_waitcnt lgkmcnt(0)\n\ts_barrier":::"memory");
  #undef DMA_K
  #undef DMA_V
  #undef CMASK
  #undef START
  #undef RESC
  #undef ROT
}
constexpr int ATTN_LDS_BYTES=LDS_BYTES;
#undef SBAR
#undef WAIT_BAR
}

#define GAS __attribute__((address_space(1)))
#define LAS __attribute__((address_space(3)))
typedef unsigned short bf16;
typedef unsigned v4u __attribute__((ext_vector_type(4)));
typedef float f32x4 __attribute__((ext_vector_type(4)));
typedef short bf16x8 __attribute__((ext_vector_type(8)));
typedef GAS unsigned gu32;
typedef GAS unsigned long long gu64;
#define RLX_AGENT __ATOMIC_RELAXED, __HIP_MEMORY_SCOPE_AGENT
#define LDS_WAIT() asm volatile("s_waitcnt lgkmcnt(0)" ::: "memory")
#define VM_WAIT() asm volatile("s_waitcnt vmcnt(0)" ::: "memory")
__device__ __forceinline__ unsigned long long rt() { return __builtin_amdgcn_s_memrealtime(); }
__device__ __forceinline__ unsigned f2bf(float f) { unsigned u = __builtin_bit_cast(unsigned, f); return (u + 0x7fffu + ((u >> 16) & 1u)) >> 16; }
__device__ __forceinline__ unsigned pk2(float lo, float hi) { return f2bf(lo) | (f2bf(hi) << 16); }

#define XB_TMO      128
#define XB_XCNT(j)  (256  + 64 * (j))
#define XB_XSUB(j)  (1280 + 64 * (j))
#define XB_XGEN(j)  (2304 + 64 * (j))
#define XB_TOP      3328
#define XB_TOPGEN   3392
#define XCD_BAR_WORDS 3456
#define XB_SPIN_CAP (1u << 18)

__device__ __forceinline__ unsigned xb_ld(unsigned* p)              { return __hip_atomic_load(p, __ATOMIC_RELAXED, __HIP_MEMORY_SCOPE_AGENT); }
__device__ __forceinline__ unsigned xb_add(unsigned* p, unsigned v) { return __hip_atomic_fetch_add(p, v, __ATOMIC_RELAXED, __HIP_MEMORY_SCOPE_AGENT); }
__device__ __forceinline__ unsigned xb_xcc_id() { return (unsigned)__builtin_amdgcn_s_getreg((3 << 11) | 20) & 0xFu; }
#define XB_SPIN(cond, bar) do { unsigned _sp = 0; while (cond) { __builtin_amdgcn_s_sleep(1); \
    if ((++_sp & 255u) == 0u) { if (xb_ld(&(bar)[XB_TMO])) break; if (_sp > XB_SPIN_CAP) { atomicAdd(&(bar)[XB_TMO], 1u); break; } } } } while (0)

struct XcdBarrier {
    unsigned* bar; unsigned x;
    volatile LAS unsigned* st;
};

__device__ __forceinline__ XcdBarrier xcd_barrier_post(unsigned* bar, volatile LAS unsigned* st, const int tid) {
    XcdBarrier b; b.bar = bar; b.x = xb_xcc_id(); b.st = st;
    if (tid == 0) (void)xb_add(&bar[XB_XCNT(b.x)], 1u);
    return b;
}
__device__ __forceinline__ void xcd_barrier_complete(unsigned* bar, unsigned x, unsigned& nloc, unsigned& nx) {
    const unsigned G = gridDim.x * gridDim.y * gridDim.z;
    unsigned sum, cnt, mine, sp = 0u;
    for (;;) {
        sum = 0u; cnt = 0u; mine = 0u;
#pragma unroll
        for (unsigned j = 0; j < 16; ++j) { const unsigned c = xb_ld(&bar[XB_XCNT(j)]); sum += c; cnt += (c > 0u) ? 1u : 0u; mine = (j == x) ? c : mine; }
        if (sum == G) break;
        __builtin_amdgcn_s_sleep(1);
        if ((++sp & 255u) == 0u) { if (xb_ld(&bar[XB_TMO])) break; if (sp > XB_SPIN_CAP) { atomicAdd(&bar[XB_TMO], 1u); break; } }
    }
    nloc = mine > 0u ? mine : 1u; nx = cnt > 0u ? cnt : 1u;
}

__device__ __forceinline__ void xcd_barrier(const XcdBarrier& b, const int tid) {
    asm volatile("s_waitcnt vmcnt(0)" ::: "memory");
    __syncthreads();
    if (tid == 0) {
        unsigned* bar = b.bar; asm volatile("" : "+s"(bar));
        __builtin_amdgcn_s_waitcnt(0);
        unsigned nloc = b.st[0], nx = b.st[1];
        if (nloc == 0u) { unsigned xx = b.x; asm volatile("" : "+s"(xx)); xcd_barrier_complete(bar, xx, nloc, nx); b.st[0] = nloc; b.st[1] = nx; }
        const unsigned old = xb_add(&bar[XB_XSUB(b.x)], 1u);
        const unsigned gen = old / nloc;
        if (old + 1u == (gen + 1u) * nloc) {
            __builtin_amdgcn_fence(__ATOMIC_RELEASE, "agent");
            asm volatile("s_waitcnt vmcnt(0)" ::: "memory");
            const unsigned og = xb_add(&bar[XB_TOP], 1u);
            const unsigned tg = og / nx;
            if (og + 1u == (tg + 1u) * nx) xb_add(&bar[XB_TOPGEN], 1u);
            else XB_SPIN(xb_ld(&bar[XB_TOPGEN]) == tg, bar);
            __builtin_amdgcn_fence(__ATOMIC_ACQUIRE, "agent");
            xb_add(&bar[XB_XGEN(b.x)], 1u);
            asm volatile("s_waitcnt vmcnt(0)" ::: "memory");
        } else {
            XB_SPIN(xb_ld(&bar[XB_XGEN(b.x)]) == gen, bar);
            __builtin_amdgcn_fence(__ATOMIC_ACQUIRE, "agent");
            asm volatile("s_waitcnt vmcnt(0)" ::: "memory");
        }
    }
    __syncthreads();
}


constexpr int NWAVES = 8, NTHR = 512, GRID = 256;
constexpr int T_TOK = 8192, T_CTX = 4096, DMOD = 1024, BW = 512, INW = 3328, NCAT = 6400, DEPTH = 4;
constexpr int S_LAT = 2048, LKV = 2304, KVW = 128;
constexpr float RMS_EPS = 1e-6f;
constexpr float QSCALE = 0.125f * 1.4426950408889634f;
constexpr size_t MiB = 1u << 20;
constexpr size_t WS_CTL = 0, CTL_ZERO_BYTES = MiB;
constexpr size_t WS_MODF = 1 * MiB;
constexpr size_t WS_ROPE = 1 * MiB + 768 * 1024;
constexpr size_t WS_A16 = 1 * MiB + 832 * 1024;
constexpr size_t WS_WCAT = 2 * MiB;
constexpr size_t WS_WGLU = 15 * MiB;
constexpr size_t WS_WFN = 16 * MiB;
constexpr size_t WS_WBR = 17 * MiB;
constexpr size_t WS_WOUT = 20 * MiB;
constexpr size_t WS_BTE = 22 * MiB;
constexpr size_t WS_BTY = 26 * MiB;
constexpr size_t WS_A2L = 34 * MiB;
constexpr size_t WS_GY = 42 * MiB;
constexpr size_t WS_A2C = 50 * MiB;
constexpr size_t WS_A1P = 50 * MiB + 512 * 1024;
constexpr size_t WS_XRES = 51 * MiB;
constexpr size_t WS_G = 83 * MiB;
constexpr size_t WS_H = 131 * MiB;
constexpr size_t WS_VTC = 147 * MiB;
constexpr size_t WS_VTL = 248 * MiB;
constexpr size_t WS_GA = 155 * MiB;
constexpr size_t WS_GF = 163 * MiB;
constexpr size_t WS_Q = 171 * MiB;
constexpr size_t WS_UF = 179 * MiB;
constexpr size_t WS_GC = 187 * MiB;
constexpr size_t WS_KC = 195 * MiB, WS_KL = 196 * MiB;
constexpr size_t WS_VC = WS_KC + 5 * MiB / 2, WS_VL = WS_KL + 5 * MiB / 2;
constexpr size_t WS_PB = 200 * MiB;
constexpr size_t WS_SC = 216 * MiB;
constexpr size_t WS_UH = 232 * MiB;
constexpr size_t WS_END = 256 * MiB;
constexpr int CW_BAR = 4096;
constexpr size_t OUT_K = 8388608, OUT_V = 10485760, OUT_S = 12582912, OUT_N = 13107200;
constexpr int RING_BYTES = 131072, LDSCTL_OFF = RING_BYTES, MISC_OFF = LDSCTL_OFF + 320, LDS_BYTES = 147456;

typedef float f32x2 __attribute__((ext_vector_type(2)));
typedef unsigned u32x2 __attribute__((ext_vector_type(2)));
__device__ __forceinline__ unsigned cvtpk(float lo, float hi) { typedef __bf16 bf16x2_t __attribute__((ext_vector_type(2))); f32x2 v = {lo, hi}; bf16x2_t b = __builtin_convertvector(v, bf16x2_t); return __builtin_bit_cast(unsigned, b); }
__device__ __forceinline__ void st_bf4(bf16* p, f32x4 v) { u32x2 w; w.x = cvtpk(v[0], v[1]); w.y = cvtpk(v[2], v[3]); *(u32x2*)p = w; }
__device__ __forceinline__ f32x4 ld_bf4(const bf16* p) { const u32x2 w = *(const u32x2*)p; f32x4 r; r[0] = __uint_as_float(w.x << 16); r[1] = __uint_as_float(w.x & 0xffff0000u); r[2] = __uint_as_float(w.y << 16); r[3] = __uint_as_float(w.y & 0xffff0000u); return r; }
__device__ __forceinline__ f32x4 bf4_to_f(u32x2 w) { f32x4 r; r[0] = __uint_as_float(w.x << 16); r[1] = __uint_as_float(w.x & 0xffff0000u); r[2] = __uint_as_float(w.y << 16); r[3] = __uint_as_float(w.y & 0xffff0000u); return r; }
__device__ __forceinline__ float bf2f(bf16 h) { return __uint_as_float((unsigned)h << 16); }
__device__ __forceinline__ float sigmoidf_(float x) { return __builtin_amdgcn_rcpf(1.0f + __expf(-x)); }
__device__ __forceinline__ f32x4 sigmoid4(f32x4 v) { f32x4 r; r[0] = sigmoidf_(v[0]); r[1] = sigmoidf_(v[1]); r[2] = sigmoidf_(v[2]); r[3] = sigmoidf_(v[3]); return r; }
__device__ __forceinline__ f32x4 silu4(f32x4 v) { return v * sigmoid4(v); }
__device__ __forceinline__ float gelu_tanh(float x) { const float y = 0.7978845608028654f * (x + 0.044715f * x * x * x); return x * sigmoidf_(2.0f * y); }
__device__ __forceinline__ float shx(float v, int mask, int lane) { return __int_as_float(__builtin_amdgcn_ds_bpermute((lane ^ mask) << 2, __float_as_int(v))); }
__device__ __forceinline__ float wave_sum(float v, int lane) {
#pragma unroll
    for (int o = 1; o < 64; o <<= 1) v += shx(v, o, lane);
    return v;
}

struct KArgs { const float* in[28]; float* out; unsigned char* ws; int ph_lo, ph_hi; };
enum { I_XP = 0, I_XS, I_CK, I_CV, I_ST, I_C, I_CCTX, I_NORMG, I_ADAW, I_ADAB, I_WIN, I_ARE, I_AIM, I_LDT, I_BRE, I_BIM, I_CRE, I_CIM, I_SD, I_GLU, I_FN, I_QG, I_KG, I_WBR, I_MW, I_MB, I_WOUT, I_FG };

struct Ctx {
    LAS unsigned char* lds; int tid, lane, wave, bid, vcu, gw, ngw;
    const float* const* in; float* out; unsigned char* ws;
    template <class Tp> __device__ __forceinline__ Tp* w(size_t off) const { return (Tp*)(ws + off); }
};

__device__ __forceinline__ int epi_opaque(int x) { asm volatile("" : "+v"(x)); return x; }
#define EPI_ROWS for (int ai = 0; ai < 2; ++ai) _Pragma("unroll") for (int m = 0; m < 4; ++m)
#define EPI_BJ for (int bj = 0; bj < 2; ++bj)
#define EPI_ROW epi_opaque(u.pm * 256 + ai * 128 + wr * 64 + m * 16 + fr)
#define EPI_C8 (bj * 128 + wc * 32 + fq * 8)
#define EPI_COL8 (u.pn * 256 + EPI_C8)
typedef const f32x4 (&AccRef)[2][2][4][2];
__device__ __forceinline__ void st_bf8(bf16* p, f32x4 lo, f32x4 hi) { v4u w; w.x = cvtpk(lo[0], lo[1]); w.y = cvtpk(lo[2], lo[3]); w.z = cvtpk(hi[0], hi[1]); w.w = cvtpk(hi[2], hi[3]); *(v4u*)p = w; }
__device__ __forceinline__ f32x4 bf8_lo(v4u w) { f32x4 r; r[0] = __uint_as_float(w.x << 16); r[1] = __uint_as_float(w.x & 0xffff0000u); r[2] = __uint_as_float(w.y << 16); r[3] = __uint_as_float(w.y & 0xffff0000u); return r; }
__device__ __forceinline__ f32x4 bf8_hi(v4u w) { f32x4 r; r[0] = __uint_as_float(w.z << 16); r[1] = __uint_as_float(w.z & 0xffff0000u); r[2] = __uint_as_float(w.w << 16); r[3] = __uint_as_float(w.w & 0xffff0000u); return r; }

struct EpiG1 {
    static constexpr bool PERM = true, AFTER_DRAIN = false;
    unsigned char* ws; float* out; const float *qg, *kg; int layer;
#define EG1_P(name, off) bf16* const name = (bf16*)(ws + (off))
    __device__ __forceinline__ void qkv(AccRef acc, const pg8::Unit& u, int wr, int wc, int fr, int fq) const {
        const int pn = u.pn; const bool isq = pn < 10;
        EG1_P(Q, WS_Q); EG1_P(Kc, WS_KC); EG1_P(Vc, WS_VC); EG1_P(Kl, WS_KL); EG1_P(Vl, WS_VL); float* const outK = out + OUT_K; float* const outV = out + OUT_V; const float* const rope = (const float*)(ws + WS_ROPE);
        const int kind = isq ? 0 : (wc < 2 ? 1 : 2);
        const int head = isq ? (pn - 8) * 4 + wc : (wc & 1);
        f32x4 gv[2][2];
        if (kind == 0) {
#pragma unroll
            EPI_BJ { gv[bj][0] = *(const f32x4*)(qg + layer * 64 + 32 * bj + 8 * fq); gv[bj][1] = *(const f32x4*)(qg + layer * 64 + 32 * bj + 8 * fq + 4); }
        } else {
#pragma unroll
            EPI_BJ { gv[bj][0] = *(const f32x4*)(kg + layer * 64 + 32 * bj + 8 * fq); gv[bj][1] = *(const f32x4*)(kg + layer * 64 + 32 * bj + 8 * fq + 4); }
        }
        const bool lat = u.pm >= 16;
#pragma unroll
        EPI_ROWS {
            const int row = EPI_ROW;
            f32x4 x[2][2];
#pragma unroll
            EPI_BJ { x[bj][0] = acc[ai][bj][m][0]; x[bj][1] = acc[ai][bj][m][1]; }
            if (kind != 2) {
                float ss = 0.f;
#pragma unroll
                EPI_BJ {
#pragma unroll
                    for (int n = 0; n < 2; ++n) { const f32x4 t = x[bj][n]; ss += (t[0] * t[0] + t[1] * t[1]) + (t[2] * t[2] + t[3] * t[3]); } }
                ss += shx(ss, 16, fq * 16 + fr); ss += shx(ss, 32, fq * 16 + fr);
                const float rstd = rsqrtf(ss * (1.0f / 64.0f) + RMS_EPS);
#pragma unroll
                EPI_BJ { x[bj][0] = x[bj][0] * rstd * gv[bj][0]; x[bj][1] = x[bj][1] * rstd * gv[bj][1]; }
            }
            int b, s;
            if (lat) { const int tl = row - T_CTX; b = tl >> 11; s = tl & 2047; } else { b = row >> 8; s = row & 255; }
            if (lat && kind != 2) {
                const int gr = s >> 6, gc = s & 63;
#pragma unroll
                EPI_BJ {
#pragma unroll
                    for (int n = 0; n < 2; ++n) { const int pos = bj ? gc : gr; const f32x4 cs = *(const f32x4*)(rope + (pos * 16 + 4 * fq + 2 * n) * 2); const f32x4 t = x[bj][n];
                        f32x4 r; r[0] = t[0] * cs[0] - t[1] * cs[1]; r[1] = t[0] * cs[1] + t[1] * cs[0]; r[2] = t[2] * cs[2] - t[3] * cs[3]; r[3] = t[2] * cs[3] + t[3] * cs[2]; x[bj][n] = r; } }
            }
#pragma unroll
            EPI_BJ { const int j = 32 * bj + 8 * fq;
                const size_t ol = ((size_t)b * LKV + s) * KVW + head * 64 + j, oc = (size_t)row * KVW + head * 64 + j, oo = (((size_t)b * DEPTH + layer) * 256 + s) * KVW + head * 64 + j;
                if (kind == 0) st_bf8(Q + (size_t)row * 512 + head * 64 + j, x[bj][0] * QSCALE, x[bj][1] * QSCALE);
                else if (kind == 1) { if (lat) st_bf8(Kl + ol, x[bj][0], x[bj][1]); else { st_bf8(Kc + oc, x[bj][0], x[bj][1]); *(f32x4*)(outK + oo) = x[bj][0]; *(f32x4*)(outK + oo + 4) = x[bj][1]; } }
                else { if (lat) st_bf8(Vl + ol, x[bj][0], x[bj][1]); else { st_bf8(Vc + oc, x[bj][0], x[bj][1]); *(f32x4*)(outV + oo) = x[bj][0]; *(f32x4*)(outV + oo + 4) = x[bj][1]; } } }
            asm volatile("" ::: "memory");
        }
    }
    __device__ __forceinline__ void operator()(AccRef acc, const pg8::Unit& u, int wr, int wc, int fr, int fq) const {
        const int pn = u.pn;
        if (pn >= 8 && pn <= 10) { qkv(acc, u, wr, wc, fr, fq); return; }
        EG1_P(UH, WS_UH); EG1_P(GA, WS_GA); EG1_P(UF, WS_UF); EG1_P(GF, WS_GF); EG1_P(GC, WS_GC);
#pragma unroll
        EPI_ROWS { const int row = EPI_ROW;
#pragma unroll
            EPI_BJ { const int col = EPI_COL8; const f32x4 lo = acc[ai][bj][m][0], hi = acc[ai][bj][m][1];
                if (pn < 2) { const int g = col >> 4, q = col & 15; st_bf8(UH + ((size_t)g * 512 + (row >> 4)) * 512 + (row & 15) * 16 + q, lo, hi); }
                else if (pn < 4) st_bf8(GA + (size_t)row * 512 + (col - 512), silu4(lo), silu4(hi));
                else if (pn < 6) st_bf8(UF + (size_t)row * 512 + (col - 1024), lo, hi);
                else if (pn < 8) st_bf8(GF + (size_t)row * 512 + (col - 1536), silu4(lo), silu4(hi));
                else st_bf8(GC + (size_t)row * 512 + (col - 2816), silu4(lo), silu4(hi));
            } }
    }
};
struct EpiMerge {
    static constexpr bool PERM = true, AFTER_DRAIN = false;
    bf16* Gm; const float* mb;
    __device__ __forceinline__ void operator()(AccRef acc, const pg8::Unit& u, int wr, int wc, int fr, int fq) const {
        f32x4 bb[2][2];
#pragma unroll
        EPI_BJ { bb[bj][0] = *(const f32x4*)(mb + EPI_COL8); bb[bj][1] = *(const f32x4*)(mb + EPI_COL8 + 4); }
#pragma unroll
        EPI_ROWS { const size_t row = EPI_ROW;
#pragma unroll
            EPI_BJ st_bf8(Gm + row * 3072 + EPI_COL8, sigmoid4(acc[ai][bj][m][0] + bb[bj][0]), sigmoid4(acc[ai][bj][m][1] + bb[bj][1])); }
    }
};
struct EpiS5A {
    static constexpr bool PERM = true, AFTER_DRAIN = false;
    float* SC;
    __device__ __forceinline__ void operator()(AccRef acc, const pg8::Unit& u, int wr, int wc, int fr, int fq) const {
#pragma unroll
        EPI_ROWS { const int chunk = EPI_ROW;
#pragma unroll
            EPI_BJ { float* p = SC + ((size_t)u.z * 512 + chunk) * 256 + EPI_C8; *(f32x4*)p = acc[ai][bj][m][0]; *(f32x4*)(p + 4) = acc[ai][bj][m][1]; } }
    }
};
__device__ __forceinline__ f32x4 gelu4(f32x4 y) { y[0] = gelu_tanh(y[0]); y[1] = gelu_tanh(y[1]); y[2] = gelu_tanh(y[2]); y[3] = gelu_tanh(y[3]); return y; }
struct EpiS5B {
    static constexpr bool PERM = true, AFTER_DRAIN = false;
    bf16* GY;
    __device__ __forceinline__ void operator()(AccRef acc, const pg8::Unit& u, int wr, int wc, int fr, int fq) const {
#pragma unroll
        EPI_ROWS { const int chunk = EPI_ROW;
#pragma unroll
            EPI_BJ { const int col = EPI_C8, t = col >> 4, p = col & 15; st_bf8(GY + ((size_t)chunk * 16 + t) * 512 + u.z * 16 + p, gelu4(acc[ai][bj][m][0]), gelu4(acc[ai][bj][m][1])); } }
    }
};
struct EpiDFT1C {
    static constexpr bool PERM = true, AFTER_DRAIN = false;
    bf16* VtC;
    __device__ __forceinline__ void operator()(AccRef acc, const pg8::Unit& u, int wr, int wc, int fr, int fq) const {
        const int grp = 2 * u.z + u.pm;
#pragma unroll
        EPI_ROWS { const int j = epi_opaque(wr * 64 + m * 16 + fr), reim = ai;
#pragma unroll
            EPI_BJ { const int tok = EPI_COL8, b = tok >> 8, s = tok & 255; st_bf8(VtC + ((size_t)b * 512 + grp * 128 + j) * 512 + reim * 256 + s, acc[ai][bj][m][0], acc[ai][bj][m][1]); } }
    }
};
struct EpiDFT1L {
    static constexpr bool PERM = true, AFTER_DRAIN = false;
    bf16* VtL;
    __device__ __forceinline__ void operator()(AccRef acc, const pg8::Unit& u, int wr, int wc, int fr, int fq) const {
        const int grp = 2 * u.z + u.pm, b = u.pn >> 4, nn = u.pn & 15;
#pragma unroll
        EPI_ROWS { const int j = epi_opaque(wr * 64 + m * 16 + fr), reim = ai; bf16* dst = VtL + ((size_t)b * 512 + grp * 128 + j) * 2048 + reim * 1024 + nn * 128 + wc * 32 + fq * 8;
            st_bf8(dst, acc[ai][0][m][0] + acc[ai][1][m][0], acc[ai][0][m][1] + acc[ai][1][m][1]);
            st_bf8(dst + (size_t)1024 * 2048, acc[ai][0][m][0] - acc[ai][1][m][0], acc[ai][0][m][1] - acc[ai][1][m][1]); }
    }
};
struct EpiDFT2 {
    static constexpr bool PERM = true, AFTER_DRAIN = false;
    bf16* ZF; int lat, half;
    __device__ __forceinline__ void operator()(AccRef acc, const pg8::Unit& u, int wr, int wc, int fr, int fq) const {
#pragma unroll
        EPI_ROWS { const int k = EPI_ROW;
#pragma unroll
            EPI_BJ { const int col = EPI_COL8, b = col >> 9, ch = col & 511;
                bf16* dst = lat ? ZF + ((size_t)b * 2048 + 2 * k + u.z) * 1024 + half * 512 + ch : ZF + ((size_t)b * 256 + k) * 512 + ch;
                st_bf8(dst, acc[ai][bj][m][0], acc[ai][bj][m][1]); } }
    }
};
#define EPI_BATCH for (int ai = 0; ai < 2; ++ai)
#define EPI_M for (int m = 0; m < 4; ++m)
struct EpiGLU {
    static constexpr bool PERM = true, AFTER_DRAIN = false;
    bf16* GA;
    __device__ __forceinline__ void operator()(AccRef acc, const pg8::Unit& u, int wr, int wc, int fr, int fq) const {
#pragma unroll
        EPI_BATCH { v4u gl[4];
#pragma unroll
            EPI_M { const size_t row = EPI_ROW; gl[m] = *(const v4u*)(GA + row * 512 + u.pn * 128 + wc * 32 + fq * 8); }
            asm volatile("" ::: "memory");
#pragma unroll
            EPI_M { const size_t row = EPI_ROW;
                st_bf8(GA + row * 512 + u.pn * 128 + wc * 32 + fq * 8, acc[ai][0][m][0] * sigmoid4(acc[ai][1][m][0]) * bf8_lo(gl[m]), acc[ai][0][m][1] * sigmoid4(acc[ai][1][m][1]) * bf8_hi(gl[m])); }
            asm volatile("" ::: "memory"); }
    }
};
struct EpiMul {
    static constexpr bool PERM = true, AFTER_DRAIN = false;
    bf16* GF;
    __device__ __forceinline__ void operator()(AccRef acc, const pg8::Unit& u, int wr, int wc, int fr, int fq) const {
#pragma unroll
        EPI_BATCH { v4u gl[4][2];
#pragma unroll
            EPI_M { const size_t row = EPI_ROW;
#pragma unroll
                EPI_BJ gl[m][bj] = *(const v4u*)(GF + row * 512 + EPI_COL8); }
            asm volatile("" ::: "memory");
#pragma unroll
            EPI_M { const size_t row = EPI_ROW;
#pragma unroll
                EPI_BJ st_bf8(GF + row * 512 + EPI_COL8, acc[ai][bj][m][0] * bf8_lo(gl[m][bj]), acc[ai][bj][m][1] * bf8_hi(gl[m][bj])); }
            asm volatile("" ::: "memory"); }
    }
};
struct EpiG4 {
    static constexpr bool PERM = true, AFTER_DRAIN = false;
    const bf16* Gm; bf16* PB; bf16* MG; int mode0;
    __device__ __forceinline__ void operator()(AccRef acc, const pg8::Unit& u, int wr, int wc, int fr, int fq) const {
        const int mode = mode0 + u.z, gsel = mode == 0 ? 2 : mode - 1;
#pragma unroll
        EPI_BATCH { v4u gl[4][2], pl[4][2];
#pragma unroll
            EPI_M { const size_t row = EPI_ROW;
#pragma unroll
                EPI_BJ { gl[m][bj] = *(const v4u*)(Gm + row * 3072 + gsel * 1024 + EPI_COL8); if (mode > 0) pl[m][bj] = *(const v4u*)(PB + row * 1024 + EPI_COL8); } }
            asm volatile("" ::: "memory");
#pragma unroll
            EPI_M { const size_t row = EPI_ROW;
#pragma unroll
                EPI_BJ { f32x4 lo = acc[ai][bj][m][0] * bf8_lo(gl[m][bj]), hi = acc[ai][bj][m][1] * bf8_hi(gl[m][bj]); if (mode > 0) { lo += bf8_lo(pl[m][bj]); hi += bf8_hi(pl[m][bj]); }
                    if (mode < 2) st_bf8(PB + row * 1024 + EPI_COL8, lo, hi); else st_bf8(MG + row * 1024 + EPI_COL8, lo, hi); } }
            asm volatile("" ::: "memory"); }
    }
};
struct EpiChainA {
    const bf16* Gm; const bf16* PB;
    __device__ __forceinline__ void operator()(f32x4 (&acc)[2][2][4][2], const pg8::Unit& u, int wr, int wc, int fr, int fq) const {
#pragma unroll
        for (int ai = 0; ai < 2; ++ai)
#pragma unroll
            for (int mh = 0; mh < 2; ++mh) { v4u g0[2][2], g1[2][2], pl[2][2];
#pragma unroll
                for (int mm = 0; mm < 2; ++mm) { const int m = 2 * mh + mm; const size_t row = EPI_ROW;
#pragma unroll
                    EPI_BJ { g0[mm][bj] = *(const v4u*)(Gm + row * 3072 + EPI_COL8); g1[mm][bj] = *(const v4u*)(Gm + row * 3072 + 1024 + EPI_COL8); pl[mm][bj] = *(const v4u*)(PB + row * 1024 + EPI_COL8); } }
                asm volatile("" ::: "memory");
#pragma unroll
                for (int mm = 0; mm < 2; ++mm) { const int m = 2 * mh + mm;
#pragma unroll
                    EPI_BJ { f32x4 lo = acc[ai][bj][m][0] * bf8_lo(g0[mm][bj]) + bf8_lo(pl[mm][bj]), hi = acc[ai][bj][m][1] * bf8_hi(g0[mm][bj]) + bf8_hi(pl[mm][bj]);
                        const f32x4 gl = bf8_lo(g1[mm][bj]), gh = bf8_hi(g1[mm][bj]);
#pragma unroll
                        for (int e = 0; e < 4; ++e) { lo[e] *= __builtin_amdgcn_rcpf(fmaxf(gl[e], 1e-6f)); hi[e] *= __builtin_amdgcn_rcpf(fmaxf(gh[e], 1e-6f)); }
                        acc[ai][bj][m][0] = lo; acc[ai][bj][m][1] = hi; } }
                asm volatile("" ::: "memory"); }
    }
};
struct EpiChainF {
    const bf16* Gm; bf16* MG;
    __device__ __forceinline__ void operator()(AccRef acc, const pg8::Unit& u, int wr, int wc, int fr, int fq) const {
#pragma unroll
        EPI_BATCH { v4u g1[4][2];
#pragma unroll
            EPI_M { const size_t row = EPI_ROW;
#pragma unroll
                EPI_BJ g1[m][bj] = *(const v4u*)(Gm + row * 3072 + 1024 + EPI_COL8); }
            asm volatile("" ::: "memory");
#pragma unroll
            EPI_M { const size_t row = EPI_ROW;
#pragma unroll
                EPI_BJ { const f32x4 gl = bf8_lo(g1[m][bj]), gh = bf8_hi(g1[m][bj]); f32x4 lo = acc[ai][bj][m][0], hi = acc[ai][bj][m][1];
#pragma unroll
                    for (int e = 0; e < 4; ++e) { lo[e] *= fmaxf(gl[e], 1e-6f); hi[e] *= fmaxf(gh[e], 1e-6f); }
                    st_bf8(MG + row * 1024 + EPI_COL8, lo, hi); } }
            asm volatile("" ::: "memory"); }
    }
};
struct EpiG5 {
    static constexpr bool PERM = true, AFTER_DRAIN = false;
    bf16 *T0, *T1;
    __device__ __forceinline__ void operator()(AccRef acc, const pg8::Unit& u, int wr, int wc, int fr, int fq) const {
        bf16* T = u.z ? T1 : T0;
#pragma unroll
        EPI_ROWS { const size_t row = EPI_ROW;
#pragma unroll
            EPI_BJ st_bf8(T + row * 1024 + EPI_COL8, acc[ai][bj][m][0], acc[ai][bj][m][1]); }
    }
};

enum { K_G1 = 0, K_MERGE, K_S5A, K_S5B, K_DFT1C, K_DFT1L, K_DFT2C, K_DFT2L0, K_DFT2L1, K_GLU, K_FN, K_PC, K_PA, K_PF, K_G5 };
__device__ __forceinline__ int xswz(int L, int n) { return (L & 7) * (n >> 3) + (L >> 3); }
#define PS_W(off) ((const bf16*)(ws + (off)))
struct PhaseSched {
    int sub, c, bid; unsigned char* ws;
    __device__ __forceinline__ void mk(pg8::UDesc& d, const bf16* A, const bf16* Bt, int lda, int ldb, int K, int hB, int kind, int pm, int pn, int z) const {
        d.A = A; d.Bt = Bt; d.lda = lda; d.ldb = ldb; d.K = K; d.hB = hB; d.kind = kind; d.pm = pm; d.pn = pn; d.z = z; d.keep = (kind == K_PF); }
    __device__ __forceinline__ void mk_merge(pg8::UDesc& d, int M, unsigned char* ws) const {
        int pm, pn; if (M < 128) { pm = M >> 2; pn = 8 + (M & 3); } else { pm = (M - 128) >> 3; pn = (M - 128) & 7; }
        mk(d, PS_W(WS_H) + (size_t)pm * 256 * 1024, PS_W(WS_WCAT) + (size_t)(INW + pn * 256) * 1024, 1024, 1024, 1024, 128, K_MERGE, pm, pn, 0); }
    __device__ __forceinline__ bool next(int i, pg8::UDesc& d) const {
        unsigned char* ws = this->ws; asm volatile("" : "+s"(ws));
        if (sub == 1) {
            if (i > 1) return false;
            pg8::StaticOrder so; so.init(T_TOK, INW, GRID, bid); pg8::Unit u;
            if (so.next(i, u)) { mk(d, PS_W(WS_H) + (size_t)u.pm * 256 * 1024, PS_W(WS_WCAT) + (size_t)u.pn * 256 * 1024, 1024, 1024, 1024, 128, K_G1, u.pm, u.pn, 0); return true; }
            if (bid >= 160) { mk_merge(d, xswz(bid - 160, 96), ws); return true; }
            return false;
        }
        if (sub == 2) {
            if (c < 128) return false;
            if (c < 192) { const int L = xswz(c - 128, 64);
                if (i == 0) { const int g = L >> 1, pm = L & 1; mk(d, PS_W(WS_UH) + ((size_t)g * 512 + pm * 256) * 512, PS_W(WS_BTE) + (size_t)g * 256 * 256, 512, 256, 256, 128, K_S5A, pm, 0, g); return true; }
                if (i == 1) { const int pair = L >> 5, gl = (L >> 4) & 1, pn = L & 15; mk(d, PS_W(WS_A1P) + (size_t)gl * 256 * 256, PS_W(WS_UF) + (size_t)pn * 256 * 512 + pair * 256, 256, 512, 256, 128, K_DFT1C, gl, pn, pair); return true; }
                if (i == 2) { mk_merge(d, 96 + xswz(c - 128, 128), ws); return true; }
                return false; }
            const int L = xswz(c - 192, 64);
            if (i == 0) { const int pair = L >> 5, gl = (L >> 4) & 1, r = L & 15, pn2 = (r >> 3) * 16 + (r & 7);
                mk(d, PS_W(WS_A1P) + (size_t)gl * 256 * 256, PS_W(WS_UF) + ((size_t)T_CTX + pn2 * 128) * 512 + pair * 256, 256, 512, 256, 1024, K_DFT1L, gl, pn2, pair); return true; }
            if (i == 1) { mk_merge(d, 96 + xswz(c - 128, 128), ws); return true; }
            return false;
        }
        if (sub == 3) {
            if (c < 64) { if (i > 0) return false; const int half = c >> 5, L = xswz(c & 31, 32), z = L >> 4, pm = (L >> 2) & 3, pn = L & 3;
                mk(d, PS_W(WS_A2L) + ((size_t)z * 1024 + pm * 256) * 2048 + half * 1024, PS_W(WS_VTL) + ((size_t)z * 1024 + pn * 256) * 2048 + half * 1024, 2048, 2048, 1024, 128, half ? K_DFT2L1 : K_DFT2L0, pm, pn, z); return true; }
            if (c < 128) { if (i > 0) return false; const int L = xswz(c - 64, 64), g = L >> 1, pm = L & 1;
                mk(d, PS_W(WS_UH) + ((size_t)g * 512 + pm * 256) * 512, PS_W(WS_BTY) + (size_t)g * 256 * 512, 512, 512, 512, 128, K_S5B, pm, 0, g); return true; }
            if (i == 0) { const int L = xswz(c - 128, 128), pm = L >> 2, pn = L & 3; mk(d, PS_W(WS_Q) + (size_t)pm * 256 * 512, PS_W(WS_WBR) + ((size_t)2 * 1024 + pn * 256) * 512, 512, 512, 512, 128, K_PC, pm, pn, 0); return true; }
            if (i == 1) { if (c < 160) { const int pn = xswz(c - 128, 32); mk(d, PS_W(WS_A2C), PS_W(WS_VTC) + (size_t)pn * 256 * 512, 512, 512, 512, 128, K_DFT2C, 0, pn, 0); return true; }
                mk_merge(d, 224 + xswz(c - 160, 96), ws); return true; }
            return false;
        }
        if (sub == 4) {
            if (i > 0) return false;
            if (c < 128) { const int L = xswz(c, 128), pm = L >> 2, pn = L & 3; mk(d, PS_W(WS_GY) + (size_t)pm * 256 * 512, PS_W(WS_WGLU) + (size_t)pn * 256 * 512, 512, 512, 512, 128, K_GLU, pm, pn, 0); return true; }
            if (c < 160) { const int L = xswz(c - 128, 32), pm = L >> 1, pn = L & 1; mk(d, PS_W(WS_UF) + (size_t)pm * 256 * 512, PS_W(WS_WFN) + (size_t)pn * 256 * 1024, 512, 1024, 512, 128, K_FN, pm, pn, 0); return true; }
            if (c < 192) { const int L = xswz(c - 160, 32), pm = L >> 1, pn = L & 1; mk(d, PS_W(WS_GC) + (size_t)pm * 256 * 1024, PS_W(WS_WFN) + (size_t)pn * 256 * 1024, 1024, 1024, 1024, 128, K_FN, 16 + pm, pn, 0); return true; }
            mk_merge(d, 320 + xswz(c - 192, 64), ws); return true;
        }
        if (sub == 5) {
            if (c >= 128 || i > 1) return false;
            const int t = (c & 7) * 16 + (c >> 3), pm = t >> 2, pn = t & 3;
            if (i == 0) mk(d, PS_W(WS_GA) + (size_t)pm * 256 * 512, PS_W(WS_WBR) + (size_t)pn * 256 * 512, 512, 512, 512, 128, K_PA, pm, pn, 0);
            else mk(d, PS_W(WS_GF) + (size_t)pm * 256 * 512, PS_W(WS_WBR) + ((size_t)1024 + pn * 256) * 512, 512, 512, 512, 128, K_PF, pm, pn, 0);
            return true;
        }
        if (i > 0) return false;
        { const int L = xswz(c, 256), z = L & 1, pm = L >> 3, pn = (L >> 1) & 3; mk(d, PS_W(WS_H) + (size_t)pm * 256 * 1024 + z * 512, PS_W(WS_WOUT) + (size_t)pn * 256 * 1024 + z * 512, 1024, 1024, 512, 128, K_G5, pm, pn, z); return true; }
    }
};
struct EpiAll {
    unsigned char* ws; float* out; const float* const* in; int layer;
    __device__ __forceinline__ bool transform(f32x4 (&acc)[2][2][4][2], const pg8::UDesc& d, int wr, int wc, int fr, int fq) const {
        if (d.kind != K_PA) return false;
        asm volatile("" : "+v"(fr), "+v"(fq), "+s"(wr), "+s"(wc));
        unsigned char* ws = this->ws; asm volatile("" : "+s"(ws));
        EpiChainA{(const bf16*)(ws + WS_G), (const bf16*)(ws + WS_PB)}(acc, pg8::Unit{d.pm, d.pn, d.z}, wr, wc, fr, fq); return true; }
    __device__ __forceinline__ void operator()(AccRef acc, const pg8::UDesc& d, int wr, int wc, int fr, int fq) const {
        asm volatile("" : "+v"(fr), "+v"(fq), "+s"(wr), "+s"(wc));
        const pg8::Unit u{d.pm, d.pn, d.z}; const int kind = d.kind;
        unsigned char* ws = this->ws; float* out = this->out; asm volatile("" : "+s"(ws), "+s"(out));
#define EA_P(off) ((bf16*)(ws + (off)))
        if (kind == K_G1) EpiG1{ws, out, in[I_QG], in[I_KG], layer}(acc, u, wr, wc, fr, fq);
        else if (kind == K_MERGE) EpiMerge{EA_P(WS_G), in[I_MB] + (size_t)layer * 3072}(acc, u, wr, wc, fr, fq);
        else if (kind == K_S5A) EpiS5A{(float*)(ws + WS_SC)}(acc, u, wr, wc, fr, fq);
        else if (kind == K_S5B) EpiS5B{EA_P(WS_GY)}(acc, u, wr, wc, fr, fq);
        else if (kind == K_DFT1C) EpiDFT1C{EA_P(WS_VTC)}(acc, u, wr, wc, fr, fq);
        else if (kind == K_DFT1L) EpiDFT1L{EA_P(WS_VTL)}(acc, u, wr, wc, fr, fq);
        else if (kind == K_DFT2C) EpiDFT2{EA_P(WS_UF), 0, 0}(acc, u, wr, wc, fr, fq);
        else if (kind == K_DFT2L0) EpiDFT2{EA_P(WS_GC), 1, 0}(acc, u, wr, wc, fr, fq);
        else if (kind == K_DFT2L1) EpiDFT2{EA_P(WS_GC), 1, 1}(acc, u, wr, wc, fr, fq);
        else if (kind == K_GLU) EpiGLU{EA_P(WS_GA)}(acc, u, wr, wc, fr, fq);
        else if (kind == K_FN) EpiMul{EA_P(WS_GF)}(acc, u, wr, wc, fr, fq);
        else if (kind == K_PC) EpiG4{EA_P(WS_G), EA_P(WS_PB), EA_P(WS_H), 0}(acc, u, wr, wc, fr, fq);
        else if (kind == K_PF) EpiChainF{EA_P(WS_G), EA_P(WS_H)}(acc, u, wr, wc, fr, fq);
        else EpiG5{EA_P(WS_PB), EA_P(WS_GA)}(acc, u, wr, wc, fr, fq);
#undef EA_P
    }
};

template <class RowMap>
__device__ __forceinline__ void transpose_item(const float* W, int K, int N, bf16* WT, const RowMap& rm, LAS float* scr, int item, int lane, int pitch = 0, int dup = 0) {
    if (pitch == 0) pitch = K;
    const int nblk = N / 32, kb = item / nblk, nb = item % nblk, k0 = 64 * kb, n0 = 32 * nb;
    { f32x4 w[8];
#pragma unroll
      for (int i = 0; i < 8; ++i) w[i] = *(const f32x4*)(W + (size_t)(k0 + 8 * i + (lane >> 3)) * N + n0 + 4 * (lane & 7));
#pragma unroll
      for (int i = 0; i < 8; ++i) { LAS float* d = scr + (8 * i + (lane >> 3)) * 33 + 4 * (lane & 7); d[0] = w[i][0]; d[1] = w[i][1]; d[2] = w[i][2]; d[3] = w[i][3]; } }
    LDS_WAIT(); asm volatile("" ::: "memory");
    const int c = lane & 7;
#pragma unroll
    for (int j = 0; j < 4; ++j) { const int n = (lane >> 3) + 8 * j; const LAS float* s = scr + (8 * c) * 33 + n;
        v4u o; o.x = cvtpk(s[0 * 33], s[1 * 33]); o.y = cvtpk(s[2 * 33], s[3 * 33]); o.z = cvtpk(s[4 * 33], s[5 * 33]); o.w = cvtpk(s[6 * 33], s[7 * 33]);
        bf16* dp = WT + (size_t)rm(n0 + n) * pitch + k0 + 8 * c; *(v4u*)dp = o; if (dup) *(v4u*)(dp + dup) = o; }
    LDS_WAIT(); asm volatile("" ::: "memory");
}
struct RmId { int off; __device__ __forceinline__ int operator()(int n) const { return off + n; } };
struct RmWin { __device__ __forceinline__ int operator()(int n) const {
        if (n < 2048 || n >= 2816) return n; const int t = (n - 2048) >> 8, cl = (n - 2048) & 255, hh = cl >> 6, jl = cl & 63; return 2048 + t * 256 + 128 * (jl >> 5) + 32 * hh + (jl & 31); } };
struct RmGlu { __device__ __forceinline__ int operator()(int c) const { const int half = c >> 9, cc = c & 511; return 256 * (cc >> 7) + 128 * half + (cc & 127); } };

__device__ __forceinline__ void ph_prologue(const Ctx& C) {
    LAS float* sil = (LAS float*)C.lds;
    LAS float* red = sil + 3072;
    for (int item = C.bid; item < 192; item += GRID) {
        const int l = item / 48, ch = item % 48;
        for (int i = C.tid; i < 3072; i += NTHR) { const float x = i < 1024 ? C.in[I_CCTX][i] : C.in[I_C][i - 1024]; sil[i] = x * sigmoidf_(x); }
        __syncthreads();
        const float* W = C.in[I_ADAW] + (size_t)l * 1024 * 3072 + ch * 64 + C.lane;
        float a0 = 0.f, a1 = 0.f, a2 = 0.f;
        for (int i0 = 0; i0 < 128; i0 += 32) { float w[32];
#pragma unroll
            for (int i = 0; i < 32; ++i) w[i] = W[(size_t)(C.wave * 128 + i0 + i) * 3072];
#pragma unroll
            for (int i = 0; i < 32; ++i) { const int k = C.wave * 128 + i0 + i; a0 += w[i] * sil[k]; a1 += w[i] * sil[1024 + k]; a2 += w[i] * sil[2048 + k]; } }
        red[(C.wave * 3 + 0) * 64 + C.lane] = a0; red[(C.wave * 3 + 1) * 64 + C.lane] = a1; red[(C.wave * 3 + 2) * 64 + C.lane] = a2;
        __syncthreads();
        if (C.tid < 192) { const int ci = C.tid >> 6, col = ch * 64 + (C.tid & 63); float s = C.in[I_ADAB][(size_t)l * 3072 + col];
#pragma unroll
            for (int w = 0; w < 8; ++w) s += red[(w * 3 + ci) * 64 + (C.tid & 63)];
            if (col >= 1024 && col < 2048) s = (1.0f + s) * C.in[I_NORMG][l * 1024 + col - 1024];
            C.w<float>(WS_MODF)[((size_t)l * 3 + ci) * 3072 + col] = s; }
        __syncthreads();
    }
    const int gt = C.bid * NTHR + C.tid, ngt = GRID * NTHR;
    constexpr int T_A2L = 2048 * 2048 / 8, T_A2C = 256 * 512 / 8, T_A1P = 512 * 256 / 8;
    for (int t = gt; t < T_A2L + T_A2C + T_A1P; t += ngt) {
        float v[8]; bf16* dst;
        if (t < T_A2L) { const int r = t >> 8, c0 = (t & 255) * 8, kk = 2 * (r & 1023) + (r >> 10); dst = C.w<bf16>(WS_A2L) + (size_t)r * 2048 + c0;
#pragma unroll
            for (int e = 0; e < 8; ++e) { const int col = c0 + e, s = col & 1023, mm = (kk * s) & 2047; float sn, cs; sincospif((float)mm * (1.0f / 1024.0f), &sn, &cs); v[e] = (col < 1024 ? cs : sn) * 0.02209708691207961f; } }
        else if (t < T_A2L + T_A2C) { const int tt = t - T_A2L, k = tt >> 6, c0 = (tt & 63) * 8; dst = C.w<bf16>(WS_A2C) + (size_t)k * 512 + c0;
#pragma unroll
            for (int e = 0; e < 8; ++e) { const int col = c0 + e, s = col & 255, mm = (k * s) & 255; float sn, cs; sincospif((float)mm * (1.0f / 128.0f), &sn, &cs); v[e] = (col < 256 ? cs : sn) * 0.0625f; } }
        else { const int tt = t - T_A2L - T_A2C, r = tt >> 5, c0 = (tt & 31) * 8; dst = C.w<bf16>(WS_A1P) + (size_t)r * 256 + c0; const int gl = r >> 8, reim = (r >> 7) & 1, j = r & 127;
#pragma unroll
            for (int e = 0; e < 8; ++e) { const int col = c0 + e, glc = col >> 7, c = col & 127, mm = (j * c) & 127; float sn, cs; sincospif((float)mm * (1.0f / 64.0f), &sn, &cs);
                v[e] = (glc == gl) ? (reim ? -sn : cs) * 0.08838834764831845f : 0.f; } }
        v4u o; o.x = cvtpk(v[0], v[1]); o.y = cvtpk(v[2], v[3]); o.z = cvtpk(v[4], v[5]); o.w = cvtpk(v[6], v[7]); *(v4u*)dst = o;
    }
    if (gt < 1024) { const int pos = gt >> 4, f = gt & 15; const float inv = powf(10000.0f, -(float)f / 16.0f), ang = (float)pos * inv;
        C.w<float>(WS_ROPE)[gt * 2] = cosf(ang); C.w<float>(WS_ROPE)[gt * 2 + 1] = sinf(ang); }
}

__device__ __forceinline__ void s5_mats_block(const Ctx& C, int l, int g, int part) {
    LAS f32x2* pw = (LAS f32x2*)C.lds;
    LAS f32x2* Bb = pw + 2 * 17 * 64;
    LAS f32x2* Cm = Bb + 2 * 64 * 16;
    LAS float* Kl = (LAS float*)(Cm + 2 * 16 * 64);
    const int tid = C.tid;
    if (tid < 128) {
        const int d = tid >> 6, n = tid & 63; const size_t gi = ((size_t)(l * 2 + d) * 32 + g);
        const float lr = C.in[I_ARE][gi * 64 + n], li = C.in[I_AIM][gi * 64 + n], dt = expf(C.in[I_LDT][gi]);
        float mag = expf(dt * lr), sn, cs; sincosf(dt * li, &sn, &cs);
        { const float are = mag * cs, aim = mag * sn; float pr = 1.0f, pi = 0.0f;
          for (int tau = 0; tau <= 16; ++tau) { pw[(d * 17 + tau) * 64 + n] = (f32x2){pr, pi}; const float nr = pr * are - pi * aim, ni = pr * aim + pi * are; pr = nr; pi = ni; } }
        const float x = mag * cs - 1.0f, y = mag * sn, den = 1.0f / (lr * lr + li * li), cr = (x * lr + y * li) * den, cim = (y * lr - x * li) * den;
        const float* br = C.in[I_BRE] + (gi * 64 + n) * 16; const float* bi = C.in[I_BIM] + (gi * 64 + n) * 16;
#pragma unroll
        for (int q = 0; q < 16; ++q) Bb[(d * 64 + n) * 16 + q] = (f32x2){cr * br[q] - cim * bi[q], cr * bi[q] + cim * br[q]};
        if (part == 0) { const f32x2 p16 = pw[(d * 17 + 16) * 64 + n]; C.w<float>(WS_A16)[(gi * 64 + n) * 2] = p16.x; C.w<float>(WS_A16)[(gi * 64 + n) * 2 + 1] = p16.y; }
    }
    for (int idx = tid; idx < 2048; idx += NTHR) { const int d = idx >> 10, p = (idx >> 6) & 15, n = idx & 63; const size_t o = (((size_t)(l * 2 + d) * 32 + g) * 16 + p) * 64 + n;
        Cm[idx] = (f32x2){C.in[I_CRE][o], C.in[I_CIM][o]}; }
    __syncthreads();
    {
        const int d = tid >> 8, p = (tid >> 4) & 15, q = tid & 15; float a0 = 0.f, a1 = 0.f;
        for (int n = 0; n < 64; ++n) { const f32x2 c = Cm[(d * 16 + p) * 64 + n], bq = Bb[(d * 64 + n) * 16 + q]; const float wr = c.x * bq.x - c.y * bq.y, wi = c.x * bq.y + c.y * bq.x;
            const f32x2 p0 = pw[(d * 17 + 2 * part) * 64 + n], p1 = pw[(d * 17 + 2 * part + 1) * 64 + n]; a0 += wr * p0.x - wi * p0.y; a1 += wr * p1.x - wi * p1.y; }
        Kl[(d * 2 + 0) * 256 + p * 16 + q] = a0; Kl[(d * 2 + 1) * 256 + p * 16 + q] = a1;
    }
    __syncthreads();
    bf16* BtE = C.w<bf16>(WS_BTE) + (size_t)g * 256 * 256; bf16* BtY = C.w<bf16>(WS_BTY) + (size_t)g * 256 * 512;
    const float* dsk = C.in[I_SD] + (size_t)l * 512 + g * 16;
    for (int task = tid; task < 2 * 2 * 16 * 32; task += NTHR) {
        const int e = task >> 10, d = (task >> 9) & 1, blk = (task >> 5) & 15, p = (task >> 1) & 15, q0 = (task & 1) * 8, tau = 2 * part + e;
        if (blk >= 16 - tau || (tau == 0 && d == 1)) continue;
        const int t = d == 0 ? blk + tau : blk, j = d == 0 ? blk : blk + tau; float v[8];
#pragma unroll
        for (int k = 0; k < 8; ++k) { float s = Kl[(d * 2 + e) * 256 + p * 16 + q0 + k]; if (tau == 0) { s += Kl[(1 * 2 + e) * 256 + p * 16 + q0 + k]; if (q0 + k == p) s += dsk[p]; } v[k] = s; }
        v4u o; o.x = cvtpk(v[0], v[1]); o.y = cvtpk(v[2], v[3]); o.z = cvtpk(v[4], v[5]); o.w = cvtpk(v[6], v[7]); *(v4u*)(BtY + (size_t)(t * 16 + p) * 512 + j * 16 + q0) = o;
    }
    for (int task = tid; task < 2 * 32 * 32; task += NTHR) {
        const int which = task >> 10, r = 32 * part + ((task >> 5) & 31), c0 = (task & 31) * 8; float v[8]; bf16* dst;
        if (which == 0) { const int d = r >> 7, reim = (r >> 6) & 1, n = r & 63, j = c0 >> 4, q0 = c0 & 15, ex = d == 0 ? 15 - j : j; dst = BtE + (size_t)r * 256 + c0; const f32x2 a = pw[(d * 17 + ex) * 64 + n];
#pragma unroll
            for (int k = 0; k < 8; ++k) { const f32x2 bq = Bb[(d * 64 + n) * 16 + q0 + k]; v[k] = reim ? (a.x * bq.y + a.y * bq.x) : (a.x * bq.x - a.y * bq.y); } }
        else { const int t = r >> 4, p = r & 15, d = c0 >> 7, reim = (c0 >> 6) & 1, n0 = c0 & 63, ex = d == 0 ? t + 1 : 16 - t; dst = BtY + (size_t)r * 512 + 256 + c0;
#pragma unroll
            for (int k = 0; k < 8; ++k) { const f32x2 c = Cm[(d * 16 + p) * 64 + n0 + k], a = pw[(d * 17 + ex) * 64 + n0 + k]; v[k] = reim ? -(c.x * a.y + c.y * a.x) : (c.x * a.x - c.y * a.y); } }
        v4u o; o.x = cvtpk(v[0], v[1]); o.y = cvtpk(v[2], v[3]); o.z = cvtpk(v[4], v[5]); o.w = cvtpk(v[6], v[7]); *(v4u*)dst = o;
    }
    __syncthreads();
}

__device__ __forceinline__ void prep_layer(const Ctx& C, int l, int parts, int blo, int bcnt) {
    if (C.vcu < blo || C.vcu >= blo + bcnt) return;
    const int bi = C.vcu - blo, wi = bi * NWAVES + C.wave, nw = bcnt * NWAVES;
    if (parts & 1) for (int it = bi; it < 256; it += bcnt) s5_mats_block(C, l, it >> 3, it & 7);
    LAS float* scr = (LAS float*)(C.lds + C.wave * 16384);
    constexpr int I_1 = 16 * 104, I_2 = 16 * 96, I_3 = 8 * 32, I_4 = 8 * 16, I_5 = 8 * 32, I_6 = 16 * 32;
    if (parts & 1) {
        for (int it = wi; it < I_1 + I_2 + I_3 + I_4; it += nw) {
            int r = it;
            if (r < I_1) { transpose_item(C.in[I_WIN] + (size_t)l * 1024 * INW, 1024, INW, C.w<bf16>(WS_WCAT), RmWin{}, scr, r, C.lane); continue; } r -= I_1;
            if (r < I_2) { transpose_item(C.in[I_MW] + (size_t)l * 1024 * 3072, 1024, 3072, C.w<bf16>(WS_WCAT), RmId{INW}, scr, r, C.lane); continue; } r -= I_2;
            if (r < I_3) { transpose_item(C.in[I_GLU] + (size_t)l * 512 * 1024, 512, 1024, C.w<bf16>(WS_WGLU), RmGlu{}, scr, r, C.lane); continue; } r -= I_3;
            transpose_item(C.in[I_FN] + (size_t)l * 512 * 512, 512, 512, C.w<bf16>(WS_WFN), RmId{0}, scr, r, C.lane, 1024, 512);
        }
        for (int t = bi * NTHR + C.tid; t < 2 * 2 * 256 * 16; t += bcnt * NTHR) {
            const int kv = t >> 13, r = t & 8191, b = r >> 12, s = (r >> 4) & 255, c0 = (r & 15) * 8;
            const float* src = C.in[kv ? I_CV : I_CK] + (((size_t)b * DEPTH + l) * 256 + s) * KVW + c0;
            const f32x4 a = *(const f32x4*)src, bq = *(const f32x4*)(src + 4);
            v4u o; o.x = cvtpk(a[0], a[1]); o.y = cvtpk(a[2], a[3]); o.z = cvtpk(bq[0], bq[1]); o.w = cvtpk(bq[2], bq[3]);
            *(v4u*)(C.w<bf16>(kv ? WS_VL : WS_KL) + ((size_t)b * LKV + S_LAT + s) * KVW + c0) = o;
        }
    }
    if (parts & 2) for (int it = wi; it < 3 * I_5; it += nw) { const int nb = it / I_5;
        transpose_item(C.in[I_WBR] + ((size_t)l * 3 + nb) * 512 * 1024, 512, 1024, C.w<bf16>(WS_WBR) + (size_t)nb * 1024 * 512, RmId{0}, scr, it - nb * I_5, C.lane); }
    if (parts & 4) for (int it = wi; it < I_6; it += nw) transpose_item(C.in[I_WOUT] + (size_t)l * 1024 * 1024, 1024, 1024, C.w<bf16>(WS_WOUT), RmId{0}, scr, it, C.lane);
}

__device__ __forceinline__ void rows_phase(const Ctx& C, int l, bool last);
__device__ __forceinline__ void ph_l1(const Ctx& C, int l) {
    if (l > 0) prep_layer(C, l, 6, 0, GRID);
    rows_phase(C, l, false);
}

__device__ __forceinline__ void rows_phase(const Ctx& C, int l, bool last) {
    const float* modf = C.w<float>(WS_MODF); bf16* XR = C.w<bf16>(WS_XRES);
    const bf16* T0 = C.w<bf16>(WS_PB); const bf16* T1 = C.w<bf16>(WS_GA);
    const int c8 = C.lane * 8;
    f32x4 v[4][2][2];
#pragma unroll
    for (int i = 0; i < 4; ++i) { const int row = C.gw + i * 2048;
        if (l == 0) { const float* xr = i < 2 ? C.in[I_XP] + (size_t)row * 1024 : C.in[I_XS] + (size_t)(row - T_CTX) * 1024;
#pragma unroll
            for (int j = 0; j < 2; ++j) { v[i][j][0] = *(const f32x4*)(xr + c8 + 512 * j); v[i][j][1] = *(const f32x4*)(xr + c8 + 512 * j + 4); }
        } else {
#pragma unroll
            for (int j = 0; j < 2; ++j) { const v4u w = *(const v4u*)(XR + (size_t)row * 1024 + c8 + 512 * j); v[i][j][0] = bf8_lo(w); v[i][j][1] = bf8_hi(w); } } }
#pragma unroll
    for (int i = 0; i < 4; ++i) { const int row = C.gw + i * 2048, ci = i < 2 ? 0 : i - 1; float ss = 0.f;
        if (l > 0) {
            const float* gp = modf + ((size_t)(l - 1) * 3 + ci) * 3072 + 2048 + c8; v4u t0[2], t1[2]; f32x4 gt[2][2];
#pragma unroll
            for (int j = 0; j < 2; ++j) { t0[j] = *(const v4u*)(T0 + (size_t)row * 1024 + c8 + 512 * j); t1[j] = *(const v4u*)(T1 + (size_t)row * 1024 + c8 + 512 * j);
                gt[j][0] = *(const f32x4*)(gp + 512 * j); gt[j][1] = *(const f32x4*)(gp + 512 * j + 4); }
#pragma unroll
            for (int j = 0; j < 2; ++j) { v[i][j][0] += gt[j][0] * (bf8_lo(t0[j]) + bf8_lo(t1[j])); v[i][j][1] += gt[j][1] * (bf8_hi(t0[j]) + bf8_hi(t1[j])); }
        }
        if (!last) {
#pragma unroll
            for (int j = 0; j < 2; ++j) st_bf8(XR + (size_t)row * 1024 + c8 + 512 * j, v[i][j][0], v[i][j][1]);
        }
#pragma unroll
        for (int j = 0; j < 2; ++j) {
#pragma unroll
            for (int h = 0; h < 2; ++h) { const f32x4 t = v[i][j][h]; ss += (t[0] * t[0] + t[1] * t[1]) + (t[2] * t[2] + t[3] * t[3]); } }
        const float rstd = rsqrtf(wave_sum(ss, C.lane) * (1.0f / 1024.0f) + RMS_EPS);
        if (last) {
#pragma unroll
            for (int j = 0; j < 2; ++j) {
#pragma unroll
                for (int h = 0; h < 2; ++h) *(f32x4*)(C.out + (size_t)row * 1024 + c8 + 512 * j + 4 * h) = v[i][j][h] * rstd * *(const f32x4*)(C.in[I_FG] + c8 + 512 * j + 4 * h); }
        } else {
            const float* mp = modf + ((size_t)l * 3 + ci) * 3072 + c8; bf16* hr = C.w<bf16>(WS_H) + (size_t)row * 1024;
#pragma unroll
            for (int j = 0; j < 2; ++j) { const f32x4 sh0 = *(const f32x4*)(mp + 512 * j), sh1 = *(const f32x4*)(mp + 512 * j + 4), gs0 = *(const f32x4*)(mp + 1024 + 512 * j), gs1 = *(const f32x4*)(mp + 1024 + 512 * j + 4);
                st_bf8(hr + c8 + 512 * j, v[i][j][0] * rstd * gs0 + sh0, v[i][j][1] * rstd * gs1 + sh1); }
        }
    }
}

__device__ __forceinline__ void scan_unit(const Ctx& C, int l, int g, int pm) {
    const float* SC = C.w<float>(WS_SC); bf16* UH = C.w<bf16>(WS_UH); const int lane = C.lane;
    const int nitems = pm ? 4 : 32;
    for (int item = C.wave; item < nitems; item += NWAVES) {
        const int bsel = item >> 1, d = item & 1, nch = pm ? 128 : 16, c0 = pm ? 256 + bsel * 128 : bsel * 16;
        const size_t gi = ((size_t)(l * 2 + d) * 32 + g) * 64 + lane;
        const float ar = C.w<float>(WS_A16)[gi * 2], ai = C.w<float>(WS_A16)[gi * 2 + 1];
        float hr = 0.f, hi = 0.f;
        if (pm) { const float* st = C.in[I_ST] + ((((size_t)bsel * DEPTH + l) * 2 + d) * 32 + g) * 128 + lane * 2; hr = st[0]; hi = st[1]; }
        float sr[16], si[16], tr[16], ti[16];
#pragma unroll
        for (int k = 0; k < 16; ++k) { const int c = d == 0 ? c0 + k : c0 + nch - 1 - k; const size_t o = ((size_t)g * 512 + c) * 256 + d * 128 + lane; sr[k] = SC[o]; si[k] = SC[o + 64]; }
        for (int i0 = 0; i0 < nch; i0 += 16) {
            if (i0 + 16 < nch) {
#pragma unroll
                for (int k = 0; k < 16; ++k) { const int c = d == 0 ? c0 + i0 + 16 + k : c0 + nch - 1 - i0 - 16 - k; const size_t o = ((size_t)g * 512 + c) * 256 + d * 128 + lane; tr[k] = SC[o]; ti[k] = SC[o + 64]; }
            }
#pragma unroll
            for (int k = 0; k < 16; ++k) { const int c = d == 0 ? c0 + i0 + k : c0 + nch - 1 - i0 - k; const size_t oh = ((size_t)g * 512 + c) * 512 + 256 + d * 128 + lane;
                UH[oh] = (bf16)(cvtpk(hr, hr) & 0xffffu); UH[oh + 64] = (bf16)(cvtpk(hi, hi) & 0xffffu);
                const float nr = ar * hr - ai * hi + sr[k], ni = ar * hi + ai * hr + si[k]; hr = nr; hi = ni; }
#pragma unroll
            for (int k = 0; k < 16; ++k) { sr[k] = tr[k]; si[k] = ti[k]; }
        }
        if (!pm) { float* o = C.out + OUT_S + ((((size_t)bsel * DEPTH + l) * 2 + d) * 32 + g) * 128 + lane * 2; o[0] = hr; o[1] = hi; }
    }
}

__device__ __forceinline__ void ph_final(const Ctx& C) { rows_phase(C, DEPTH, true); }

__device__ __forceinline__ void attn_any(const Ctx& C, int uidx) {
    size_t tok0, kvoff; int NT, h;
    if (uidx < 128) { const int b = uidx >> 6, qb = uidx & 7; h = (uidx >> 3) & 7; tok0 = (size_t)T_CTX + b * 2048 + qb * 256; kvoff = (size_t)(WS_KL - WS_KC) / 2 + (size_t)b * LKV * KVW; NT = LKV / 64; }
    else { const int u2 = uidx - 128, b = u2 >> 3; h = u2 & 7; tok0 = (size_t)b * 256; kvoff = tok0 * KVW; NT = 4; }
    kvoff += (h >> 2) * 64;
    const attn_body::bf16* Q = (const attn_body::bf16*)C.w<bf16>(WS_Q) + tok0 * 512 + h * 64;
    const attn_body::bf16* Kp = (const attn_body::bf16*)C.w<bf16>(WS_KC) + kvoff;
    attn_body::attn_unit<8>(Q, Kp, Kp + (WS_VC - WS_KC) / 2, (attn_body::bf16*)Q, (const attn_body::bf16*)C.w<bf16>(WS_GC) + tok0 * 512 + h * 64, 512, KVW, NT, (char*)C.lds, C.tid);
}

#ifndef MK_PER_PHASE
#define MK_PER_PHASE 0
#endif
constexpr int NSUB = 7, N_PHASES = 2 + NSUB * DEPTH;


__global__ void __launch_bounds__(NTHR, 2) fwd_kernel(KArgs args) {
    extern __shared__ __attribute__((aligned(16))) unsigned char lds_raw[];
    Ctx C; C.lds = (LAS unsigned char*)lds_raw; C.tid = threadIdx.x; C.lane = C.tid & 63; C.wave = __builtin_amdgcn_readfirstlane(C.tid >> 6); C.bid = blockIdx.x;
    int wave_s = C.wave;
    C.gw = C.bid * NWAVES + C.wave; C.ngw = GRID * NWAVES; C.in = args.in; C.out = args.out; C.ws = args.ws;
    for (int u = C.tid; u < (LDS_BYTES - LDSCTL_OFF) / 4; u += NTHR) ((LAS unsigned*)(C.lds + LDSCTL_OFF))[u] = 0u;
    __syncthreads();
    volatile LAS unsigned* MISC = (volatile LAS unsigned*)(C.lds + MISC_OFF);
    XcdBarrier bar; bar.bar = (unsigned*)(C.ws + WS_CTL) + CW_BAR; bar.x = 0; bar.st = nullptr;
    const bool multi = args.ph_hi - args.ph_lo > 1;
    if (multi) bar = xcd_barrier_post((unsigned*)(C.ws + WS_CTL) + CW_BAR, MISC + 8, C.tid);

    for (int ph = args.ph_lo; ph < args.ph_hi; ++ph) {
        { int l_; asm volatile("v_mbcnt_lo_u32_b32 %0, -1, 0\n\tv_mbcnt_hi_u32_b32 %0, -1, %0" : "=v"(l_)); asm volatile("" : "+s"(wave_s)); int b_ = blockIdx.x; asm volatile("" : "+s"(b_)); C.bid = b_; C.vcu = b_;   C.lane = l_; C.wave = wave_s; C.tid = wave_s * 64 + l_; C.gw = C.bid * NWAVES + C.wave;
          unsigned char* w_ = args.ws; asm volatile("" : "+s"(w_)); C.ws = w_; float* o_ = args.out; asm volatile("" : "+s"(o_)); C.out = o_; }
        const int c = C.vcu;
        if (ph == 0) { ph_prologue(C); __syncthreads(); prep_layer(C, 0, 7, 0, GRID); }
        else if (ph == N_PHASES - 1) ph_final(C);
        else {
            const int l = (ph - 1) / NSUB, sub = (ph - 1) % NSUB;
            if (sub == 0) ph_l1(C, l);
            else {
                if (sub == 2 && c < 128) for (int i = 0; i < 2; ++i) attn_any(C, c + 128 * i);
                if (sub == 3 && c >= 64 && c < 128) { const int L = xswz(c - 64, 64); scan_unit(C, l, L >> 1, L & 1); VM_WAIT(); }
                __syncthreads();
                { PhaseSched S{sub, c, C.bid, C.ws}; EpiAll E{C.ws, C.out, C.in, l}; int t_ = C.tid; asm volatile("" : "+v"(t_));
                  pg8::gemm_stream<EpiAll, PhaseSched>(C.lds, S, E, t_); }
                if (sub == 5 && l + 1 < DEPTH) { __syncthreads(); prep_layer(C, l + 1, 1, 128, 128); }
            }
        }
        if (ph + 1 < args.ph_hi) xcd_barrier(bar, C.tid);
    }
}

extern "C" void kernel_launch(void* const* d_in, const int* in_sizes, int n_in, void* d_out, int out_size, void* d_ws, size_t ws_size, hipStream_t stream) {
    static int ready = 0;
    if (ready == 0) {
        if (n_in != 28 || out_size != (int)OUT_N || ws_size < WS_END) { fprintf(stderr, "kernel_launch: unexpected problem shape (n_in %d, out %d, ws %zu)\n", n_in, out_size, ws_size); ready = -1; return; }
        int dev = 0, cus = 0;
        if (hipGetDevice(&dev) != hipSuccess || hipDeviceGetAttribute(&cus, hipDeviceAttributeMultiprocessorCount, dev) != hipSuccess) { ready = -1; return; }
        if (hipFuncSetAttribute((const void*)fwd_kernel, hipFuncAttributeMaxDynamicSharedMemorySize, LDS_BYTES) != hipSuccess) { fprintf(stderr, "kernel_launch: hipFuncSetAttribute failed\n"); ready = -1; return; }
        if (cus < GRID) { fprintf(stderr, "kernel_launch: device has %d CUs, this kernel needs %d resident workgroups\n", cus, GRID); ready = -1; return; }
        ready = 1;
    }
    if (ready < 0) return;
    (void)hipMemsetAsync((char*)d_ws + WS_CTL, 0, CTL_ZERO_BYTES, stream);
    KArgs a{};
    for (int i = 0; i < 28; ++i) a.in[i] = (const float*)d_in[i];
    a.out = (float*)d_out; a.ws = (unsigned char*)d_ws;
#if MK_PER_PHASE
    for (int ph = 0; ph < N_PHASES; ++ph) { a.ph_lo = ph; a.ph_hi = ph + 1; hipLaunchKernelGGL(fwd_kernel, dim3(GRID), dim3(NTHR), LDS_BYTES, stream, a); }
#else
    a.ph_lo = 0; a.ph_hi = N_PHASES; hipLaunchKernelGGL(fwd_kernel, dim3(GRID), dim3(NTHR), LDS_BYTES, stream, a);
#endif
}
```

```cpp
#include <hip/hip_runtime.h>
#include <hip/hip_bf16.h>
#include <cstdio>
#include <cstdint>
#include <cmath>
namespace pg8 {
#define PG8_LAS __attribute__((address_space(3)))
typedef unsigned short bf16_t;
typedef short bf16x8 __attribute__((ext_vector_type(8)));
typedef float f32x4 __attribute__((ext_vector_type(4)));
typedef unsigned u32x4 __attribute__((ext_vector_type(4)));
constexpr int BM = 256, BK = 64, HALF = 128, HTB = HALF * BK * 2  , STAGE_BYTES = 8 * HTB, NXCD = 8, WGM = 8;

__host__ __device__ __forceinline__ int lds_byte(int r, int c) { const int st = (r >> 4) * 2 + (c >> 5), rr = r & 15, cc = c & 31, ob = rr * 64 + cc * 2; return st * 1024 + (ob ^ (((ob >> 9) & 1) << 5)); }
__host__ __device__ __forceinline__ void stage_rc(int b, int& R, int& C) { const int st = b / 1024, sb = b % 1024, swz = sb ^ (((sb >> 9) & 1) << 5); R = (st >> 1) * 16 + swz / 64; C = (st & 1) * 32 + (swz % 64) / 2; }
__host__ __device__ __forceinline__ int perm32(int rho) { const int n = rho >> 4, i = rho & 15; return 8 * (i >> 2) + 4 * n + (i & 3); }


struct Unit { int pm, pn, z; };
struct StaticOrder {
    int nM, nN, nwg, G, c;
    __host__ __device__ void init(int M, int N, int G_, int c_) { nM = M / BM; nN = N / BM; nwg = nM * nN; G = G_; c = c_; }
    __host__ __device__ bool next(int i, Unit& u) const {
        const long L = (long)i * G + c; if (L >= nwg) return false;
        int wgid = (int)L; { const int q = nwg / NXCD, r = nwg % NXCD, xcd = wgid % NXCD, off = wgid / NXCD; wgid = (xcd < r ? xcd * (q + 1) : r * (q + 1) + (xcd - r) * q) + off; }
        const int nig = WGM * nN, gid = wgid / nig, fm = gid * WGM, gsz = (nM - fm) < WGM ? (nM - fm) : WGM;
        u.pm = fm + ((wgid % nig) % gsz); u.pn = (wgid % nig) / gsz; return true;
    }
    __device__ __forceinline__ void a_ready(const Unit&) const {}
    __device__ __forceinline__ void done(const Unit&) const {}
};
struct UDesc { const bf16_t* A; const bf16_t* Bt; int lda, ldb, K, hB; int kind, pm, pn, z, keep; };
template <class Epi, class Sched>
__device__ __forceinline__ void gemm_stream(PG8_LAS unsigned char* lds, const Sched& S, const Epi& E, const int tid_in) {
    const int tid = tid_in, wid = __builtin_amdgcn_readfirstlane(tid >> 6), lane = tid & 63, wr = wid >> 2, wc = wid & 3, fr = lane & 15, fq = lane >> 4;
    int RA, RB, CC;
    { int R, C; stage_rc(tid * 16, R, C); RA = R; RB = (R & ~31) + perm32(R & 31); CC = C; }
    const size_t kstep = (size_t)(BK * 2);
    const unsigned ldsw = (unsigned)wid * 1024u;
    const int aoff = lds_byte(wr * 64 + fr, fq * 8), boff = lds_byte(wc * 32 + fr, fq * 8);
#define PG8_SA(b, h) (((b) * 2 + (h)) * HTB)
#define PG8_SB(b, h) ((4 + (b) * 2 + (h)) * HTB)
#define PG8_STAGE_X(bufoff, gbase, RR, ld) do { const unsigned _vo = (unsigned)(RR * (ld) + CC) * 2u; \
        __builtin_amdgcn_global_load_lds((const unsigned*)((const char*)(gbase) + _vo), (PG8_LAS unsigned*)(lds + (bufoff) + ldsw), 16, 0, 0); \
        __builtin_amdgcn_global_load_lds((const unsigned*)((const char*)(gbase) + (size_t)(ld) * 128 + _vo), (PG8_LAS unsigned*)(lds + (bufoff) + ldsw + 8192), 16, 0, 0); } while (0)
#define PG8_STAGE_A(bufoff, gbase, ld) PG8_STAGE_X(bufoff, gbase, RA, ld)
#define PG8_STAGE_B(bufoff, gbase, ld) PG8_STAGE_X(bufoff, gbase, RB, ld)
#define PG8_LDA(dst, b, h) do { _Pragma("unroll") for (int m = 0; m < 4; ++m) _Pragma("unroll") for (int k = 0; k < 2; ++k) dst[m][k] = *(const PG8_LAS bf16x8*)(lds + PG8_SA(b, h) + aoff + m * 2048 + k * 1024); } while (0)
#define PG8_LDB(dst, b, h) do { _Pragma("unroll") for (int n = 0; n < 2; ++n) _Pragma("unroll") for (int k = 0; k < 2; ++k) dst[n][k] = *(const PG8_LAS bf16x8*)(lds + PG8_SB(b, h) + boff + n * 2048 + k * 1024); } while (0)
#define PG8_MMA(ai, bj, At, Bt) do { __builtin_amdgcn_s_setprio(1); _Pragma("unroll") for (int m = 0; m < 4; ++m) _Pragma("unroll") for (int n = 0; n < 2; ++n) _Pragma("unroll") for (int k = 0; k < 2; ++k) \
        acc[ai][bj][m][n] = __builtin_amdgcn_mfma_f32_16x16x32_bf16(Bt[n][k], At[m][k], acc[ai][bj][m][n], 0, 0, 0); __builtin_amdgcn_s_setprio(0); } while (0)
#define PG8_WAIT_V(n) asm volatile("s_waitcnt vmcnt(" #n ")" ::: "memory")
#define PG8_WAIT_L(n) asm volatile("s_waitcnt lgkmcnt(" #n ")" ::: "memory")
#define PG8_BAR __builtin_amdgcn_s_barrier()
#define PG8_SCHED __builtin_amdgcn_sched_barrier(0)
    UDesc cur, nxt; int ui = 0;
    if (!S.next(0, cur)) return;
    f32x4 acc[2][2][4][2];
#pragma unroll
    for (int a = 0; a < 2; ++a)
#pragma unroll
        for (int b = 0; b < 2; ++b)
#pragma unroll
            for (int m = 0; m < 4; ++m)
#pragma unroll
                for (int n = 0; n < 2; ++n) acc[a][b][m][n] = (f32x4){0.f, 0.f, 0.f, 0.f};
    bf16x8 At[4][2], B0[2][2], B1[2][2];
    const char* cA = (const char*)cur.A; const char* cB = (const char*)cur.Bt; int ldaC = cur.lda, ldbC = cur.ldb; unsigned hstepA = (unsigned)HALF * ldaC * 2, hstepB = (unsigned)cur.hB * ldbC * 2;
    PG8_STAGE_B(PG8_SB(0, 0), cB, ldbC); PG8_STAGE_B(PG8_SB(0, 1), cB + hstepB, ldbC); PG8_STAGE_A(PG8_SA(0, 0), cA, ldaC); PG8_STAGE_A(PG8_SA(0, 1), cA + hstepA, ldaC);
    if (wr == 1) PG8_BAR;
    PG8_WAIT_V(2); PG8_BAR;
    PG8_STAGE_B(PG8_SB(1, 0), cB + kstep, ldbC); PG8_STAGE_A(PG8_SA(1, 0), cA + kstep, ldaC); PG8_STAGE_B(PG8_SB(1, 1), cB + hstepB + kstep, ldbC);
    PG8_WAIT_V(6); PG8_BAR;
    for (;;) {
        const bool has_next = S.next(ui + 1, nxt);
        const char* nA = has_next ? (const char*)nxt.A : cA; const char* nB = has_next ? (const char*)nxt.Bt : cB;
        const int ldaN = has_next ? nxt.lda : ldaC, ldbN = has_next ? nxt.ldb : ldbC; const unsigned hstepAN = (unsigned)HALF * ldaN * 2, hstepBN = has_next ? (unsigned)nxt.hB * ldbN * 2 : hstepB;
        const int nt = cur.K / BK;
        for (int t = 0; t < nt; t += 2) {
            const bool last = (t == nt - 2);
            const char* a1 = cA + (size_t)(t + 1) * kstep;
            const char* a2 = last ? nA : cA + (size_t)(t + 2) * kstep; const char* b2 = last ? nB : cB + (size_t)(t + 2) * kstep;
            const char* a3 = a2 + kstep; const char* b3 = b2 + kstep;
            const int lda2 = last ? ldaN : ldaC, ldb2 = last ? ldbN : ldbC; const unsigned hA2 = last ? hstepAN : hstepA, hB2 = last ? hstepBN : hstepB;
            PG8_LDB(B0, 0, 0); PG8_LDB(B1, 0, 1); PG8_SCHED; PG8_LDA(At, 0, 0); PG8_STAGE_A(PG8_SA(1, 1), a1 + hstepA, ldaC);
            PG8_WAIT_V(8); PG8_WAIT_L(0); PG8_BAR; PG8_MMA(0, 0, At, B0); PG8_MMA(0, 1, At, B1); PG8_BAR; PG8_SCHED;
            PG8_LDA(At, 0, 1); PG8_STAGE_B(PG8_SB(0, 0), b2, ldb2); PG8_STAGE_B(PG8_SB(0, 1), b2 + hB2, ldb2); PG8_STAGE_A(PG8_SA(0, 0), a2, lda2);
            PG8_WAIT_V(8); PG8_WAIT_L(0); PG8_BAR; PG8_MMA(1, 0, At, B0); PG8_MMA(1, 1, At, B1); PG8_BAR; PG8_SCHED;
            PG8_LDB(B0, 1, 0); PG8_LDB(B1, 1, 1); PG8_SCHED; PG8_LDA(At, 1, 0); PG8_STAGE_A(PG8_SA(0, 1), a2 + hA2, lda2);
            PG8_WAIT_V(8); PG8_WAIT_L(0); PG8_BAR; PG8_MMA(0, 0, At, B0); PG8_MMA(0, 1, At, B1); PG8_BAR; PG8_SCHED;
            PG8_LDA(At, 1, 1); PG8_STAGE_B(PG8_SB(1, 0), b3, ldb2); PG8_STAGE_B(PG8_SB(1, 1), b3 + hB2, ldb2); PG8_STAGE_A(PG8_SA(1, 0), a3, lda2);
            PG8_WAIT_V(8); PG8_WAIT_L(0); PG8_BAR; PG8_MMA(1, 0, At, B0); PG8_MMA(1, 1, At, B1); PG8_BAR; PG8_SCHED;
        }
        if (wr == 0) PG8_BAR;
        const bool chained = E.transform(acc, cur, wr, wc, fr, fq);
        if (!chained) E(acc, cur, wr, wc, fr, fq);
        if (!has_next) break;
        if (!chained) {
#pragma unroll
        for (int a = 0; a < 2; ++a)
#pragma unroll
            for (int b = 0; b < 2; ++b)
#pragma unroll
                for (int m = 0; m < 4; ++m)
#pragma unroll
                    for (int n = 0; n < 2; ++n) acc[a][b][m][n] = (f32x4){0.f, 0.f, 0.f, 0.f};
        }
        cur = nxt; cA = nA; cB = nB; ldaC = ldaN; ldbC = ldbN; hstepA = hstepAN; hstepB = hstepBN; ++ui;
        if (wr == 1) PG8_BAR;
    }
    PG8_WAIT_V(0);
    PG8_BAR;
#undef PG8_SA
#undef PG8_SB
#undef PG8_STAGE_X
#undef PG8_STAGE_A
#undef PG8_STAGE_B
#undef PG8_LDA
#undef PG8_LDB
#undef PG8_MMA
#undef PG8_WAIT_V
#undef PG8_WAIT_L
#undef PG8_BAR
#undef PG8_SCHED
}
}

#include <hip/hip_bf16.h>
#include <cmath>
namespace attn_body {
using bf16=__hip_bfloat16;
using bf16x8=__attribute__((ext_vector_type(8)))short;
using s16x4=__attribute__((ext_vector_type(4)))short;
using f32x16=__attribute__((ext_vector_type(16)))float;
using u32x4=__attribute__((ext_vector_type(4)))unsigned;
constexpr int D=64;
constexpr int NW=8,QBLK=32,QB=QBLK*NW,KVBLK=64;
__device__ __forceinline__ int crow(int r,int hi){return (r&3)+8*(r>>2)+4*hi;}
#define SBAR() __builtin_amdgcn_sched_barrier(0)
constexpr int NSLOT=3, SLOTB=8192;
constexpr int LDS_K=0, LDS_V=NSLOT*SLOTB, LDS_WS=2*NSLOT*SLOTB, LDS_OST=LDS_WS+NW*64*4, LDS_BYTES=LDS_OST+NW*4096;
constexpr float C2=0.125f*1.4426950408889634f;
__device__ __forceinline__ void glds16(const void*gsrc,unsigned lds_dst){unsigned keep;
  asm volatile("s_mov_b32 %0, m0\n\ts_mov_b32 m0, %2\n\ts_nop 0\n\tglobal_load_lds_dwordx4 %1, off\n\ts_mov_b32 m0, %0":"=&s"(keep):"v"(gsrc),"s"(lds_dst):"memory");}
__device__ __forceinline__ float max3f(float a,float b,float c){float r;asm("v_max3_f32 %0, %1, %2, %3":"=v"(r):"v"(a),"v"(b),"v"(c));return r;}
__device__ __forceinline__ float max2f(float a,float b){float r;asm("v_max_f32_e32 %0, %1, %2":"=v"(r):"v"(a),"v"(b));return r;}
__device__ __forceinline__ float fadd_s(float a,float b){float r;asm("v_add_f32_e32 %0, %1, %2":"=v"(r):"v"(a),"v"(b));return r;}
__device__ __forceinline__ float fsub_s(float a,float b){float r;asm("v_sub_f32_e32 %0, %1, %2":"=v"(r):"v"(a),"v"(b));return r;}
typedef float f32x2_t __attribute__((ext_vector_type(2))); typedef __bf16 bf16x2_t __attribute__((ext_vector_type(2)));
__device__ __forceinline__ unsigned cvtpk_s(float lo,float hi){f32x2_t v={lo,hi};bf16x2_t b=__builtin_convertvector(v,bf16x2_t);return __builtin_bit_cast(unsigned,b);}
#define WAIT_BAR(N) asm volatile("s_waitcnt vmcnt(" #N ") lgkmcnt(0)\n\ts_barrier":::"memory")

__device__ __forceinline__ void qkt(f32x16&p0,f32x16&p1,const char*Kslot,const bf16x8*qr,const f32x16&negm,int r32,int hi){
  const char*kb=Kslot+hi*1024+r32*16;
  #pragma unroll
  for(int d0=0;d0<4;++d0){
    const bf16x8 b0=*reinterpret_cast<const bf16x8*>(kb+d0*2048);
    const bf16x8 b1=*reinterpret_cast<const bf16x8*>(kb+d0*2048+512);
    if(d0==0){p0=__builtin_amdgcn_mfma_f32_32x32x16_bf16(b0,qr[0],negm,0,0,0);p1=__builtin_amdgcn_mfma_f32_32x32x16_bf16(b1,qr[0],negm,0,0,0);}
    else{p0=__builtin_amdgcn_mfma_f32_32x32x16_bf16(b0,qr[d0],p0,0,0,0);p1=__builtin_amdgcn_mfma_f32_32x32x16_bf16(b1,qr[d0],p1,0,0,0);}}
}
typedef __attribute__((address_space(3))) const char* lds_cptr;
typedef short v4i16_t __attribute__((ext_vector_type(4)));
__device__ __forceinline__ void kload8(bf16x8*kf,lds_cptr kp){
  kf[0]=*(const __attribute__((address_space(3))) bf16x8*)(kp);      kf[1]=*(const __attribute__((address_space(3))) bf16x8*)(kp+512);
  kf[2]=*(const __attribute__((address_space(3))) bf16x8*)(kp+2048); kf[3]=*(const __attribute__((address_space(3))) bf16x8*)(kp+2560);
  kf[4]=*(const __attribute__((address_space(3))) bf16x8*)(kp+4096); kf[5]=*(const __attribute__((address_space(3))) bf16x8*)(kp+4608);
  kf[6]=*(const __attribute__((address_space(3))) bf16x8*)(kp+6144); kf[7]=*(const __attribute__((address_space(3))) bf16x8*)(kp+6656);
}
__device__ __forceinline__ void kload2(bf16x8*kf,lds_cptr kp,int j){ kf[2*j]=*(const __attribute__((address_space(3))) bf16x8*)(kp+j*2048); kf[2*j+1]=*(const __attribute__((address_space(3))) bf16x8*)(kp+j*2048+512); }
__device__ __forceinline__ s16x4 vtr(lds_cptr p){ return __builtin_bit_cast(s16x4,__builtin_amdgcn_ds_read_tr16_b64_v4i16((__attribute__((address_space(3))) v4i16_t*)p)); }
__device__ __forceinline__ float rowmax(const f32x16&p0,const f32x16&p1){
  float a=max3f(p0[0],p0[1],p1[0]),b=max3f(p0[2],p0[3],p1[1]);a=max3f(a,p1[2],p1[3]);
  #pragma unroll
  for(int r=4;r<16;r+=4){a=max3f(a,p0[r],p0[r+1]);b=max3f(b,p0[r+2],p0[r+3]);a=max3f(a,p1[r],p1[r+1]);b=max3f(b,p1[r+2],p1[r+3]);}
  const float m=max2f(a,b);
  auto rr=__builtin_amdgcn_permlane32_swap(__float_as_uint(m),__float_as_uint(m),false,false);
  return max2f(__uint_as_float(rr[0]),__uint_as_float(rr[1]));
}
__device__ __forceinline__ void pv(f32x16*o,int vb,bf16x8 pa0,bf16x8 pa1,bf16x8 pa2,bf16x8 pa3){
  #pragma unroll
  for(int d0=0;d0<2;++d0){s16x4 lo[4],hi[4];
    #pragma unroll
    for(int ks=0;ks<4;++ks){
      asm volatile("ds_read_b64_tr_b16 %0,%1 offset:%c2":"=&v"(lo[ks]):"v"(vb),"i"(d0*4096+ks*1024):"memory");
      asm volatile("ds_read_b64_tr_b16 %0,%1 offset:%c2":"=&v"(hi[ks]):"v"(vb),"i"(d0*4096+ks*1024+512):"memory");}
    asm volatile("s_waitcnt lgkmcnt(0)":::"memory");SBAR();
    #define PK(k) (bf16x8){lo[k][0],lo[k][1],lo[k][2],lo[k][3],hi[k][0],hi[k][1],hi[k][2],hi[k][3]}
    o[d0]=__builtin_amdgcn_mfma_f32_32x32x16_bf16(pa0,PK(0),o[d0],0,0,0);
    o[d0]=__builtin_amdgcn_mfma_f32_32x32x16_bf16(pa1,PK(1),o[d0],0,0,0);
    o[d0]=__builtin_amdgcn_mfma_f32_32x32x16_bf16(pa2,PK(2),o[d0],0,0,0);
    o[d0]=__builtin_amdgcn_mfma_f32_32x32x16_bf16(pa3,PK(3),o[d0],0,0,0);
    #undef PK
  }
}

#ifndef ATTN_STORE16
#define ATTN_STORE16(p,v) (*(u32x4*)(p)=(v))
#endif
template<int THRL> __device__ __forceinline__ void attn_unit(const bf16*Qu,const bf16*Kh,const bf16*Vh,bf16*Ou,const bf16*Gu,const int QP,const int KP,const int NT,char*shm,const int tid_in){
  const int tid=tid_in,lane=tid&63,r32=lane&31,hi=lane>>5; const int wid=__builtin_amdgcn_readfirstlane(tid>>6);
  const bf16*Qw=Qu+(long)(wid*QBLK)*QP;
  const unsigned lds0=(unsigned)(uintptr_t)shm;
  float*wsf=(float*)(shm+LDS_WS)+wid*64;
  const bf16*ksrc=Kh+(long)lane*KP+wid*8;
  const bf16*vsrc=Vh+(long)(16*(wid&3)+(lane>>2))*KP+(wid>>2)*32+(lane&3)*8;
  const unsigned kdst=lds0+LDS_K+wid*1024, vdst=lds0+LDS_V+wid*1024;
  #define DMA_K(t,slot) glds16(ksrc+(long)(t)*KVBLK*KP,(unsigned)__builtin_amdgcn_readfirstlane(kdst+(slot)))
  #define DMA_V(t,slot) glds16(vsrc+(long)(t)*KVBLK*KP,(unsigned)__builtin_amdgcn_readfirstlane(vdst+(slot)))
  const int vb0=(int)(lds0+LDS_V)+((lane>>4)&1)*32+(lane&3)*8+(4*hi+((lane&15)>>2))*64;
  const char*Kbase=shm+LDS_K; bf16x8 kf[8];
  const lds_cptr shm3=(lds_cptr)shm; const lds_cptr kp0=shm3+LDS_K+hi*1024+r32*16; const lds_cptr vp0=shm3+LDS_V+((lane>>4)&1)*32+(lane&3)*8+(4*hi+((lane&15)>>2))*64;
  DMA_K(0,0);DMA_V(0,0);DMA_K(1,SLOTB);
  bf16x8 qr[4];
  #pragma unroll
  for(int d0=0;d0<4;++d0)qr[d0]=*reinterpret_cast<const bf16x8*>(&Qw[(long)r32*QP+d0*16+hi*8]);
  float mhat=0.f,l_reg=0.f;f32x16 o[2];o[0]=f32x16{};o[1]=f32x16{};f32x16 negm; {float zf_; asm volatile("v_mov_b32 %0, 0":"=v"(zf_)); _Pragma("unroll") for(int r=0;r<16;++r)negm[r]=zf_;} asm volatile("":"+v"(negm));
  #define CMASK(P0,P1,t) do{}while(0)
  bool resc=false;
  #define START(P0,P1) do{ const float rm=rowmax(P0,P1); resc=false; \
    { const float dl=rm; mhat=fadd_s(mhat,dl); \
      _Pragma("unroll") for(int r=0;r<16;++r){P0[r]=fsub_s(P0[r],dl);P1[r]=fsub_s(P1[r],dl);} \
      _Pragma("unroll") for(int r=0;r<16;++r)negm[r]=-mhat; asm volatile("":"+v"(negm)); } \
    _Pragma("unroll") for(int r=0;r<16;++r)P0[r]=__builtin_amdgcn_exp2f(P0[r]); }while(0)
  #define RESC() do{ if(resc){ asm volatile("s_waitcnt lgkmcnt(0)":::"memory"); \
      _Pragma("unroll") for(int d_=0;d_<2;++d_) _Pragma("unroll") for(int r=0;r<16;++r)o[d_][r]*=wsf[crow(r,hi)]; } }while(0)
  f32x16 pA0,pA1,pB0,pB1;
  int sl_prev=0,sl_cur=0,sl_next=SLOTB;
  #define ROT() do{sl_prev=sl_cur;sl_cur=sl_next;sl_next=(sl_next==(NSLOT-1)*SLOTB)?0:sl_next+SLOTB;}while(0)
  DMA_K(2,2*SLOTB);
  WAIT_BAR(3);
  qkt(pA0,pA1,Kbase,qr,negm,r32,hi);asm volatile("s_nop 15\n\ts_nop 7":"+v"(pA0),"+v"(pA1));CMASK(pA0,pA1,0);
  START(pA0,pA1);
  _Pragma("unroll") for(int r=0;r<16;++r)pA1[r]=__builtin_amdgcn_exp2f(pA1[r]);
  WAIT_BAR(0);
  DMA_K(3,0);DMA_V(1,SLOTB);
  ROT();
  kload8(kf,kp0+sl_cur);
  WAIT_BAR(2);
  s16x4 vlo[8],vhi[8]; u32x4 pw0,pw1,pw2,pw3;
  #define PKW(P,B) cvtpk_s(P[B],P[B+1])
  #define PAF(k) __builtin_bit_cast(bf16x8,pw##k)
  #define VFR(i) (bf16x8){vlo[i][0],vlo[i][1],vlo[i][2],vlo[i][3],vhi[i][0],vhi[i][1],vhi[i][2],vhi[i][3]}
  #define PIN(x) asm volatile("":"+v"(x))
  #define MX3(a,b,c) __builtin_fmaxf(__builtin_fmaxf((a),(b)),(c))
  #define GAPA(MF,A0,A1,A2,A3,W0,W1,PW) do{ MF; sacc+=A0; sacc+=A1; sacc+=A2; sacc+=A3; PIN(sacc); W0; W1; PIN(PW); SBAR(); }while(0)
  #define EX(v) __builtin_amdgcn_exp2f(v)
  #define GAPB(MF,X,B) do{ MF; X[B]=EX(X[B]); X[B+1]=EX(X[B+1]); X[B+2]=EX(X[B+2]); X[B+3]=EX(X[B+3]); PIN(X); SBAR(); }while(0)
  #define VRD(i) do{ vlo[i]=vtr(vp_+(((i)>>2)*4096+((i)&3)*1024)); vhi[i]=vtr(vp_+(((i)>>2)*4096+((i)&3)*1024+512)); }while(0)
  #define KRD(G,j) do{ if(G){ kload2(kf,kp0+sl_next,j); SBAR(); } }while(0)
  #define STEP(C0,C1,P0,P1,t,GK,GV,GL) do{ SBAR(); \
    const lds_cptr vp_=vp0+sl_prev; \
    VRD(0); SBAR(); float sacc=(P0[0]+P0[1]); \
    GAPA(C0=__builtin_amdgcn_mfma_f32_32x32x16_bf16(kf[0],qr[0],negm,0,0,0), P0[2],P0[3],P0[4],P0[5],     pw0[0]=PKW(P0,0), pw0[1]=PKW(P0,2), pw0); \
    VRD(4); SBAR(); GAPA(C1=__builtin_amdgcn_mfma_f32_32x32x16_bf16(kf[1],qr[0],negm,0,0,0), P0[6],P0[7],P0[8],P0[9],     pw0[2]=PKW(P0,4), pw0[3]=PKW(P0,6), pw0); \
    VRD(1); SBAR(); GAPA(C0=__builtin_amdgcn_mfma_f32_32x32x16_bf16(kf[2],qr[1],C0,0,0,0),   P0[10],P0[11],P0[12],P0[13], pw1[0]=PKW(P0,8), pw1[1]=PKW(P0,10), pw1); \
    VRD(5); SBAR(); GAPA(C1=__builtin_amdgcn_mfma_f32_32x32x16_bf16(kf[3],qr[1],C1,0,0,0),   P0[14],P0[15],P1[0],P1[1],   pw1[2]=PKW(P0,12),pw1[3]=PKW(P0,14), pw1); \
    VRD(2); SBAR(); GAPA(C0=__builtin_amdgcn_mfma_f32_32x32x16_bf16(kf[4],qr[2],C0,0,0,0),   P1[2],P1[3],P1[4],P1[5],     pw2[0]=PKW(P1,0), pw2[1]=PKW(P1,2), pw2); \
    VRD(6); SBAR(); GAPA(C1=__builtin_amdgcn_mfma_f32_32x32x16_bf16(kf[5],qr[2],C1,0,0,0),   P1[6],P1[7],P1[8],P1[9],     pw2[2]=PKW(P1,4), pw2[3]=PKW(P1,6), pw2); \
    VRD(3); SBAR(); GAPA(C0=__builtin_amdgcn_mfma_f32_32x32x16_bf16(kf[6],qr[3],C0,0,0,0),   P1[10],P1[11],P1[12],P1[13], pw3[0]=PKW(P1,8), pw3[1]=PKW(P1,10), pw3); \
    VRD(7); SBAR(); GAPA(C1=__builtin_amdgcn_mfma_f32_32x32x16_bf16(kf[7],qr[3],C1,0,0,0),   P1[14],P1[15],0.f,0.f,       pw3[2]=PKW(P1,12),pw3[3]=PKW(P1,14), pw3); \
    l_reg+=sacc; \
    if(GK){DMA_K((t)+3,sl_cur);} if(GV){DMA_V((t)+1,sl_next);} \
    CMASK(C0,C1,t); \
    { float a=MX3(C0[0],C0[1],C1[0]),b=MX3(C0[2],C0[3],C1[1]); a=MX3(a,C1[2],C1[3]); \
      _Pragma("unroll") for(int r=4;r<16;r+=4){a=MX3(a,C0[r],C0[r+1]);b=MX3(b,C0[r+2],C0[r+3]);a=MX3(a,C1[r],C1[r+1]);b=MX3(b,C1[r+2],C1[r+3]);} \
      float rm=__builtin_fmaxf(a,b); { auto rr=__builtin_amdgcn_permlane32_swap(__float_as_uint(rm),__float_as_uint(rm),false,false); rm=__builtin_fmaxf(__uint_as_float(rr[0]),__uint_as_float(rr[1])); } \
      resc=false; \
      if(__builtin_expect(__any(rm>(float)THRL),0)){ const float dl=__builtin_fmaxf(rm,0.f); mhat+=dl; \
        _Pragma("unroll") for(int r=0;r<16;++r){C0[r]-=dl;C1[r]-=dl;} \
        _Pragma("unroll") for(int r=0;r<16;++r)negm[r]=-mhat; asm volatile("":"+v"(negm)); \
        const float f=__builtin_amdgcn_exp2f(-dl); l_reg*=f; if(hi==0)wsf[r32]=f; resc=true; } } \
    SBAR(); \
    GAPB(o[0]=__builtin_amdgcn_mfma_f32_32x32x16_bf16(PAF(0),VFR(0),o[0],0,0,0), C0,0); \
    GAPB(o[1]=__builtin_amdgcn_mfma_f32_32x32x16_bf16(PAF(0),VFR(4),o[1],0,0,0), C0,4); \
    KRD(GL,0); GAPB(o[0]=__builtin_amdgcn_mfma_f32_32x32x16_bf16(PAF(1),VFR(1),o[0],0,0,0), C0,8); \
    KRD(GL,1); GAPB(o[1]=__builtin_amdgcn_mfma_f32_32x32x16_bf16(PAF(1),VFR(5),o[1],0,0,0), C0,12); \
    KRD(GL,2); GAPB(o[0]=__builtin_amdgcn_mfma_f32_32x32x16_bf16(PAF(2),VFR(2),o[0],0,0,0), C1,0); \
    KRD(GL,3); GAPB(o[1]=__builtin_amdgcn_mfma_f32_32x32x16_bf16(PAF(2),VFR(6),o[1],0,0,0), C1,4); \
    GAPB(o[0]=__builtin_amdgcn_mfma_f32_32x32x16_bf16(PAF(3),VFR(3),o[0],0,0,0), C1,8); \
    GAPB(o[1]=__builtin_amdgcn_mfma_f32_32x32x16_bf16(PAF(3),VFR(7),o[1],0,0,0), C1,12); \
    }while(0)
  int t=1;
  #undef CMASK
  #define CMASK(P0,P1,t) do{}while(0)
  for(;t+5<NT;t+=2){
    STEP(pB0,pB1,pA0,pA1,t,true,true,true);     WAIT_BAR(2); RESC(); ROT();
    STEP(pA0,pA1,pB0,pB1,t+1,true,true,true);   WAIT_BAR(2); RESC(); ROT();
  }
  #undef CMASK
  #define CMASK(P0,P1,t) do{}while(0)
  #define ENDW(tt) do{ if((tt)+3<NT){WAIT_BAR(2);} else if((tt)+2<NT){WAIT_BAR(1);} else {WAIT_BAR(0);} }while(0)
  for(;t+1<NT;t+=2){
    STEP(pB0,pB1,pA0,pA1,t,(t+3<NT),(t+1<NT),(t+1<NT));       ENDW(t);   RESC(); ROT();
    STEP(pA0,pA1,pB0,pB1,t+1,(t+4<NT),(t+2<NT),(t+2<NT));     ENDW(t+1); RESC(); ROT();
  }
  STEP(pB0,pB1,pA0,pA1,NT-1,false,false,false); RESC();
  { float sacc=pB0[0]+pB0[1]; _Pragma("unroll") for(int r=2;r<16;++r)sacc+=pB0[r]; _Pragma("unroll") for(int r=0;r<16;++r)sacc+=pB1[r]; l_reg+=sacc;
    pw0=(u32x4){PKW(pB0,0),PKW(pB0,2),PKW(pB0,4),PKW(pB0,6)};pw1=(u32x4){PKW(pB0,8),PKW(pB0,10),PKW(pB0,12),PKW(pB0,14)};pw2=(u32x4){PKW(pB1,0),PKW(pB1,2),PKW(pB1,4),PKW(pB1,6)};pw3=(u32x4){PKW(pB1,8),PKW(pB1,10),PKW(pB1,12),PKW(pB1,14)};
    SBAR(); pv(o,vb0+sl_cur,PAF(0),PAF(1),PAF(2),PAF(3)); }
  #undef PKW
  #undef PAF
  #undef VFR
  #undef PIN
  #undef MX3
  #undef GAPA
  #undef GAPB
  #undef EX
  #undef VRD
  #undef KRD
  #undef STEP
  #undef ENDW
  {auto rr=__builtin_amdgcn_permlane32_swap(__float_as_uint(l_reg),__float_as_uint(l_reg),false,false);l_reg=__uint_as_float(rr[0])+__uint_as_float(rr[1]);}
  if(hi==0)wsf[32+r32]=l_reg;asm volatile("s_waitcnt lgkmcnt(0)":::"memory");
  float rli[16];
  #pragma unroll
  for(int r=0;r<16;++r)rli[r]=__builtin_amdgcn_rcpf(wsf[32+crow(r,hi)]);
  bf16*Ow=Ou+(long)(wid*QBLK)*QP; const bf16*Gw=Gu+(long)(wid*QBLK)*QP;
  { bf16*stg=(bf16*)(shm+LDS_OST)+wid*2048;
    #pragma unroll
    for(int r=0;r<16;++r){const int orow=crow(r,hi);
      #pragma unroll
      for(int d0=0;d0<2;++d0)stg[orow*64+d0*32+r32]=__float2bfloat16(o[d0][r]*rli[r]);}
    asm volatile("s_waitcnt lgkmcnt(0)":::"memory");
    #pragma unroll
    for(int i=0;i<4;++i){const int row=i*8+(lane>>3),ch=lane&7; const u32x4 v=*(const u32x4*)(stg+row*64+ch*8); const u32x4 gv=*(const u32x4*)(Gw+(long)row*QP+ch*8); u32x4 w;
      #pragma unroll
      for(int e=0;e<4;++e){const float a0=__uint_as_float(v[e]<<16)*__uint_as_float(gv[e]<<16),a1=__uint_as_float(v[e]&0xffff0000u)*__uint_as_float(gv[e]&0xffff0000u); w[e]=cvtpk_s(a0,a1);}
      *(u32x4*)(Ow+(long)row*QP+ch*8)=w;} }
  asm volatile("s_waitcnt lgkmcnt(0)\n\ts_barrier":::"memory");
  #undef DMA_K
  #undef DMA_V
  #undef CMASK
  #undef START
  #undef RESC
  #undef ROT
}
constexpr int ATTN_LDS_BYTES=LDS_BYTES;
#undef SBAR
#undef WAIT_BAR
}

#define GAS __attribute__((address_space(1)))
#define LAS __attribute__((address_space(3)))
typedef unsigned short bf16;
typedef unsigned v4u __attribute__((ext_vector_type(4)));
typedef float f32x4 __attribute__((ext_vector_type(4)));
typedef short bf16x8 __attribute__((ext_vector_type(8)));
typedef GAS unsigned gu32;
typedef GAS unsigned long long gu64;
#define RLX_AGENT __ATOMIC_RELAXED, __HIP_MEMORY_SCOPE_AGENT
#define LDS_WAIT() asm volatile("s_waitcnt lgkmcnt(0)" ::: "memory")
#define VM_WAIT() asm volatile("s_waitcnt vmcnt(0)" ::: "memory")
__device__ __forceinline__ unsigned long long rt() { return __builtin_amdgcn_s_memrealtime(); }
__device__ __forceinline__ unsigned f2bf(float f) { unsigned u = __builtin_bit_cast(unsigned, f); return (u + 0x7fffu + ((u >> 16) & 1u)) >> 16; }
__device__ __forceinline__ unsigned pk2(float lo, float hi) { return f2bf(lo) | (f2bf(hi) << 16); }

#define XB_TMO      128
#define XB_XCNT(j)  (256  + 64 * (j))
#define XB_XSUB(j)  (1280 + 64 * (j))
#define XB_XGEN(j)  (2304 + 64 * (j))
#define XB_TOP      3328
#define XB_TOPGEN   3392
#define XCD_BAR_WORDS 3456
#define XB_SPIN_CAP (1u << 18)

__device__ __forceinline__ unsigned xb_ld(unsigned* p)              { return __hip_atomic_load(p, __ATOMIC_RELAXED, __HIP_MEMORY_SCOPE_AGENT); }
__device__ __forceinline__ unsigned xb_add(unsigned* p, unsigned v) { return __hip_atomic_fetch_add(p, v, __ATOMIC_RELAXED, __HIP_MEMORY_SCOPE_AGENT); }
__device__ __forceinline__ unsigned xb_xcc_id() { return (unsigned)__builtin_amdgcn_s_getreg((3 << 11) | 20) & 0xFu; }
#define XB_SPIN(cond, bar) do { unsigned _sp = 0; while (cond) { __builtin_amdgcn_s_sleep(1); \
    if ((++_sp & 255u) == 0u) { if (xb_ld(&(bar)[XB_TMO])) break; if (_sp > XB_SPIN_CAP) { atomicAdd(&(bar)[XB_TMO], 1u); break; } } } } while (0)

struct XcdBarrier {
    unsigned* bar; unsigned x;
    volatile LAS unsigned* st;
};

__device__ __forceinline__ XcdBarrier xcd_barrier_post(unsigned* bar, volatile LAS unsigned* st, const int tid) {
    XcdBarrier b; b.bar = bar; b.x = xb_xcc_id(); b.st = st;
    if (tid == 0) (void)xb_add(&bar[XB_XCNT(b.x)], 1u);
    return b;
}
__device__ __forceinline__ void xcd_barrier_complete(unsigned* bar, unsigned x, unsigned& nloc, unsigned& nx) {
    const unsigned G = gridDim.x * gridDim.y * gridDim.z;
    unsigned sum, cnt, mine, sp = 0u;
    for (;;) {
        sum = 0u; cnt = 0u; mine = 0u;
#pragma unroll
        for (unsigned j = 0; j < 16; ++j) { const unsigned c = xb_ld(&bar[XB_XCNT(j)]); sum += c; cnt += (c > 0u) ? 1u : 0u; mine = (j == x) ? c : mine; }
        if (sum == G) break;
        __builtin_amdgcn_s_sleep(1);
        if ((++sp & 255u) == 0u) { if (xb_ld(&bar[XB_TMO])) break; if (sp > XB_SPIN_CAP) { atomicAdd(&bar[XB_TMO], 1u); break; } }
    }
    nloc = mine > 0u ? mine : 1u; nx = cnt > 0u ? cnt : 1u;
}

__device__ __forceinline__ void xcd_barrier(const XcdBarrier& b, const int tid) {
    asm volatile("s_waitcnt vmcnt(0)" ::: "memory");
    __syncthreads();
    if (tid == 0) {
        unsigned* bar = b.bar; asm volatile("" : "+s"(bar));
        __builtin_amdgcn_s_waitcnt(0);
        unsigned nloc = b.st[0], nx = b.st[1];
        if (nloc == 0u) { unsigned xx = b.x; asm volatile("" : "+s"(xx)); xcd_barrier_complete(bar, xx, nloc, nx); b.st[0] = nloc; b.st[1] = nx; }
        const unsigned old = xb_add(&bar[XB_XSUB(b.x)], 1u);
        const unsigned gen = old / nloc;
        if (old + 1u == (gen + 1u) * nloc) {
            __builtin_amdgcn_fence(__ATOMIC_RELEASE, "agent");
            asm volatile("s_waitcnt vmcnt(0)" ::: "memory");
            const unsigned og = xb_add(&bar[XB_TOP], 1u);
            const unsigned tg = og / nx;
            if (og + 1u == (tg + 1u) * nx) xb_add(&bar[XB_TOPGEN], 1u);
            else XB_SPIN(xb_ld(&bar[XB_TOPGEN]) == tg, bar);
            __builtin_amdgcn_fence(__ATOMIC_ACQUIRE, "agent");
            xb_add(&bar[XB_XGEN(b.x)], 1u);
            asm volatile("s_waitcnt vmcnt(0)" ::: "memory");
        } else {
            XB_SPIN(xb_ld(&bar[XB_XGEN(b.x)]) == gen, bar);
            __builtin_amdgcn_fence(__ATOMIC_ACQUIRE, "agent");
            asm volatile("s_waitcnt vmcnt(0)" ::: "memory");
        }
    }
    __syncthreads();
}


constexpr int NWAVES = 8, NTHR = 512, GRID = 256;
constexpr int T_TOK = 8192, T_CTX = 4096, DMOD = 1024, BW = 512, INW = 3328, NCAT = 6400, DEPTH = 4;
constexpr int S_LAT = 2048, LKV = 2304, KVW = 128;
constexpr float RMS_EPS = 1e-6f;
constexpr float QSCALE = 0.125f * 1.4426950408889634f;
constexpr size_t MiB = 1u << 20;
constexpr size_t WS_CTL = 0, CTL_ZERO_BYTES = MiB;
constexpr size_t WS_MODF = 1 * MiB;
constexpr size_t WS_ROPE = 1 * MiB + 768 * 1024;
constexpr size_t WS_A16 = 1 * MiB + 832 * 1024;
constexpr size_t WS_WCAT = 2 * MiB;
constexpr size_t WS_WGLU = 15 * MiB;
constexpr size_t WS_WFN = 16 * MiB;
constexpr size_t WS_WBR = 17 * MiB, WS_WBR2 = 80 * MiB;
constexpr size_t WS_WOUT = 20 * MiB, WS_WOUT2 = 67 * MiB;
__host__ __device__ constexpr size_t ws_wbr(int l) { return (l & 1) ? WS_WBR2 : WS_WBR; }
__host__ __device__ constexpr size_t ws_wout(int l) { return (l & 1) ? WS_WOUT2 : WS_WOUT; }
constexpr size_t WS_BTE = 22 * MiB;
constexpr size_t WS_BTY = 26 * MiB;
constexpr size_t WS_A2L = 34 * MiB;
constexpr size_t WS_GY = 42 * MiB;
constexpr size_t WS_A2C = 50 * MiB;
constexpr size_t WS_A1P = 50 * MiB + 512 * 1024;
constexpr size_t WS_XRES = 51 * MiB;
constexpr size_t WS_G = 83 * MiB;
constexpr size_t WS_H = 131 * MiB;
constexpr size_t WS_VTC = 147 * MiB;
constexpr size_t WS_VTL = 248 * MiB;
constexpr size_t WS_GA = 155 * MiB;
constexpr size_t WS_GF = 163 * MiB;
constexpr size_t WS_Q = 171 * MiB;
constexpr size_t WS_UF = 179 * MiB;
constexpr size_t WS_GC = 187 * MiB;
constexpr size_t WS_KC = 195 * MiB, WS_KL = 196 * MiB;
constexpr size_t WS_VC = WS_KC + 5 * MiB / 2, WS_VL = WS_KL + 5 * MiB / 2;
constexpr size_t WS_PB = 200 * MiB;
constexpr size_t WS_SC = 216 * MiB;
constexpr size_t WS_UH = 232 * MiB;
constexpr size_t WS_END = 256 * MiB;
constexpr int CW_BAR = 4096;
constexpr size_t OUT_K = 8388608, OUT_V = 10485760, OUT_S = 12582912, OUT_N = 13107200;
constexpr int RING_BYTES = 131072, LDSCTL_OFF = RING_BYTES, MISC_OFF = LDSCTL_OFF + 320, LDS_BYTES = 147456;

typedef float f32x2 __attribute__((ext_vector_type(2)));
typedef unsigned u32x2 __attribute__((ext_vector_type(2)));
__device__ __forceinline__ unsigned cvtpk(float lo, float hi) { typedef __bf16 bf16x2_t __attribute__((ext_vector_type(2))); f32x2 v = {lo, hi}; bf16x2_t b = __builtin_convertvector(v, bf16x2_t); return __builtin_bit_cast(unsigned, b); }
__device__ __forceinline__ void st_bf4(bf16* p, f32x4 v) { u32x2 w; w.x = cvtpk(v[0], v[1]); w.y = cvtpk(v[2], v[3]); *(u32x2*)p = w; }
__device__ __forceinline__ f32x4 ld_bf4(const bf16* p) { const u32x2 w = *(const u32x2*)p; f32x4 r; r[0] = __uint_as_float(w.x << 16); r[1] = __uint_as_float(w.x & 0xffff0000u); r[2] = __uint_as_float(w.y << 16); r[3] = __uint_as_float(w.y & 0xffff0000u); return r; }
__device__ __forceinline__ f32x4 bf4_to_f(u32x2 w) { f32x4 r; r[0] = __uint_as_float(w.x << 16); r[1] = __uint_as_float(w.x & 0xffff0000u); r[2] = __uint_as_float(w.y << 16); r[3] = __uint_as_float(w.y & 0xffff0000u); return r; }
__device__ __forceinline__ float bf2f(bf16 h) { return __uint_as_float((unsigned)h << 16); }
__device__ __forceinline__ float sigmoidf_(float x) { return __builtin_amdgcn_rcpf(1.0f + __expf(-x)); }
__device__ __forceinline__ f32x4 sigmoid4(f32x4 v) { f32x4 r; r[0] = sigmoidf_(v[0]); r[1] = sigmoidf_(v[1]); r[2] = sigmoidf_(v[2]); r[3] = sigmoidf_(v[3]); return r; }
__device__ __forceinline__ f32x4 silu4(f32x4 v) { return v * sigmoid4(v); }
__device__ __forceinline__ float gelu_tanh(float x) { const float y = 0.7978845608028654f * (x + 0.044715f * x * x * x); return x * sigmoidf_(2.0f * y); }
__device__ __forceinline__ float shx(float v, int mask, int lane) { return __int_as_float(__builtin_amdgcn_ds_bpermute((lane ^ mask) << 2, __float_as_int(v))); }
__device__ __forceinline__ float wave_sum(float v, int lane) {
#pragma unroll
    for (int o = 1; o < 64; o <<= 1) v += shx(v, o, lane);
    return v;
}

struct KArgs { const float* in[28]; float* out; unsigned char* ws; int ph_lo, ph_hi; };
enum { I_XP = 0, I_XS, I_CK, I_CV, I_ST, I_C, I_CCTX, I_NORMG, I_ADAW, I_ADAB, I_WIN, I_ARE, I_AIM, I_LDT, I_BRE, I_BIM, I_CRE, I_CIM, I_SD, I_GLU, I_FN, I_QG, I_KG, I_WBR, I_MW, I_MB, I_WOUT, I_FG };

struct Ctx {
    LAS unsigned char* lds; int tid, lane, wave, bid, vcu, gw, ngw;
    const float* const* in; float* out; unsigned char* ws;
    template <class Tp> __device__ __forceinline__ Tp* w(size_t off) const { return (Tp*)(ws + off); }
};

__device__ __forceinline__ int epi_opaque(int x) { asm volatile("" : "+v"(x)); return x; }
#define EPI_ROWS for (int ai = 0; ai < 2; ++ai) _Pragma("unroll") for (int m = 0; m < 4; ++m)
#define EPI_BJ for (int bj = 0; bj < 2; ++bj)
#define EPI_ROW epi_opaque(u.pm * 256 + ai * 128 + wr * 64 + m * 16 + fr)
#define EPI_C8 (bj * 128 + wc * 32 + fq * 8)
#define EPI_COL8 (u.pn * 256 + EPI_C8)
typedef const f32x4 (&AccRef)[2][2][4][2];
__device__ __forceinline__ void st_bf8(bf16* p, f32x4 lo, f32x4 hi) { v4u w; w.x = cvtpk(lo[0], lo[1]); w.y = cvtpk(lo[2], lo[3]); w.z = cvtpk(hi[0], hi[1]); w.w = cvtpk(hi[2], hi[3]); *(v4u*)p = w; }
__device__ __forceinline__ f32x4 bf8_lo(v4u w) { f32x4 r; r[0] = __uint_as_float(w.x << 16); r[1] = __uint_as_float(w.x & 0xffff0000u); r[2] = __uint_as_float(w.y << 16); r[3] = __uint_as_float(w.y & 0xffff0000u); return r; }
__device__ __forceinline__ f32x4 bf8_hi(v4u w) { f32x4 r; r[0] = __uint_as_float(w.z << 16); r[1] = __uint_as_float(w.z & 0xffff0000u); r[2] = __uint_as_float(w.w << 16); r[3] = __uint_as_float(w.w & 0xffff0000u); return r; }

struct EpiG1 {
    static constexpr bool PERM = true, AFTER_DRAIN = false;
    unsigned char* ws; float* out; const float *qg, *kg; int layer;
#define EG1_P(name, off) bf16* const name = (bf16*)(ws + (off))
    __device__ __forceinline__ void qkv(AccRef acc, const pg8::Unit& u, int wr, int wc, int fr, int fq) const {
        const int pn = u.pn; const bool isq = pn < 10;
        EG1_P(Q, WS_Q); EG1_P(Kc, WS_KC); EG1_P(Vc, WS_VC); EG1_P(Kl, WS_KL); EG1_P(Vl, WS_VL); float* const outK = out + OUT_K; float* const outV = out + OUT_V; const float* const rope = (const float*)(ws + WS_ROPE);
        const int kind = isq ? 0 : (wc < 2 ? 1 : 2);
        const int head = isq ? (pn - 8) * 4 + wc : (wc & 1);
        f32x4 gv[2][2];
        if (kind == 0) {
#pragma unroll
            EPI_BJ { gv[bj][0] = *(const f32x4*)(qg + layer * 64 + 32 * bj + 8 * fq); gv[bj][1] = *(const f32x4*)(qg + layer * 64 + 32 * bj + 8 * fq + 4); }
        } else {
#pragma unroll
            EPI_BJ { gv[bj][0] = *(const f32x4*)(kg + layer * 64 + 32 * bj + 8 * fq); gv[bj][1] = *(const f32x4*)(kg + layer * 64 + 32 * bj + 8 * fq + 4); }
        }
        const bool lat = u.pm >= 16;
#pragma unroll
        EPI_ROWS {
            const int row = EPI_ROW;
            f32x4 x[2][2];
#pragma unroll
            EPI_BJ { x[bj][0] = acc[ai][bj][m][0]; x[bj][1] = acc[ai][bj][m][1]; }
            if (kind != 2) {
                float ss = 0.f;
#pragma unroll
                EPI_BJ {
#pragma unroll
                    for (int n = 0; n < 2; ++n) { const f32x4 t = x[bj][n]; ss += (t[0] * t[0] + t[1] * t[1]) + (t[2] * t[2] + t[3] * t[3]); } }
                ss += shx(ss, 16, fq * 16 + fr); ss += shx(ss, 32, fq * 16 + fr);
                const float rstd = rsqrtf(ss * (1.0f / 64.0f) + RMS_EPS);
#pragma unroll
                EPI_BJ { x[bj][0] = x[bj][0] * rstd * gv[bj][0]; x[bj][1] = x[bj][1] * rstd * gv[bj][1]; }
            }
            int b, s;
            if (lat) { const int tl = row - T_CTX; b = tl >> 11; s = tl & 2047; } else { b = row >> 8; s = row & 255; }
            if (lat && kind != 2) {
                const int gr = s >> 6, gc = s & 63;
#pragma unroll
                EPI_BJ {
#pragma unroll
                    for (int n = 0; n < 2; ++n) { const int pos = bj ? gc : gr; const f32x4 cs = *(const f32x4*)(rope + (pos * 16 + 4 * fq + 2 * n) * 2); const f32x4 t = x[bj][n];
                        f32x4 r; r[0] = t[0] * cs[0] - t[1] * cs[1]; r[1] = t[0] * cs[1] + t[1] * cs[0]; r[2] = t[2] * cs[2] - t[3] * cs[3]; r[3] = t[2] * cs[3] + t[3] * cs[2]; x[bj][n] = r; } }
            }
#pragma unroll
            EPI_BJ { const int j = 32 * bj + 8 * fq;
                const size_t ol = ((size_t)b * LKV + s) * KVW + head * 64 + j, oc = (size_t)row * KVW + head * 64 + j, oo = (((size_t)b * DEPTH + layer) * 256 + s) * KVW + head * 64 + j;
                if (kind == 0) st_bf8(Q + (size_t)row * 512 + head * 64 + j, x[bj][0] * QSCALE, x[bj][1] * QSCALE);
                else if (kind == 1) { if (lat) st_bf8(Kl + ol, x[bj][0], x[bj][1]); else { st_bf8(Kc + oc, x[bj][0], x[bj][1]); *(f32x4*)(outK + oo) = x[bj][0]; *(f32x4*)(outK + oo + 4) = x[bj][1]; } }
                else { if (lat) st_bf8(Vl + ol, x[bj][0], x[bj][1]); else { st_bf8(Vc + oc, x[bj][0], x[bj][1]); *(f32x4*)(outV + oo) = x[bj][0]; *(f32x4*)(outV + oo + 4) = x[bj][1]; } } }
            asm volatile("" ::: "memory");
        }
    }
    __device__ __forceinline__ void operator()(AccRef acc, const pg8::Unit& u, int wr, int wc, int fr, int fq) const {
        const int pn = u.pn;
        if (pn >= 8 && pn <= 10) { qkv(acc, u, wr, wc, fr, fq); return; }
        EG1_P(UH, WS_UH); EG1_P(GA, WS_GA); EG1_P(UF, WS_UF); EG1_P(GF, WS_GF); EG1_P(GC, WS_GC);
#pragma unroll
        EPI_ROWS { const int row = EPI_ROW;
#pragma unroll
            EPI_BJ { const int col = EPI_COL8; const f32x4 lo = acc[ai][bj][m][0], hi = acc[ai][bj][m][1];
                if (pn < 2) { const int g = col >> 4, q = col & 15; st_bf8(UH + ((size_t)g * 512 + (row >> 4)) * 512 + (row & 15) * 16 + q, lo, hi); }
                else if (pn < 4) st_bf8(GA + (size_t)row * 512 + (col - 512), silu4(lo), silu4(hi));
                else if (pn < 6) st_bf8(UF + (size_t)row * 512 + (col - 1024), lo, hi);
                else if (pn < 8) st_bf8(GF + (size_t)row * 512 + (col - 1536), silu4(lo), silu4(hi));
                else st_bf8(GC + (size_t)row * 512 + (col - 2816), silu4(lo), silu4(hi));
            } }
    }
};
struct EpiMerge {
    static constexpr bool PERM = true, AFTER_DRAIN = false;
    bf16* Gm; const float* mb;
    __device__ __forceinline__ void operator()(AccRef acc, const pg8::Unit& u, int wr, int wc, int fr, int fq) const {
        f32x4 bb[2][2];
#pragma unroll
        EPI_BJ { bb[bj][0] = *(const f32x4*)(mb + EPI_COL8); bb[bj][1] = *(const f32x4*)(mb + EPI_COL8 + 4); }
#pragma unroll
        EPI_ROWS { const size_t row = EPI_ROW;
#pragma unroll
            EPI_BJ st_bf8(Gm + row * 3072 + EPI_COL8, sigmoid4(acc[ai][bj][m][0] + bb[bj][0]), sigmoid4(acc[ai][bj][m][1] + bb[bj][1])); }
    }
};
struct EpiS5A {
    static constexpr bool PERM = true, AFTER_DRAIN = false;
    float* SC;
    __device__ __forceinline__ void operator()(AccRef acc, const pg8::Unit& u, int wr, int wc, int fr, int fq) const {
#pragma unroll
        EPI_ROWS { const int chunk = EPI_ROW;
#pragma unroll
            EPI_BJ { float* p = SC + ((size_t)u.z * 512 + chunk) * 256 + EPI_C8; *(f32x4*)p = acc[ai][bj][m][0]; *(f32x4*)(p + 4) = acc[ai][bj][m][1]; } }
    }
};
__device__ __forceinline__ f32x4 gelu4(f32x4 y) { y[0] = gelu_tanh(y[0]); y[1] = gelu_tanh(y[1]); y[2] = gelu_tanh(y[2]); y[3] = gelu_tanh(y[3]); return y; }
struct EpiS5B {
    static constexpr bool PERM = true, AFTER_DRAIN = false;
    bf16* GY;
    __device__ __forceinline__ void operator()(AccRef acc, const pg8::Unit& u, int wr, int wc, int fr, int fq) const {
#pragma unroll
        EPI_ROWS { const int chunk = EPI_ROW;
#pragma unroll
            EPI_BJ { const int col = EPI_C8, t = col >> 4, p = col & 15; st_bf8(GY + ((size_t)chunk * 16 + t) * 512 + u.z * 16 + p, gelu4(acc[ai][bj][m][0]), gelu4(acc[ai][bj][m][1])); } }
    }
};
struct EpiDFT1C {
    static constexpr bool PERM = true, AFTER_DRAIN = false;
    bf16* VtC;
    __device__ __forceinline__ void operator()(AccRef acc, const pg8::Unit& u, int wr, int wc, int fr, int fq) const {
        const int grp = 2 * u.z + u.pm;
#pragma unroll
        EPI_ROWS { const int j = epi_opaque(wr * 64 + m * 16 + fr), reim = ai;
#pragma unroll
            EPI_BJ { const int tok = EPI_COL8, b = tok >> 8, s = tok & 255; st_bf8(VtC + ((size_t)b * 512 + grp * 128 + j) * 512 + reim * 256 + s, acc[ai][bj][m][0], acc[ai][bj][m][1]); } }
    }
};
struct EpiDFT1L {
    static constexpr bool PERM = true, AFTER_DRAIN = false;
    bf16* VtL;
    __device__ __forceinline__ void operator()(AccRef acc, const pg8::Unit& u, int wr, int wc, int fr, int fq) const {
        const int grp = 2 * u.z + u.pm, b = u.pn >> 4, nn = u.pn & 15;
#pragma unroll
        EPI_ROWS { const int j = epi_opaque(wr * 64 + m * 16 + fr), reim = ai; bf16* dst = VtL + ((size_t)b * 512 + grp * 128 + j) * 2048 + reim * 1024 + nn * 128 + wc * 32 + fq * 8;
            st_bf8(dst, acc[ai][0][m][0] + acc[ai][1][m][0], acc[ai][0][m][1] + acc[ai][1][m][1]);
            st_bf8(dst + (size_t)1024 * 2048, acc[ai][0][m][0] - acc[ai][1][m][0], acc[ai][0][m][1] - acc[ai][1][m][1]); }
    }
};
struct EpiDFT2 {
    static constexpr bool PERM = true, AFTER_DRAIN = false;
    bf16* ZF; int lat, half;
    __device__ __forceinline__ void operator()(AccRef acc, const pg8::Unit& u, int wr, int wc, int fr, int fq) const {
#pragma unroll
        EPI_ROWS { const int k = EPI_ROW;
#pragma unroll
            EPI_BJ { const int col = EPI_COL8, b = col >> 9, ch = col & 511;
                bf16* dst = lat ? ZF + ((size_t)b * 2048 + 2 * k + u.z) * 1024 + half * 512 + ch : ZF + ((size_t)b * 256 + k) * 512 + ch;
                st_bf8(dst, acc[ai][bj][m][0], acc[ai][bj][m][1]); } }
    }
};
#define EPI_BATCH for (int ai = 0; ai < 2; ++ai)
#define EPI_M for (int m = 0; m < 4; ++m)
struct EpiGLU {
    static constexpr bool PERM = true, AFTER_DRAIN = false;
    bf16* GA;
    __device__ __forceinline__ void operator()(AccRef acc, const pg8::Unit& u, int wr, int wc, int fr, int fq) const {
#pragma unroll
        EPI_BATCH { v4u gl[4];
#pragma unroll
            EPI_M { const size_t row = EPI_ROW; gl[m] = *(const v4u*)(GA + row * 512 + u.pn * 128 + wc * 32 + fq * 8); }
            asm volatile("" ::: "memory");
#pragma unroll
            EPI_M { const size_t row = EPI_ROW;
                st_bf8(GA + row * 512 + u.pn * 128 + wc * 32 + fq * 8, acc[ai][0][m][0] * sigmoid4(acc[ai][1][m][0]) * bf8_lo(gl[m]), acc[ai][0][m][1] * sigmoid4(acc[ai][1][m][1]) * bf8_hi(gl[m])); }
            asm volatile("" ::: "memory"); }
    }
};
struct EpiMul {
    static constexpr bool PERM = true, AFTER_DRAIN = false;
    bf16* GF;
    __device__ __forceinline__ void operator()(AccRef acc, const pg8::Unit& u, int wr, int wc, int fr, int fq) const {
#pragma unroll
        EPI_BATCH { v4u gl[4][2];
#pragma unroll
            EPI_M { const size_t row = EPI_ROW;
#pragma unroll
                EPI_BJ gl[m][bj] = *(const v4u*)(GF + row * 512 + EPI_COL8); }
            asm volatile("" ::: "memory");
#pragma unroll
            EPI_M { const size_t row = EPI_ROW;
#pragma unroll
                EPI_BJ st_bf8(GF + row * 512 + EPI_COL8, acc[ai][bj][m][0] * bf8_lo(gl[m][bj]), acc[ai][bj][m][1] * bf8_hi(gl[m][bj])); }
            asm volatile("" ::: "memory"); }
    }
};
struct EpiG4 {
    static constexpr bool PERM = true, AFTER_DRAIN = false;
    const bf16* Gm; bf16* PB; bf16* MG; int mode0;
    __device__ __forceinline__ void operator()(AccRef acc, const pg8::Unit& u, int wr, int wc, int fr, int fq) const {
        const int mode = mode0 + u.z, gsel = mode == 0 ? 2 : mode - 1;
#pragma unroll
        EPI_BATCH { v4u gl[4][2], pl[4][2];
#pragma unroll
            EPI_M { const size_t row = EPI_ROW;
#pragma unroll
                EPI_BJ { gl[m][bj] = *(const v4u*)(Gm + row * 3072 + gsel * 1024 + EPI_COL8); if (mode > 0) pl[m][bj] = *(const v4u*)(PB + row * 1024 + EPI_COL8); } }
            asm volatile("" ::: "memory");
#pragma unroll
            EPI_M { const size_t row = EPI_ROW;
#pragma unroll
                EPI_BJ { f32x4 lo = acc[ai][bj][m][0] * bf8_lo(gl[m][bj]), hi = acc[ai][bj][m][1] * bf8_hi(gl[m][bj]); if (mode > 0) { lo += bf8_lo(pl[m][bj]); hi += bf8_hi(pl[m][bj]); }
                    if (mode < 2) st_bf8(PB + row * 1024 + EPI_COL8, lo, hi); else st_bf8(MG + row * 1024 + EPI_COL8, lo, hi); } }
            asm volatile("" ::: "memory"); }
    }
};
struct EpiChainA {
    const bf16* Gm; const bf16* PB;
    __device__ __forceinline__ void operator()(f32x4 (&acc)[2][2][4][2], const pg8::Unit& u, int wr, int wc, int fr, int fq) const {
#pragma unroll
        for (int ai = 0; ai < 2; ++ai)
#pragma unroll
            for (int mh = 0; mh < 2; ++mh) { v4u g0[2][2], g1[2][2], pl[2][2];
#pragma unroll
                for (int mm = 0; mm < 2; ++mm) { const int m = 2 * mh + mm; const size_t row = EPI_ROW;
#pragma unroll
                    EPI_BJ { g0[mm][bj] = *(const v4u*)(Gm + row * 3072 + EPI_COL8); g1[mm][bj] = *(const v4u*)(Gm + row * 3072 + 1024 + EPI_COL8); pl[mm][bj] = *(const v4u*)(PB + row * 1024 + EPI_COL8); } }
                asm volatile("" ::: "memory");
#pragma unroll
                for (int mm = 0; mm < 2; ++mm) { const int m = 2 * mh + mm;
#pragma unroll
                    EPI_BJ { f32x4 lo = acc[ai][bj][m][0] * bf8_lo(g0[mm][bj]) + bf8_lo(pl[mm][bj]), hi = acc[ai][bj][m][1] * bf8_hi(g0[mm][bj]) + bf8_hi(pl[mm][bj]);
                        const f32x4 gl = bf8_lo(g1[mm][bj]), gh = bf8_hi(g1[mm][bj]);
#pragma unroll
                        for (int e = 0; e < 4; ++e) { lo[e] *= __builtin_amdgcn_rcpf(fmaxf(gl[e], 1e-6f)); hi[e] *= __builtin_amdgcn_rcpf(fmaxf(gh[e], 1e-6f)); }
                        acc[ai][bj][m][0] = lo; acc[ai][bj][m][1] = hi; } }
                asm volatile("" ::: "memory"); }
    }
};
struct EpiChainF {
    const bf16* Gm; bf16* MG;
    __device__ __forceinline__ void operator()(AccRef acc, const pg8::Unit& u, int wr, int wc, int fr, int fq) const {
#pragma unroll
        EPI_BATCH { v4u g1[4][2];
#pragma unroll
            EPI_M { const size_t row = EPI_ROW;
#pragma unroll
                EPI_BJ g1[m][bj] = *(const v4u*)(Gm + row * 3072 + 1024 + EPI_COL8); }
            asm volatile("" ::: "memory");
#pragma unroll
            EPI_M { const size_t row = EPI_ROW;
#pragma unroll
                EPI_BJ { const f32x4 gl = bf8_lo(g1[m][bj]), gh = bf8_hi(g1[m][bj]); f32x4 lo = acc[ai][bj][m][0], hi = acc[ai][bj][m][1];
#pragma unroll
                    for (int e = 0; e < 4; ++e) { lo[e] *= fmaxf(gl[e], 1e-6f); hi[e] *= fmaxf(gh[e], 1e-6f); }
                    st_bf8(MG + row * 1024 + EPI_COL8, lo, hi); } }
            asm volatile("" ::: "memory"); }
    }
};
struct EpiG5 {
    static constexpr bool PERM = true, AFTER_DRAIN = false;
    bf16 *T0, *T1;
    __device__ __forceinline__ void operator()(AccRef acc, const pg8::Unit& u, int wr, int wc, int fr, int fq) const {
        bf16* T = u.z ? T1 : T0;
#pragma unroll
        EPI_ROWS { const size_t row = EPI_ROW;
#pragma unroll
            EPI_BJ st_bf8(T + row * 1024 + EPI_COL8, acc[ai][bj][m][0], acc[ai][bj][m][1]); }
    }
};

enum { K_G1 = 0, K_MERGE, K_S5A, K_S5B, K_DFT1C, K_DFT1L, K_DFT2C, K_DFT2L0, K_DFT2L1, K_GLU, K_FN, K_PC, K_PA, K_PF, K_G5 };
__device__ __forceinline__ int xswz(int L, int n) { return (L & 7) * (n >> 3) + (L >> 3); }
#define PS_W(off) ((const bf16*)(ws + (off)))
struct PhaseSched {
    int sub, c, bid; unsigned char* ws; int layer;
    __device__ __forceinline__ void mk(pg8::UDesc& d, const bf16* A, const bf16* Bt, int lda, int ldb, int K, int hB, int kind, int pm, int pn, int z) const {
        d.A = A; d.Bt = Bt; d.lda = lda; d.ldb = ldb; d.K = K; d.hB = hB; d.kind = kind; d.pm = pm; d.pn = pn; d.z = z; d.keep = (kind == K_PF); }
    __device__ __forceinline__ void mk_merge(pg8::UDesc& d, int M, unsigned char* ws) const {
        int pm, pn; if (M < 128) { pm = M >> 2; pn = 8 + (M & 3); } else { pm = (M - 128) >> 3; pn = (M - 128) & 7; }
        mk(d, PS_W(WS_H) + (size_t)pm * 256 * 1024, PS_W(WS_WCAT) + (size_t)(INW + pn * 256) * 1024, 1024, 1024, 1024, 128, K_MERGE, pm, pn, 0); }
    __device__ __forceinline__ bool next(int i, pg8::UDesc& d) const {
        unsigned char* ws = this->ws; asm volatile("" : "+s"(ws));
        if (sub == 1) {
            if (i > 1) return false;
            pg8::StaticOrder so; so.init(T_TOK, INW, GRID, bid); pg8::Unit u;
            if (so.next(i, u)) { mk(d, PS_W(WS_H) + (size_t)u.pm * 256 * 1024, PS_W(WS_WCAT) + (size_t)u.pn * 256 * 1024, 1024, 1024, 1024, 128, K_G1, u.pm, u.pn, 0); return true; }
            if (bid >= 160) { mk_merge(d, xswz(bid - 160, 96), ws); return true; }
            return false;
        }
        if (sub == 2) {
            if (c < 128) return false;
            if (c < 192) { const int L = xswz(c - 128, 64);
                if (i == 0) { const int g = L >> 1, pm = L & 1; mk(d, PS_W(WS_UH) + ((size_t)g * 512 + pm * 256) * 512, PS_W(WS_BTE) + (size_t)g * 256 * 256, 512, 256, 256, 128, K_S5A, pm, 0, g); return true; }
                if (i == 1) { const int pair = L >> 5, gl = (L >> 4) & 1, pn = L & 15; mk(d, PS_W(WS_A1P) + (size_t)gl * 256 * 256, PS_W(WS_UF) + (size_t)pn * 256 * 512 + pair * 256, 256, 512, 256, 128, K_DFT1C, gl, pn, pair); return true; }
                if (i == 2) { mk_merge(d, 96 + xswz(c - 128, 128), ws); return true; }
                return false; }
            const int L = xswz(c - 192, 64);
            if (i == 0) { const int pair = L >> 5, gl = (L >> 4) & 1, r = L & 15, pn2 = (r >> 3) * 16 + (r & 7);
                mk(d, PS_W(WS_A1P) + (size_t)gl * 256 * 256, PS_W(WS_UF) + ((size_t)T_CTX + pn2 * 128) * 512 + pair * 256, 256, 512, 256, 1024, K_DFT1L, gl, pn2, pair); return true; }
            if (i == 1) { mk_merge(d, 96 + xswz(c - 128, 128), ws); return true; }
            return false;
        }
        if (sub == 3) {
            if (c < 64) { if (i > 0) return false; const int half = c >> 5, L = xswz(c & 31, 32), z = L >> 4, pm = (L >> 2) & 3, pn = L & 3;
                mk(d, PS_W(WS_A2L) + ((size_t)z * 1024 + pm * 256) * 2048 + half * 1024, PS_W(WS_VTL) + ((size_t)z * 1024 + pn * 256) * 2048 + half * 1024, 2048, 2048, 1024, 128, half ? K_DFT2L1 : K_DFT2L0, pm, pn, z); return true; }
            if (c < 128) { if (i > 0) return false; const int L = xswz(c - 64, 64), g = L >> 1, pm = L & 1;
                mk(d, PS_W(WS_UH) + ((size_t)g * 512 + pm * 256) * 512, PS_W(WS_BTY) + (size_t)g * 256 * 512, 512, 512, 512, 128, K_S5B, pm, 0, g); return true; }
            if (i == 0) { const int L = xswz(c - 128, 128), pm = L >> 2, pn = L & 3; mk(d, PS_W(WS_Q) + (size_t)pm * 256 * 512, PS_W(ws_wbr(layer)) + ((size_t)2 * 1024 + pn * 256) * 512, 512, 512, 512, 128, K_PC, pm, pn, 0); return true; }
            if (i == 1) { if (c < 160) { const int pn = xswz(c - 128, 32); mk(d, PS_W(WS_A2C), PS_W(WS_VTC) + (size_t)pn * 256 * 512, 512, 512, 512, 128, K_DFT2C, 0, pn, 0); return true; }
                mk_merge(d, 224 + xswz(c - 160, 96), ws); return true; }
            return false;
        }
        if (sub == 4) {
            if (i > 0) return false;
            if (c < 128) { const int L = xswz(c, 128), pm = L >> 2, pn = L & 3; mk(d, PS_W(WS_GY) + (size_t)pm * 256 * 512, PS_W(WS_WGLU) + (size_t)pn * 256 * 512, 512, 512, 512, 128, K_GLU, pm, pn, 0); return true; }
            if (c < 160) { const int L = xswz(c - 128, 32), pm = L >> 1, pn = L & 1; mk(d, PS_W(WS_UF) + (size_t)pm * 256 * 512, PS_W(WS_WFN) + (size_t)pn * 256 * 1024, 512, 1024, 512, 128, K_FN, pm, pn, 0); return true; }
            if (c < 192) { const int L = xswz(c - 160, 32), pm = L >> 1, pn = L & 1; mk(d, PS_W(WS_GC) + (size_t)pm * 256 * 1024, PS_W(WS_WFN) + (size_t)pn * 256 * 1024, 1024, 1024, 1024, 128, K_FN, 16 + pm, pn, 0); return true; }
            mk_merge(d, 320 + xswz(c - 192, 64), ws); return true;
        }
        if (sub == 5) {
            if (c >= 128 || i > 1) return false;
            const int t = (c & 7) * 16 + (c >> 3), pm = t >> 2, pn = t & 3;
            if (i == 0) mk(d, PS_W(WS_GA) + (size_t)pm * 256 * 512, PS_W(ws_wbr(layer)) + (size_t)pn * 256 * 512, 512, 512, 512, 128, K_PA, pm, pn, 0);
            else mk(d, PS_W(WS_GF) + (size_t)pm * 256 * 512, PS_W(ws_wbr(layer)) + ((size_t)1024 + pn * 256) * 512, 512, 512, 512, 128, K_PF, pm, pn, 0);
            return true;
        }
        if (i > 0) return false;
        { const int L = xswz(c, 256), z = L & 1, pm = L >> 3, pn = (L >> 1) & 3; mk(d, PS_W(WS_H) + (size_t)pm * 256 * 1024 + z * 512, PS_W(ws_wout(layer)) + (size_t)pn * 256 * 1024 + z * 512, 1024, 1024, 512, 128, K_G5, pm, pn, z); return true; }
    }
};
struct EpiAll {
    unsigned char* ws; float* out; const float* const* in; int layer;
    __device__ __forceinline__ bool transform(f32x4 (&acc)[2][2][4][2], const pg8::UDesc& d, int wr, int wc, int fr, int fq) const {
        if (d.kind != K_PA) return false;
        asm volatile("" : "+v"(fr), "+v"(fq), "+s"(wr), "+s"(wc));
        unsigned char* ws = this->ws; asm volatile("" : "+s"(ws));
        EpiChainA{(const bf16*)(ws + WS_G), (const bf16*)(ws + WS_PB)}(acc, pg8::Unit{d.pm, d.pn, d.z}, wr, wc, fr, fq); return true; }
    __device__ __forceinline__ void operator()(AccRef acc, const pg8::UDesc& d, int wr, int wc, int fr, int fq) const {
        asm volatile("" : "+v"(fr), "+v"(fq), "+s"(wr), "+s"(wc));
        const pg8::Unit u{d.pm, d.pn, d.z}; const int kind = d.kind;
        unsigned char* ws = this->ws; float* out = this->out; asm volatile("" : "+s"(ws), "+s"(out));
#define EA_P(off) ((bf16*)(ws + (off)))
        if (kind == K_G1) EpiG1{ws, out, in[I_QG], in[I_KG], layer}(acc, u, wr, wc, fr, fq);
        else if (kind == K_MERGE) EpiMerge{EA_P(WS_G), in[I_MB] + (size_t)layer * 3072}(acc, u, wr, wc, fr, fq);
        else if (kind == K_S5A) EpiS5A{(float*)(ws + WS_SC)}(acc, u, wr, wc, fr, fq);
        else if (kind == K_S5B) EpiS5B{EA_P(WS_GY)}(acc, u, wr, wc, fr, fq);
        else if (kind == K_DFT1C) EpiDFT1C{EA_P(WS_VTC)}(acc, u, wr, wc, fr, fq);
        else if (kind == K_DFT1L) EpiDFT1L{EA_P(WS_VTL)}(acc, u, wr, wc, fr, fq);
        else if (kind == K_DFT2C) EpiDFT2{EA_P(WS_UF), 0, 0}(acc, u, wr, wc, fr, fq);
        else if (kind == K_DFT2L0) EpiDFT2{EA_P(WS_GC), 1, 0}(acc, u, wr, wc, fr, fq);
        else if (kind == K_DFT2L1) EpiDFT2{EA_P(WS_GC), 1, 1}(acc, u, wr, wc, fr, fq);
        else if (kind == K_GLU) EpiGLU{EA_P(WS_GA)}(acc, u, wr, wc, fr, fq);
        else if (kind == K_FN) EpiMul{EA_P(WS_GF)}(acc, u, wr, wc, fr, fq);
        else if (kind == K_PC) EpiG4{EA_P(WS_G), EA_P(WS_PB), EA_P(WS_H), 0}(acc, u, wr, wc, fr, fq);
        else if (kind == K_PF) EpiChainF{EA_P(WS_G), EA_P(WS_H)}(acc, u, wr, wc, fr, fq);
        else EpiG5{EA_P(WS_PB), EA_P(WS_GA)}(acc, u, wr, wc, fr, fq);
#undef EA_P
    }
};

template <class RowMap>
__device__ __forceinline__ void transpose_item(const float* W, int K, int N, bf16* WT, const RowMap& rm, LAS float* scr, int item, int lane, int pitch = 0, int dup = 0) {
    if (pitch == 0) pitch = K;
    const int nblk = N / 32, kb = item / nblk, nb = item % nblk, k0 = 64 * kb, n0 = 32 * nb;
    { f32x4 w[8];
#pragma unroll
      for (int i = 0; i < 8; ++i) w[i] = *(const f32x4*)(W + (size_t)(k0 + 8 * i + (lane >> 3)) * N + n0 + 4 * (lane & 7));
#pragma unroll
      for (int i = 0; i < 8; ++i) { LAS float* d = scr + (8 * i + (lane >> 3)) * 33 + 4 * (lane & 7); d[0] = w[i][0]; d[1] = w[i][1]; d[2] = w[i][2]; d[3] = w[i][3]; } }
    LDS_WAIT(); asm volatile("" ::: "memory");
    const int c = lane & 7;
#pragma unroll
    for (int j = 0; j < 4; ++j) { const int n = (lane >> 3) + 8 * j; const LAS float* s = scr + (8 * c) * 33 + n;
        v4u o; o.x = cvtpk(s[0 * 33], s[1 * 33]); o.y = cvtpk(s[2 * 33], s[3 * 33]); o.z = cvtpk(s[4 * 33], s[5 * 33]); o.w = cvtpk(s[6 * 33], s[7 * 33]);
        bf16* dp = WT + (size_t)rm(n0 + n) * pitch + k0 + 8 * c; *(v4u*)dp = o; if (dup) *(v4u*)(dp + dup) = o; }
    LDS_WAIT(); asm volatile("" ::: "memory");
}
struct RmId { int off; __device__ __forceinline__ int operator()(int n) const { return off + n; } };
struct RmWin { __device__ __forceinline__ int operator()(int n) const {
        if (n < 2048 || n >= 2816) return n; const int t = (n - 2048) >> 8, cl = (n - 2048) & 255, hh = cl >> 6, jl = cl & 63; return 2048 + t * 256 + 128 * (jl >> 5) + 32 * hh + (jl & 31); } };
struct RmGlu { __device__ __forceinline__ int operator()(int c) const { const int half = c >> 9, cc = c & 511; return 256 * (cc >> 7) + 128 * half + (cc & 127); } };

__device__ __forceinline__ void ph_prologue(const Ctx& C) {
    LAS float* sil = (LAS float*)C.lds;
    LAS float* red = sil + 3072;
    for (int item = C.bid; item < 192; item += GRID) {
        const int l = item / 48, ch = item % 48;
        for (int i = C.tid; i < 3072; i += NTHR) { const float x = i < 1024 ? C.in[I_CCTX][i] : C.in[I_C][i - 1024]; sil[i] = x * sigmoidf_(x); }
        __syncthreads();
        const float* W = C.in[I_ADAW] + (size_t)l * 1024 * 3072 + ch * 64 + C.lane;
        float a0 = 0.f, a1 = 0.f, a2 = 0.f;
        for (int i0 = 0; i0 < 128; i0 += 32) { float w[32];
#pragma unroll
            for (int i = 0; i < 32; ++i) w[i] = W[(size_t)(C.wave * 128 + i0 + i) * 3072];
#pragma unroll
            for (int i = 0; i < 32; ++i) { const int k = C.wave * 128 + i0 + i; a0 += w[i] * sil[k]; a1 += w[i] * sil[1024 + k]; a2 += w[i] * sil[2048 + k]; } }
        red[(C.wave * 3 + 0) * 64 + C.lane] = a0; red[(C.wave * 3 + 1) * 64 + C.lane] = a1; red[(C.wave * 3 + 2) * 64 + C.lane] = a2;
        __syncthreads();
        if (C.tid < 192) { const int ci = C.tid >> 6, col = ch * 64 + (C.tid & 63); float s = C.in[I_ADAB][(size_t)l * 3072 + col];
#pragma unroll
            for (int w = 0; w < 8; ++w) s += red[(w * 3 + ci) * 64 + (C.tid & 63)];
            if (col >= 1024 && col < 2048) s = (1.0f + s) * C.in[I_NORMG][l * 1024 + col - 1024];
            C.w<float>(WS_MODF)[((size_t)l * 3 + ci) * 3072 + col] = s; }
        __syncthreads();
    }
    const int gt = C.bid * NTHR + C.tid, ngt = GRID * NTHR;
    constexpr int T_A2L = 2048 * 2048 / 8, T_A2C = 256 * 512 / 8, T_A1P = 512 * 256 / 8;
    for (int t = gt; t < T_A2L + T_A2C + T_A1P; t += ngt) {
        float v[8]; bf16* dst;
        if (t < T_A2L) { const int r = t >> 8, c0 = (t & 255) * 8, kk = 2 * (r & 1023) + (r >> 10); dst = C.w<bf16>(WS_A2L) + (size_t)r * 2048 + c0;
#pragma unroll
            for (int e = 0; e < 8; ++e) { const int col = c0 + e, s = col & 1023, mm = (kk * s) & 2047; float sn, cs; sincospif((float)mm * (1.0f / 1024.0f), &sn, &cs); v[e] = (col < 1024 ? cs : sn) * 0.02209708691207961f; } }
        else if (t < T_A2L + T_A2C) { const int tt = t - T_A2L, k = tt >> 6, c0 = (tt & 63) * 8; dst = C.w<bf16>(WS_A2C) + (size_t)k * 512 + c0;
#pragma unroll
            for (int e = 0; e < 8; ++e) { const int col = c0 + e, s = col & 255, mm = (k * s) & 255; float sn, cs; sincospif((float)mm * (1.0f / 128.0f), &sn, &cs); v[e] = (col < 256 ? cs : sn) * 0.0625f; } }
        else { const int tt = t - T_A2L - T_A2C, r = tt >> 5, c0 = (tt & 31) * 8; dst = C.w<bf16>(WS_A1P) + (size_t)r * 256 + c0; const int gl = r >> 8, reim = (r >> 7) & 1, j = r & 127;
#pragma unroll
            for (int e = 0; e < 8; ++e) { const int col = c0 + e, glc = col >> 7, c = col & 127, mm = (j * c) & 127; float sn, cs; sincospif((float)mm * (1.0f / 64.0f), &sn, &cs);
                v[e] = (glc == gl) ? (reim ? -sn : cs) * 0.08838834764831845f : 0.f; } }
        v4u o; o.x = cvtpk(v[0], v[1]); o.y = cvtpk(v[2], v[3]); o.z = cvtpk(v[4], v[5]); o.w = cvtpk(v[6], v[7]); *(v4u*)dst = o;
    }
    if (gt < 1024) { const int pos = gt >> 4, f = gt & 15; const float inv = powf(10000.0f, -(float)f / 16.0f), ang = (float)pos * inv;
        C.w<float>(WS_ROPE)[gt * 2] = cosf(ang); C.w<float>(WS_ROPE)[gt * 2 + 1] = sinf(ang); }
}

__device__ __forceinline__ void s5_mats_block(const Ctx& C, int l, int g, int part) {
    LAS f32x2* pw = (LAS f32x2*)C.lds;
    LAS f32x2* Bb = pw + 2 * 17 * 64;
    LAS f32x2* Cm = Bb + 2 * 64 * 16;
    LAS float* Kl = (LAS float*)(Cm + 2 * 16 * 64);
    const int tid = C.tid;
    if (tid < 128) {
        const int d = tid >> 6, n = tid & 63; const size_t gi = ((size_t)(l * 2 + d) * 32 + g);
        const float lr = C.in[I_ARE][gi * 64 + n], li = C.in[I_AIM][gi * 64 + n], dt = expf(C.in[I_LDT][gi]);
        float mag = expf(dt * lr), sn, cs; sincosf(dt * li, &sn, &cs);
        { const float are = mag * cs, aim = mag * sn; float pr = 1.0f, pi = 0.0f;
          for (int tau = 0; tau <= 16; ++tau) { pw[(d * 17 + tau) * 64 + n] = (f32x2){pr, pi}; const float nr = pr * are - pi * aim, ni = pr * aim + pi * are; pr = nr; pi = ni; } }
        const float x = mag * cs - 1.0f, y = mag * sn, den = 1.0f / (lr * lr + li * li), cr = (x * lr + y * li) * den, cim = (y * lr - x * li) * den;
        const float* br = C.in[I_BRE] + (gi * 64 + n) * 16; const float* bi = C.in[I_BIM] + (gi * 64 + n) * 16;
#pragma unroll
        for (int q = 0; q < 16; ++q) Bb[(d * 64 + n) * 16 + q] = (f32x2){cr * br[q] - cim * bi[q], cr * bi[q] + cim * br[q]};
        if (part == 0) { const f32x2 p16 = pw[(d * 17 + 16) * 64 + n]; C.w<float>(WS_A16)[(gi * 64 + n) * 2] = p16.x; C.w<float>(WS_A16)[(gi * 64 + n) * 2 + 1] = p16.y; }
    }
    for (int idx = tid; idx < 2048; idx += NTHR) { const int d = idx >> 10, p = (idx >> 6) & 15, n = idx & 63; const size_t o = (((size_t)(l * 2 + d) * 32 + g) * 16 + p) * 64 + n;
        Cm[idx] = (f32x2){C.in[I_CRE][o], C.in[I_CIM][o]}; }
    __syncthreads();
    {
        const int d = tid >> 8, p = (tid >> 4) & 15, q = tid & 15; float a0 = 0.f, a1 = 0.f;
        for (int n = 0; n < 64; ++n) { const f32x2 c = Cm[(d * 16 + p) * 64 + n], bq = Bb[(d * 64 + n) * 16 + q]; const float wr = c.x * bq.x - c.y * bq.y, wi = c.x * bq.y + c.y * bq.x;
            const f32x2 p0 = pw[(d * 17 + 2 * part) * 64 + n], p1 = pw[(d * 17 + 2 * part + 1) * 64 + n]; a0 += wr * p0.x - wi * p0.y; a1 += wr * p1.x - wi * p1.y; }
        Kl[(d * 2 + 0) * 256 + p * 16 + q] = a0; Kl[(d * 2 + 1) * 256 + p * 16 + q] = a1;
    }
    __syncthreads();
    bf16* BtE = C.w<bf16>(WS_BTE) + (size_t)g * 256 * 256; bf16* BtY = C.w<bf16>(WS_BTY) + (size_t)g * 256 * 512;
    const float* dsk = C.in[I_SD] + (size_t)l * 512 + g * 16;
    for (int task = tid; task < 2 * 2 * 16 * 32; task += NTHR) {
        const int e = task >> 10, d = (task >> 9) & 1, blk = (task >> 5) & 15, p = (task >> 1) & 15, q0 = (task & 1) * 8, tau = 2 * part + e;
        if (blk >= 16 - tau || (tau == 0 && d == 1)) continue;
        const int t = d == 0 ? blk + tau : blk, j = d == 0 ? blk : blk + tau; float v[8];
#pragma unroll
        for (int k = 0; k < 8; ++k) { float s = Kl[(d * 2 + e) * 256 + p * 16 + q0 + k]; if (tau == 0) { s += Kl[(1 * 2 + e) * 256 + p * 16 + q0 + k]; if (q0 + k == p) s += dsk[p]; } v[k] = s; }
        v4u o; o.x = cvtpk(v[0], v[1]); o.y = cvtpk(v[2], v[3]); o.z = cvtpk(v[4], v[5]); o.w = cvtpk(v[6], v[7]); *(v4u*)(BtY + (size_t)(t * 16 + p) * 512 + j * 16 + q0) = o;
    }
    for (int task = tid; task < 2 * 32 * 32; task += NTHR) {
        const int which = task >> 10, r = 32 * part + ((task >> 5) & 31), c0 = (task & 31) * 8; float v[8]; bf16* dst;
        if (which == 0) { const int d = r >> 7, reim = (r >> 6) & 1, n = r & 63, j = c0 >> 4, q0 = c0 & 15, ex = d == 0 ? 15 - j : j; dst = BtE + (size_t)r * 256 + c0; const f32x2 a = pw[(d * 17 + ex) * 64 + n];
#pragma unroll
            for (int k = 0; k < 8; ++k) { const f32x2 bq = Bb[(d * 64 + n) * 16 + q0 + k]; v[k] = reim ? (a.x * bq.y + a.y * bq.x) : (a.x * bq.x - a.y * bq.y); } }
        else { const int t = r >> 4, p = r & 15, d = c0 >> 7, reim = (c0 >> 6) & 1, n0 = c0 & 63, ex = d == 0 ? t + 1 : 16 - t; dst = BtY + (size_t)r * 512 + 256 + c0;
#pragma unroll
            for (int k = 0; k < 8; ++k) { const f32x2 c = Cm[(d * 16 + p) * 64 + n0 + k], a = pw[(d * 17 + ex) * 64 + n0 + k]; v[k] = reim ? -(c.x * a.y + c.y * a.x) : (c.x * a.x - c.y * a.y); } }
        v4u o; o.x = cvtpk(v[0], v[1]); o.y = cvtpk(v[2], v[3]); o.z = cvtpk(v[4], v[5]); o.w = cvtpk(v[6], v[7]); *(v4u*)dst = o;
    }
    __syncthreads();
}

__device__ __forceinline__ void prep_layer(const Ctx& C, int l, int parts, int blo, int bcnt) {
    if (C.vcu < blo || C.vcu >= blo + bcnt) return;
    const int bi = C.vcu - blo, wi = bi * NWAVES + C.wave, nw = bcnt * NWAVES;
    if (parts & 1) for (int it = bi; it < 256; it += bcnt) s5_mats_block(C, l, it >> 3, it & 7);
    LAS float* scr = (LAS float*)(C.lds + C.wave * 16384);
    constexpr int I_1 = 16 * 104, I_2 = 16 * 96, I_3 = 8 * 32, I_4 = 8 * 16, I_5 = 8 * 32, I_6 = 16 * 32;
    if (parts & 1) {
        for (int it = wi; it < I_1 + I_2 + I_3 + I_4; it += nw) {
            int r = it;
            if (r < I_1) { transpose_item(C.in[I_WIN] + (size_t)l * 1024 * INW, 1024, INW, C.w<bf16>(WS_WCAT), RmWin{}, scr, r, C.lane); continue; } r -= I_1;
            if (r < I_2) { transpose_item(C.in[I_MW] + (size_t)l * 1024 * 3072, 1024, 3072, C.w<bf16>(WS_WCAT), RmId{INW}, scr, r, C.lane); continue; } r -= I_2;
            if (r < I_3) { transpose_item(C.in[I_GLU] + (size_t)l * 512 * 1024, 512, 1024, C.w<bf16>(WS_WGLU), RmGlu{}, scr, r, C.lane); continue; } r -= I_3;
            transpose_item(C.in[I_FN] + (size_t)l * 512 * 512, 512, 512, C.w<bf16>(WS_WFN), RmId{0}, scr, r, C.lane, 1024, 512);
        }
        for (int t = bi * NTHR + C.tid; t < 2 * 2 * 256 * 16; t += bcnt * NTHR) {
            const int kv = t >> 13, r = t & 8191, b = r >> 12, s = (r >> 4) & 255, c0 = (r & 15) * 8;
            const float* src = C.in[kv ? I_CV : I_CK] + (((size_t)b * DEPTH + l) * 256 + s) * KVW + c0;
            const f32x4 a = *(const f32x4*)src, bq = *(const f32x4*)(src + 4);
            v4u o; o.x = cvtpk(a[0], a[1]); o.y = cvtpk(a[2], a[3]); o.z = cvtpk(bq[0], bq[1]); o.w = cvtpk(bq[2], bq[3]);
            *(v4u*)(C.w<bf16>(kv ? WS_VL : WS_KL) + ((size_t)b * LKV + S_LAT + s) * KVW + c0) = o;
        }
    }
    if (parts & 2) for (int it = wi; it < 3 * I_5; it += nw) { const int nb = it / I_5;
        transpose_item(C.in[I_WBR] + ((size_t)l * 3 + nb) * 512 * 1024, 512, 1024, C.w<bf16>(ws_wbr(l)) + (size_t)nb * 1024 * 512, RmId{0}, scr, it - nb * I_5, C.lane); }
    if (parts & 4) for (int it = wi; it < I_6; it += nw) transpose_item(C.in[I_WOUT] + (size_t)l * 1024 * 1024, 1024, 1024, C.w<bf16>(ws_wout(l)), RmId{0}, scr, it, C.lane);
}

__device__ __forceinline__ void rows_phase(const Ctx& C, int l, bool last);
__device__ __forceinline__ void ph_l1(const Ctx& C, int l) {
    rows_phase(C, l, false);
}

__device__ __forceinline__ void rows_phase(const Ctx& C, int l, bool last) {
    const float* modf = C.w<float>(WS_MODF); bf16* XR = C.w<bf16>(WS_XRES);
    const bf16* T0 = C.w<bf16>(WS_PB); const bf16* T1 = C.w<bf16>(WS_GA);
    const int c8 = C.lane * 8;
    f32x4 v[4][2][2];
#pragma unroll
    for (int i = 0; i < 4; ++i) { const int row = C.gw + i * 2048;
        if (l == 0) { const float* xr = i < 2 ? C.in[I_XP] + (size_t)row * 1024 : C.in[I_XS] + (size_t)(row - T_CTX) * 1024;
#pragma unroll
            for (int j = 0; j < 2; ++j) { v[i][j][0] = *(const f32x4*)(xr + c8 + 512 * j); v[i][j][1] = *(const f32x4*)(xr + c8 + 512 * j + 4); }
        } else {
#pragma unroll
            for (int j = 0; j < 2; ++j) { const v4u w = *(const v4u*)(XR + (size_t)row * 1024 + c8 + 512 * j); v[i][j][0] = bf8_lo(w); v[i][j][1] = bf8_hi(w); } } }
#pragma unroll
    for (int i = 0; i < 4; ++i) { const int row = C.gw + i * 2048, ci = i < 2 ? 0 : i - 1; float ss = 0.f;
        if (l > 0) {
            const float* gp = modf + ((size_t)(l - 1) * 3 + ci) * 3072 + 2048 + c8; v4u t0[2], t1[2]; f32x4 gt[2][2];
#pragma unroll
            for (int j = 0; j < 2; ++j) { t0[j] = *(const v4u*)(T0 + (size_t)row * 1024 + c8 + 512 * j); t1[j] = *(const v4u*)(T1 + (size_t)row * 1024 + c8 + 512 * j);
                gt[j][0] = *(const f32x4*)(gp + 512 * j); gt[j][1] = *(const f32x4*)(gp + 512 * j + 4); }
#pragma unroll
            for (int j = 0; j < 2; ++j) { v[i][j][0] += gt[j][0] * (bf8_lo(t0[j]) + bf8_lo(t1[j])); v[i][j][1] += gt[j][1] * (bf8_hi(t0[j]) + bf8_hi(t1[j])); }
        }
        if (!last) {
#pragma unroll
            for (int j = 0; j < 2; ++j) st_bf8(XR + (size_t)row * 1024 + c8 + 512 * j, v[i][j][0], v[i][j][1]);
        }
#pragma unroll
        for (int j = 0; j < 2; ++j) {
#pragma unroll
            for (int h = 0; h < 2; ++h) { const f32x4 t = v[i][j][h]; ss += (t[0] * t[0] + t[1] * t[1]) + (t[2] * t[2] + t[3] * t[3]); } }
        const float rstd = rsqrtf(wave_sum(ss, C.lane) * (1.0f / 1024.0f) + RMS_EPS);
        if (last) {
#pragma unroll
            for (int j = 0; j < 2; ++j) {
#pragma unroll
                for (int h = 0; h < 2; ++h) *(f32x4*)(C.out + (size_t)row * 1024 + c8 + 512 * j + 4 * h) = v[i][j][h] * rstd * *(const f32x4*)(C.in[I_FG] + c8 + 512 * j + 4 * h); }
        } else {
            const float* mp = modf + ((size_t)l * 3 + ci) * 3072 + c8; bf16* hr = C.w<bf16>(WS_H) + (size_t)row * 1024;
#pragma unroll
            for (int j = 0; j < 2; ++j) { const f32x4 sh0 = *(const f32x4*)(mp + 512 * j), sh1 = *(const f32x4*)(mp + 512 * j + 4), gs0 = *(const f32x4*)(mp + 1024 + 512 * j), gs1 = *(const f32x4*)(mp + 1024 + 512 * j + 4);
                st_bf8(hr + c8 + 512 * j, v[i][j][0] * rstd * gs0 + sh0, v[i][j][1] * rstd * gs1 + sh1); }
        }
    }
}

__device__ __forceinline__ void scan_unit(const Ctx& C, int l, int g, int pm) {
    const float* SC = C.w<float>(WS_SC); bf16* UH = C.w<bf16>(WS_UH); const int lane = C.lane;
    const int nitems = pm ? 4 : 32;
    for (int item = C.wave; item < nitems; item += NWAVES) {
        const int bsel = item >> 1, d = item & 1, nch = pm ? 128 : 16, c0 = pm ? 256 + bsel * 128 : bsel * 16;
        const size_t gi = ((size_t)(l * 2 + d) * 32 + g) * 64 + lane;
        const float ar = C.w<float>(WS_A16)[gi * 2], ai = C.w<float>(WS_A16)[gi * 2 + 1];
        float hr = 0.f, hi = 0.f;
        if (pm) { const float* st = C.in[I_ST] + ((((size_t)bsel * DEPTH + l) * 2 + d) * 32 + g) * 128 + lane * 2; hr = st[0]; hi = st[1]; }
        float sr[16], si[16], tr[16], ti[16];
#pragma unroll
        for (int k = 0; k < 16; ++k) { const int c = d == 0 ? c0 + k : c0 + nch - 1 - k; const size_t o = ((size_t)g * 512 + c) * 256 + d * 128 + lane; sr[k] = SC[o]; si[k] = SC[o + 64]; }
        for (int i0 = 0; i0 < nch; i0 += 16) {
            if (i0 + 16 < nch) {
#pragma unroll
                for (int k = 0; k < 16; ++k) { const int c = d == 0 ? c0 + i0 + 16 + k : c0 + nch - 1 - i0 - 16 - k; const size_t o = ((size_t)g * 512 + c) * 256 + d * 128 + lane; tr[k] = SC[o]; ti[k] = SC[o + 64]; }
            }
#pragma unroll
            for (int k = 0; k < 16; ++k) { const int c = d == 0 ? c0 + i0 + k : c0 + nch - 1 - i0 - k; const size_t oh = ((size_t)g * 512 + c) * 512 + 256 + d * 128 + lane;
                UH[oh] = (bf16)(cvtpk(hr, hr) & 0xffffu); UH[oh + 64] = (bf16)(cvtpk(hi, hi) & 0xffffu);
                const float nr = ar * hr - ai * hi + sr[k], ni = ar * hi + ai * hr + si[k]; hr = nr; hi = ni; }
#pragma unroll
            for (int k = 0; k < 16; ++k) { sr[k] = tr[k]; si[k] = ti[k]; }
        }
        if (!pm) { float* o = C.out + OUT_S + ((((size_t)bsel * DEPTH + l) * 2 + d) * 32 + g) * 128 + lane * 2; o[0] = hr; o[1] = hi; }
    }
}

__device__ __forceinline__ void ph_final(const Ctx& C) { rows_phase(C, DEPTH, true); }

__device__ __forceinline__ void attn_any(const Ctx& C, int uidx) {
    size_t tok0, kvoff; int NT, h;
    if (uidx < 128) { const int b = uidx >> 6, qb = uidx & 7; h = (uidx >> 3) & 7; tok0 = (size_t)T_CTX + b * 2048 + qb * 256; kvoff = (size_t)(WS_KL - WS_KC) / 2 + (size_t)b * LKV * KVW; NT = LKV / 64; }
    else { const int u2 = uidx - 128, b = u2 >> 3; h = u2 & 7; tok0 = (size_t)b * 256; kvoff = tok0 * KVW; NT = 4; }
    kvoff += (h >> 2) * 64;
    const attn_body::bf16* Q = (const attn_body::bf16*)C.w<bf16>(WS_Q) + tok0 * 512 + h * 64;
    const attn_body::bf16* Kp = (const attn_body::bf16*)C.w<bf16>(WS_KC) + kvoff;
    attn_body::attn_unit<8>(Q, Kp, Kp + (WS_VC - WS_KC) / 2, (attn_body::bf16*)Q, (const attn_body::bf16*)C.w<bf16>(WS_GC) + tok0 * 512 + h * 64, 512, KVW, NT, (char*)C.lds, C.tid);
}

#ifndef MK_PER_PHASE
#define MK_PER_PHASE 0
#endif
constexpr int NSUB = 7, N_PHASES = 2 + NSUB * DEPTH;


__global__ void __launch_bounds__(NTHR, 2) fwd_kernel(KArgs args) {
    extern __shared__ __attribute__((aligned(16))) unsigned char lds_raw[];
    Ctx C; C.lds = (LAS unsigned char*)lds_raw; C.tid = threadIdx.x; C.lane = C.tid & 63; C.wave = __builtin_amdgcn_readfirstlane(C.tid >> 6); C.bid = blockIdx.x;
    int wave_s = C.wave;
    C.gw = C.bid * NWAVES + C.wave; C.ngw = GRID * NWAVES; C.in = args.in; C.out = args.out; C.ws = args.ws;
    for (int u = C.tid; u < (LDS_BYTES - LDSCTL_OFF) / 4; u += NTHR) ((LAS unsigned*)(C.lds + LDSCTL_OFF))[u] = 0u;
    __syncthreads();
    volatile LAS unsigned* MISC = (volatile LAS unsigned*)(C.lds + MISC_OFF);
    XcdBarrier bar; bar.bar = (unsigned*)(C.ws + WS_CTL) + CW_BAR; bar.x = 0; bar.st = nullptr;
    const bool multi = args.ph_hi - args.ph_lo > 1;
    if (multi) bar = xcd_barrier_post((unsigned*)(C.ws + WS_CTL) + CW_BAR, MISC + 8, C.tid);

    for (int ph = args.ph_lo; ph < args.ph_hi; ++ph) {
        { int l_; asm volatile("v_mbcnt_lo_u32_b32 %0, -1, 0\n\tv_mbcnt_hi_u32_b32 %0, -1, %0" : "=v"(l_)); asm volatile("" : "+s"(wave_s)); int b_ = blockIdx.x; asm volatile("" : "+s"(b_)); C.bid = b_; C.vcu = b_;   C.lane = l_; C.wave = wave_s; C.tid = wave_s * 64 + l_; C.gw = C.bid * NWAVES + C.wave;
          unsigned char* w_ = args.ws; asm volatile("" : "+s"(w_)); C.ws = w_; float* o_ = args.out; asm volatile("" : "+s"(o_)); C.out = o_; }
        const int c = C.vcu;
        if (ph == 0) { ph_prologue(C); __syncthreads(); prep_layer(C, 0, 7, 0, GRID); }
        else if (ph == N_PHASES - 1) ph_final(C);
        else {
            const int l = (ph - 1) / NSUB, sub = (ph - 1) % NSUB;
            if (sub == 0) ph_l1(C, l);
            else {
                if (sub == 2 && c < 128) for (int i = 0; i < 2; ++i) attn_any(C, c + 128 * i);
                if (sub == 3 && c >= 64 && c < 128) { const int L = xswz(c - 64, 64); scan_unit(C, l, L >> 1, L & 1); VM_WAIT(); }
                __syncthreads();
                { PhaseSched S{sub, c, C.bid, C.ws, l}; EpiAll E{C.ws, C.out, C.in, l}; int t_ = C.tid; asm volatile("" : "+v"(t_));
                  pg8::gemm_stream<EpiAll, PhaseSched>(C.lds, S, E, t_); }
                if (sub == 5 && l + 1 < DEPTH) { __syncthreads(); prep_layer(C, l + 1, 7, 128, 128); }
            }
        }
        if (ph + 1 < args.ph_hi) xcd_barrier(bar, C.tid);
    }
}

extern "C" void kernel_launch(void* const* d_in, const int* in_sizes, int n_in, void* d_out, int out_size, void* d_ws, size_t ws_size, hipStream_t stream) {
    static int ready = 0;
    if (ready == 0) {
        if (n_in != 28 || out_size != (int)OUT_N || ws_size < WS_END) { fprintf(stderr, "kernel_launch: unexpected problem shape (n_in %d, out %d, ws %zu)\n", n_in, out_size, ws_size); ready = -1; return; }
        int dev = 0, cus = 0;
        if (hipGetDevice(&dev) != hipSuccess || hipDeviceGetAttribute(&cus, hipDeviceAttributeMultiprocessorCount, dev) != hipSuccess) { ready = -1; return; }
        if (hipFuncSetAttribute((const void*)fwd_kernel, hipFuncAttributeMaxDynamicSharedMemorySize, LDS_BYTES) != hipSuccess) { fprintf(stderr, "kernel_launch: hipFuncSetAttribute failed\n"); ready = -1; return; }
        if (cus < GRID) { fprintf(stderr, "kernel_launch: device has %d CUs, this kernel needs %d resident workgroups\n", cus, GRID); ready = -1; return; }
        ready = 1;
    }
    if (ready < 0) return;
    (void)hipMemsetAsync((char*)d_ws + WS_CTL, 0, CTL_ZERO_BYTES, stream);
    KArgs a{};
    for (int i = 0; i < 28; ++i) a.in[i] = (const float*)d_in[i];
    a.out = (float*)d_out; a.ws = (unsigned char*)d_ws;
#if MK_PER_PHASE
    for (int ph = 0; ph < N_PHASES; ++ph) { a.ph_lo = ph; a.ph_hi = ph + 1; hipLaunchKernelGGL(fwd_kernel, dim3(GRID), dim3(NTHR), LDS_BYTES, stream, a); }
#else
    a.ph_lo = 0; a.ph_hi = N_PHASES; hipLaunchKernelGGL(fwd_kernel, dim3(GRID), dim3(NTHR), LDS_BYTES, stream, a);
#endif
}
```

```cpp
#include <hip/hip_runtime.h>
#include <hip/hip_bf16.h>
#include <cstdio>
#include <cstdint>
#include <cmath>
namespace pg8 {
#define PG8_LAS __attribute__((address_space(3)))
typedef unsigned short bf16_t;
typedef short bf16x8 __attribute__((ext_vector_type(8)));
typedef float f32x4 __attribute__((ext_vector_type(4)));
typedef unsigned u32x4 __attribute__((ext_vector_type(4)));
constexpr int BM = 256, BK = 64, HALF = 128, HTB = HALF * BK * 2  , STAGE_BYTES = 8 * HTB, NXCD = 8, WGM = 8;

__host__ __device__ __forceinline__ int lds_byte(int r, int c) { const int st = (r >> 4) * 2 + (c >> 5), rr = r & 15, cc = c & 31, ob = rr * 64 + cc * 2; return st * 1024 + (ob ^ (((ob >> 9) & 1) << 5)); }
__host__ __device__ __forceinline__ void stage_rc(int b, int& R, int& C) { const int st = b / 1024, sb = b % 1024, swz = sb ^ (((sb >> 9) & 1) << 5); R = (st >> 1) * 16 + swz / 64; C = (st & 1) * 32 + (swz % 64) / 2; }
__host__ __device__ __forceinline__ int perm32(int rho) { const int n = rho >> 4, i = rho & 15; return 8 * (i >> 2) + 4 * n + (i & 3); }


struct Unit { int pm, pn, z; };
struct StaticOrder {
    int nM, nN, nwg, G, c;
    __host__ __device__ void init(int M, int N, int G_, int c_) { nM = M / BM; nN = N / BM; nwg = nM * nN; G = G_; c = c_; }
    __host__ __device__ bool next(int i, Unit& u) const {
        const long L = (long)i * G + c; if (L >= nwg) return false;
        int wgid = (int)L; { const int q = nwg / NXCD, r = nwg % NXCD, xcd = wgid % NXCD, off = wgid / NXCD; wgid = (xcd < r ? xcd * (q + 1) : r * (q + 1) + (xcd - r) * q) + off; }
        const int nig = WGM * nN, gid = wgid / nig, fm = gid * WGM, gsz = (nM - fm) < WGM ? (nM - fm) : WGM;
        u.pm = fm + ((wgid % nig) % gsz); u.pn = (wgid % nig) / gsz; return true;
    }
    __device__ __forceinline__ void a_ready(const Unit&) const {}
    __device__ __forceinline__ void done(const Unit&) const {}
};
struct UDesc { const bf16_t* A; const bf16_t* Bt; int lda, ldb, K, hB; int kind, pm, pn, z, keep; };
template <class Epi, class Sched>
__device__ __forceinline__ void gemm_stream(PG8_LAS unsigned char* lds, const Sched& S, const Epi& E, const int tid_in) {
    const int tid = tid_in, wid = __builtin_amdgcn_readfirstlane(tid >> 6), lane = tid & 63, wr = wid >> 2, wc = wid & 3, fr = lane & 15, fq = lane >> 4;
    int RA, RB, CC;
    { int R, C; stage_rc(tid * 16, R, C); RA = R; RB = (R & ~31) + perm32(R & 31); CC = C; }
    const size_t kstep = (size_t)(BK * 2);
    const unsigned ldsw = (unsigned)wid * 1024u;
    const int aoff = lds_byte(wr * 64 + fr, fq * 8), boff = lds_byte(wc * 32 + fr, fq * 8);
#define PG8_SA(b, h) (((b) * 2 + (h)) * HTB)
#define PG8_SB(b, h) ((4 + (b) * 2 + (h)) * HTB)
#define PG8_STAGE_X(bufoff, gbase, RR, ld) do { const unsigned _vo = (unsigned)(RR * (ld) + CC) * 2u; \
        __builtin_amdgcn_global_load_lds((const unsigned*)((const char*)(gbase) + _vo), (PG8_LAS unsigned*)(lds + (bufoff) + ldsw), 16, 0, 0); \
        __builtin_amdgcn_global_load_lds((const unsigned*)((const char*)(gbase) + (size_t)(ld) * 128 + _vo), (PG8_LAS unsigned*)(lds + (bufoff) + ldsw + 8192), 16, 0, 0); } while (0)
#define PG8_STAGE_A(bufoff, gbase, ld) PG8_STAGE_X(bufoff, gbase, RA, ld)
#define PG8_STAGE_B(bufoff, gbase, ld) PG8_STAGE_X(bufoff, gbase, RB, ld)
#define PG8_LDA(dst, b, h) do { _Pragma("unroll") for (int m = 0; m < 4; ++m) _Pragma("unroll") for (int k = 0; k < 2; ++k) dst[m][k] = *(const PG8_LAS bf16x8*)(lds + PG8_SA(b, h) + aoff + m * 2048 + k * 1024); } while (0)
#define PG8_LDB(dst, b, h) do { _Pragma("unroll") for (int n = 0; n < 2; ++n) _Pragma("unroll") for (int k = 0; k < 2; ++k) dst[n][k] = *(const PG8_LAS bf16x8*)(lds + PG8_SB(b, h) + boff + n * 2048 + k * 1024); } while (0)
#define PG8_MMA(ai, bj, At, Bt) do { __builtin_amdgcn_s_setprio(1); _Pragma("unroll") for (int m = 0; m < 4; ++m) _Pragma("unroll") for (int n = 0; n < 2; ++n) _Pragma("unroll") for (int k = 0; k < 2; ++k) \
        acc[ai][bj][m][n] = __builtin_amdgcn_mfma_f32_16x16x32_bf16(Bt[n][k], At[m][k], acc[ai][bj][m][n], 0, 0, 0); __builtin_amdgcn_s_setprio(0); } while (0)
#define PG8_WAIT_V(n) asm volatile("s_waitcnt vmcnt(" #n ")" ::: "memory")
#define PG8_WAIT_L(n) asm volatile("s_waitcnt lgkmcnt(" #n ")" ::: "memory")
#define PG8_BAR __builtin_amdgcn_s_barrier()
#define PG8_SCHED __builtin_amdgcn_sched_barrier(0)
    UDesc cur, nxt; int ui = 0;
    if (!S.next(0, cur)) return;
    f32x4 acc[2][2][4][2];
#pragma unroll
    for (int a = 0; a < 2; ++a)
#pragma unroll
        for (int b = 0; b < 2; ++b)
#pragma unroll
            for (int m = 0; m < 4; ++m)
#pragma unroll
                for (int n = 0; n < 2; ++n) acc[a][b][m][n] = (f32x4){0.f, 0.f, 0.f, 0.f};
    bf16x8 At[4][2], B0[2][2], B1[2][2];
    const char* cA = (const char*)cur.A; const char* cB = (const char*)cur.Bt; int ldaC = cur.lda, ldbC = cur.ldb; unsigned hstepA = (unsigned)HALF * ldaC * 2, hstepB = (unsigned)cur.hB * ldbC * 2;
    PG8_STAGE_B(PG8_SB(0, 0), cB, ldbC); PG8_STAGE_B(PG8_SB(0, 1), cB + hstepB, ldbC); PG8_STAGE_A(PG8_SA(0, 0), cA, ldaC); PG8_STAGE_A(PG8_SA(0, 1), cA + hstepA, ldaC);
    if (wr == 1) PG8_BAR;
    PG8_WAIT_V(2); PG8_BAR;
    PG8_STAGE_B(PG8_SB(1, 0), cB + kstep, ldbC); PG8_STAGE_A(PG8_SA(1, 0), cA + kstep, ldaC); PG8_STAGE_B(PG8_SB(1, 1), cB + hstepB + kstep, ldbC);
    PG8_WAIT_V(6); PG8_BAR;
    for (;;) {
        const bool has_next = S.next(ui + 1, nxt);
        const char* nA = has_next ? (const char*)nxt.A : cA; const char* nB = has_next ? (const char*)nxt.Bt : cB;
        const int ldaN = has_next ? nxt.lda : ldaC, ldbN = has_next ? nxt.ldb : ldbC; const unsigned hstepAN = (unsigned)HALF * ldaN * 2, hstepBN = has_next ? (unsigned)nxt.hB * ldbN * 2 : hstepB;
        const int nt = cur.K / BK;
        for (int t = 0; t < nt; t += 2) {
            const bool last = (t == nt - 2);
            const char* a1 = cA + (size_t)(t + 1) * kstep;
            const char* a2 = last ? nA : cA + (size_t)(t + 2) * kstep; const char* b2 = last ? nB : cB + (size_t)(t + 2) * kstep;
            const char* a3 = a2 + kstep; const char* b3 = b2 + kstep;
            const int lda2 = last ? ldaN : ldaC, ldb2 = last ? ldbN : ldbC; const unsigned hA2 = last ? hstepAN : hstepA, hB2 = last ? hstepBN : hstepB;
            PG8_LDB(B0, 0, 0); PG8_LDB(B1, 0, 1); PG8_SCHED; PG8_LDA(At, 0, 0); PG8_STAGE_A(PG8_SA(1, 1), a1 + hstepA, ldaC);
            PG8_WAIT_V(8); PG8_WAIT_L(0); PG8_BAR; PG8_MMA(0, 0, At, B0); PG8_MMA(0, 1, At, B1); PG8_BAR; PG8_SCHED;
            PG8_LDA(At, 0, 1); PG8_STAGE_B(PG8_SB(0, 0), b2, ldb2); PG8_STAGE_B(PG8_SB(0, 1), b2 + hB2, ldb2); PG8_STAGE_A(PG8_SA(0, 0), a2, lda2);
            PG8_WAIT_V(8); PG8_WAIT_L(0); PG8_BAR; PG8_MMA(1, 0, At, B0); PG8_MMA(1, 1, At, B1); PG8_BAR; PG8_SCHED;
            PG8_LDB(B0, 1, 0); PG8_LDB(B1, 1, 1); PG8_SCHED; PG8_LDA(At, 1, 0); PG8_STAGE_A(PG8_SA(0, 1), a2 + hA2, lda2);
            PG8_WAIT_V(8); PG8_WAIT_L(0); PG8_BAR; PG8_MMA(0, 0, At, B0); PG8_MMA(0, 1, At, B1); PG8_BAR; PG8_SCHED;
            PG8_LDA(At, 1, 1); PG8_STAGE_B(PG8_SB(1, 0), b3, ldb2); PG8_STAGE_B(PG8_SB(1, 1), b3 + hB2, ldb2); PG8_STAGE_A(PG8_SA(1, 0), a3, lda2);
            PG8_WAIT_V(8); PG8_WAIT_L(0); PG8_BAR; PG8_MMA(1, 0, At, B0); PG8_MMA(1, 1, At, B1); PG8_BAR; PG8_SCHED;
        }
        if (wr == 0) PG8_BAR;
        const bool chained = E.transform(acc, cur, wr, wc, fr, fq);
        if (!chained) E(acc, cur, wr, wc, fr, fq);
        if (!has_next) break;
        if (!chained) {
#pragma unroll
        for (int a = 0; a < 2; ++a)
#pragma unroll
            for (int b = 0; b < 2; ++b)
#pragma unroll
                for (int m = 0; m < 4; ++m)
#pragma unroll
                    for (int n = 0; n < 2; ++n) acc[a][b][m][n] = (f32x4){0.f, 0.f, 0.f, 0.f};
        }
        cur = nxt; cA = nA; cB = nB; ldaC = ldaN; ldbC = ldbN; hstepA = hstepAN; hstepB = hstepBN; ++ui;
        if (wr == 1) PG8_BAR;
    }
    PG8_WAIT_V(0);
    PG8_BAR;
#undef PG8_SA
#undef PG8_SB
#undef PG8_STAGE_X
#undef PG8_STAGE_A
#undef PG8_STAGE_B
#undef PG8_LDA
#undef PG8_LDB
#undef PG8_MMA
#undef PG8_WAIT_V
#undef PG8_WAIT_L
#undef PG8_BAR
#undef PG8_SCHED
}
}

#include <hip/hip_bf16.h>
#include <cmath>
namespace attn_body {
using bf16=__hip_bfloat16;
using bf16x8=__attribute__((ext_vector_type(8)))short;
using s16x4=__attribute__((ext_vector_type(4)))short;
using f32x16=__attribute__((ext_vector_type(16)))float;
using u32x4=__attribute__((ext_vector_type(4)))unsigned;
constexpr int D=64;
constexpr int NW=8,QBLK=32,QB=QBLK*NW,KVBLK=64;
__device__ __forceinline__ int crow(int r,int hi){return (r&3)+8*(r>>2)+4*hi;}
#define SBAR() __builtin_amdgcn_sched_barrier(0)
constexpr int NSLOT=3, SLOTB=8192;
constexpr int LDS_K=0, LDS_V=NSLOT*SLOTB, LDS_WS=2*NSLOT*SLOTB, LDS_OST=LDS_WS+NW*64*4, LDS_BYTES=LDS_OST+NW*4096;
constexpr float C2=0.125f*1.4426950408889634f;
__device__ __forceinline__ void glds16(const void*gsrc,unsigned lds_dst){unsigned keep;
  asm volatile("s_mov_b32 %0, m0\n\ts_mov_b32 m0, %2\n\ts_nop 0\n\tglobal_load_lds_dwordx4 %1, off\n\ts_mov_b32 m0, %0":"=&s"(keep):"v"(gsrc),"s"(lds_dst):"memory");}
__device__ __forceinline__ float max3f(float a,float b,float c){float r;asm("v_max3_f32 %0, %1, %2, %3":"=v"(r):"v"(a),"v"(b),"v"(c));return r;}
__device__ __forceinline__ float max2f(float a,float b){float r;asm("v_max_f32_e32 %0, %1, %2":"=v"(r):"v"(a),"v"(b));return r;}
__device__ __forceinline__ float fadd_s(float a,float b){float r;asm("v_add_f32_e32 %0, %1, %2":"=v"(r):"v"(a),"v"(b));return r;}
__device__ __forceinline__ float fsub_s(float a,float b){float r;asm("v_sub_f32_e32 %0, %1, %2":"=v"(r):"v"(a),"v"(b));return r;}
typedef float f32x2_t __attribute__((ext_vector_type(2))); typedef __bf16 bf16x2_t __attribute__((ext_vector_type(2)));
__device__ __forceinline__ unsigned cvtpk_s(float lo,float hi){f32x2_t v={lo,hi};bf16x2_t b=__builtin_convertvector(v,bf16x2_t);return __builtin_bit_cast(unsigned,b);}
#define WAIT_BAR(N) asm volatile("s_waitcnt vmcnt(" #N ") lgkmcnt(0)\n\ts_barrier":::"memory")

__device__ __forceinline__ void qkt(f32x16&p0,f32x16&p1,const char*Kslot,const bf16x8*qr,const f32x16&negm,int r32,int hi){
  const char*kb=Kslot+hi*1024+r32*16;
  #pragma unroll
  for(int d0=0;d0<4;++d0){
    const bf16x8 b0=*reinterpret_cast<const bf16x8*>(kb+d0*2048);
    const bf16x8 b1=*reinterpret_cast<const bf16x8*>(kb+d0*2048+512);
    if(d0==0){p0=__builtin_amdgcn_mfma_f32_32x32x16_bf16(b0,qr[0],negm,0,0,0);p1=__builtin_amdgcn_mfma_f32_32x32x16_bf16(b1,qr[0],negm,0,0,0);}
    else{p0=__builtin_amdgcn_mfma_f32_32x32x16_bf16(b0,qr[d0],p0,0,0,0);p1=__builtin_amdgcn_mfma_f32_32x32x16_bf16(b1,qr[d0],p1,0,0,0);}}
}
typedef __attribute__((address_space(3))) const char* lds_cptr;
typedef short v4i16_t __attribute__((ext_vector_type(4)));
__device__ __forceinline__ void kload8(bf16x8*kf,lds_cptr kp){
  kf[0]=*(const __attribute__((address_space(3))) bf16x8*)(kp);      kf[1]=*(const __attribute__((address_space(3))) bf16x8*)(kp+512);
  kf[2]=*(const __attribute__((address_space(3))) bf16x8*)(kp+2048); kf[3]=*(const __attribute__((address_space(3))) bf16x8*)(kp+2560);
  kf[4]=*(const __attribute__((address_space(3))) bf16x8*)(kp+4096); kf[5]=*(const __attribute__((address_space(3))) bf16x8*)(kp+4608);
  kf[6]=*(const __attribute__((address_space(3))) bf16x8*)(kp+6144); kf[7]=*(const __attribute__((address_space(3))) bf16x8*)(kp+6656);
}
__device__ __forceinline__ void kload2(bf16x8*kf,lds_cptr kp,int j){ kf[2*j]=*(const __attribute__((address_space(3))) bf16x8*)(kp+j*2048); kf[2*j+1]=*(const __attribute__((address_space(3))) bf16x8*)(kp+j*2048+512); }
__device__ __forceinline__ s16x4 vtr(lds_cptr p){ return __builtin_bit_cast(s16x4,__builtin_amdgcn_ds_read_tr16_b64_v4i16((__attribute__((address_space(3))) v4i16_t*)p)); }
__device__ __forceinline__ float rowmax(const f32x16&p0,const f32x16&p1){
  float a=max3f(p0[0],p0[1],p1[0]),b=max3f(p0[2],p0[3],p1[1]);a=max3f(a,p1[2],p1[3]);
  #pragma unroll
  for(int r=4;r<16;r+=4){a=max3f(a,p0[r],p0[r+1]);b=max3f(b,p0[r+2],p0[r+3]);a=max3f(a,p1[r],p1[r+1]);b=max3f(b,p1[r+2],p1[r+3]);}
  const float m=max2f(a,b);
  auto rr=__builtin_amdgcn_permlane32_swap(__float_as_uint(m),__float_as_uint(m),false,false);
  return max2f(__uint_as_float(rr[0]),__uint_as_float(rr[1]));
}
__device__ __forceinline__ void pv(f32x16*o,int vb,bf16x8 pa0,bf16x8 pa1,bf16x8 pa2,bf16x8 pa3){
  #pragma unroll
  for(int d0=0;d0<2;++d0){s16x4 lo[4],hi[4];
    #pragma unroll
    for(int ks=0;ks<4;++ks){
      asm volatile("ds_read_b64_tr_b16 %0,%1 offset:%c2":"=&v"(lo[ks]):"v"(vb),"i"(d0*4096+ks*1024):"memory");
      asm volatile("ds_read_b64_tr_b16 %0,%1 offset:%c2":"=&v"(hi[ks]):"v"(vb),"i"(d0*4096+ks*1024+512):"memory");}
    asm volatile("s_waitcnt lgkmcnt(0)":::"memory");SBAR();
    #define PK(k) (bf16x8){lo[k][0],lo[k][1],lo[k][2],lo[k][3],hi[k][0],hi[k][1],hi[k][2],hi[k][3]}
    o[d0]=__builtin_amdgcn_mfma_f32_32x32x16_bf16(pa0,PK(0),o[d0],0,0,0);
    o[d0]=__builtin_amdgcn_mfma_f32_32x32x16_bf16(pa1,PK(1),o[d0],0,0,0);
    o[d0]=__builtin_amdgcn_mfma_f32_32x32x16_bf16(pa2,PK(2),o[d0],0,0,0);
    o[d0]=__builtin_amdgcn_mfma_f32_32x32x16_bf16(pa3,PK(3),o[d0],0,0,0);
    #undef PK
  }
}

#ifndef ATTN_STORE16
#define ATTN_STORE16(p,v) (*(u32x4*)(p)=(v))
#endif
template<int THRL> __device__ __forceinline__ void attn_unit(const bf16*Qu,const bf16*Kh,const bf16*Vh,bf16*Ou,const bf16*Gu,const int QP,const int KP,const int NT,char*shm,const int tid_in){
  const int tid=tid_in,lane=tid&63,r32=lane&31,hi=lane>>5; const int wid=__builtin_amdgcn_readfirstlane(tid>>6);
  const bf16*Qw=Qu+(long)(wid*QBLK)*QP;
  const unsigned lds0=(unsigned)(uintptr_t)shm;
  float*wsf=(float*)(shm+LDS_WS)+wid*64;
  const bf16*ksrc=Kh+(long)lane*KP+wid*8;
  const bf16*vsrc=Vh+(long)(16*(wid&3)+(lane>>2))*KP+(wid>>2)*32+(lane&3)*8;
  const unsigned kdst=lds0+LDS_K+wid*1024, vdst=lds0+LDS_V+wid*1024;
  #define DMA_K(t,slot) glds16(ksrc+(long)(t)*KVBLK*KP,(unsigned)__builtin_amdgcn_readfirstlane(kdst+(slot)))
  #define DMA_V(t,slot) glds16(vsrc+(long)(t)*KVBLK*KP,(unsigned)__builtin_amdgcn_readfirstlane(vdst+(slot)))
  const int vb0=(int)(lds0+LDS_V)+((lane>>4)&1)*32+(lane&3)*8+(4*hi+((lane&15)>>2))*64;
  const char*Kbase=shm+LDS_K; bf16x8 kf[8];
  const lds_cptr shm3=(lds_cptr)shm; const lds_cptr kp0=shm3+LDS_K+hi*1024+r32*16; const lds_cptr vp0=shm3+LDS_V+((lane>>4)&1)*32+(lane&3)*8+(4*hi+((lane&15)>>2))*64;
  DMA_K(0,0);DMA_V(0,0);DMA_K(1,SLOTB);
  bf16x8 qr[4];
  #pragma unroll
  for(int d0=0;d0<4;++d0)qr[d0]=*reinterpret_cast<const bf16x8*>(&Qw[(long)r32*QP+d0*16+hi*8]);
  float mhat=0.f,l_reg=0.f;f32x16 o[2];o[0]=f32x16{};o[1]=f32x16{};f32x16 negm; {float zf_; asm volatile("v_mov_b32 %0, 0":"=v"(zf_)); _Pragma("unroll") for(int r=0;r<16;++r)negm[r]=zf_;} asm volatile("":"+v"(negm));
  #define CMASK(P0,P1,t) do{}while(0)
  bool resc=false;
  #define START(P0,P1) do{ const float rm=rowmax(P0,P1); resc=false; \
    { const float dl=rm; mhat=fadd_s(mhat,dl); \
      _Pragma("unroll") for(int r=0;r<16;++r){P0[r]=fsub_s(P0[r],dl);P1[r]=fsub_s(P1[r],dl);} \
      _Pragma("unroll") for(int r=0;r<16;++r)negm[r]=-mhat; asm volatile("":"+v"(negm)); } \
    _Pragma("unroll") for(int r=0;r<16;++r)P0[r]=__builtin_amdgcn_exp2f(P0[r]); }while(0)
  #define RESC() do{ if(resc){ asm volatile("s_waitcnt lgkmcnt(0)":::"memory"); \
      _Pragma("unroll") for(int d_=0;d_<2;++d_) _Pragma("unroll") for(int r=0;r<16;++r)o[d_][r]*=wsf[crow(r,hi)]; } }while(0)
  f32x16 pA0,pA1,pB0,pB1;
  int sl_prev=0,sl_cur=0,sl_next=SLOTB;
  #define ROT() do{sl_prev=sl_cur;sl_cur=sl_next;sl_next=(sl_next==(NSLOT-1)*SLOTB)?0:sl_next+SLOTB;}while(0)
  DMA_K(2,2*SLOTB);
  WAIT_BAR(3);
  qkt(pA0,pA1,Kbase,qr,negm,r32,hi);asm volatile("s_nop 15\n\ts_nop 7":"+v"(pA0),"+v"(pA1));CMASK(pA0,pA1,0);
  START(pA0,pA1);
  _Pragma("unroll") for(int r=0;r<16;++r)pA1[r]=__builtin_amdgcn_exp2f(pA1[r]);
  WAIT_BAR(0);
  DMA_K(3,0);DMA_V(1,SLOTB);
  ROT();
  kload8(kf,kp0+sl_cur);
  WAIT_BAR(2);
  s16x4 vlo[8],vhi[8]; u32x4 pw0,pw1,pw2,pw3;
  #define PKW(P,B) cvtpk_s(P[B],P[B+1])
  #define PAF(k) __builtin_bit_cast(bf16x8,pw##k)
  #define VFR(i) (bf16x8){vlo[i][0],vlo[i][1],vlo[i][2],vlo[i][3],vhi[i][0],vhi[i][1],vhi[i][2],vhi[i][3]}
  #define PIN(x) asm volatile("":"+v"(x))
  #define MX3(a,b,c) __builtin_fmaxf(__builtin_fmaxf((a),(b)),(c))
  #define GAPA(MF,A0,A1,A2,A3,W0,W1,PW) do{ MF; sacc+=A0; sacc+=A1; sacc+=A2; sacc+=A3; PIN(sacc); W0; W1; PIN(PW); SBAR(); }while(0)
  #define EX(v) __builtin_amdgcn_exp2f(v)
  #define GAPB(MF,X,B) do{ MF; X[B]=EX(X[B]); X[B+1]=EX(X[B+1]); X[B+2]=EX(X[B+2]); X[B+3]=EX(X[B+3]); PIN(X); SBAR(); }while(0)
  #define VRD(i) do{ vlo[i]=vtr(vp_+(((i)>>2)*4096+((i)&3)*1024)); vhi[i]=vtr(vp_+(((i)>>2)*4096+((i)&3)*1024+512)); }while(0)
  #define KRD(G,j) do{ if(G){ kload2(kf,kp0+sl_next,j); SBAR(); } }while(0)
  #define STEP(C0,C1,P0,P1,t,GK,GV,GL) do{ SBAR(); \
    const lds_cptr vp_=vp0+sl_prev; \
    VRD(0); SBAR(); float sacc=(P0[0]+P0[1]); \
    GAPA(C0=__builtin_amdgcn_mfma_f32_32x32x16_bf16(kf[0],qr[0],negm,0,0,0), P0[2],P0[3],P0[4],P0[5],     pw0[0]=PKW(P0,0), pw0[1]=PKW(P0,2), pw0); \
    VRD(4); SBAR(); GAPA(C1=__builtin_amdgcn_mfma_f32_32x32x16_bf16(kf[1],qr[0],negm,0,0,0), P0[6],P0[7],P0[8],P0[9],     pw0[2]=PKW(P0,4), pw0[3]=PKW(P0,6), pw0); \
    VRD(1); SBAR(); GAPA(C0=__builtin_amdgcn_mfma_f32_32x32x16_bf16(kf[2],qr[1],C0,0,0,0),   P0[10],P0[11],P0[12],P0[13], pw1[0]=PKW(P0,8), pw1[1]=PKW(P0,10), pw1); \
    VRD(5); SBAR(); GAPA(C1=__builtin_amdgcn_mfma_f32_32x32x16_bf16(kf[3],qr[1],C1,0,0,0),   P0[14],P0[15],P1[0],P1[1],   pw1[2]=PKW(P0,12),pw1[3]=PKW(P0,14), pw1); \
    VRD(2); SBAR(); GAPA(C0=__builtin_amdgcn_mfma_f32_32x32x16_bf16(kf[4],qr[2],C0,0,0,0),   P1[2],P1[3],P1[4],P1[5],     pw2[0]=PKW(P1,0), pw2[1]=PKW(P1,2), pw2); \
    VRD(6); SBAR(); GAPA(C1=__builtin_amdgcn_mfma_f32_32x32x16_bf16(kf[5],qr[2],C1,0,0,0),   P1[6],P1[7],P1[8],P1[9],     pw2[2]=PKW(P1,4), pw2[3]=PKW(P1,6), pw2); \
    VRD(3); SBAR(); GAPA(C0=__builtin_amdgcn_mfma_f32_32x32x16_bf16(kf[6],qr[3],C0,0,0,0),   P1[10],P1[11],P1[12],P1[13], pw3[0]=PKW(P1,8), pw3[1]=PKW(P1,10), pw3); \
    VRD(7); SBAR(); GAPA(C1=__builtin_amdgcn_mfma_f32_32x32x16_bf16(kf[7],qr[3],C1,0,0,0),   P1[14],P1[15],0.f,0.f,       pw3[2]=PKW(P1,12),pw3[3]=PKW(P1,14), pw3); \
    l_reg+=sacc; \
    if(GK){DMA_K((t)+3,sl_cur);} if(GV){DMA_V((t)+1,sl_next);} \
    CMASK(C0,C1,t); \
    { float a=MX3(C0[0],C0[1],C1[0]),b=MX3(C0[2],C0[3],C1[1]); a=MX3(a,C1[2],C1[3]); \
      _Pragma("unroll") for(int r=4;r<16;r+=4){a=MX3(a,C0[r],C0[r+1]);b=MX3(b,C0[r+2],C0[r+3]);a=MX3(a,C1[r],C1[r+1]);b=MX3(b,C1[r+2],C1[r+3]);} \
      float rm=__builtin_fmaxf(a,b); { auto rr=__builtin_amdgcn_permlane32_swap(__float_as_uint(rm),__float_as_uint(rm),false,false); rm=__builtin_fmaxf(__uint_as_float(rr[0]),__uint_as_float(rr[1])); } \
      resc=false; \
      if(__builtin_expect(__any(rm>(float)THRL),0)){ const float dl=__builtin_fmaxf(rm,0.f); mhat+=dl; \
        _Pragma("unroll") for(int r=0;r<16;++r){C0[r]-=dl;C1[r]-=dl;} \
        _Pragma("unroll") for(int r=0;r<16;++r)negm[r]=-mhat; asm volatile("":"+v"(negm)); \
        const float f=__builtin_amdgcn_exp2f(-dl); l_reg*=f; if(hi==0)wsf[r32]=f; resc=true; } } \
    SBAR(); \
    GAPB(o[0]=__builtin_amdgcn_mfma_f32_32x32x16_bf16(PAF(0),VFR(0),o[0],0,0,0), C0,0); \
    GAPB(o[1]=__builtin_amdgcn_mfma_f32_32x32x16_bf16(PAF(0),VFR(4),o[1],0,0,0), C0,4); \
    KRD(GL,0); GAPB(o[0]=__builtin_amdgcn_mfma_f32_32x32x16_bf16(PAF(1),VFR(1),o[0],0,0,0), C0,8); \
    KRD(GL,1); GAPB(o[1]=__builtin_amdgcn_mfma_f32_32x32x16_bf16(PAF(1),VFR(5),o[1],0,0,0), C0,12); \
    KRD(GL,2); GAPB(o[0]=__builtin_amdgcn_mfma_f32_32x32x16_bf16(PAF(2),VFR(2),o[0],0,0,0), C1,0); \
    KRD(GL,3); GAPB(o[1]=__builtin_amdgcn_mfma_f32_32x32x16_bf16(PAF(2),VFR(6),o[1],0,0,0), C1,4); \
    GAPB(o[0]=__builtin_amdgcn_mfma_f32_32x32x16_bf16(PAF(3),VFR(3),o[0],0,0,0), C1,8); \
    GAPB(o[1]=__builtin_amdgcn_mfma_f32_32x32x16_bf16(PAF(3),VFR(7),o[1],0,0,0), C1,12); \
    }while(0)
  int t=1;
  #undef CMASK
  #define CMASK(P0,P1,t) do{}while(0)
  for(;t+5<NT;t+=2){
    STEP(pB0,pB1,pA0,pA1,t,true,true,true);     WAIT_BAR(2); RESC(); ROT();
    STEP(pA0,pA1,pB0,pB1,t+1,true,true,true);   WAIT_BAR(2); RESC(); ROT();
  }
  #undef CMASK
  #define CMASK(P0,P1,t) do{}while(0)
  #define ENDW(tt) do{ if((tt)+3<NT){WAIT_BAR(2);} else if((tt)+2<NT){WAIT_BAR(1);} else {WAIT_BAR(0);} }while(0)
  for(;t+1<NT;t+=2){
    STEP(pB0,pB1,pA0,pA1,t,(t+3<NT),(t+1<NT),(t+1<NT));       ENDW(t);   RESC(); ROT();
    STEP(pA0,pA1,pB0,pB1,t+1,(t+4<NT),(t+2<NT),(t+2<NT));     ENDW(t+1); RESC(); ROT();
  }
  STEP(pB0,pB1,pA0,pA1,NT-1,false,false,false); RESC();
  { float sacc=pB0[0]+pB0[1]; _Pragma("unroll") for(int r=2;r<16;++r)sacc+=pB0[r]; _Pragma("unroll") for(int r=0;r<16;++r)sacc+=pB1[r]; l_reg+=sacc;
    pw0=(u32x4){PKW(pB0,0),PKW(pB0,2),PKW(pB0,4),PKW(pB0,6)};pw1=(u32x4){PKW(pB0,8),PKW(pB0,10),PKW(pB0,12),PKW(pB0,14)};pw2=(u32x4){PKW(pB1,0),PKW(pB1,2),PKW(pB1,4),PKW(pB1,6)};pw3=(u32x4){PKW(pB1,8),PKW(pB1,10),PKW(pB1,12),PKW(pB1,14)};
    SBAR(); pv(o,vb0+sl_cur,PAF(0),PAF(1),PAF(2),PAF(3)); }
  #undef PKW
  #undef PAF
  #undef VFR
  #undef PIN
  #undef MX3
  #undef GAPA
  #undef GAPB
  #undef EX
  #undef VRD
  #undef KRD
  #undef STEP
  #undef ENDW
  {auto rr=__builtin_amdgcn_permlane32_swap(__float_as_uint(l_reg),__float_as_uint(l_reg),false,false);l_reg=__uint_as_float(rr[0])+__uint_as_float(rr[1]);}
  if(hi==0)wsf[32+r32]=l_reg;asm volatile("s_waitcnt lgkmcnt(0)":::"memory");
  float rli[16];
  #pragma unroll
  for(int r=0;r<16;++r)rli[r]=__builtin_amdgcn_rcpf(wsf[32+crow(r,hi)]);
  bf16*Ow=Ou+(long)(wid*QBLK)*QP; const bf16*Gw=Gu+(long)(wid*QBLK)*QP;
  { bf16*stg=(bf16*)(shm+LDS_OST)+wid*2048;
    #pragma unroll
    for(int r=0;r<16;++r){const int orow=crow(r,hi);
      #pragma unroll
      for(int d0=0;d0<2;++d0)stg[orow*64+d0*32+r32]=__float2bfloat16(o[d0][r]*rli[r]);}
    asm volatile("s_waitcnt lgkmcnt(0)":::"memory");
    #pragma unroll
    for(int i=0;i<4;++i){const int row=i*8+(lane>>3),ch=lane&7; const u32x4 v=*(const u32x4*)(stg+row*64+ch*8); const u32x4 gv=*(const u32x4*)(Gw+(long)row*QP+ch*8); u32x4 w;
      #pragma unroll
      for(int e=0;e<4;++e){const float a0=__uint_as_float(v[e]<<16)*__uint_as_float(gv[e]<<16),a1=__uint_as_float(v[e]&0xffff0000u)*__uint_as_float(gv[e]&0xffff0000u); w[e]=cvtpk_s(a0,a1);}
      *(u32x4*)(Ow+(long)row*QP+ch*8)=w;} }
  asm volatile("s_waitcnt lgkmcnt(0)\n\ts_barrier":::"memory");
  #undef DMA_K
  #undef DMA_V
  #undef CMASK
  #undef START
  #undef RESC
  #undef ROT
}
constexpr int ATTN_LDS_BYTES=LDS_BYTES;
#undef SBAR
#undef WAIT_BAR
}

#define GAS __attribute__((address_space(1)))
#define LAS __attribute__((address_space(3)))
typedef unsigned short bf16;
typedef unsigned v4u __attribute__((ext_vector_type(4)));
typedef float f32x4 __attribute__((ext_vector_type(4)));
typedef short bf16x8 __attribute__((ext_vector_type(8)));
typedef GAS unsigned gu32;
typedef GAS unsigned long long gu64;
#define RLX_AGENT __ATOMIC_RELAXED, __HIP_MEMORY_SCOPE_AGENT
#define LDS_WAIT() asm volatile("s_waitcnt lgkmcnt(0)" ::: "memory")
#define VM_WAIT() asm volatile("s_waitcnt vmcnt(0)" ::: "memory")
__device__ __forceinline__ unsigned long long rt() { return __builtin_amdgcn_s_memrealtime(); }
__device__ __forceinline__ unsigned f2bf(float f) { unsigned u = __builtin_bit_cast(unsigned, f); return (u + 0x7fffu + ((u >> 16) & 1u)) >> 16; }
__device__ __forceinline__ unsigned pk2(float lo, float hi) { return f2bf(lo) | (f2bf(hi) << 16); }

#define XB_TMO      128
#define XB_XCNT(j)  (256  + 64 * (j))
#define XB_XSUB(j)  (1280 + 64 * (j))
#define XB_XGEN(j)  (2304 + 64 * (j))
#define XB_TOP      3328
#define XB_TOPGEN   3392
#define XCD_BAR_WORDS 3456
#define XB_SPIN_CAP (1u << 18)

__device__ __forceinline__ unsigned xb_ld(unsigned* p)              { return __hip_atomic_load(p, __ATOMIC_RELAXED, __HIP_MEMORY_SCOPE_AGENT); }
__device__ __forceinline__ unsigned xb_add(unsigned* p, unsigned v) { return __hip_atomic_fetch_add(p, v, __ATOMIC_RELAXED, __HIP_MEMORY_SCOPE_AGENT); }
__device__ __forceinline__ unsigned xb_xcc_id() { return (unsigned)__builtin_amdgcn_s_getreg((3 << 11) | 20) & 0xFu; }
#define XB_SPIN(cond, bar) do { unsigned _sp = 0; while (cond) { __builtin_amdgcn_s_sleep(1); \
    if ((++_sp & 255u) == 0u) { if (xb_ld(&(bar)[XB_TMO])) break; if (_sp > XB_SPIN_CAP) { atomicAdd(&(bar)[XB_TMO], 1u); break; } } } } while (0)

struct XcdBarrier {
    unsigned* bar; unsigned x;
    volatile LAS unsigned* st;
};

__device__ __forceinline__ XcdBarrier xcd_barrier_post(unsigned* bar, volatile LAS unsigned* st, const int tid) {
    XcdBarrier b; b.bar = bar; b.x = xb_xcc_id(); b.st = st;
    if (tid == 0) (void)xb_add(&bar[XB_XCNT(b.x)], 1u);
    return b;
}
__device__ __forceinline__ void xcd_barrier_complete(unsigned* bar, unsigned x, unsigned& nloc, unsigned& nx) {
    const unsigned G = gridDim.x * gridDim.y * gridDim.z;
    unsigned sum, cnt, mine, sp = 0u;
    for (;;) {
        sum = 0u; cnt = 0u; mine = 0u;
#pragma unroll
        for (unsigned j = 0; j < 16; ++j) { const unsigned c = xb_ld(&bar[XB_XCNT(j)]); sum += c; cnt += (c > 0u) ? 1u : 0u; mine = (j == x) ? c : mine; }
        if (sum == G) break;
        __builtin_amdgcn_s_sleep(1);
        if ((++sp & 255u) == 0u) { if (xb_ld(&bar[XB_TMO])) break; if (sp > XB_SPIN_CAP) { atomicAdd(&bar[XB_TMO], 1u); break; } }
    }
    nloc = mine > 0u ? mine : 1u; nx = cnt > 0u ? cnt : 1u;
}

__device__ __forceinline__ void xcd_barrier(const XcdBarrier& b, const int tid) {
    asm volatile("s_waitcnt vmcnt(0)" ::: "memory");
    __syncthreads();
    if (tid == 0) {
        unsigned* bar = b.bar; asm volatile("" : "+s"(bar));
        __builtin_amdgcn_s_waitcnt(0);
        unsigned nloc = b.st[0], nx = b.st[1];
        if (nloc == 0u) { unsigned xx = b.x; asm volatile("" : "+s"(xx)); xcd_barrier_complete(bar, xx, nloc, nx); b.st[0] = nloc; b.st[1] = nx; }
        const unsigned old = xb_add(&bar[XB_XSUB(b.x)], 1u);
        const unsigned gen = old / nloc;
        if (old + 1u == (gen + 1u) * nloc) {
            __builtin_amdgcn_fence(__ATOMIC_RELEASE, "agent");
            asm volatile("s_waitcnt vmcnt(0)" ::: "memory");
            const unsigned og = xb_add(&bar[XB_TOP], 1u);
            const unsigned tg = og / nx;
            if (og + 1u == (tg + 1u) * nx) xb_add(&bar[XB_TOPGEN], 1u);
            else XB_SPIN(xb_ld(&bar[XB_TOPGEN]) == tg, bar);
            __builtin_amdgcn_fence(__ATOMIC_ACQUIRE, "agent");
            xb_add(&bar[XB_XGEN(b.x)], 1u);
            asm volatile("s_waitcnt vmcnt(0)" ::: "memory");
        } else {
            XB_SPIN(xb_ld(&bar[XB_XGEN(b.x)]) == gen, bar);
            __builtin_amdgcn_fence(__ATOMIC_ACQUIRE, "agent");
            asm volatile("s_waitcnt vmcnt(0)" ::: "memory");
        }
    }
    __syncthreads();
}


constexpr int NWAVES = 8, NTHR = 512, GRID = 256;
constexpr int T_TOK = 8192, T_CTX = 4096, DMOD = 1024, BW = 512, INW = 3328, NCAT = 6400, DEPTH = 4;
constexpr int S_LAT = 2048, LKV = 2304, KVW = 128;
constexpr float RMS_EPS = 1e-6f;
constexpr float QSCALE = 0.125f * 1.4426950408889634f;
constexpr size_t MiB = 1u << 20;
constexpr size_t WS_CTL = 0, CTL_ZERO_BYTES = MiB;
constexpr size_t WS_MODF = 1 * MiB;
constexpr size_t WS_ROPE = 1 * MiB + 768 * 1024;
constexpr size_t WS_A16 = 1 * MiB + 832 * 1024;
constexpr size_t WS_WCAT = 2 * MiB;
constexpr size_t WS_WGLU = 15 * MiB;
constexpr size_t WS_WFN = 16 * MiB;
constexpr size_t WS_WBR = 17 * MiB, WS_WBR2 = 80 * MiB;
constexpr size_t WS_WOUT = 20 * MiB, WS_WOUT2 = 67 * MiB;
__host__ __device__ constexpr size_t ws_wbr(int l) { return (l & 1) ? WS_WBR2 : WS_WBR; }
__host__ __device__ constexpr size_t ws_wout(int l) { return (l & 1) ? WS_WOUT2 : WS_WOUT; }
constexpr size_t WS_BTE = 22 * MiB;
constexpr size_t WS_BTY = 26 * MiB;
constexpr size_t WS_A2L = 34 * MiB;
constexpr size_t WS_GY = 42 * MiB;
constexpr size_t WS_A2C = 50 * MiB;
constexpr size_t WS_A1P = 50 * MiB + 512 * 1024;
constexpr size_t WS_XRES = 51 * MiB;
constexpr size_t WS_G = 83 * MiB;
constexpr size_t WS_H = 131 * MiB;
constexpr size_t WS_VTC = 147 * MiB;
constexpr size_t WS_VTL = 248 * MiB;
constexpr size_t WS_GA = 155 * MiB;
constexpr size_t WS_GF = 163 * MiB;
constexpr size_t WS_Q = 171 * MiB;
constexpr size_t WS_UF = 179 * MiB;
constexpr size_t WS_GC = 187 * MiB;
constexpr size_t WS_KC = 195 * MiB, WS_KL = 196 * MiB;
constexpr size_t WS_VC = WS_KC + 5 * MiB / 2, WS_VL = WS_KL + 5 * MiB / 2;
constexpr size_t WS_PB = 200 * MiB;
constexpr size_t WS_SC = 216 * MiB;
constexpr size_t WS_UH = 232 * MiB;
constexpr size_t WS_END = 256 * MiB;
constexpr int CW_BAR = 4096;
constexpr size_t OUT_K = 8388608, OUT_V = 10485760, OUT_S = 12582912, OUT_N = 13107200;
constexpr int RING_BYTES = 131072, LDSCTL_OFF = RING_BYTES, MISC_OFF = LDSCTL_OFF + 320, LDS_BYTES = 147456;

typedef float f32x2 __attribute__((ext_vector_type(2)));
typedef unsigned u32x2 __attribute__((ext_vector_type(2)));
__device__ __forceinline__ unsigned cvtpk(float lo, float hi) { typedef __bf16 bf16x2_t __attribute__((ext_vector_type(2))); f32x2 v = {lo, hi}; bf16x2_t b = __builtin_convertvector(v, bf16x2_t); return __builtin_bit_cast(unsigned, b); }
__device__ __forceinline__ void st_bf4(bf16* p, f32x4 v) { u32x2 w; w.x = cvtpk(v[0], v[1]); w.y = cvtpk(v[2], v[3]); *(u32x2*)p = w; }
__device__ __forceinline__ f32x4 ld_bf4(const bf16* p) { const u32x2 w = *(const u32x2*)p; f32x4 r; r[0] = __uint_as_float(w.x << 16); r[1] = __uint_as_float(w.x & 0xffff0000u); r[2] = __uint_as_float(w.y << 16); r[3] = __uint_as_float(w.y & 0xffff0000u); return r; }
__device__ __forceinline__ f32x4 bf4_to_f(u32x2 w) { f32x4 r; r[0] = __uint_as_float(w.x << 16); r[1] = __uint_as_float(w.x & 0xffff0000u); r[2] = __uint_as_float(w.y << 16); r[3] = __uint_as_float(w.y & 0xffff0000u); return r; }
__device__ __forceinline__ float bf2f(bf16 h) { return __uint_as_float((unsigned)h << 16); }
__device__ __forceinline__ float sigmoidf_(float x) { return __builtin_amdgcn_rcpf(1.0f + __expf(-x)); }
__device__ __forceinline__ f32x4 sigmoid4(f32x4 v) { f32x4 r; r[0] = sigmoidf_(v[0]); r[1] = sigmoidf_(v[1]); r[2] = sigmoidf_(v[2]); r[3] = sigmoidf_(v[3]); return r; }
__device__ __forceinline__ f32x4 silu4(f32x4 v) { return v * sigmoid4(v); }
__device__ __forceinline__ float gelu_tanh(float x) { const float y = 0.7978845608028654f * (x + 0.044715f * x * x * x); return x * sigmoidf_(2.0f * y); }
__device__ __forceinline__ float shx(float v, int mask, int lane) { return __int_as_float(__builtin_amdgcn_ds_bpermute((lane ^ mask) << 2, __float_as_int(v))); }
__device__ __forceinline__ float wave_sum(float v, int lane) {
#pragma unroll
    for (int o = 1; o < 64; o <<= 1) v += shx(v, o, lane);
    return v;
}

struct KArgs { const float* in[28]; float* out; unsigned char* ws; int ph_lo, ph_hi; };
enum { I_XP = 0, I_XS, I_CK, I_CV, I_ST, I_C, I_CCTX, I_NORMG, I_ADAW, I_ADAB, I_WIN, I_ARE, I_AIM, I_LDT, I_BRE, I_BIM, I_CRE, I_CIM, I_SD, I_GLU, I_FN, I_QG, I_KG, I_WBR, I_MW, I_MB, I_WOUT, I_FG };

struct Ctx {
    LAS unsigned char* lds; int tid, lane, wave, bid, vcu, gw, ngw;
    const float* const* in; float* out; unsigned char* ws;
    template <class Tp> __device__ __forceinline__ Tp* w(size_t off) const { return (Tp*)(ws + off); }
};

__device__ __forceinline__ int epi_opaque(int x) { asm volatile("" : "+v"(x)); return x; }
#define EPI_ROWS for (int ai = 0; ai < 2; ++ai) _Pragma("unroll") for (int m = 0; m < 4; ++m)
#define EPI_BJ for (int bj = 0; bj < 2; ++bj)
#define EPI_ROW epi_opaque(u.pm * 256 + ai * 128 + wr * 64 + m * 16 + fr)
#define EPI_C8 (bj * 128 + wc * 32 + fq * 8)
#define EPI_COL8 (u.pn * 256 + EPI_C8)
typedef const f32x4 (&AccRef)[2][2][4][2];
__device__ __forceinline__ void st_bf8(bf16* p, f32x4 lo, f32x4 hi) { v4u w; w.x = cvtpk(lo[0], lo[1]); w.y = cvtpk(lo[2], lo[3]); w.z = cvtpk(hi[0], hi[1]); w.w = cvtpk(hi[2], hi[3]); *(v4u*)p = w; }
__device__ __forceinline__ f32x4 bf8_lo(v4u w) { f32x4 r; r[0] = __uint_as_float(w.x << 16); r[1] = __uint_as_float(w.x & 0xffff0000u); r[2] = __uint_as_float(w.y << 16); r[3] = __uint_as_float(w.y & 0xffff0000u); return r; }
__device__ __forceinline__ f32x4 bf8_hi(v4u w) { f32x4 r; r[0] = __uint_as_float(w.z << 16); r[1] = __uint_as_float(w.z & 0xffff0000u); r[2] = __uint_as_float(w.w << 16); r[3] = __uint_as_float(w.w & 0xffff0000u); return r; }

struct EpiG1 {
    static constexpr bool PERM = true, AFTER_DRAIN = false;
    unsigned char* ws; float* out; const float *qg, *kg; int layer;
#define EG1_P(name, off) bf16* const name = (bf16*)(ws + (off))
    __device__ __forceinline__ void qkv(AccRef acc, const pg8::Unit& u, int wr, int wc, int fr, int fq) const {
        const int pn = u.pn; const bool isq = pn < 10;
        EG1_P(Q, WS_Q); EG1_P(Kc, WS_KC); EG1_P(Vc, WS_VC); EG1_P(Kl, WS_KL); EG1_P(Vl, WS_VL); float* const outK = out + OUT_K; float* const outV = out + OUT_V; const float* const rope = (const float*)(ws + WS_ROPE);
        const int kind = isq ? 0 : (wc < 2 ? 1 : 2);
        const int head = isq ? (pn - 8) * 4 + wc : (wc & 1);
        f32x4 gv[2][2];
        if (kind == 0) {
#pragma unroll
            EPI_BJ { gv[bj][0] = *(const f32x4*)(qg + layer * 64 + 32 * bj + 8 * fq); gv[bj][1] = *(const f32x4*)(qg + layer * 64 + 32 * bj + 8 * fq + 4); }
        } else {
#pragma unroll
            EPI_BJ { gv[bj][0] = *(const f32x4*)(kg + layer * 64 + 32 * bj + 8 * fq); gv[bj][1] = *(const f32x4*)(kg + layer * 64 + 32 * bj + 8 * fq + 4); }
        }
        const bool lat = u.pm >= 16;
#pragma unroll
        EPI_ROWS {
            const int row = EPI_ROW;
            f32x4 x[2][2];
#pragma unroll
            EPI_BJ { x[bj][0] = acc[ai][bj][m][0]; x[bj][1] = acc[ai][bj][m][1]; }
            if (kind != 2) {
                float ss = 0.f;
#pragma unroll
                EPI_BJ {
#pragma unroll
                    for (int n = 0; n < 2; ++n) { const f32x4 t = x[bj][n]; ss += (t[0] * t[0] + t[1] * t[1]) + (t[2] * t[2] + t[3] * t[3]); } }
                ss += shx(ss, 16, fq * 16 + fr); ss += shx(ss, 32, fq * 16 + fr);
                const float rstd = rsqrtf(ss * (1.0f / 64.0f) + RMS_EPS);
#pragma unroll
                EPI_BJ { x[bj][0] = x[bj][0] * rstd * gv[bj][0]; x[bj][1] = x[bj][1] * rstd * gv[bj][1]; }
            }
            int b, s;
            if (lat) { const int tl = row - T_CTX; b = tl >> 11; s = tl & 2047; } else { b = row >> 8; s = row & 255; }
            if (lat && kind != 2) {
                const int gr = s >> 6, gc = s & 63;
#pragma unroll
                EPI_BJ {
#pragma unroll
                    for (int n = 0; n < 2; ++n) { const int pos = bj ? gc : gr; const f32x4 cs = *(const f32x4*)(rope + (pos * 16 + 4 * fq + 2 * n) * 2); const f32x4 t = x[bj][n];
                        f32x4 r; r[0] = t[0] * cs[0] - t[1] * cs[1]; r[1] = t[0] * cs[1] + t[1] * cs[0]; r[2] = t[2] * cs[2] - t[3] * cs[3]; r[3] = t[2] * cs[3] + t[3] * cs[2]; x[bj][n] = r; } }
            }
#pragma unroll
            EPI_BJ { const int j = 32 * bj + 8 * fq;
                const size_t ol = ((size_t)b * LKV + s) * KVW + head * 64 + j, oc = (size_t)row * KVW + head * 64 + j, oo = (((size_t)b * DEPTH + layer) * 256 + s) * KVW + head * 64 + j;
                if (kind == 0) st_bf8(Q + (size_t)row * 512 + head * 64 + j, x[bj][0] * QSCALE, x[bj][1] * QSCALE);
                else if (kind == 1) { if (lat) st_bf8(Kl + ol, x[bj][0], x[bj][1]); else { st_bf8(Kc + oc, x[bj][0], x[bj][1]); *(f32x4*)(outK + oo) = x[bj][0]; *(f32x4*)(outK + oo + 4) = x[bj][1]; } }
                else { if (lat) st_bf8(Vl + ol, x[bj][0], x[bj][1]); else { st_bf8(Vc + oc, x[bj][0], x[bj][1]); *(f32x4*)(outV + oo) = x[bj][0]; *(f32x4*)(outV + oo + 4) = x[bj][1]; } } }
            asm volatile("" ::: "memory");
        }
    }
    __device__ __forceinline__ void operator()(AccRef acc, const pg8::Unit& u, int wr, int wc, int fr, int fq) const {
        const int pn = u.pn;
        if (pn >= 8 && pn <= 10) { qkv(acc, u, wr, wc, fr, fq); return; }
        EG1_P(UH, WS_UH); EG1_P(GA, WS_GA); EG1_P(UF, WS_UF); EG1_P(GF, WS_GF); EG1_P(GC, WS_GC);
#pragma unroll
        EPI_ROWS { const int row = EPI_ROW;
#pragma unroll
            EPI_BJ { const int col = EPI_COL8; const f32x4 lo = acc[ai][bj][m][0], hi = acc[ai][bj][m][1];
                if (pn < 2) { const int g = col >> 4, q = col & 15; st_bf8(UH + ((size_t)g * 512 + (row >> 4)) * 512 + (row & 15) * 16 + q, lo, hi); }
                else if (pn < 4) st_bf8(GA + (size_t)row * 512 + (col - 512), silu4(lo), silu4(hi));
                else if (pn < 6) st_bf8(UF + (size_t)row * 512 + (col - 1024), lo, hi);
                else if (pn < 8) st_bf8(GF + (size_t)row * 512 + (col - 1536), silu4(lo), silu4(hi));
                else st_bf8(GC + (size_t)row * 512 + (col - 2816), silu4(lo), silu4(hi));
            } }
    }
};
struct EpiMerge {
    static constexpr bool PERM = true, AFTER_DRAIN = false;
    bf16* Gm; const float* mb;
    __device__ __forceinline__ void operator()(AccRef acc, const pg8::Unit& u, int wr, int wc, int fr, int fq) const {
        f32x4 bb[2][2];
#pragma unroll
        EPI_BJ { bb[bj][0] = *(const f32x4*)(mb + EPI_COL8); bb[bj][1] = *(const f32x4*)(mb + EPI_COL8 + 4); }
#pragma unroll
        EPI_ROWS { const size_t row = EPI_ROW;
#pragma unroll
            EPI_BJ st_bf8(Gm + row * 3072 + EPI_COL8, sigmoid4(acc[ai][bj][m][0] + bb[bj][0]), sigmoid4(acc[ai][bj][m][1] + bb[bj][1])); }
    }
};
struct EpiS5A {
    static constexpr bool PERM = true, AFTER_DRAIN = false;
    float* SC;
    __device__ __forceinline__ void operator()(AccRef acc, const pg8::Unit& u, int wr, int wc, int fr, int fq) const {
#pragma unroll
        EPI_ROWS { const int chunk = EPI_ROW;
#pragma unroll
            EPI_BJ { float* p = SC + ((size_t)u.z * 512 + chunk) * 256 + EPI_C8; *(f32x4*)p = acc[ai][bj][m][0]; *(f32x4*)(p + 4) = acc[ai][bj][m][1]; } }
    }
};
__device__ __forceinline__ f32x4 gelu4(f32x4 y) { y[0] = gelu_tanh(y[0]); y[1] = gelu_tanh(y[1]); y[2] = gelu_tanh(y[2]); y[3] = gelu_tanh(y[3]); return y; }
struct EpiS5B {
    static constexpr bool PERM = true, AFTER_DRAIN = false;
    bf16* GY;
    __device__ __forceinline__ void operator()(AccRef acc, const pg8::Unit& u, int wr, int wc, int fr, int fq) const {
#pragma unroll
        EPI_ROWS { const int chunk = EPI_ROW;
#pragma unroll
            EPI_BJ { const int col = EPI_C8, t = col >> 4, p = col & 15; st_bf8(GY + ((size_t)chunk * 16 + t) * 512 + u.z * 16 + p, gelu4(acc[ai][bj][m][0]), gelu4(acc[ai][bj][m][1])); } }
    }
};
struct EpiDFT1C {
    static constexpr bool PERM = true, AFTER_DRAIN = false;
    bf16* VtC;
    __device__ __forceinline__ void operator()(AccRef acc, const pg8::Unit& u, int wr, int wc, int fr, int fq) const {
        const int grp = 2 * u.z + u.pm;
#pragma unroll
        EPI_ROWS { const int j = epi_opaque(wr * 64 + m * 16 + fr), reim = ai;
#pragma unroll
            EPI_BJ { const int tok = EPI_COL8, b = tok >> 8, s = tok & 255; st_bf8(VtC + ((size_t)b * 512 + grp * 128 + j) * 512 + reim * 256 + s, acc[ai][bj][m][0], acc[ai][bj][m][1]); } }
    }
};
struct EpiDFT1L {
    static constexpr bool PERM = true, AFTER_DRAIN = false;
    bf16* VtL;
    __device__ __forceinline__ void operator()(AccRef acc, const pg8::Unit& u, int wr, int wc, int fr, int fq) const {
        const int grp = 2 * u.z + u.pm, b = u.pn >> 4, nn = u.pn & 15;
#pragma unroll
        EPI_ROWS { const int j = epi_opaque(wr * 64 + m * 16 + fr), reim = ai; bf16* dst = VtL + ((size_t)b * 512 + grp * 128 + j) * 2048 + reim * 1024 + nn * 128 + wc * 32 + fq * 8;
            st_bf8(dst, acc[ai][0][m][0] + acc[ai][1][m][0], acc[ai][0][m][1] + acc[ai][1][m][1]);
            st_bf8(dst + (size_t)1024 * 2048, acc[ai][0][m][0] - acc[ai][1][m][0], acc[ai][0][m][1] - acc[ai][1][m][1]); }
    }
};
struct EpiDFT2 {
    static constexpr bool PERM = true, AFTER_DRAIN = false;
    bf16* ZF; int lat, half;
    __device__ __forceinline__ void operator()(AccRef acc, const pg8::Unit& u, int wr, int wc, int fr, int fq) const {
#pragma unroll
        EPI_ROWS { const int k = EPI_ROW;
#pragma unroll
            EPI_BJ { const int col = EPI_COL8, b = col >> 9, ch = col & 511;
                bf16* dst = lat ? ZF + ((size_t)b * 2048 + 2 * k + u.z) * 1024 + half * 512 + ch : ZF + ((size_t)b * 256 + k) * 512 + ch;
                st_bf8(dst, acc[ai][bj][m][0], acc[ai][bj][m][1]); } }
    }
};
#define EPI_BATCH for (int ai = 0; ai < 2; ++ai)
#define EPI_M for (int m = 0; m < 4; ++m)
struct EpiGLU {
    static constexpr bool PERM = true, AFTER_DRAIN = false;
    bf16* GA;
    __device__ __forceinline__ void operator()(AccRef acc, const pg8::Unit& u, int wr, int wc, int fr, int fq) const {
#pragma unroll
        EPI_BATCH { v4u gl[4];
#pragma unroll
            EPI_M { const size_t row = EPI_ROW; gl[m] = *(const v4u*)(GA + row * 512 + u.pn * 128 + wc * 32 + fq * 8); }
            asm volatile("" ::: "memory");
#pragma unroll
            EPI_M { const size_t row = EPI_ROW;
                st_bf8(GA + row * 512 + u.pn * 128 + wc * 32 + fq * 8, acc[ai][0][m][0] * sigmoid4(acc[ai][1][m][0]) * bf8_lo(gl[m]), acc[ai][0][m][1] * sigmoid4(acc[ai][1][m][1]) * bf8_hi(gl[m])); }
            asm volatile("" ::: "memory"); }
    }
};
struct EpiMul {
    static constexpr bool PERM = true, AFTER_DRAIN = false;
    bf16* GF;
    __device__ __forceinline__ void operator()(AccRef acc, const pg8::Unit& u, int wr, int wc, int fr, int fq) const {
#pragma unroll
        EPI_BATCH { v4u gl[4][2];
#pragma unroll
            EPI_M { const size_t row = EPI_ROW;
#pragma unroll
                EPI_BJ gl[m][bj] = *(const v4u*)(GF + row * 512 + EPI_COL8); }
            asm volatile("" ::: "memory");
#pragma unroll
            EPI_M { const size_t row = EPI_ROW;
#pragma unroll
                EPI_BJ st_bf8(GF + row * 512 + EPI_COL8, acc[ai][bj][m][0] * bf8_lo(gl[m][bj]), acc[ai][bj][m][1] * bf8_hi(gl[m][bj])); }
            asm volatile("" ::: "memory"); }
    }
};
struct EpiG4 {
    static constexpr bool PERM = true, AFTER_DRAIN = false;
    const bf16* Gm; bf16* PB; bf16* MG; int mode0;
    __device__ __forceinline__ void operator()(AccRef acc, const pg8::Unit& u, int wr, int wc, int fr, int fq) const {
        const int mode = mode0 + u.z, gsel = mode == 0 ? 2 : mode - 1;
#pragma unroll
        EPI_BATCH { v4u gl[4][2], pl[4][2];
#pragma unroll
            EPI_M { const size_t row = EPI_ROW;
#pragma unroll
                EPI_BJ { gl[m][bj] = *(const v4u*)(Gm + row * 3072 + gsel * 1024 + EPI_COL8); if (mode > 0) pl[m][bj] = *(const v4u*)(PB + row * 1024 + EPI_COL8); } }
            asm volatile("" ::: "memory");
#pragma unroll
            EPI_M { const size_t row = EPI_ROW;
#pragma unroll
                EPI_BJ { f32x4 lo = acc[ai][bj][m][0] * bf8_lo(gl[m][bj]), hi = acc[ai][bj][m][1] * bf8_hi(gl[m][bj]); if (mode > 0) { lo += bf8_lo(pl[m][bj]); hi += bf8_hi(pl[m][bj]); }
                    if (mode < 2) st_bf8(PB + row * 1024 + EPI_COL8, lo, hi); else st_bf8(MG + row * 1024 + EPI_COL8, lo, hi); } }
            asm volatile("" ::: "memory"); }
    }
};
struct EpiChainA {
    const bf16* Gm; const bf16* PB;
    __device__ __forceinline__ void operator()(f32x4 (&acc)[2][2][4][2], const pg8::Unit& u, int wr, int wc, int fr, int fq) const {
#pragma unroll
        for (int ai = 0; ai < 2; ++ai)
#pragma unroll
            for (int mh = 0; mh < 2; ++mh) { v4u g0[2][2], g1[2][2], pl[2][2];
#pragma unroll
                for (int mm = 0; mm < 2; ++mm) { const int m = 2 * mh + mm; const size_t row = EPI_ROW;
#pragma unroll
                    EPI_BJ { g0[mm][bj] = *(const v4u*)(Gm + row * 3072 + EPI_COL8); g1[mm][bj] = *(const v4u*)(Gm + row * 3072 + 1024 + EPI_COL8); pl[mm][bj] = *(const v4u*)(PB + row * 1024 + EPI_COL8); } }
                asm volatile("" ::: "memory");
#pragma unroll
                for (int mm = 0; mm < 2; ++mm) { const int m = 2 * mh + mm;
#pragma unroll
                    EPI_BJ { f32x4 lo = acc[ai][bj][m][0] * bf8_lo(g0[mm][bj]) + bf8_lo(pl[mm][bj]), hi = acc[ai][bj][m][1] * bf8_hi(g0[mm][bj]) + bf8_hi(pl[mm][bj]);
                        const f32x4 gl = bf8_lo(g1[mm][bj]), gh = bf8_hi(g1[mm][bj]);
#pragma unroll
                        for (int e = 0; e < 4; ++e) { lo[e] *= __builtin_amdgcn_rcpf(fmaxf(gl[e], 1e-6f)); hi[e] *= __builtin_amdgcn_rcpf(fmaxf(gh[e], 1e-6f)); }
                        acc[ai][bj][m][0] = lo; acc[ai][bj][m][1] = hi; } }
                asm volatile("" ::: "memory"); }
    }
};
struct EpiChainF {
    const bf16* Gm; bf16* MG;
    __device__ __forceinline__ void operator()(AccRef acc, const pg8::Unit& u, int wr, int wc, int fr, int fq) const {
#pragma unroll
        EPI_BATCH { v4u g1[4][2];
#pragma unroll
            EPI_M { const size_t row = EPI_ROW;
#pragma unroll
                EPI_BJ g1[m][bj] = *(const v4u*)(Gm + row * 3072 + 1024 + EPI_COL8); }
            asm volatile("" ::: "memory");
#pragma unroll
            EPI_M { const size_t row = EPI_ROW;
#pragma unroll
                EPI_BJ { const f32x4 gl = bf8_lo(g1[m][bj]), gh = bf8_hi(g1[m][bj]); f32x4 lo = acc[ai][bj][m][0], hi = acc[ai][bj][m][1];
#pragma unroll
                    for (int e = 0; e < 4; ++e) { lo[e] *= fmaxf(gl[e], 1e-6f); hi[e] *= fmaxf(gh[e], 1e-6f); }
                    st_bf8(MG + row * 1024 + EPI_COL8, lo, hi); } }
            asm volatile("" ::: "memory"); }
    }
};
struct EpiG5 {
    static constexpr bool PERM = true, AFTER_DRAIN = false;
    bf16 *T0, *T1;
    __device__ __forceinline__ void operator()(AccRef acc, const pg8::Unit& u, int wr, int wc, int fr, int fq) const {
        bf16* T = u.z ? T1 : T0;
#pragma unroll
        EPI_ROWS { const size_t row = EPI_ROW;
#pragma unroll
            EPI_BJ st_bf8(T + row * 1024 + EPI_COL8, acc[ai][bj][m][0], acc[ai][bj][m][1]); }
    }
};

enum { K_G1 = 0, K_MERGE, K_S5A, K_S5B, K_DFT1C, K_DFT1L, K_DFT2C, K_DFT2L0, K_DFT2L1, K_GLU, K_FN, K_PC, K_PA, K_PF, K_G5 };
__device__ __forceinline__ int xswz(int L, int n) { return (L & 7) * (n >> 3) + (L >> 3); }
#define PS_W(off) ((const bf16*)(ws + (off)))
struct PhaseSched {
    int sub, c, bid; unsigned char* ws; int layer;
    __device__ __forceinline__ void mk(pg8::UDesc& d, const bf16* A, const bf16* Bt, int lda, int ldb, int K, int hB, int kind, int pm, int pn, int z) const {
        d.A = A; d.Bt = Bt; d.lda = lda; d.ldb = ldb; d.K = K; d.hB = hB; d.kind = kind; d.pm = pm; d.pn = pn; d.z = z; d.keep = (kind == K_PF); }
    __device__ __forceinline__ void mk_merge(pg8::UDesc& d, int M, unsigned char* ws) const {
        int pm, pn; if (M < 128) { pm = M >> 2; pn = 8 + (M & 3); } else { pm = (M - 128) >> 3; pn = (M - 128) & 7; }
        mk(d, PS_W(WS_H) + (size_t)pm * 256 * 1024, PS_W(WS_WCAT) + (size_t)(INW + pn * 256) * 1024, 1024, 1024, 1024, 128, K_MERGE, pm, pn, 0); }
    __device__ __forceinline__ bool next(int i, pg8::UDesc& d) const {
        unsigned char* ws = this->ws; asm volatile("" : "+s"(ws));
        if (sub == 1) {
            if (i > 1) return false;
            pg8::StaticOrder so; so.init(T_TOK, INW, GRID, bid); pg8::Unit u;
            if (so.next(i, u)) { mk(d, PS_W(WS_H) + (size_t)u.pm * 256 * 1024, PS_W(WS_WCAT) + (size_t)u.pn * 256 * 1024, 1024, 1024, 1024, 128, K_G1, u.pm, u.pn, 0); return true; }
            if (bid >= 160) { mk_merge(d, xswz(bid - 160, 96), ws); return true; }
            return false;
        }
        if (sub == 2) {
            if (c < 128) return false;
            if (c < 192) { const int L = xswz(c - 128, 64);
                if (i == 0) { const int g = L >> 1, pm = L & 1; mk(d, PS_W(WS_UH) + ((size_t)g * 512 + pm * 256) * 512, PS_W(WS_BTE) + (size_t)g * 256 * 256, 512, 256, 256, 128, K_S5A, pm, 0, g); return true; }
                if (i == 1) { const int pair = L >> 5, gl = (L >> 4) & 1, pn = L & 15; mk(d, PS_W(WS_A1P) + (size_t)gl * 256 * 256, PS_W(WS_UF) + (size_t)pn * 256 * 512 + pair * 256, 256, 512, 256, 128, K_DFT1C, gl, pn, pair); return true; }
                if (i == 2) { mk_merge(d, 96 + xswz(c - 128, 128), ws); return true; }
                return false; }
            const int L = xswz(c - 192, 64);
            if (i == 0) { const int pair = L >> 5, gl = (L >> 4) & 1, r = L & 15, pn2 = (r >> 3) * 16 + (r & 7);
                mk(d, PS_W(WS_A1P) + (size_t)gl * 256 * 256, PS_W(WS_UF) + ((size_t)T_CTX + pn2 * 128) * 512 + pair * 256, 256, 512, 256, 1024, K_DFT1L, gl, pn2, pair); return true; }
            if (i == 1) { mk_merge(d, 96 + xswz(c - 128, 128), ws); return true; }
            return false;
        }
        if (sub == 3) {
            if (c < 64) { if (i > 0) return false; const int half = c >> 5, L = xswz(c & 31, 32), z = L >> 4, pm = (L >> 2) & 3, pn = L & 3;
                mk(d, PS_W(WS_A2L) + ((size_t)z * 1024 + pm * 256) * 2048 + half * 1024, PS_W(WS_VTL) + ((size_t)z * 1024 + pn * 256) * 2048 + half * 1024, 2048, 2048, 1024, 128, half ? K_DFT2L1 : K_DFT2L0, pm, pn, z); return true; }
            if (c < 128) { if (i > 0) return false; const int L = xswz(c - 64, 64), g = L >> 1, pm = L & 1;
                mk(d, PS_W(WS_UH) + ((size_t)g * 512 + pm * 256) * 512, PS_W(WS_BTY) + (size_t)g * 256 * 512, 512, 512, 512, 128, K_S5B, pm, 0, g); return true; }
            if (i == 0) { const int L = xswz(c - 128, 128), pm = L >> 2, pn = L & 3; mk(d, PS_W(WS_Q) + (size_t)pm * 256 * 512, PS_W(ws_wbr(layer)) + ((size_t)2 * 1024 + pn * 256) * 512, 512, 512, 512, 128, K_PC, pm, pn, 0); return true; }
            if (i == 1) { if (c < 160) { const int pn = xswz(c - 128, 32); mk(d, PS_W(WS_A2C), PS_W(WS_VTC) + (size_t)pn * 256 * 512, 512, 512, 512, 128, K_DFT2C, 0, pn, 0); return true; }
                mk_merge(d, 224 + xswz(c - 160, 96), ws); return true; }
            return false;
        }
        if (sub == 4) {
            if (i > 0) return false;
            if (c < 128) { const int L = xswz(c, 128), pm = L >> 2, pn = L & 3; mk(d, PS_W(WS_GY) + (size_t)pm * 256 * 512, PS_W(WS_WGLU) + (size_t)pn * 256 * 512, 512, 512, 512, 128, K_GLU, pm, pn, 0); return true; }
            if (c < 160) { const int L = xswz(c - 128, 32), pm = L >> 1, pn = L & 1; mk(d, PS_W(WS_UF) + (size_t)pm * 256 * 512, PS_W(WS_WFN) + (size_t)pn * 256 * 1024, 512, 1024, 512, 128, K_FN, pm, pn, 0); return true; }
            if (c < 192) { const int L = xswz(c - 160, 32), pm = L >> 1, pn = L & 1; mk(d, PS_W(WS_GC) + (size_t)pm * 256 * 1024, PS_W(WS_WFN) + (size_t)pn * 256 * 1024, 1024, 1024, 1024, 128, K_FN, 16 + pm, pn, 0); return true; }
            mk_merge(d, 320 + xswz(c - 192, 64), ws); return true;
        }
        if (sub == 5) {
            if (c >= 128 || i > 1) return false;
            const int t = (c & 7) * 16 + (c >> 3), pm = t >> 2, pn = t & 3;
            if (i == 0) mk(d, PS_W(WS_GA) + (size_t)pm * 256 * 512, PS_W(ws_wbr(layer)) + (size_t)pn * 256 * 512, 512, 512, 512, 128, K_PA, pm, pn, 0);
            else mk(d, PS_W(WS_GF) + (size_t)pm * 256 * 512, PS_W(ws_wbr(layer)) + ((size_t)1024 + pn * 256) * 512, 512, 512, 512, 128, K_PF, pm, pn, 0);
            return true;
        }
        if (i > 0) return false;
        { const int L = xswz(c, 256), z = L & 1, pm = L >> 3, pn = (L >> 1) & 3; mk(d, PS_W(WS_H) + (size_t)pm * 256 * 1024 + z * 512, PS_W(ws_wout(layer)) + (size_t)pn * 256 * 1024 + z * 512, 1024, 1024, 512, 128, K_G5, pm, pn, z); return true; }
    }
};
struct EpiAll {
    unsigned char* ws; float* out; const float* const* in; int layer;
    __device__ __forceinline__ bool transform(f32x4 (&acc)[2][2][4][2], const pg8::UDesc& d, int wr, int wc, int fr, int fq) const {
        if (d.kind != K_PA) return false;
        asm volatile("" : "+v"(fr), "+v"(fq), "+s"(wr), "+s"(wc));
        unsigned char* ws = this->ws; asm volatile("" : "+s"(ws));
        EpiChainA{(const bf16*)(ws + WS_G), (const bf16*)(ws + WS_PB)}(acc, pg8::Unit{d.pm, d.pn, d.z}, wr, wc, fr, fq); return true; }
    __device__ __forceinline__ void operator()(AccRef acc, const pg8::UDesc& d, int wr, int wc, int fr, int fq) const {
        asm volatile("" : "+v"(fr), "+v"(fq), "+s"(wr), "+s"(wc));
        const pg8::Unit u{d.pm, d.pn, d.z}; const int kind = d.kind;
        unsigned char* ws = this->ws; float* out = this->out; asm volatile("" : "+s"(ws), "+s"(out));
#define EA_P(off) ((bf16*)(ws + (off)))
        if (kind == K_G1) EpiG1{ws, out, in[I_QG], in[I_KG], layer}(acc, u, wr, wc, fr, fq);
        else if (kind == K_MERGE) EpiMerge{EA_P(WS_G), in[I_MB] + (size_t)layer * 3072}(acc, u, wr, wc, fr, fq);
        else if (kind == K_S5A) EpiS5A{(float*)(ws + WS_SC)}(acc, u, wr, wc, fr, fq);
        else if (kind == K_S5B) EpiS5B{EA_P(WS_GY)}(acc, u, wr, wc, fr, fq);
        else if (kind == K_DFT1C) EpiDFT1C{EA_P(WS_VTC)}(acc, u, wr, wc, fr, fq);
        else if (kind == K_DFT1L) EpiDFT1L{EA_P(WS_VTL)}(acc, u, wr, wc, fr, fq);
        else if (kind == K_DFT2C) EpiDFT2{EA_P(WS_UF), 0, 0}(acc, u, wr, wc, fr, fq);
        else if (kind == K_DFT2L0) EpiDFT2{EA_P(WS_GC), 1, 0}(acc, u, wr, wc, fr, fq);
        else if (kind == K_DFT2L1) EpiDFT2{EA_P(WS_GC), 1, 1}(acc, u, wr, wc, fr, fq);
        else if (kind == K_GLU) EpiGLU{EA_P(WS_GA)}(acc, u, wr, wc, fr, fq);
        else if (kind == K_FN) EpiMul{EA_P(WS_GF)}(acc, u, wr, wc, fr, fq);
        else if (kind == K_PC) EpiG4{EA_P(WS_G), EA_P(WS_PB), EA_P(WS_H), 0}(acc, u, wr, wc, fr, fq);
        else if (kind == K_PF) EpiChainF{EA_P(WS_G), EA_P(WS_H)}(acc, u, wr, wc, fr, fq);
        else EpiG5{EA_P(WS_PB), EA_P(WS_GA)}(acc, u, wr, wc, fr, fq);
#undef EA_P
    }
};

template <class RowMap>
__device__ __forceinline__ void transpose_item(const float* W, int K, int N, bf16* WT, const RowMap& rm, LAS float* scr, int item, int lane, int pitch = 0, int dup = 0) {
    if (pitch == 0) pitch = K;
    const int nblk = N / 32, kb = item / nblk, nb = item % nblk, k0 = 64 * kb, n0 = 32 * nb;
    { f32x4 w[8];
#pragma unroll
      for (int i = 0; i < 8; ++i) w[i] = *(const f32x4*)(W + (size_t)(k0 + 8 * i + (lane >> 3)) * N + n0 + 4 * (lane & 7));
#pragma unroll
      for (int i = 0; i < 8; ++i) { LAS float* d = scr + (8 * i + (lane >> 3)) * 33 + 4 * (lane & 7); d[0] = w[i][0]; d[1] = w[i][1]; d[2] = w[i][2]; d[3] = w[i][3]; } }
    LDS_WAIT(); asm volatile("" ::: "memory");
    const int c = lane & 7;
#pragma unroll
    for (int j = 0; j < 4; ++j) { const int n = (lane >> 3) + 8 * j; const LAS float* s = scr + (8 * c) * 33 + n;
        v4u o; o.x = cvtpk(s[0 * 33], s[1 * 33]); o.y = cvtpk(s[2 * 33], s[3 * 33]); o.z = cvtpk(s[4 * 33], s[5 * 33]); o.w = cvtpk(s[6 * 33], s[7 * 33]);
        bf16* dp = WT + (size_t)rm(n0 + n) * pitch + k0 + 8 * c; *(v4u*)dp = o; if (dup) *(v4u*)(dp + dup) = o; }
    LDS_WAIT(); asm volatile("" ::: "memory");
}
struct RmId { int off; __device__ __forceinline__ int operator()(int n) const { return off + n; } };
struct RmWin { __device__ __forceinline__ int operator()(int n) const {
        if (n < 2048 || n >= 2816) return n; const int t = (n - 2048) >> 8, cl = (n - 2048) & 255, hh = cl >> 6, jl = cl & 63; return 2048 + t * 256 + 128 * (jl >> 5) + 32 * hh + (jl & 31); } };
struct RmGlu { __device__ __forceinline__ int operator()(int c) const { const int half = c >> 9, cc = c & 511; return 256 * (cc >> 7) + 128 * half + (cc & 127); } };

__device__ __forceinline__ void ph_prologue(const Ctx& C) {
    LAS float* sil = (LAS float*)C.lds;
    LAS float* red = sil + 3072;
    for (int item = C.bid; item < 192; item += GRID) {
        const int l = item / 48, ch = item % 48;
        for (int i = C.tid; i < 3072; i += NTHR) { const float x = i < 1024 ? C.in[I_CCTX][i] : C.in[I_C][i - 1024]; sil[i] = x * sigmoidf_(x); }
        __syncthreads();
        const float* W = C.in[I_ADAW] + (size_t)l * 1024 * 3072 + ch * 64 + C.lane;
        float a0 = 0.f, a1 = 0.f, a2 = 0.f;
        for (int i0 = 0; i0 < 128; i0 += 32) { float w[32];
#pragma unroll
            for (int i = 0; i < 32; ++i) w[i] = W[(size_t)(C.wave * 128 + i0 + i) * 3072];
#pragma unroll
            for (int i = 0; i < 32; ++i) { const int k = C.wave * 128 + i0 + i; a0 += w[i] * sil[k]; a1 += w[i] * sil[1024 + k]; a2 += w[i] * sil[2048 + k]; } }
        red[(C.wave * 3 + 0) * 64 + C.lane] = a0; red[(C.wave * 3 + 1) * 64 + C.lane] = a1; red[(C.wave * 3 + 2) * 64 + C.lane] = a2;
        __syncthreads();
        if (C.tid < 192) { const int ci = C.tid >> 6, col = ch * 64 + (C.tid & 63); float s = C.in[I_ADAB][(size_t)l * 3072 + col];
#pragma unroll
            for (int w = 0; w < 8; ++w) s += red[(w * 3 + ci) * 64 + (C.tid & 63)];
            if (col >= 1024 && col < 2048) s = (1.0f + s) * C.in[I_NORMG][l * 1024 + col - 1024];
            C.w<float>(WS_MODF)[((size_t)l * 3 + ci) * 3072 + col] = s; }
        __syncthreads();
    }
    const int gt = C.bid * NTHR + C.tid, ngt = GRID * NTHR;
    constexpr int T_A2L = 2048 * 2048 / 8, T_A2C = 256 * 512 / 8, T_A1P = 512 * 256 / 8;
    for (int t = gt; t < T_A2L + T_A2C + T_A1P; t += ngt) {
        float v[8]; bf16* dst;
        if (t < T_A2L) { const int r = t >> 8, c0 = (t & 255) * 8, kk = 2 * (r & 1023) + (r >> 10); dst = C.w<bf16>(WS_A2L) + (size_t)r * 2048 + c0;
#pragma unroll
            for (int e = 0; e < 8; ++e) { const int col = c0 + e, s = col & 1023, mm = (kk * s) & 2047; float sn, cs; sincospif((float)mm * (1.0f / 1024.0f), &sn, &cs); v[e] = (col < 1024 ? cs : sn) * 0.02209708691207961f; } }
        else if (t < T_A2L + T_A2C) { const int tt = t - T_A2L, k = tt >> 6, c0 = (tt & 63) * 8; dst = C.w<bf16>(WS_A2C) + (size_t)k * 512 + c0;
#pragma unroll
            for (int e = 0; e < 8; ++e) { const int col = c0 + e, s = col & 255, mm = (k * s) & 255; float sn, cs; sincospif((float)mm * (1.0f / 128.0f), &sn, &cs); v[e] = (col < 256 ? cs : sn) * 0.0625f; } }
        else { const int tt = t - T_A2L - T_A2C, r = tt >> 5, c0 = (tt & 31) * 8; dst = C.w<bf16>(WS_A1P) + (size_t)r * 256 + c0; const int gl = r >> 8, reim = (r >> 7) & 1, j = r & 127;
#pragma unroll
            for (int e = 0; e < 8; ++e) { const int col = c0 + e, glc = col >> 7, c = col & 127, mm = (j * c) & 127; float sn, cs; sincospif((float)mm * (1.0f / 64.0f), &sn, &cs);
                v[e] = (glc == gl) ? (reim ? -sn : cs) * 0.08838834764831845f : 0.f; } }
        v4u o; o.x = cvtpk(v[0], v[1]); o.y = cvtpk(v[2], v[3]); o.z = cvtpk(v[4], v[5]); o.w = cvtpk(v[6], v[7]); *(v4u*)dst = o;
    }
    if (gt < 1024) { const int pos = gt >> 4, f = gt & 15; const float inv = powf(10000.0f, -(float)f / 16.0f), ang = (float)pos * inv;
        C.w<float>(WS_ROPE)[gt * 2] = cosf(ang); C.w<float>(WS_ROPE)[gt * 2 + 1] = sinf(ang); }
}

__device__ __forceinline__ void s5_mats_block(const Ctx& C, int l, int g, int part) {
    LAS f32x2* pw = (LAS f32x2*)C.lds;
    LAS f32x2* Bb = pw + 2 * 17 * 64;
    LAS f32x2* Cm = Bb + 2 * 64 * 16;
    LAS float* Kl = (LAS float*)(Cm + 2 * 16 * 64);
    const int tid = C.tid;
    f32x2 cmv[4];
#pragma unroll
    for (int k = 0; k < 4; ++k) { const int idx = tid + k * NTHR, d = idx >> 10, p = (idx >> 6) & 15, n = idx & 63; const size_t o = (((size_t)(l * 2 + d) * 32 + g) * 16 + p) * 64 + n; cmv[k] = (f32x2){C.in[I_CRE][o], C.in[I_CIM][o]}; }
    const float dskp = C.in[I_SD][(size_t)l * 512 + g * 16 + ((tid >> 1) & 15)];
    float lr = 0.f, li = 0.f, ldt = 0.f; f32x4 brv[4], biv[4];
    if (tid < 128) {
        const int d = tid >> 6, n = tid & 63; const size_t gi = ((size_t)(l * 2 + d) * 32 + g);
        lr = C.in[I_ARE][gi * 64 + n]; li = C.in[I_AIM][gi * 64 + n]; ldt = C.in[I_LDT][gi];
        const float* br = C.in[I_BRE] + (gi * 64 + n) * 16; const float* bi = C.in[I_BIM] + (gi * 64 + n) * 16;
#pragma unroll
        for (int k = 0; k < 4; ++k) { brv[k] = *(const f32x4*)(br + 4 * k); biv[k] = *(const f32x4*)(bi + 4 * k); }
    }
    asm volatile("" ::: "memory");
#pragma unroll
    for (int k = 0; k < 4; ++k) Cm[tid + k * NTHR] = cmv[k];
    if (tid < 128) {
        const int d = tid >> 6, n = tid & 63; const size_t gi = ((size_t)(l * 2 + d) * 32 + g);
        const float dt = expf(ldt);
        float mag = expf(dt * lr), sn, cs; sincosf(dt * li, &sn, &cs);
        { const float are = mag * cs, aim = mag * sn; float pr = 1.0f, pi = 0.0f;
          for (int tau = 0; tau <= 16; ++tau) { pw[(d * 17 + tau) * 64 + n] = (f32x2){pr, pi}; const float nr = pr * are - pi * aim, ni = pr * aim + pi * are; pr = nr; pi = ni; } }
        const float x = mag * cs - 1.0f, y = mag * sn, den = 1.0f / (lr * lr + li * li), cr = (x * lr + y * li) * den, cim = (y * lr - x * li) * den;
#pragma unroll
        for (int q = 0; q < 16; ++q) { const float brq = brv[q >> 2][q & 3], biq = biv[q >> 2][q & 3]; Bb[(d * 64 + n) * 16 + q] = (f32x2){cr * brq - cim * biq, cr * biq + cim * brq}; }
        if (part == 0) { const f32x2 p16 = pw[(d * 17 + 16) * 64 + n]; C.w<float>(WS_A16)[(gi * 64 + n) * 2] = p16.x; C.w<float>(WS_A16)[(gi * 64 + n) * 2 + 1] = p16.y; }
    }
    __syncthreads();
    {
        const int d = tid >> 8, p = (tid >> 4) & 15, q = tid & 15; float a0 = 0.f, a1 = 0.f;
        for (int n = 0; n < 64; ++n) { const f32x2 c = Cm[(d * 16 + p) * 64 + n], bq = Bb[(d * 64 + n) * 16 + q]; const float wr = c.x * bq.x - c.y * bq.y, wi = c.x * bq.y + c.y * bq.x;
            const f32x2 p0 = pw[(d * 17 + 2 * part) * 64 + n], p1 = pw[(d * 17 + 2 * part + 1) * 64 + n]; a0 += wr * p0.x - wi * p0.y; a1 += wr * p1.x - wi * p1.y; }
        Kl[(d * 2 + 0) * 256 + p * 16 + q] = a0; Kl[(d * 2 + 1) * 256 + p * 16 + q] = a1;
    }
    __syncthreads();
    bf16* BtE = C.w<bf16>(WS_BTE) + (size_t)g * 256 * 256; bf16* BtY = C.w<bf16>(WS_BTY) + (size_t)g * 256 * 512;
    for (int task = tid; task < 2 * 2 * 16 * 32; task += NTHR) {
        const int e = task >> 10, d = (task >> 9) & 1, blk = (task >> 5) & 15, p = (task >> 1) & 15, q0 = (task & 1) * 8, tau = 2 * part + e;
        if (blk >= 16 - tau || (tau == 0 && d == 1)) continue;
        const int t = d == 0 ? blk + tau : blk, j = d == 0 ? blk : blk + tau; float v[8];
#pragma unroll
        for (int k = 0; k < 8; ++k) { float s = Kl[(d * 2 + e) * 256 + p * 16 + q0 + k]; if (tau == 0) { s += Kl[(1 * 2 + e) * 256 + p * 16 + q0 + k]; if (q0 + k == p) s += dskp; } v[k] = s; }
        v4u o; o.x = cvtpk(v[0], v[1]); o.y = cvtpk(v[2], v[3]); o.z = cvtpk(v[4], v[5]); o.w = cvtpk(v[6], v[7]); *(v4u*)(BtY + (size_t)(t * 16 + p) * 512 + j * 16 + q0) = o;
    }
    for (int task = tid; task < 2 * 32 * 32; task += NTHR) {
        const int which = task >> 10, r = 32 * part + ((task >> 5) & 31), c0 = (task & 31) * 8; float v[8]; bf16* dst;
        if (which == 0) { const int d = r >> 7, reim = (r >> 6) & 1, n = r & 63, j = c0 >> 4, q0 = c0 & 15, ex = d == 0 ? 15 - j : j; dst = BtE + (size_t)r * 256 + c0; const f32x2 a = pw[(d * 17 + ex) * 64 + n];
#pragma unroll
            for (int k = 0; k < 8; ++k) { const f32x2 bq = Bb[(d * 64 + n) * 16 + q0 + k]; v[k] = reim ? (a.x * bq.y + a.y * bq.x) : (a.x * bq.x - a.y * bq.y); } }
        else { const int t = r >> 4, p = r & 15, d = c0 >> 7, reim = (c0 >> 6) & 1, n0 = c0 & 63, ex = d == 0 ? t + 1 : 16 - t; dst = BtY + (size_t)r * 512 + 256 + c0;
#pragma unroll
            for (int k = 0; k < 8; ++k) { const f32x2 c = Cm[(d * 16 + p) * 64 + n0 + k], a = pw[(d * 17 + ex) * 64 + n0 + k]; v[k] = reim ? -(c.x * a.y + c.y * a.x) : (c.x * a.x - c.y * a.y); } }
        v4u o; o.x = cvtpk(v[0], v[1]); o.y = cvtpk(v[2], v[3]); o.z = cvtpk(v[4], v[5]); o.w = cvtpk(v[6], v[7]); *(v4u*)dst = o;
    }
    __syncthreads();
}

__device__ __forceinline__ void prep_layer(const Ctx& C, int l, int parts, int blo, int bcnt) {
    if (C.vcu < blo || C.vcu >= blo + bcnt) return;
    const int bi = C.vcu - blo, wi = bi * NWAVES + C.wave, nw = bcnt * NWAVES;
    if (parts & 8) for (int it = bi; it < 256; it += bcnt) s5_mats_block(C, l, it >> 3, it & 7);
    LAS float* scr = (LAS float*)(C.lds + C.wave * 16384);
    constexpr int I_1 = 16 * 104, I_2 = 16 * 96, I_3 = 8 * 32, I_4 = 8 * 16, I_5 = 8 * 32, I_6 = 16 * 32;
    if (parts & 1) {
        for (int it = wi; it < I_1 + I_2 + I_3 + I_4; it += nw) {
            int r = it;
            if (r < I_1) { transpose_item(C.in[I_WIN] + (size_t)l * 1024 * INW, 1024, INW, C.w<bf16>(WS_WCAT), RmWin{}, scr, r, C.lane); continue; } r -= I_1;
            if (r < I_2) { transpose_item(C.in[I_MW] + (size_t)l * 1024 * 3072, 1024, 3072, C.w<bf16>(WS_WCAT), RmId{INW}, scr, r, C.lane); continue; } r -= I_2;
            if (r < I_3) { transpose_item(C.in[I_GLU] + (size_t)l * 512 * 1024, 512, 1024, C.w<bf16>(WS_WGLU), RmGlu{}, scr, r, C.lane); continue; } r -= I_3;
            transpose_item(C.in[I_FN] + (size_t)l * 512 * 512, 512, 512, C.w<bf16>(WS_WFN), RmId{0}, scr, r, C.lane, 1024, 512);
        }
        for (int t = bi * NTHR + C.tid; t < 2 * 2 * 256 * 16; t += bcnt * NTHR) {
            const int kv = t >> 13, r = t & 8191, b = r >> 12, s = (r >> 4) & 255, c0 = (r & 15) * 8;
            const float* src = C.in[kv ? I_CV : I_CK] + (((size_t)b * DEPTH + l) * 256 + s) * KVW + c0;
            const f32x4 a = *(const f32x4*)src, bq = *(const f32x4*)(src + 4);
            v4u o; o.x = cvtpk(a[0], a[1]); o.y = cvtpk(a[2], a[3]); o.z = cvtpk(bq[0], bq[1]); o.w = cvtpk(bq[2], bq[3]);
            *(v4u*)(C.w<bf16>(kv ? WS_VL : WS_KL) + ((size_t)b * LKV + S_LAT + s) * KVW + c0) = o;
        }
    }
    if (parts & 2) for (int it = wi; it < 3 * I_5; it += nw) { const int nb = it / I_5;
        transpose_item(C.in[I_WBR] + ((size_t)l * 3 + nb) * 512 * 1024, 512, 1024, C.w<bf16>(ws_wbr(l)) + (size_t)nb * 1024 * 512, RmId{0}, scr, it - nb * I_5, C.lane); }
    if (parts & 4) for (int it = wi; it < I_6; it += nw) transpose_item(C.in[I_WOUT] + (size_t)l * 1024 * 1024, 1024, 1024, C.w<bf16>(ws_wout(l)), RmId{0}, scr, it, C.lane);
}

__device__ __forceinline__ void rows_phase(const Ctx& C, int l, bool last);
#ifndef PREP_G4
#define PREP_G4 15
#endif
__device__ __forceinline__ void ph_l1(const Ctx& C, int l) {
    if (PREP_G4 != 15 && l > 0) { prep_layer(C, l, 15 & ~PREP_G4, 0, GRID); __syncthreads(); }
    rows_phase(C, l, false);
}

__device__ __forceinline__ void rows_phase(const Ctx& C, int l, bool last) {
    const float* modf = C.w<float>(WS_MODF); bf16* XR = C.w<bf16>(WS_XRES);
    const bf16* T0 = C.w<bf16>(WS_PB); const bf16* T1 = C.w<bf16>(WS_GA);
    const int c8 = C.lane * 8;
    f32x4 v[4][2][2];
#pragma unroll
    for (int i = 0; i < 4; ++i) { const int row = C.gw + i * 2048;
        if (l == 0) { const float* xr = i < 2 ? C.in[I_XP] + (size_t)row * 1024 : C.in[I_XS] + (size_t)(row - T_CTX) * 1024;
#pragma unroll
            for (int j = 0; j < 2; ++j) { v[i][j][0] = *(const f32x4*)(xr + c8 + 512 * j); v[i][j][1] = *(const f32x4*)(xr + c8 + 512 * j + 4); }
        } else {
#pragma unroll
            for (int j = 0; j < 2; ++j) { const v4u w = *(const v4u*)(XR + (size_t)row * 1024 + c8 + 512 * j); v[i][j][0] = bf8_lo(w); v[i][j][1] = bf8_hi(w); } } }
#pragma unroll
    for (int i = 0; i < 4; ++i) { const int row = C.gw + i * 2048, ci = i < 2 ? 0 : i - 1; float ss = 0.f;
        if (l > 0) {
            const float* gp = modf + ((size_t)(l - 1) * 3 + ci) * 3072 + 2048 + c8; v4u t0[2], t1[2]; f32x4 gt[2][2];
#pragma unroll
            for (int j = 0; j < 2; ++j) { t0[j] = *(const v4u*)(T0 + (size_t)row * 1024 + c8 + 512 * j); t1[j] = *(const v4u*)(T1 + (size_t)row * 1024 + c8 + 512 * j);
                gt[j][0] = *(const f32x4*)(gp + 512 * j); gt[j][1] = *(const f32x4*)(gp + 512 * j + 4); }
#pragma unroll
            for (int j = 0; j < 2; ++j) { v[i][j][0] += gt[j][0] * (bf8_lo(t0[j]) + bf8_lo(t1[j])); v[i][j][1] += gt[j][1] * (bf8_hi(t0[j]) + bf8_hi(t1[j])); }
        }
        if (!last) {
#pragma unroll
            for (int j = 0; j < 2; ++j) st_bf8(XR + (size_t)row * 1024 + c8 + 512 * j, v[i][j][0], v[i][j][1]);
        }
#pragma unroll
        for (int j = 0; j < 2; ++j) {
#pragma unroll
            for (int h = 0; h < 2; ++h) { const f32x4 t = v[i][j][h]; ss += (t[0] * t[0] + t[1] * t[1]) + (t[2] * t[2] + t[3] * t[3]); } }
        const float rstd = rsqrtf(wave_sum(ss, C.lane) * (1.0f / 1024.0f) + RMS_EPS);
        if (last) {
#pragma unroll
            for (int j = 0; j < 2; ++j) {
#pragma unroll
                for (int h = 0; h < 2; ++h) *(f32x4*)(C.out + (size_t)row * 1024 + c8 + 512 * j + 4 * h) = v[i][j][h] * rstd * *(const f32x4*)(C.in[I_FG] + c8 + 512 * j + 4 * h); }
        } else {
            const float* mp = modf + ((size_t)l * 3 + ci) * 3072 + c8; bf16* hr = C.w<bf16>(WS_H) + (size_t)row * 1024;
#pragma unroll
            for (int j = 0; j < 2; ++j) { const f32x4 sh0 = *(const f32x4*)(mp + 512 * j), sh1 = *(const f32x4*)(mp + 512 * j + 4), gs0 = *(const f32x4*)(mp + 1024 + 512 * j), gs1 = *(const f32x4*)(mp + 1024 + 512 * j + 4);
                st_bf8(hr + c8 + 512 * j, v[i][j][0] * rstd * gs0 + sh0, v[i][j][1] * rstd * gs1 + sh1); }
        }
    }
}

__device__ __forceinline__ void scan_unit(const Ctx& C, int l, int g, int pm) {
    const float* SC = C.w<float>(WS_SC); bf16* UH = C.w<bf16>(WS_UH); const int lane = C.lane;
    const int nitems = pm ? 4 : 32;
    for (int item = C.wave; item < nitems; item += NWAVES) {
        const int bsel = item >> 1, d = item & 1, nch = pm ? 128 : 16, c0 = pm ? 256 + bsel * 128 : bsel * 16;
        const size_t gi = ((size_t)(l * 2 + d) * 32 + g) * 64 + lane;
        const float ar = C.w<float>(WS_A16)[gi * 2], ai = C.w<float>(WS_A16)[gi * 2 + 1];
        float hr = 0.f, hi = 0.f;
        if (pm) { const float* st = C.in[I_ST] + ((((size_t)bsel * DEPTH + l) * 2 + d) * 32 + g) * 128 + lane * 2; hr = st[0]; hi = st[1]; }
        float sr[16], si[16], tr[16], ti[16];
#pragma unroll
        for (int k = 0; k < 16; ++k) { const int c = d == 0 ? c0 + k : c0 + nch - 1 - k; const size_t o = ((size_t)g * 512 + c) * 256 + d * 128 + lane; sr[k] = SC[o]; si[k] = SC[o + 64]; }
        for (int i0 = 0; i0 < nch; i0 += 16) {
            if (i0 + 16 < nch) {
#pragma unroll
                for (int k = 0; k < 16; ++k) { const int c = d == 0 ? c0 + i0 + 16 + k : c0 + nch - 1 - i0 - 16 - k; const size_t o = ((size_t)g * 512 + c) * 256 + d * 128 + lane; tr[k] = SC[o]; ti[k] = SC[o + 64]; }
            }
#pragma unroll
            for (int k = 0; k < 16; ++k) { const int c = d == 0 ? c0 + i0 + k : c0 + nch - 1 - i0 - k; const size_t oh = ((size_t)g * 512 + c) * 512 + 256 + d * 128 + lane;
                UH[oh] = (bf16)(cvtpk(hr, hr) & 0xffffu); UH[oh + 64] = (bf16)(cvtpk(hi, hi) & 0xffffu);
                const float nr = ar * hr - ai * hi + sr[k], ni = ar * hi + ai * hr + si[k]; hr = nr; hi = ni; }
#pragma unroll
            for (int k = 0; k < 16; ++k) { sr[k] = tr[k]; si[k] = ti[k]; }
        }
        if (!pm) { float* o = C.out + OUT_S + ((((size_t)bsel * DEPTH + l) * 2 + d) * 32 + g) * 128 + lane * 2; o[0] = hr; o[1] = hi; }
    }
}

__device__ __forceinline__ void ph_final(const Ctx& C) { rows_phase(C, DEPTH, true); }

__device__ __forceinline__ void attn_any(const Ctx& C, int uidx) {
    size_t tok0, kvoff; int NT, h;
    if (uidx < 128) { const int b = uidx >> 6, qb = uidx & 7; h = (uidx >> 3) & 7; tok0 = (size_t)T_CTX + b * 2048 + qb * 256; kvoff = (size_t)(WS_KL - WS_KC) / 2 + (size_t)b * LKV * KVW; NT = LKV / 64; }
    else { const int u2 = uidx - 128, b = u2 >> 3; h = u2 & 7; tok0 = (size_t)b * 256; kvoff = tok0 * KVW; NT = 4; }
    kvoff += (h >> 2) * 64;
    const attn_body::bf16* Q = (const attn_body::bf16*)C.w<bf16>(WS_Q) + tok0 * 512 + h * 64;
    const attn_body::bf16* Kp = (const attn_body::bf16*)C.w<bf16>(WS_KC) + kvoff;
    attn_body::attn_unit<8>(Q, Kp, Kp + (WS_VC - WS_KC) / 2, (attn_body::bf16*)Q, (const attn_body::bf16*)C.w<bf16>(WS_GC) + tok0 * 512 + h * 64, 512, KVW, NT, (char*)C.lds, C.tid);
}

#ifndef MK_PER_PHASE
#define MK_PER_PHASE 0
#endif
constexpr int NSUB = 7, N_PHASES = 2 + NSUB * DEPTH;


__global__ void __launch_bounds__(NTHR, 2) fwd_kernel(KArgs args) {
    extern __shared__ __attribute__((aligned(16))) unsigned char lds_raw[];
    Ctx C; C.lds = (LAS unsigned char*)lds_raw; C.tid = threadIdx.x; C.lane = C.tid & 63; C.wave = __builtin_amdgcn_readfirstlane(C.tid >> 6); C.bid = blockIdx.x;
    int wave_s = C.wave;
    C.gw = C.bid * NWAVES + C.wave; C.ngw = GRID * NWAVES; C.in = args.in; C.out = args.out; C.ws = args.ws;
    for (int u = C.tid; u < (LDS_BYTES - LDSCTL_OFF) / 4; u += NTHR) ((LAS unsigned*)(C.lds + LDSCTL_OFF))[u] = 0u;
    __syncthreads();
    volatile LAS unsigned* MISC = (volatile LAS unsigned*)(C.lds + MISC_OFF);
    XcdBarrier bar; bar.bar = (unsigned*)(C.ws + WS_CTL) + CW_BAR; bar.x = 0; bar.st = nullptr;
    const bool multi = args.ph_hi - args.ph_lo > 1;
    if (multi) bar = xcd_barrier_post((unsigned*)(C.ws + WS_CTL) + CW_BAR, MISC + 8, C.tid);

    for (int ph = args.ph_lo; ph < args.ph_hi; ++ph) {
        { int l_; asm volatile("v_mbcnt_lo_u32_b32 %0, -1, 0\n\tv_mbcnt_hi_u32_b32 %0, -1, %0" : "=v"(l_)); asm volatile("" : "+s"(wave_s)); int b_ = blockIdx.x; asm volatile("" : "+s"(b_)); C.bid = b_; C.vcu = b_;   C.lane = l_; C.wave = wave_s; C.tid = wave_s * 64 + l_; C.gw = C.bid * NWAVES + C.wave;
          unsigned char* w_ = args.ws; asm volatile("" : "+s"(w_)); C.ws = w_; float* o_ = args.out; asm volatile("" : "+s"(o_)); C.out = o_; }
        const int c = C.vcu;
        if (ph == 0) { ph_prologue(C); __syncthreads(); prep_layer(C, 0, 15, 0, GRID); }
        else if (ph == N_PHASES - 1) ph_final(C);
        else {
            const int l = (ph - 1) / NSUB, sub = (ph - 1) % NSUB;
            if (sub == 0) ph_l1(C, l);
            else {
                if (sub == 2 && c < 128) for (int i = 0; i < 2; ++i) attn_any(C, c + 128 * i);
                if (sub == 3 && c >= 64 && c < 128) { const int L = xswz(c - 64, 64); scan_unit(C, l, L >> 1, L & 1); VM_WAIT(); }
                __syncthreads();
                { PhaseSched S{sub, c, C.bid, C.ws, l}; EpiAll E{C.ws, C.out, C.in, l}; int t_ = C.tid; asm volatile("" : "+v"(t_));
                  pg8::gemm_stream<EpiAll, PhaseSched>(C.lds, S, E, t_); }
                if (sub == 5 && l + 1 < DEPTH) { __syncthreads(); prep_layer(C, l + 1, PREP_G4, 128, 128); }
            }
        }
        if (ph + 1 < args.ph_hi) xcd_barrier(bar, C.tid);
    }
}

extern "C" void kernel_launch(void* const* d_in, const int* in_sizes, int n_in, void* d_out, int out_size, void* d_ws, size_t ws_size, hipStream_t stream) {
    static int ready = 0;
    if (ready == 0) {
        if (n_in != 28 || out_size != (int)OUT_N || ws_size < WS_END) { fprintf(stderr, "kernel_launch: unexpected problem shape (n_in %d, out %d, ws %zu)\n", n_in, out_size, ws_size); ready = -1; return; }
        int dev = 0, cus = 0;
        if (hipGetDevice(&dev) != hipSuccess || hipDeviceGetAttribute(&cus, hipDeviceAttributeMultiprocessorCount, dev) != hipSuccess) { ready = -1; return; }
        if (hipFuncSetAttribute((const void*)fwd_kernel, hipFuncAttributeMaxDynamicSharedMemorySize, LDS_BYTES) != hipSuccess) { fprintf(stderr, "kernel_launch: hipFuncSetAttribute failed\n"); ready = -1; return; }
        if (cus < GRID) { fprintf(stderr, "kernel_launch: device has %d CUs, this kernel needs %d resident workgroups\n", cus, GRID); ready = -1; return; }
        ready = 1;
    }
    if (ready < 0) return;
    (void)hipMemsetAsync((char*)d_ws + WS_CTL, 0, CTL_ZERO_BYTES, stream);
    KArgs a{};
    for (int i = 0; i < 28; ++i) a.in[i] = (const float*)d_in[i];
    a.out = (float*)d_out; a.ws = (unsigned char*)d_ws;
#if MK_PER_PHASE
    for (int ph = 0; ph < N_PHASES; ++ph) { a.ph_lo = ph; a.ph_hi = ph + 1; hipLaunchKernelGGL(fwd_kernel, dim3(GRID), dim3(NTHR), LDS_BYTES, stream, a); }
#else
    a.ph_lo = 0; a.ph_hi = N_PHASES; hipLaunchKernelGGL(fwd_kernel, dim3(GRID), dim3(NTHR), LDS_BYTES, stream, a);
#endif
}
```

```cpp
#include <hip/hip_runtime.h>
#include <hip/hip_bf16.h>
#include <cstdio>
#include <cstdint>
#include <cmath>
namespace pg8 {
#define PG8_LAS __attribute__((address_space(3)))
typedef unsigned short bf16_t;
typedef short bf16x8 __attribute__((ext_vector_type(8)));
typedef float f32x4 __attribute__((ext_vector_type(4)));
typedef unsigned u32x4 __attribute__((ext_vector_type(4)));
constexpr int BM = 256, BK = 64, HALF = 128, HTB = HALF * BK * 2  , STAGE_BYTES = 8 * HTB, NXCD = 8, WGM = 8;

__host__ __device__ __forceinline__ int lds_byte(int r, int c) { const int st = (r >> 4) * 2 + (c >> 5), rr = r & 15, cc = c & 31, ob = rr * 64 + cc * 2; return st * 1024 + (ob ^ (((ob >> 9) & 1) << 5)); }
__host__ __device__ __forceinline__ void stage_rc(int b, int& R, int& C) { const int st = b / 1024, sb = b % 1024, swz = sb ^ (((sb >> 9) & 1) << 5); R = (st >> 1) * 16 + swz / 64; C = (st & 1) * 32 + (swz % 64) / 2; }
__host__ __device__ __forceinline__ int perm32(int rho) { const int n = rho >> 4, i = rho & 15; return 8 * (i >> 2) + 4 * n + (i & 3); }


struct Unit { int pm, pn, z; };
struct StaticOrder {
    int nM, nN, nwg, G, c;
    __host__ __device__ void init(int M, int N, int G_, int c_) { nM = M / BM; nN = N / BM; nwg = nM * nN; G = G_; c = c_; }
    __host__ __device__ bool next(int i, Unit& u) const {
        const long L = (long)i * G + c; if (L >= nwg) return false;
        int wgid = (int)L; { const int q = nwg / NXCD, r = nwg % NXCD, xcd = wgid % NXCD, off = wgid / NXCD; wgid = (xcd < r ? xcd * (q + 1) : r * (q + 1) + (xcd - r) * q) + off; }
        const int nig = WGM * nN, gid = wgid / nig, fm = gid * WGM, gsz = (nM - fm) < WGM ? (nM - fm) : WGM;
        u.pm = fm + ((wgid % nig) % gsz); u.pn = (wgid % nig) / gsz; return true;
    }
    __device__ __forceinline__ void a_ready(const Unit&) const {}
    __device__ __forceinline__ void done(const Unit&) const {}
};
struct UDesc { const bf16_t* A; const bf16_t* Bt; int lda, ldb, K, hB; int kind, pm, pn, z, keep; };
template <class Epi, class Sched>
__device__ __forceinline__ void gemm_stream(PG8_LAS unsigned char* lds, const Sched& S, const Epi& E, const int tid_in) {
    const int tid = tid_in, wid = __builtin_amdgcn_readfirstlane(tid >> 6), lane = tid & 63, wr = wid >> 2, wc = wid & 3, fr = lane & 15, fq = lane >> 4;
    int RA, RB, CC;
    { int R, C; stage_rc(tid * 16, R, C); RA = R; RB = (R & ~31) + perm32(R & 31); CC = C; }
    const size_t kstep = (size_t)(BK * 2);
    const unsigned ldsw = (unsigned)wid * 1024u;
    const int aoff = lds_byte(wr * 64 + fr, fq * 8), boff = lds_byte(wc * 32 + fr, fq * 8);
#define PG8_SA(b, h) (((b) * 2 + (h)) * HTB)
#define PG8_SB(b, h) ((4 + (b) * 2 + (h)) * HTB)
#define PG8_STAGE_X(bufoff, gbase, RR, ld) do { const unsigned _vo = (unsigned)(RR * (ld) + CC) * 2u; \
        __builtin_amdgcn_global_load_lds((const unsigned*)((const char*)(gbase) + _vo), (PG8_LAS unsigned*)(lds + (bufoff) + ldsw), 16, 0, 0); \
        __builtin_amdgcn_global_load_lds((const unsigned*)((const char*)(gbase) + (size_t)(ld) * 128 + _vo), (PG8_LAS unsigned*)(lds + (bufoff) + ldsw + 8192), 16, 0, 0); } while (0)
#define PG8_STAGE_A(bufoff, gbase, ld) PG8_STAGE_X(bufoff, gbase, RA, ld)
#define PG8_STAGE_B(bufoff, gbase, ld) PG8_STAGE_X(bufoff, gbase, RB, ld)
#define PG8_LDA(dst, b, h) do { _Pragma("unroll") for (int m = 0; m < 4; ++m) _Pragma("unroll") for (int k = 0; k < 2; ++k) dst[m][k] = *(const PG8_LAS bf16x8*)(lds + PG8_SA(b, h) + aoff + m * 2048 + k * 1024); } while (0)
#define PG8_LDB(dst, b, h) do { _Pragma("unroll") for (int n = 0; n < 2; ++n) _Pragma("unroll") for (int k = 0; k < 2; ++k) dst[n][k] = *(const PG8_LAS bf16x8*)(lds + PG8_SB(b, h) + boff + n * 2048 + k * 1024); } while (0)
#define PG8_MMA(ai, bj, At, Bt) do { __builtin_amdgcn_s_setprio(1); _Pragma("unroll") for (int m = 0; m < 4; ++m) _Pragma("unroll") for (int n = 0; n < 2; ++n) _Pragma("unroll") for (int k = 0; k < 2; ++k) \
        acc[ai][bj][m][n] = __builtin_amdgcn_mfma_f32_16x16x32_bf16(Bt[n][k], At[m][k], acc[ai][bj][m][n], 0, 0, 0); __builtin_amdgcn_s_setprio(0); } while (0)
#define PG8_WAIT_V(n) asm volatile("s_waitcnt vmcnt(" #n ")" ::: "memory")
#define PG8_WAIT_L(n) asm volatile("s_waitcnt lgkmcnt(" #n ")" ::: "memory")
#define PG8_BAR __builtin_amdgcn_s_barrier()
#define PG8_SCHED __builtin_amdgcn_sched_barrier(0)
    UDesc cur, nxt; int ui = 0;
    if (!S.next(0, cur)) return;
    f32x4 acc[2][2][4][2];
#pragma unroll
    for (int a = 0; a < 2; ++a)
#pragma unroll
        for (int b = 0; b < 2; ++b)
#pragma unroll
            for (int m = 0; m < 4; ++m)
#pragma unroll
                for (int n = 0; n < 2; ++n) acc[a][b][m][n] = (f32x4){0.f, 0.f, 0.f, 0.f};
    bf16x8 At[4][2], B0[2][2], B1[2][2];
    const char* cA = (const char*)cur.A; const char* cB = (const char*)cur.Bt; int ldaC = cur.lda, ldbC = cur.ldb; unsigned hstepA = (unsigned)HALF * ldaC * 2, hstepB = (unsigned)cur.hB * ldbC * 2;
    PG8_STAGE_B(PG8_SB(0, 0), cB, ldbC); PG8_STAGE_B(PG8_SB(0, 1), cB + hstepB, ldbC); PG8_STAGE_A(PG8_SA(0, 0), cA, ldaC); PG8_STAGE_A(PG8_SA(0, 1), cA + hstepA, ldaC);
    if (wr == 1) PG8_BAR;
    PG8_WAIT_V(2); PG8_BAR;
    PG8_STAGE_B(PG8_SB(1, 0), cB + kstep, ldbC); PG8_STAGE_A(PG8_SA(1, 0), cA + kstep, ldaC); PG8_STAGE_B(PG8_SB(1, 1), cB + hstepB + kstep, ldbC);
    PG8_WAIT_V(6); PG8_BAR;
    for (;;) {
        const bool has_next = S.next(ui + 1, nxt);
        const char* nA = has_next ? (const char*)nxt.A : cA; const char* nB = has_next ? (const char*)nxt.Bt : cB;
        const int ldaN = has_next ? nxt.lda : ldaC, ldbN = has_next ? nxt.ldb : ldbC; const unsigned hstepAN = (unsigned)HALF * ldaN * 2, hstepBN = has_next ? (unsigned)nxt.hB * ldbN * 2 : hstepB;
        const int nt = cur.K / BK;
        for (int t = 0; t < nt; t += 2) {
            const bool last = (t == nt - 2);
            const char* a1 = cA + (size_t)(t + 1) * kstep;
            const char* a2 = last ? nA : cA + (size_t)(t + 2) * kstep; const char* b2 = last ? nB : cB + (size_t)(t + 2) * kstep;
            const char* a3 = a2 + kstep; const char* b3 = b2 + kstep;
            const int lda2 = last ? ldaN : ldaC, ldb2 = last ? ldbN : ldbC; const unsigned hA2 = last ? hstepAN : hstepA, hB2 = last ? hstepBN : hstepB;
            PG8_LDB(B0, 0, 0); PG8_LDB(B1, 0, 1); PG8_SCHED; PG8_LDA(At, 0, 0); PG8_STAGE_A(PG8_SA(1, 1), a1 + hstepA, ldaC);
            PG8_WAIT_V(8); PG8_WAIT_L(0); PG8_BAR; PG8_MMA(0, 0, At, B0); PG8_MMA(0, 1, At, B1); PG8_BAR; PG8_SCHED;
            PG8_LDA(At, 0, 1); PG8_STAGE_B(PG8_SB(0, 0), b2, ldb2); PG8_STAGE_B(PG8_SB(0, 1), b2 + hB2, ldb2); PG8_STAGE_A(PG8_SA(0, 0), a2, lda2);
            PG8_WAIT_V(8); PG8_WAIT_L(0); PG8_BAR; PG8_MMA(1, 0, At, B0); PG8_MMA(1, 1, At, B1); PG8_BAR; PG8_SCHED;
            PG8_LDB(B0, 1, 0); PG8_LDB(B1, 1, 1); PG8_SCHED; PG8_LDA(At, 1, 0); PG8_STAGE_A(PG8_SA(0, 1), a2 + hA2, lda2);
            PG8_WAIT_V(8); PG8_WAIT_L(0); PG8_BAR; PG8_MMA(0, 0, At, B0); PG8_MMA(0, 1, At, B1); PG8_BAR; PG8_SCHED;
            PG8_LDA(At, 1, 1); PG8_STAGE_B(PG8_SB(1, 0), b3, ldb2); PG8_STAGE_B(PG8_SB(1, 1), b3 + hB2, ldb2); PG8_STAGE_A(PG8_SA(1, 0), a3, lda2);
            PG8_WAIT_V(8); PG8_WAIT_L(0); PG8_BAR; PG8_MMA(1, 0, At, B0); PG8_MMA(1, 1, At, B1); PG8_BAR; PG8_SCHED;
        }
        if (wr == 0) PG8_BAR;
        const bool chained = E.transform(acc, cur, wr, wc, fr, fq);
        if (!chained) E(acc, cur, wr, wc, fr, fq);
        if (!has_next) break;
        if (!chained) {
#pragma unroll
        for (int a = 0; a < 2; ++a)
#pragma unroll
            for (int b = 0; b < 2; ++b)
#pragma unroll
                for (int m = 0; m < 4; ++m)
#pragma unroll
                    for (int n = 0; n < 2; ++n) acc[a][b][m][n] = (f32x4){0.f, 0.f, 0.f, 0.f};
        }
        cur = nxt; cA = nA; cB = nB; ldaC = ldaN; ldbC = ldbN; hstepA = hstepAN; hstepB = hstepBN; ++ui;
        if (wr == 1) PG8_BAR;
    }
    PG8_WAIT_V(0);
    PG8_BAR;
#undef PG8_SA
#undef PG8_SB
#undef PG8_STAGE_X
#undef PG8_STAGE_A
#undef PG8_STAGE_B
#undef PG8_LDA
#undef PG8_LDB
#undef PG8_MMA
#undef PG8_WAIT_V
#undef PG8_WAIT_L
#undef PG8_BAR
#undef PG8_SCHED
}
}

#include <hip/hip_bf16.h>
#include <cmath>
namespace attn_body {
using bf16=__hip_bfloat16;
using bf16x8=__attribute__((ext_vector_type(8)))short;
using s16x4=__attribute__((ext_vector_type(4)))short;
using f32x16=__attribute__((ext_vector_type(16)))float;
using u32x4=__attribute__((ext_vector_type(4)))unsigned;
constexpr int D=64;
constexpr int NW=8,QBLK=32,QB=QBLK*NW,KVBLK=64;
__device__ __forceinline__ int crow(int r,int hi){return (r&3)+8*(r>>2)+4*hi;}
#define SBAR() __builtin_amdgcn_sched_barrier(0)
constexpr int NSLOT=3, SLOTB=8192;
constexpr int LDS_K=0, LDS_V=NSLOT*SLOTB, LDS_WS=2*NSLOT*SLOTB, LDS_OST=LDS_WS+NW*64*4, LDS_BYTES=LDS_OST+NW*4096;
constexpr float C2=0.125f*1.4426950408889634f;
__device__ __forceinline__ void glds16(const void*gsrc,unsigned lds_dst){unsigned keep;
  asm volatile("s_mov_b32 %0, m0\n\ts_mov_b32 m0, %2\n\ts_nop 0\n\tglobal_load_lds_dwordx4 %1, off\n\ts_mov_b32 m0, %0":"=&s"(keep):"v"(gsrc),"s"(lds_dst):"memory");}
__device__ __forceinline__ float max3f(float a,float b,float c){float r;asm("v_max3_f32 %0, %1, %2, %3":"=v"(r):"v"(a),"v"(b),"v"(c));return r;}
__device__ __forceinline__ float max2f(float a,float b){float r;asm("v_max_f32_e32 %0, %1, %2":"=v"(r):"v"(a),"v"(b));return r;}
__device__ __forceinline__ float fadd_s(float a,float b){float r;asm("v_add_f32_e32 %0, %1, %2":"=v"(r):"v"(a),"v"(b));return r;}
__device__ __forceinline__ float fsub_s(float a,float b){float r;asm("v_sub_f32_e32 %0, %1, %2":"=v"(r):"v"(a),"v"(b));return r;}
typedef float f32x2_t __attribute__((ext_vector_type(2))); typedef __bf16 bf16x2_t __attribute__((ext_vector_type(2)));
__device__ __forceinline__ unsigned cvtpk_s(float lo,float hi){f32x2_t v={lo,hi};bf16x2_t b=__builtin_convertvector(v,bf16x2_t);return __builtin_bit_cast(unsigned,b);}
#define WAIT_BAR(N) asm volatile("s_waitcnt vmcnt(" #N ") lgkmcnt(0)\n\ts_barrier":::"memory")

__device__ __forceinline__ void qkt(f32x16&p0,f32x16&p1,const char*Kslot,const bf16x8*qr,const f32x16&negm,int r32,int hi){
  const char*kb=Kslot+hi*1024+r32*16;
  #pragma unroll
  for(int d0=0;d0<4;++d0){
    const bf16x8 b0=*reinterpret_cast<const bf16x8*>(kb+d0*2048);
    const bf16x8 b1=*reinterpret_cast<const bf16x8*>(kb+d0*2048+512);
    if(d0==0){p0=__builtin_amdgcn_mfma_f32_32x32x16_bf16(b0,qr[0],negm,0,0,0);p1=__builtin_amdgcn_mfma_f32_32x32x16_bf16(b1,qr[0],negm,0,0,0);}
    else{p0=__builtin_amdgcn_mfma_f32_32x32x16_bf16(b0,qr[d0],p0,0,0,0);p1=__builtin_amdgcn_mfma_f32_32x32x16_bf16(b1,qr[d0],p1,0,0,0);}}
}
typedef __attribute__((address_space(3))) const char* lds_cptr;
typedef short v4i16_t __attribute__((ext_vector_type(4)));
__device__ __forceinline__ void kload8(bf16x8*kf,lds_cptr kp){
  kf[0]=*(const __attribute__((address_space(3))) bf16x8*)(kp);      kf[1]=*(const __attribute__((address_space(3))) bf16x8*)(kp+512);
  kf[2]=*(const __attribute__((address_space(3))) bf16x8*)(kp+2048); kf[3]=*(const __attribute__((address_space(3))) bf16x8*)(kp+2560);
  kf[4]=*(const __attribute__((address_space(3))) bf16x8*)(kp+4096); kf[5]=*(const __attribute__((address_space(3))) bf16x8*)(kp+4608);
  kf[6]=*(const __attribute__((address_space(3))) bf16x8*)(kp+6144); kf[7]=*(const __attribute__((address_space(3))) bf16x8*)(kp+6656);
}
__device__ __forceinline__ void kload2(bf16x8*kf,lds_cptr kp,int j){ kf[2*j]=*(const __attribute__((address_space(3))) bf16x8*)(kp+j*2048); kf[2*j+1]=*(const __attribute__((address_space(3))) bf16x8*)(kp+j*2048+512); }
__device__ __forceinline__ s16x4 vtr(lds_cptr p){ return __builtin_bit_cast(s16x4,__builtin_amdgcn_ds_read_tr16_b64_v4i16((__attribute__((address_space(3))) v4i16_t*)p)); }
__device__ __forceinline__ float rowmax(const f32x16&p0,const f32x16&p1){
  float a=max3f(p0[0],p0[1],p1[0]),b=max3f(p0[2],p0[3],p1[1]);a=max3f(a,p1[2],p1[3]);
  #pragma unroll
  for(int r=4;r<16;r+=4){a=max3f(a,p0[r],p0[r+1]);b=max3f(b,p0[r+2],p0[r+3]);a=max3f(a,p1[r],p1[r+1]);b=max3f(b,p1[r+2],p1[r+3]);}
  const float m=max2f(a,b);
  auto rr=__builtin_amdgcn_permlane32_swap(__float_as_uint(m),__float_as_uint(m),false,false);
  return max2f(__uint_as_float(rr[0]),__uint_as_float(rr[1]));
}
__device__ __forceinline__ void pv(f32x16*o,int vb,bf16x8 pa0,bf16x8 pa1,bf16x8 pa2,bf16x8 pa3){
  #pragma unroll
  for(int d0=0;d0<2;++d0){s16x4 lo[4],hi[4];
    #pragma unroll
    for(int ks=0;ks<4;++ks){
      asm volatile("ds_read_b64_tr_b16 %0,%1 offset:%c2":"=&v"(lo[ks]):"v"(vb),"i"(d0*4096+ks*1024):"memory");
      asm volatile("ds_read_b64_tr_b16 %0,%1 offset:%c2":"=&v"(hi[ks]):"v"(vb),"i"(d0*4096+ks*1024+512):"memory");}
    asm volatile("s_waitcnt lgkmcnt(0)":::"memory");SBAR();
    #define PK(k) (bf16x8){lo[k][0],lo[k][1],lo[k][2],lo[k][3],hi[k][0],hi[k][1],hi[k][2],hi[k][3]}
    o[d0]=__builtin_amdgcn_mfma_f32_32x32x16_bf16(pa0,PK(0),o[d0],0,0,0);
    o[d0]=__builtin_amdgcn_mfma_f32_32x32x16_bf16(pa1,PK(1),o[d0],0,0,0);
    o[d0]=__builtin_amdgcn_mfma_f32_32x32x16_bf16(pa2,PK(2),o[d0],0,0,0);
    o[d0]=__builtin_amdgcn_mfma_f32_32x32x16_bf16(pa3,PK(3),o[d0],0,0,0);
    #undef PK
  }
}

#ifndef ATTN_STORE16
#define ATTN_STORE16(p,v) (*(u32x4*)(p)=(v))
#endif
template<int THRL> __device__ __forceinline__ void attn_unit(const bf16*Qu,const bf16*Kh,const bf16*Vh,bf16*Ou,const bf16*Gu,const int QP,const int KP,const int NT,char*shm,const int tid_in){
  const int tid=tid_in,lane=tid&63,r32=lane&31,hi=lane>>5; const int wid=__builtin_amdgcn_readfirstlane(tid>>6);
  const bf16*Qw=Qu+(long)(wid*QBLK)*QP;
  const unsigned lds0=(unsigned)(uintptr_t)shm;
  float*wsf=(float*)(shm+LDS_WS)+wid*64;
  const bf16*ksrc=Kh+(long)lane*KP+wid*8;
  const bf16*vsrc=Vh+(long)(16*(wid&3)+(lane>>2))*KP+(wid>>2)*32+(lane&3)*8;
  const unsigned kdst=lds0+LDS_K+wid*1024, vdst=lds0+LDS_V+wid*1024;
  #define DMA_K(t,slot) glds16(ksrc+(long)(t)*KVBLK*KP,(unsigned)__builtin_amdgcn_readfirstlane(kdst+(slot)))
  #define DMA_V(t,slot) glds16(vsrc+(long)(t)*KVBLK*KP,(unsigned)__builtin_amdgcn_readfirstlane(vdst+(slot)))
  const int vb0=(int)(lds0+LDS_V)+((lane>>4)&1)*32+(lane&3)*8+(4*hi+((lane&15)>>2))*64;
  const char*Kbase=shm+LDS_K; bf16x8 kf[8];
  const lds_cptr shm3=(lds_cptr)shm; const lds_cptr kp0=shm3+LDS_K+hi*1024+r32*16; const lds_cptr vp0=shm3+LDS_V+((lane>>4)&1)*32+(lane&3)*8+(4*hi+((lane&15)>>2))*64;
  DMA_K(0,0);DMA_V(0,0);DMA_K(1,SLOTB);
  bf16x8 qr[4];
  #pragma unroll
  for(int d0=0;d0<4;++d0)qr[d0]=*reinterpret_cast<const bf16x8*>(&Qw[(long)r32*QP+d0*16+hi*8]);
  float mhat=0.f,l_reg=0.f;f32x16 o[2];o[0]=f32x16{};o[1]=f32x16{};f32x16 negm; {float zf_; asm volatile("v_mov_b32 %0, 0":"=v"(zf_)); _Pragma("unroll") for(int r=0;r<16;++r)negm[r]=zf_;} asm volatile("":"+v"(negm));
  #define CMASK(P0,P1,t) do{}while(0)
  bool resc=false;
  #define START(P0,P1) do{ const float rm=rowmax(P0,P1); resc=false; \
    { const float dl=rm; mhat=fadd_s(mhat,dl); \
      _Pragma("unroll") for(int r=0;r<16;++r){P0[r]=fsub_s(P0[r],dl);P1[r]=fsub_s(P1[r],dl);} \
      _Pragma("unroll") for(int r=0;r<16;++r)negm[r]=-mhat; asm volatile("":"+v"(negm)); } \
    _Pragma("unroll") for(int r=0;r<16;++r)P0[r]=__builtin_amdgcn_exp2f(P0[r]); }while(0)
  #define RESC() do{ if(resc){ asm volatile("s_waitcnt lgkmcnt(0)":::"memory"); \
      _Pragma("unroll") for(int d_=0;d_<2;++d_) _Pragma("unroll") for(int r=0;r<16;++r)o[d_][r]*=wsf[crow(r,hi)]; } }while(0)
  f32x16 pA0,pA1,pB0,pB1;
  int sl_prev=0,sl_cur=0,sl_next=SLOTB;
  #define ROT() do{sl_prev=sl_cur;sl_cur=sl_next;sl_next=(sl_next==(NSLOT-1)*SLOTB)?0:sl_next+SLOTB;}while(0)
  DMA_K(2,2*SLOTB);
  WAIT_BAR(3);
  qkt(pA0,pA1,Kbase,qr,negm,r32,hi);asm volatile("s_nop 15\n\ts_nop 7":"+v"(pA0),"+v"(pA1));CMASK(pA0,pA1,0);
  START(pA0,pA1);
  _Pragma("unroll") for(int r=0;r<16;++r)pA1[r]=__builtin_amdgcn_exp2f(pA1[r]);
  WAIT_BAR(0);
  DMA_K(3,0);DMA_V(1,SLOTB);
  ROT();
  kload8(kf,kp0+sl_cur);
  WAIT_BAR(2);
  s16x4 vlo[8],vhi[8]; u32x4 pw0,pw1,pw2,pw3;
  #define PKW(P,B) cvtpk_s(P[B],P[B+1])
  #define PAF(k) __builtin_bit_cast(bf16x8,pw##k)
  #define VFR(i) (bf16x8){vlo[i][0],vlo[i][1],vlo[i][2],vlo[i][3],vhi[i][0],vhi[i][1],vhi[i][2],vhi[i][3]}
  #define PIN(x) asm volatile("":"+v"(x))
  #define MX3(a,b,c) __builtin_fmaxf(__builtin_fmaxf((a),(b)),(c))
  #define GAPA(MF,A0,A1,A2,A3,W0,W1,PW) do{ MF; sacc+=A0; sacc+=A1; sacc+=A2; sacc+=A3; PIN(sacc); W0; W1; PIN(PW); SBAR(); }while(0)
  #define EX(v) __builtin_amdgcn_exp2f(v)
  #define GAPB(MF,X,B) do{ MF; X[B]=EX(X[B]); X[B+1]=EX(X[B+1]); X[B+2]=EX(X[B+2]); X[B+3]=EX(X[B+3]); PIN(X); SBAR(); }while(0)
  #define VRD(i) do{ vlo[i]=vtr(vp_+(((i)>>2)*4096+((i)&3)*1024)); vhi[i]=vtr(vp_+(((i)>>2)*4096+((i)&3)*1024+512)); }while(0)
  #define KRD(G,j) do{ if(G){ kload2(kf,kp0+sl_next,j); SBAR(); } }while(0)
  #define STEP(C0,C1,P0,P1,t,GK,GV,GL) do{ SBAR(); \
    const lds_cptr vp_=vp0+sl_prev; \
    VRD(0); SBAR(); float sacc=(P0[0]+P0[1]); \
    GAPA(C0=__builtin_amdgcn_mfma_f32_32x32x16_bf16(kf[0],qr[0],negm,0,0,0), P0[2],P0[3],P0[4],P0[5],     pw0[0]=PKW(P0,0), pw0[1]=PKW(P0,2), pw0); \
    VRD(4); SBAR(); GAPA(C1=__builtin_amdgcn_mfma_f32_32x32x16_bf16(kf[1],qr[0],negm,0,0,0), P0[6],P0[7],P0[8],P0[9],     pw0[2]=PKW(P0,4), pw0[3]=PKW(P0,6), pw0); \
    VRD(1); SBAR(); GAPA(C0=__builtin_amdgcn_mfma_f32_32x32x16_bf16(kf[2],qr[1],C0,0,0,0),   P0[10],P0[11],P0[12],P0[13], pw1[0]=PKW(P0,8), pw1[1]=PKW(P0,10), pw1); \
    VRD(5); SBAR(); GAPA(C1=__builtin_amdgcn_mfma_f32_32x32x16_bf16(kf[3],qr[1],C1,0,0,0),   P0[14],P0[15],P1[0],P1[1],   pw1[2]=PKW(P0,12),pw1[3]=PKW(P0,14), pw1); \
    VRD(2); SBAR(); GAPA(C0=__builtin_amdgcn_mfma_f32_32x32x16_bf16(kf[4],qr[2],C0,0,0,0),   P1[2],P1[3],P1[4],P1[5],     pw2[0]=PKW(P1,0), pw2[1]=PKW(P1,2), pw2); \
    VRD(6); SBAR(); GAPA(C1=__builtin_amdgcn_mfma_f32_32x32x16_bf16(kf[5],qr[2],C1,0,0,0),   P1[6],P1[7],P1[8],P1[9],     pw2[2]=PKW(P1,4), pw2[3]=PKW(P1,6), pw2); \
    VRD(3); SBAR(); GAPA(C0=__builtin_amdgcn_mfma_f32_32x32x16_bf16(kf[6],qr[3],C0,0,0,0),   P1[10],P1[11],P1[12],P1[13], pw3[0]=PKW(P1,8), pw3[1]=PKW(P1,10), pw3); \
    VRD(7); SBAR(); GAPA(C1=__builtin_amdgcn_mfma_f32_32x32x16_bf16(kf[7],qr[3],C1,0,0,0),   P1[14],P1[15],0.f,0.f,       pw3[2]=PKW(P1,12),pw3[3]=PKW(P1,14), pw3); \
    l_reg+=sacc; \
    if(GK){DMA_K((t)+3,sl_cur);} if(GV){DMA_V((t)+1,sl_next);} \
    CMASK(C0,C1,t); \
    { float a=MX3(C0[0],C0[1],C1[0]),b=MX3(C0[2],C0[3],C1[1]); a=MX3(a,C1[2],C1[3]); \
      _Pragma("unroll") for(int r=4;r<16;r+=4){a=MX3(a,C0[r],C0[r+1]);b=MX3(b,C0[r+2],C0[r+3]);a=MX3(a,C1[r],C1[r+1]);b=MX3(b,C1[r+2],C1[r+3]);} \
      float rm=__builtin_fmaxf(a,b); { auto rr=__builtin_amdgcn_permlane32_swap(__float_as_uint(rm),__float_as_uint(rm),false,false); rm=__builtin_fmaxf(__uint_as_float(rr[0]),__uint_as_float(rr[1])); } \
      resc=false; \
      if(__builtin_expect(__any(rm>(float)THRL),0)){ const float dl=__builtin_fmaxf(rm,0.f); mhat+=dl; \
        _Pragma("unroll") for(int r=0;r<16;++r){C0[r]-=dl;C1[r]-=dl;} \
        _Pragma("unroll") for(int r=0;r<16;++r)negm[r]=-mhat; asm volatile("":"+v"(negm)); \
        const float f=__builtin_amdgcn_exp2f(-dl); l_reg*=f; if(hi==0)wsf[r32]=f; resc=true; } } \
    SBAR(); \
    GAPB(o[0]=__builtin_amdgcn_mfma_f32_32x32x16_bf16(PAF(0),VFR(0),o[0],0,0,0), C0,0); \
    GAPB(o[1]=__builtin_amdgcn_mfma_f32_32x32x16_bf16(PAF(0),VFR(4),o[1],0,0,0), C0,4); \
    KRD(GL,0); GAPB(o[0]=__builtin_amdgcn_mfma_f32_32x32x16_bf16(PAF(1),VFR(1),o[0],0,0,0), C0,8); \
    KRD(GL,1); GAPB(o[1]=__builtin_amdgcn_mfma_f32_32x32x16_bf16(PAF(1),VFR(5),o[1],0,0,0), C0,12); \
    KRD(GL,2); GAPB(o[0]=__builtin_amdgcn_mfma_f32_32x32x16_bf16(PAF(2),VFR(2),o[0],0,0,0), C1,0); \
    KRD(GL,3); GAPB(o[1]=__builtin_amdgcn_mfma_f32_32x32x16_bf16(PAF(2),VFR(6),o[1],0,0,0), C1,4); \
    GAPB(o[0]=__builtin_amdgcn_mfma_f32_32x32x16_bf16(PAF(3),VFR(3),o[0],0,0,0), C1,8); \
    GAPB(o[1]=__builtin_amdgcn_mfma_f32_32x32x16_bf16(PAF(3),VFR(7),o[1],0,0,0), C1,12); \
    }while(0)
  int t=1;
  #undef CMASK
  #define CMASK(P0,P1,t) do{}while(0)
  for(;t+5<NT;t+=2){
    STEP(pB0,pB1,pA0,pA1,t,true,true,true);     WAIT_BAR(2); RESC(); ROT();
    STEP(pA0,pA1,pB0,pB1,t+1,true,true,true);   WAIT_BAR(2); RESC(); ROT();
  }
  #undef CMASK
  #define CMASK(P0,P1,t) do{}while(0)
  #define ENDW(tt) do{ if((tt)+3<NT){WAIT_BAR(2);} else if((tt)+2<NT){WAIT_BAR(1);} else {WAIT_BAR(0);} }while(0)
  for(;t+1<NT;t+=2){
    STEP(pB0,pB1,pA0,pA1,t,(t+3<NT),(t+1<NT),(t+1<NT));       ENDW(t);   RESC(); ROT();
    STEP(pA0,pA1,pB0,pB1,t+1,(t+4<NT),(t+2<NT),(t+2<NT));     ENDW(t+1); RESC(); ROT();
  }
  STEP(pB0,pB1,pA0,pA1,NT-1,false,false,false); RESC();
  { float sacc=pB0[0]+pB0[1]; _Pragma("unroll") for(int r=2;r<16;++r)sacc+=pB0[r]; _Pragma("unroll") for(int r=0;r<16;++r)sacc+=pB1[r]; l_reg+=sacc;
    pw0=(u32x4){PKW(pB0,0),PKW(pB0,2),PKW(pB0,4),PKW(pB0,6)};pw1=(u32x4){PKW(pB0,8),PKW(pB0,10),PKW(pB0,12),PKW(pB0,14)};pw2=(u32x4){PKW(pB1,0),PKW(pB1,2),PKW(pB1,4),PKW(pB1,6)};pw3=(u32x4){PKW(pB1,8),PKW(pB1,10),PKW(pB1,12),PKW(pB1,14)};
    SBAR(); pv(o,vb0+sl_cur,PAF(0),PAF(1),PAF(2),PAF(3)); }
  #undef PKW
  #undef PAF
  #undef VFR
  #undef PIN
  #undef MX3
  #undef GAPA
  #undef GAPB
  #undef EX
  #undef VRD
  #undef KRD
  #undef STEP
  #undef ENDW
  {auto rr=__builtin_amdgcn_permlane32_swap(__float_as_uint(l_reg),__float_as_uint(l_reg),false,false);l_reg=__uint_as_float(rr[0])+__uint_as_float(rr[1]);}
  if(hi==0)wsf[32+r32]=l_reg;asm volatile("s_waitcnt lgkmcnt(0)":::"memory");
  float rli[16];
  #pragma unroll
  for(int r=0;r<16;++r)rli[r]=__builtin_amdgcn_rcpf(wsf[32+crow(r,hi)]);
  bf16*Ow=Ou+(long)(wid*QBLK)*QP; const bf16*Gw=Gu+(long)(wid*QBLK)*QP;
  { bf16*stg=(bf16*)(shm+LDS_OST)+wid*2048;
    #pragma unroll
    for(int r=0;r<16;++r){const int orow=crow(r,hi);
      #pragma unroll
      for(int d0=0;d0<2;++d0)stg[orow*64+d0*32+r32]=__float2bfloat16(o[d0][r]*rli[r]);}
    asm volatile("s_waitcnt lgkmcnt(0)":::"memory");
    #pragma unroll
    for(int i=0;i<4;++i){const int row=i*8+(lane>>3),ch=lane&7; const u32x4 v=*(const u32x4*)(stg+row*64+ch*8); const u32x4 gv=*(const u32x4*)(Gw+(long)row*QP+ch*8); u32x4 w;
      #pragma unroll
      for(int e=0;e<4;++e){const float a0=__uint_as_float(v[e]<<16)*__uint_as_float(gv[e]<<16),a1=__uint_as_float(v[e]&0xffff0000u)*__uint_as_float(gv[e]&0xffff0000u); w[e]=cvtpk_s(a0,a1);}
      *(u32x4*)(Ow+(long)row*QP+ch*8)=w;} }
  asm volatile("s_waitcnt lgkmcnt(0)\n\ts_barrier":::"memory");
  #undef DMA_K
  #undef DMA_V
  #undef CMASK
  #undef START
  #undef RESC
  #undef ROT
}
constexpr int ATTN_LDS_BYTES=LDS_BYTES;
#undef SBAR
#undef WAIT_BAR
}

#define GAS __attribute__((address_space(1)))
#define LAS __attribute__((address_space(3)))
typedef unsigned short bf16;
typedef unsigned v4u __attribute__((ext_vector_type(4)));
typedef float f32x4 __attribute__((ext_vector_type(4)));
typedef short bf16x8 __attribute__((ext_vector_type(8)));
typedef GAS unsigned gu32;
typedef GAS unsigned long long gu64;
#define RLX_AGENT __ATOMIC_RELAXED, __HIP_MEMORY_SCOPE_AGENT
#define LDS_WAIT() asm volatile("s_waitcnt lgkmcnt(0)" ::: "memory")
#define VM_WAIT() asm volatile("s_waitcnt vmcnt(0)" ::: "memory")
__device__ __forceinline__ unsigned long long rt() { return __builtin_amdgcn_s_memrealtime(); }
__device__ __forceinline__ unsigned f2bf(float f) { unsigned u = __builtin_bit_cast(unsigned, f); return (u + 0x7fffu + ((u >> 16) & 1u)) >> 16; }
__device__ __forceinline__ unsigned pk2(float lo, float hi) { return f2bf(lo) | (f2bf(hi) << 16); }

#define XB_TMO      128
#define XB_XCNT(j)  (256  + 64 * (j))
#define XB_XSUB(j)  (1280 + 64 * (j))
#define XB_XGEN(j)  (2304 + 64 * (j))
#define XB_TOP      3328
#define XB_TOPGEN   3392
#define XCD_BAR_WORDS 3456
#define XB_SPIN_CAP (1u << 18)

__device__ __forceinline__ unsigned xb_ld(unsigned* p)              { return __hip_atomic_load(p, __ATOMIC_RELAXED, __HIP_MEMORY_SCOPE_AGENT); }
__device__ __forceinline__ unsigned xb_add(unsigned* p, unsigned v) { return __hip_atomic_fetch_add(p, v, __ATOMIC_RELAXED, __HIP_MEMORY_SCOPE_AGENT); }
__device__ __forceinline__ unsigned xb_xcc_id() { return (unsigned)__builtin_amdgcn_s_getreg((3 << 11) | 20) & 0xFu; }
#define XB_SPIN(cond, bar) do { unsigned _sp = 0; while (cond) { __builtin_amdgcn_s_sleep(1); \
    if ((++_sp & 255u) == 0u) { if (xb_ld(&(bar)[XB_TMO])) break; if (_sp > XB_SPIN_CAP) { atomicAdd(&(bar)[XB_TMO], 1u); break; } } } } while (0)

struct XcdBarrier {
    unsigned* bar; unsigned x;
    volatile LAS unsigned* st;
};

__device__ __forceinline__ XcdBarrier xcd_barrier_post(unsigned* bar, volatile LAS unsigned* st, const int tid) {
    XcdBarrier b; b.bar = bar; b.x = xb_xcc_id(); b.st = st;
    if (tid == 0) (void)xb_add(&bar[XB_XCNT(b.x)], 1u);
    return b;
}
__device__ __forceinline__ void xcd_barrier_complete(unsigned* bar, unsigned x, unsigned& nloc, unsigned& nx) {
    const unsigned G = gridDim.x * gridDim.y * gridDim.z;
    unsigned sum, cnt, mine, sp = 0u;
    for (;;) {
        sum = 0u; cnt = 0u; mine = 0u;
#pragma unroll
        for (unsigned j = 0; j < 16; ++j) { const unsigned c = xb_ld(&bar[XB_XCNT(j)]); sum += c; cnt += (c > 0u) ? 1u : 0u; mine = (j == x) ? c : mine; }
        if (sum == G) break;
        __builtin_amdgcn_s_sleep(1);
        if ((++sp & 255u) == 0u) { if (xb_ld(&bar[XB_TMO])) break; if (sp > XB_SPIN_CAP) { atomicAdd(&bar[XB_TMO], 1u); break; } }
    }
    nloc = mine > 0u ? mine : 1u; nx = cnt > 0u ? cnt : 1u;
}

__device__ __forceinline__ void xcd_barrier(const XcdBarrier& b, const int tid) {
    asm volatile("s_waitcnt vmcnt(0)" ::: "memory");
    __syncthreads();
    if (tid == 0) {
        unsigned* bar = b.bar; asm volatile("" : "+s"(bar));
        __builtin_amdgcn_s_waitcnt(0);
        unsigned nloc = b.st[0], nx = b.st[1];
        if (nloc == 0u) { unsigned xx = b.x; asm volatile("" : "+s"(xx)); xcd_barrier_complete(bar, xx, nloc, nx); b.st[0] = nloc; b.st[1] = nx; }
        const unsigned old = xb_add(&bar[XB_XSUB(b.x)], 1u);
        const unsigned gen = old / nloc;
        if (old + 1u == (gen + 1u) * nloc) {
            __builtin_amdgcn_fence(__ATOMIC_RELEASE, "agent");
            asm volatile("s_waitcnt vmcnt(0)" ::: "memory");
            const unsigned og = xb_add(&bar[XB_TOP], 1u);
            const unsigned tg = og / nx;
            if (og + 1u == (tg + 1u) * nx) xb_add(&bar[XB_TOPGEN], 1u);
            else XB_SPIN(xb_ld(&bar[XB_TOPGEN]) == tg, bar);
            __builtin_amdgcn_fence(__ATOMIC_ACQUIRE, "agent");
            asm volatile("s_waitcnt vmcnt(0)" ::: "memory");
        } else {
            XB_SPIN(xb_ld(&bar[XB_TOPGEN]) == gen, bar);
            __builtin_amdgcn_fence(__ATOMIC_ACQUIRE, "agent");
            asm volatile("s_waitcnt vmcnt(0)" ::: "memory");
        }
    }
    __syncthreads();
}


constexpr int NWAVES = 8, NTHR = 512, GRID = 256;
constexpr int T_TOK = 8192, T_CTX = 4096, DMOD = 1024, BW = 512, INW = 3328, NCAT = 6400, DEPTH = 4;
constexpr int S_LAT = 2048, LKV = 2304, KVW = 128;
constexpr float RMS_EPS = 1e-6f;
constexpr float QSCALE = 0.125f * 1.4426950408889634f;
constexpr size_t MiB = 1u << 20;
constexpr size_t WS_CTL = 0, CTL_ZERO_BYTES = MiB;
constexpr size_t WS_MODF = 1 * MiB;
constexpr size_t WS_ROPE = 1 * MiB + 768 * 1024;
constexpr size_t WS_A16 = 1 * MiB + 832 * 1024;
constexpr size_t WS_WCAT = 2 * MiB;
constexpr size_t WS_WGLU = 15 * MiB;
constexpr size_t WS_WFN = 16 * MiB;
constexpr size_t WS_WBR = 17 * MiB, WS_WBR2 = 80 * MiB;
constexpr size_t WS_WOUT = 20 * MiB, WS_WOUT2 = 67 * MiB;
__host__ __device__ constexpr size_t ws_wbr(int l) { return (l & 1) ? WS_WBR2 : WS_WBR; }
__host__ __device__ constexpr size_t ws_wout(int l) { return (l & 1) ? WS_WOUT2 : WS_WOUT; }
constexpr size_t WS_BTE = 22 * MiB;
constexpr size_t WS_BTY = 26 * MiB;
constexpr size_t WS_A2L = 34 * MiB;
constexpr size_t WS_GY = 42 * MiB;
constexpr size_t WS_A2C = 50 * MiB;
constexpr size_t WS_A1P = 50 * MiB + 512 * 1024;
constexpr size_t WS_XRES = 51 * MiB;
constexpr size_t WS_G = 83 * MiB;
constexpr size_t WS_H = 131 * MiB;
constexpr size_t WS_VTC = 147 * MiB;
constexpr size_t WS_VTL = 248 * MiB;
constexpr size_t WS_GA = 155 * MiB;
constexpr size_t WS_GF = 163 * MiB;
constexpr size_t WS_Q = 171 * MiB;
constexpr size_t WS_UF = 179 * MiB;
constexpr size_t WS_GC = 187 * MiB;
constexpr size_t WS_KC = 195 * MiB, WS_KL = 196 * MiB;
constexpr size_t WS_VC = WS_KC + 5 * MiB / 2, WS_VL = WS_KL + 5 * MiB / 2;
constexpr size_t WS_PB = 200 * MiB;
constexpr size_t WS_SC = 216 * MiB;
constexpr size_t WS_UH = 232 * MiB;
constexpr size_t WS_END = 256 * MiB;
constexpr int CW_BAR = 4096;
constexpr size_t OUT_K = 8388608, OUT_V = 10485760, OUT_S = 12582912, OUT_N = 13107200;
constexpr int RING_BYTES = 131072, LDSCTL_OFF = RING_BYTES, MISC_OFF = LDSCTL_OFF + 320, LDS_BYTES = 147456;

typedef float f32x2 __attribute__((ext_vector_type(2)));
typedef unsigned u32x2 __attribute__((ext_vector_type(2)));
__device__ __forceinline__ unsigned cvtpk(float lo, float hi) { typedef __bf16 bf16x2_t __attribute__((ext_vector_type(2))); f32x2 v = {lo, hi}; bf16x2_t b = __builtin_convertvector(v, bf16x2_t); return __builtin_bit_cast(unsigned, b); }
__device__ __forceinline__ void st_bf4(bf16* p, f32x4 v) { u32x2 w; w.x = cvtpk(v[0], v[1]); w.y = cvtpk(v[2], v[3]); *(u32x2*)p = w; }
__device__ __forceinline__ f32x4 ld_bf4(const bf16* p) { const u32x2 w = *(const u32x2*)p; f32x4 r; r[0] = __uint_as_float(w.x << 16); r[1] = __uint_as_float(w.x & 0xffff0000u); r[2] = __uint_as_float(w.y << 16); r[3] = __uint_as_float(w.y & 0xffff0000u); return r; }
__device__ __forceinline__ f32x4 bf4_to_f(u32x2 w) { f32x4 r; r[0] = __uint_as_float(w.x << 16); r[1] = __uint_as_float(w.x & 0xffff0000u); r[2] = __uint_as_float(w.y << 16); r[3] = __uint_as_float(w.y & 0xffff0000u); return r; }
__device__ __forceinline__ float bf2f(bf16 h) { return __uint_as_float((unsigned)h << 16); }
__device__ __forceinline__ float sigmoidf_(float x) { return __builtin_amdgcn_rcpf(1.0f + __expf(-x)); }
__device__ __forceinline__ f32x4 sigmoid4(f32x4 v) { f32x4 r; r[0] = sigmoidf_(v[0]); r[1] = sigmoidf_(v[1]); r[2] = sigmoidf_(v[2]); r[3] = sigmoidf_(v[3]); return r; }
__device__ __forceinline__ f32x4 silu4(f32x4 v) { return v * sigmoid4(v); }
__device__ __forceinline__ float gelu_tanh(float x) { const float y = 0.7978845608028654f * (x + 0.044715f * x * x * x); return x * sigmoidf_(2.0f * y); }
__device__ __forceinline__ float shx(float v, int mask, int lane) { return __int_as_float(__builtin_amdgcn_ds_bpermute((lane ^ mask) << 2, __float_as_int(v))); }
__device__ __forceinline__ float wave_sum(float v, int lane) {
#pragma unroll
    for (int o = 1; o < 64; o <<= 1) v += shx(v, o, lane);
    return v;
}

struct KArgs { const float* in[28]; float* out; unsigned char* ws; int ph_lo, ph_hi; };
enum { I_XP = 0, I_XS, I_CK, I_CV, I_ST, I_C, I_CCTX, I_NORMG, I_ADAW, I_ADAB, I_WIN, I_ARE, I_AIM, I_LDT, I_BRE, I_BIM, I_CRE, I_CIM, I_SD, I_GLU, I_FN, I_QG, I_KG, I_WBR, I_MW, I_MB, I_WOUT, I_FG };

struct Ctx {
    LAS unsigned char* lds; int tid, lane, wave, bid, vcu, gw, ngw;
    const float* const* in; float* out; unsigned char* ws;
    template <class Tp> __device__ __forceinline__ Tp* w(size_t off) const { return (Tp*)(ws + off); }
};

__device__ __forceinline__ int epi_opaque(int x) { asm volatile("" : "+v"(x)); return x; }
#define EPI_ROWS for (int ai = 0; ai < 2; ++ai) _Pragma("unroll") for (int m = 0; m < 4; ++m)
#define EPI_BJ for (int bj = 0; bj < 2; ++bj)
#define EPI_ROW epi_opaque(u.pm * 256 + ai * 128 + wr * 64 + m * 16 + fr)
#define EPI_C8 (bj * 128 + wc * 32 + fq * 8)
#define EPI_COL8 (u.pn * 256 + EPI_C8)
typedef const f32x4 (&AccRef)[2][2][4][2];
__device__ __forceinline__ void st_bf8(bf16* p, f32x4 lo, f32x4 hi) { v4u w; w.x = cvtpk(lo[0], lo[1]); w.y = cvtpk(lo[2], lo[3]); w.z = cvtpk(hi[0], hi[1]); w.w = cvtpk(hi[2], hi[3]); *(v4u*)p = w; }
__device__ __forceinline__ f32x4 bf8_lo(v4u w) { f32x4 r; r[0] = __uint_as_float(w.x << 16); r[1] = __uint_as_float(w.x & 0xffff0000u); r[2] = __uint_as_float(w.y << 16); r[3] = __uint_as_float(w.y & 0xffff0000u); return r; }
__device__ __forceinline__ f32x4 bf8_hi(v4u w) { f32x4 r; r[0] = __uint_as_float(w.z << 16); r[1] = __uint_as_float(w.z & 0xffff0000u); r[2] = __uint_as_float(w.w << 16); r[3] = __uint_as_float(w.w & 0xffff0000u); return r; }

struct EpiG1 {
    static constexpr bool PERM = true, AFTER_DRAIN = false;
    unsigned char* ws; float* out; const float *qg, *kg; int layer;
#define EG1_P(name, off) bf16* const name = (bf16*)(ws + (off))
    __device__ __forceinline__ void qkv(AccRef acc, const pg8::Unit& u, int wr, int wc, int fr, int fq) const {
        const int pn = u.pn; const bool isq = pn < 10;
        EG1_P(Q, WS_Q); EG1_P(Kc, WS_KC); EG1_P(Vc, WS_VC); EG1_P(Kl, WS_KL); EG1_P(Vl, WS_VL); float* const outK = out + OUT_K; float* const outV = out + OUT_V; const float* const rope = (const float*)(ws + WS_ROPE);
        const int kind = isq ? 0 : (wc < 2 ? 1 : 2);
        const int head = isq ? (pn - 8) * 4 + wc : (wc & 1);
        f32x4 gv[2][2];
        if (kind == 0) {
#pragma unroll
            EPI_BJ { gv[bj][0] = *(const f32x4*)(qg + layer * 64 + 32 * bj + 8 * fq); gv[bj][1] = *(const f32x4*)(qg + layer * 64 + 32 * bj + 8 * fq + 4); }
        } else {
#pragma unroll
            EPI_BJ { gv[bj][0] = *(const f32x4*)(kg + layer * 64 + 32 * bj + 8 * fq); gv[bj][1] = *(const f32x4*)(kg + layer * 64 + 32 * bj + 8 * fq + 4); }
        }
        const bool lat = u.pm >= 16;
#pragma unroll
        EPI_ROWS {
            const int row = EPI_ROW;
            f32x4 x[2][2];
#pragma unroll
            EPI_BJ { x[bj][0] = acc[ai][bj][m][0]; x[bj][1] = acc[ai][bj][m][1]; }
            if (kind != 2) {
                float ss = 0.f;
#pragma unroll
                EPI_BJ {
#pragma unroll
                    for (int n = 0; n < 2; ++n) { const f32x4 t = x[bj][n]; ss += (t[0] * t[0] + t[1] * t[1]) + (t[2] * t[2] + t[3] * t[3]); } }
                ss += shx(ss, 16, fq * 16 + fr); ss += shx(ss, 32, fq * 16 + fr);
                const float rstd = rsqrtf(ss * (1.0f / 64.0f) + RMS_EPS);
#pragma unroll
                EPI_BJ { x[bj][0] = x[bj][0] * rstd * gv[bj][0]; x[bj][1] = x[bj][1] * rstd * gv[bj][1]; }
            }
            int b, s;
            if (lat) { const int tl = row - T_CTX; b = tl >> 11; s = tl & 2047; } else { b = row >> 8; s = row & 255; }
            if (lat && kind != 2) {
                const int gr = s >> 6, gc = s & 63;
#pragma unroll
                EPI_BJ {
#pragma unroll
                    for (int n = 0; n < 2; ++n) { const int pos = bj ? gc : gr; const f32x4 cs = *(const f32x4*)(rope + (pos * 16 + 4 * fq + 2 * n) * 2); const f32x4 t = x[bj][n];
                        f32x4 r; r[0] = t[0] * cs[0] - t[1] * cs[1]; r[1] = t[0] * cs[1] + t[1] * cs[0]; r[2] = t[2] * cs[2] - t[3] * cs[3]; r[3] = t[2] * cs[3] + t[3] * cs[2]; x[bj][n] = r; } }
            }
#pragma unroll
            EPI_BJ { const int j = 32 * bj + 8 * fq;
                const size_t ol = ((size_t)b * LKV + s) * KVW + head * 64 + j, oc = (size_t)row * KVW + head * 64 + j, oo = (((size_t)b * DEPTH + layer) * 256 + s) * KVW + head * 64 + j;
                if (kind == 0) st_bf8(Q + (size_t)row * 512 + head * 64 + j, x[bj][0] * QSCALE, x[bj][1] * QSCALE);
                else if (kind == 1) { if (lat) st_bf8(Kl + ol, x[bj][0], x[bj][1]); else { st_bf8(Kc + oc, x[bj][0], x[bj][1]); *(f32x4*)(outK + oo) = x[bj][0]; *(f32x4*)(outK + oo + 4) = x[bj][1]; } }
                else { if (lat) st_bf8(Vl + ol, x[bj][0], x[bj][1]); else { st_bf8(Vc + oc, x[bj][0], x[bj][1]); *(f32x4*)(outV + oo) = x[bj][0]; *(f32x4*)(outV + oo + 4) = x[bj][1]; } } }
            asm volatile("" ::: "memory");
        }
    }
    __device__ __forceinline__ void operator()(AccRef acc, const pg8::Unit& u, int wr, int wc, int fr, int fq) const {
        const int pn = u.pn;
        if (pn >= 8 && pn <= 10) { qkv(acc, u, wr, wc, fr, fq); return; }
        EG1_P(UH, WS_UH); EG1_P(GA, WS_GA); EG1_P(UF, WS_UF); EG1_P(GF, WS_GF); EG1_P(GC, WS_GC);
#pragma unroll
        EPI_ROWS { const int row = EPI_ROW;
#pragma unroll
            EPI_BJ { const int col = EPI_COL8; const f32x4 lo = acc[ai][bj][m][0], hi = acc[ai][bj][m][1];
                if (pn < 2) { const int g = col >> 4, q = col & 15; st_bf8(UH + ((size_t)g * 512 + (row >> 4)) * 512 + (row & 15) * 16 + q, lo, hi); }
                else if (pn < 4) st_bf8(GA + (size_t)row * 512 + (col - 512), silu4(lo), silu4(hi));
                else if (pn < 6) st_bf8(UF + (size_t)row * 512 + (col - 1024), lo, hi);
                else if (pn < 8) st_bf8(GF + (size_t)row * 512 + (col - 1536), silu4(lo), silu4(hi));
                else st_bf8(GC + (size_t)row * 512 + (col - 2816), silu4(lo), silu4(hi));
            } }
    }
};
struct EpiMerge {
    static constexpr bool PERM = true, AFTER_DRAIN = false;
    bf16* Gm; const float* mb;
    __device__ __forceinline__ void operator()(AccRef acc, const pg8::Unit& u, int wr, int wc, int fr, int fq) const {
        f32x4 bb[2][2];
#pragma unroll
        EPI_BJ { bb[bj][0] = *(const f32x4*)(mb + EPI_COL8); bb[bj][1] = *(const f32x4*)(mb + EPI_COL8 + 4); }
#pragma unroll
        EPI_ROWS { const size_t row = EPI_ROW;
#pragma unroll
            EPI_BJ st_bf8(Gm + row * 3072 + EPI_COL8, sigmoid4(acc[ai][bj][m][0] + bb[bj][0]), sigmoid4(acc[ai][bj][m][1] + bb[bj][1])); }
    }
};
struct EpiS5A {
    static constexpr bool PERM = true, AFTER_DRAIN = false;
    float* SC;
    __device__ __forceinline__ void operator()(AccRef acc, const pg8::Unit& u, int wr, int wc, int fr, int fq) const {
#pragma unroll
        EPI_ROWS { const int chunk = EPI_ROW;
#pragma unroll
            EPI_BJ st_bf8((bf16*)SC + ((size_t)u.z * 512 + chunk) * 256 + EPI_C8, acc[ai][bj][m][0], acc[ai][bj][m][1]); }
    }
};
__device__ __forceinline__ f32x4 gelu4(f32x4 y) { y[0] = gelu_tanh(y[0]); y[1] = gelu_tanh(y[1]); y[2] = gelu_tanh(y[2]); y[3] = gelu_tanh(y[3]); return y; }
struct EpiS5B {
    static constexpr bool PERM = true, AFTER_DRAIN = false;
    bf16* GY;
    __device__ __forceinline__ void operator()(AccRef acc, const pg8::Unit& u, int wr, int wc, int fr, int fq) const {
#pragma unroll
        EPI_ROWS { const int chunk = EPI_ROW;
#pragma unroll
            EPI_BJ { const int col = EPI_C8, t = col >> 4, p = col & 15; st_bf8(GY + ((size_t)chunk * 16 + t) * 512 + u.z * 16 + p, gelu4(acc[ai][bj][m][0]), gelu4(acc[ai][bj][m][1])); } }
    }
};
struct EpiDFT1C {
    static constexpr bool PERM = true, AFTER_DRAIN = false;
    bf16* VtC;
    __device__ __forceinline__ void operator()(AccRef acc, const pg8::Unit& u, int wr, int wc, int fr, int fq) const {
        const int grp = 2 * u.z + u.pm;
#pragma unroll
        EPI_ROWS { const int j = epi_opaque(wr * 64 + m * 16 + fr), reim = ai;
#pragma unroll
            EPI_BJ { const int tok = EPI_COL8, b = tok >> 8, s = tok & 255; st_bf8(VtC + ((size_t)b * 512 + grp * 128 + j) * 512 + reim * 256 + s, acc[ai][bj][m][0], acc[ai][bj][m][1]); } }
    }
};
struct EpiDFT1L {
    static constexpr bool PERM = true, AFTER_DRAIN = false;
    bf16* VtL;
    __device__ __forceinline__ void operator()(AccRef acc, const pg8::Unit& u, int wr, int wc, int fr, int fq) const {
        const int grp = 2 * u.z + u.pm, b = u.pn >> 4, nn = u.pn & 15;
#pragma unroll
        EPI_ROWS { const int j = epi_opaque(wr * 64 + m * 16 + fr), reim = ai; bf16* dst = VtL + ((size_t)b * 512 + grp * 128 + j) * 2048 + reim * 1024 + nn * 128 + wc * 32 + fq * 8;
            st_bf8(dst, acc[ai][0][m][0] + acc[ai][1][m][0], acc[ai][0][m][1] + acc[ai][1][m][1]);
            st_bf8(dst + (size_t)1024 * 2048, acc[ai][0][m][0] - acc[ai][1][m][0], acc[ai][0][m][1] - acc[ai][1][m][1]); }
    }
};
struct EpiDFT2 {
    static constexpr bool PERM = true, AFTER_DRAIN = false;
    bf16* ZF; int lat, half;
    __device__ __forceinline__ void operator()(AccRef acc, const pg8::Unit& u, int wr, int wc, int fr, int fq) const {
#pragma unroll
        EPI_ROWS { const int k = EPI_ROW;
#pragma unroll
            EPI_BJ { const int col = EPI_COL8, b = col >> 9, ch = col & 511;
                bf16* dst = lat ? ZF + ((size_t)b * 2048 + 2 * k + u.z) * 1024 + half * 512 + ch : ZF + ((size_t)b * 256 + k) * 512 + ch;
                st_bf8(dst, acc[ai][bj][m][0], acc[ai][bj][m][1]); } }
    }
};
#define EPI_BATCH for (int ai = 0; ai < 2; ++ai)
#define EPI_M for (int m = 0; m < 4; ++m)
struct EpiGLU {
    static constexpr bool PERM = true, AFTER_DRAIN = false;
    bf16* GA;
    __device__ __forceinline__ void operator()(AccRef acc, const pg8::Unit& u, int wr, int wc, int fr, int fq) const {
#pragma unroll
        EPI_BATCH { v4u gl[4];
#pragma unroll
            EPI_M { const size_t row = EPI_ROW; gl[m] = *(const v4u*)(GA + row * 512 + u.pn * 128 + wc * 32 + fq * 8); }
            asm volatile("" ::: "memory");
#pragma unroll
            EPI_M { const size_t row = EPI_ROW;
                st_bf8(GA + row * 512 + u.pn * 128 + wc * 32 + fq * 8, acc[ai][0][m][0] * sigmoid4(acc[ai][1][m][0]) * bf8_lo(gl[m]), acc[ai][0][m][1] * sigmoid4(acc[ai][1][m][1]) * bf8_hi(gl[m])); }
            asm volatile("" ::: "memory"); }
    }
};
struct EpiMul {
    static constexpr bool PERM = true, AFTER_DRAIN = false;
    bf16* GF;
    __device__ __forceinline__ void operator()(AccRef acc, const pg8::Unit& u, int wr, int wc, int fr, int fq) const {
        v4u gl[2][4][2];
#pragma unroll
        EPI_ROWS { const size_t row = EPI_ROW;
#pragma unroll
            EPI_BJ gl[ai][m][bj] = *(const v4u*)(GF + row * 512 + EPI_COL8); }
        asm volatile("" ::: "memory");
#pragma unroll
        EPI_ROWS { const size_t row = EPI_ROW;
#pragma unroll
            EPI_BJ st_bf8(GF + row * 512 + EPI_COL8, acc[ai][bj][m][0] * bf8_lo(gl[ai][m][bj]), acc[ai][bj][m][1] * bf8_hi(gl[ai][m][bj])); }
        asm volatile("" ::: "memory");
    }
};
struct EpiPC {
    static constexpr bool PERM = true, AFTER_DRAIN = false;
    const bf16* Gm; bf16* PB;
    __device__ __forceinline__ void operator()(AccRef acc, const pg8::Unit& u, int wr, int wc, int fr, int fq) const {
        v4u gl[2][4][2];
#pragma unroll
        EPI_ROWS { const size_t row = EPI_ROW;
#pragma unroll
            EPI_BJ gl[ai][m][bj] = *(const v4u*)(Gm + row * 3072 + 2048 + EPI_COL8); }
        asm volatile("" ::: "memory");
#pragma unroll
        EPI_ROWS { const size_t row = EPI_ROW;
#pragma unroll
            EPI_BJ st_bf8(PB + row * 1024 + EPI_COL8, acc[ai][bj][m][0] * bf8_lo(gl[ai][m][bj]), acc[ai][bj][m][1] * bf8_hi(gl[ai][m][bj])); }
        asm volatile("" ::: "memory");
    }
};
struct EpiChainA {
    const bf16* Gm; const bf16* PB;
    template <int R0, int NB> __device__ __forceinline__ void batch(f32x4 (&acc)[2][2][4][2], const pg8::Unit& u, int wr, int wc, int fr, int fq) const {
        v4u g0[NB][2], g1[NB][2], pl[NB][2];
#pragma unroll
        for (int k = 0; k < NB; ++k) { const int ai = (R0 + k) >> 2, m = (R0 + k) & 3; const size_t row = EPI_ROW;
#pragma unroll
            EPI_BJ { g0[k][bj] = *(const v4u*)(Gm + row * 3072 + EPI_COL8); g1[k][bj] = *(const v4u*)(Gm + row * 3072 + 1024 + EPI_COL8); pl[k][bj] = *(const v4u*)(PB + row * 1024 + EPI_COL8); } }
        asm volatile("" ::: "memory");
#pragma unroll
        for (int k = 0; k < NB; ++k) { const int ai = (R0 + k) >> 2, m = (R0 + k) & 3;
#pragma unroll
            EPI_BJ { f32x4 lo = acc[ai][bj][m][0] * bf8_lo(g0[k][bj]) + bf8_lo(pl[k][bj]), hi = acc[ai][bj][m][1] * bf8_hi(g0[k][bj]) + bf8_hi(pl[k][bj]);
                const f32x4 gl = bf8_lo(g1[k][bj]), gh = bf8_hi(g1[k][bj]);
#pragma unroll
                for (int e = 0; e < 4; ++e) { lo[e] *= __builtin_amdgcn_rcpf(fmaxf(gl[e], 1e-6f)); hi[e] *= __builtin_amdgcn_rcpf(fmaxf(gh[e], 1e-6f)); }
                acc[ai][bj][m][0] = lo; acc[ai][bj][m][1] = hi; } }
        asm volatile("" ::: "memory");
    }
    __device__ __forceinline__ void operator()(f32x4 (&acc)[2][2][4][2], const pg8::Unit& u, int wr, int wc, int fr, int fq) const {
        batch<0, 3>(acc, u, wr, wc, fr, fq); batch<3, 3>(acc, u, wr, wc, fr, fq); batch<6, 2>(acc, u, wr, wc, fr, fq);
    }
};
struct EpiChainF {
    const bf16* Gm; bf16* MG;
    __device__ __forceinline__ void operator()(AccRef acc, const pg8::Unit& u, int wr, int wc, int fr, int fq) const {
        v4u g1[2][4][2];
#pragma unroll
        EPI_ROWS { const size_t row = EPI_ROW;
#pragma unroll
            EPI_BJ g1[ai][m][bj] = *(const v4u*)(Gm + row * 3072 + 1024 + EPI_COL8); }
        asm volatile("" ::: "memory");
#pragma unroll
        EPI_ROWS { const size_t row = EPI_ROW;
#pragma unroll
            EPI_BJ { const f32x4 gl = bf8_lo(g1[ai][m][bj]), gh = bf8_hi(g1[ai][m][bj]); f32x4 lo = acc[ai][bj][m][0], hi = acc[ai][bj][m][1];
#pragma unroll
                for (int e = 0; e < 4; ++e) { lo[e] *= fmaxf(gl[e], 1e-6f); hi[e] *= fmaxf(gh[e], 1e-6f); }
                st_bf8(MG + row * 1024 + EPI_COL8, lo, hi); } }
        asm volatile("" ::: "memory");
    }
};
struct EpiG5 {
    static constexpr bool PERM = true, AFTER_DRAIN = false;
    bf16 *T0, *T1;
    __device__ __forceinline__ void operator()(AccRef acc, const pg8::Unit& u, int wr, int wc, int fr, int fq) const {
        bf16* T = u.z ? T1 : T0;
#pragma unroll
        EPI_ROWS { const size_t row = EPI_ROW;
#pragma unroll
            EPI_BJ st_bf8(T + row * 1024 + EPI_COL8, acc[ai][bj][m][0], acc[ai][bj][m][1]); }
    }
};

enum { K_G1 = 0, K_MERGE, K_S5A, K_S5B, K_DFT1C, K_DFT1L, K_DFT2C, K_DFT2L0, K_DFT2L1, K_GLU, K_FN, K_PC, K_PA, K_PF, K_G5 };
__device__ __forceinline__ int xswz(int L, int n) { return (L & 7) * (n >> 3) + (L >> 3); }
#define PS_W(off) ((const bf16*)(ws + (off)))
struct PhaseSched {
    int sub, c, bid; unsigned char* ws; int layer;
    __device__ __forceinline__ void mk(pg8::UDesc& d, const bf16* A, const bf16* Bt, int lda, int ldb, int K, int hB, int kind, int pm, int pn, int z) const {
        d.A = A; d.Bt = Bt; d.lda = lda; d.ldb = ldb; d.K = K; d.hB = hB; d.kind = kind; d.pm = pm; d.pn = pn; d.z = z; d.keep = (kind == K_PF); }
    __device__ __forceinline__ void mk_merge(pg8::UDesc& d, int M, unsigned char* ws) const {
        int pm, pn; if (M < 96) { pm = M / 3; pn = 8 + (M - 3 * pm); } else if (M < 128) { pm = M - 96; pn = 11; } else { pm = (M - 128) >> 3; pn = (M - 128) & 7; }
        mk(d, PS_W(WS_H) + (size_t)pm * 256 * 1024, PS_W(WS_WCAT) + (size_t)(INW + pn * 256) * 1024, 1024, 1024, 1024, 128, K_MERGE, pm, pn, 0); }
    __device__ __forceinline__ void mk_merge_own(pg8::UDesc& d, int cc, unsigned tiles, unsigned char* ws) const {
        const int x = cc & 7, j = cc >> 3, pm = 4 * x + (j & 3), pn = (int)((tiles >> (4 * (j >> 2))) & 15u);
        mk(d, PS_W(WS_H) + (size_t)pm * 256 * 1024, PS_W(WS_WCAT) + (size_t)(INW + pn * 256) * 1024, 1024, 1024, 1024, 128, K_MERGE, pm, pn, 0); }
    __device__ __forceinline__ bool next(int i, pg8::UDesc& d) const {
        unsigned char* ws = this->ws; asm volatile("" : "+s"(ws));
        if (sub == 1) {
            if (i > 1) return false;
            const int x = c & 7, k = c >> 3, pm = 4 * x + (k & 3), pr = k >> 2;
            const int col = (int)(((i == 0 ? 0xB7632A98u : 0xCFED5410u) >> (4 * pr)) & 15u);
            if (col < 13) mk(d, PS_W(WS_H) + (size_t)pm * 256 * 1024, PS_W(WS_WCAT) + (size_t)col * 256 * 1024, 1024, 1024, 1024, 128, K_G1, pm, col, 0);
            else mk_merge(d, pm * 3 + (col - 13), ws);
            return true;
        }
        if (sub == 2) {
            if (c < 128) return false;
            if (c < 192) { const int L = xswz(c - 128, 64);
                if (i == 0) { const int g = L >> 1, pm = L & 1; mk(d, PS_W(WS_UH) + ((size_t)g * 512 + pm * 256) * 512, PS_W(WS_BTE) + (size_t)g * 256 * 256, 512, 256, 256, 128, K_S5A, pm, 0, g); return true; }
                if (i == 1) { const int pair = L >> 5, gl = (L >> 4) & 1, pn = L & 15; mk(d, PS_W(WS_A1P) + (size_t)gl * 256 * 256, PS_W(WS_UF) + (size_t)pn * 256 * 512 + pair * 256, 256, 512, 256, 128, K_DFT1C, gl, pn, pair); return true; }
                if (i == 2) { mk_merge_own(d, c - 128, 0x210Bu, ws); return true; }
                return false; }
            const int L = xswz(c - 192, 64);
            if (i == 0) { const int pair = L >> 5, gl = (L >> 4) & 1, r = L & 15, pn2 = (r >> 3) * 16 + (r & 7);
                mk(d, PS_W(WS_A1P) + (size_t)gl * 256 * 256, PS_W(WS_UF) + ((size_t)T_CTX + pn2 * 128) * 512 + pair * 256, 256, 512, 256, 1024, K_DFT1L, gl, pn2, pair); return true; }
            if (i == 1) { mk_merge_own(d, c - 128, 0x210Bu, ws); return true; }
            return false;
        }
        if (sub == 3) {
            if (c < 64) { if (i > 0) return false; const int half = c >> 5, L = xswz(c & 31, 32), z = L >> 4, pm = (L >> 2) & 3, pn = L & 3;
                mk(d, PS_W(WS_A2L) + ((size_t)z * 1024 + pm * 256) * 2048 + half * 1024, PS_W(WS_VTL) + ((size_t)z * 1024 + pn * 256) * 2048 + half * 1024, 2048, 2048, 1024, 128, half ? K_DFT2L1 : K_DFT2L0, pm, pn, z); return true; }
            if (c < 128) { if (i > 0) return false; const int L = xswz(c - 64, 64), g = L >> 1, pm = L & 1;
                mk(d, PS_W(WS_UH) + ((size_t)g * 512 + pm * 256) * 512, PS_W(WS_BTY) + (size_t)g * 256 * 512, 512, 512, 512, 128, K_S5B, pm, 0, g); return true; }
            if (i == 0) { const int L = xswz(c - 128, 128), pm = L >> 2, pn = L & 3; mk(d, PS_W(WS_Q) + (size_t)pm * 256 * 512, PS_W(ws_wbr(layer)) + ((size_t)2 * 1024 + pn * 256) * 512, 512, 512, 512, 128, K_PC, pm, pn, 0); return true; }
            if (i == 1) { if (c < 160) { const int pn = xswz(c - 128, 32); mk(d, PS_W(WS_A2C), PS_W(WS_VTC) + (size_t)pn * 256 * 512, 512, 512, 512, 128, K_DFT2C, 0, pn, 0); return true; }
                mk_merge_own(d, c - 160, 0x543u, ws); return true; }
            return false;
        }
        if (sub == 4) {
            if (i > 0) return false;
            if (c < 128) { const int L = xswz(c, 128), pm = L >> 2, pn = L & 3; mk(d, PS_W(WS_GY) + (size_t)pm * 256 * 512, PS_W(WS_WGLU) + (size_t)pn * 256 * 512, 512, 512, 512, 128, K_GLU, pm, pn, 0); return true; }
            if (c < 160) { const int L = xswz(c - 128, 32), pm = L >> 1, pn = L & 1; mk(d, PS_W(WS_UF) + (size_t)pm * 256 * 512, PS_W(WS_WFN) + (size_t)pn * 256 * 1024, 512, 1024, 512, 128, K_FN, pm, pn, 0); return true; }
            if (c < 192) { const int L = xswz(c - 160, 32), pm = L >> 1, pn = L & 1; mk(d, PS_W(WS_GC) + (size_t)pm * 256 * 1024, PS_W(WS_WFN) + (size_t)pn * 256 * 1024, 1024, 1024, 1024, 128, K_FN, 16 + pm, pn, 0); return true; }
            mk_merge_own(d, c - 192, 0x76u, ws); return true;
        }
        if (sub == 5) {
            if (c >= 128 || i > 1) return false;
            const int t = (c & 7) * 16 + (c >> 3), pm = t >> 2, pn = t & 3;
            if (i == 0) mk(d, PS_W(WS_GA) + (size_t)pm * 256 * 512, PS_W(ws_wbr(layer)) + (size_t)pn * 256 * 512, 512, 512, 512, 128, K_PA, pm, pn, 0);
            else mk(d, PS_W(WS_GF) + (size_t)pm * 256 * 512, PS_W(ws_wbr(layer)) + ((size_t)1024 + pn * 256) * 512, 512, 512, 512, 128, K_PF, pm, pn, 0);
            return true;
        }
        if (i > 0) return false;
        { const int L = xswz(c, 256), z = L & 1, pm = L >> 3, pn = (L >> 1) & 3; mk(d, PS_W(WS_H) + (size_t)pm * 256 * 1024 + z * 512, PS_W(ws_wout(layer)) + (size_t)pn * 256 * 1024 + z * 512, 1024, 1024, 512, 128, K_G5, pm, pn, z); return true; }
    }
};
struct EpiAll {
    unsigned char* ws; float* out; const float* const* in; int layer;
    __device__ __forceinline__ bool transform(f32x4 (&acc)[2][2][4][2], const pg8::UDesc& d, int wr, int wc, int fr, int fq) const {
        if (d.kind != K_PA) return false;
        asm volatile("" : "+v"(fr), "+v"(fq), "+s"(wr), "+s"(wc));
        unsigned char* ws = this->ws; asm volatile("" : "+s"(ws));
        EpiChainA{(const bf16*)(ws + WS_G), (const bf16*)(ws + WS_PB)}(acc, pg8::Unit{d.pm, d.pn, d.z}, wr, wc, fr, fq); return true; }
    __device__ __forceinline__ void operator()(AccRef acc, const pg8::UDesc& d, int wr, int wc, int fr, int fq) const {
        asm volatile("" : "+v"(fr), "+v"(fq), "+s"(wr), "+s"(wc));
        const pg8::Unit u{d.pm, d.pn, d.z}; const int kind = d.kind;
        unsigned char* ws = this->ws; float* out = this->out; asm volatile("" : "+s"(ws), "+s"(out));
#define EA_P(off) ((bf16*)(ws + (off)))
        if (kind == K_G1) EpiG1{ws, out, in[I_QG], in[I_KG], layer}(acc, u, wr, wc, fr, fq);
        else if (kind == K_MERGE) EpiMerge{EA_P(WS_G), in[I_MB] + (size_t)layer * 3072}(acc, u, wr, wc, fr, fq);
        else if (kind == K_S5A) EpiS5A{(float*)(ws + WS_SC)}(acc, u, wr, wc, fr, fq);
        else if (kind == K_S5B) EpiS5B{EA_P(WS_GY)}(acc, u, wr, wc, fr, fq);
        else if (kind == K_DFT1C) EpiDFT1C{EA_P(WS_VTC)}(acc, u, wr, wc, fr, fq);
        else if (kind == K_DFT1L) EpiDFT1L{EA_P(WS_VTL)}(acc, u, wr, wc, fr, fq);
        else if (kind == K_DFT2C) EpiDFT2{EA_P(WS_UF), 0, 0}(acc, u, wr, wc, fr, fq);
        else if (kind == K_DFT2L0) EpiDFT2{EA_P(WS_GC), 1, 0}(acc, u, wr, wc, fr, fq);
        else if (kind == K_DFT2L1) EpiDFT2{EA_P(WS_GC), 1, 1}(acc, u, wr, wc, fr, fq);
        else if (kind == K_GLU) EpiGLU{EA_P(WS_GA)}(acc, u, wr, wc, fr, fq);
        else if (kind == K_FN) EpiMul{EA_P(WS_GF)}(acc, u, wr, wc, fr, fq);
        else if (kind == K_PC) EpiPC{EA_P(WS_G), EA_P(WS_PB)}(acc, u, wr, wc, fr, fq);
        else if (kind == K_PF) EpiChainF{EA_P(WS_G), EA_P(WS_H)}(acc, u, wr, wc, fr, fq);
        else EpiG5{EA_P(WS_PB), EA_P(WS_GA)}(acc, u, wr, wc, fr, fq);
#undef EA_P
    }
};

template <class RowMap>
__device__ __forceinline__ void transpose_item(const float* W, int K, int N, bf16* WT, const RowMap& rm, LAS float* scr, int item, int lane, int pitch = 0, int dup = 0) {
    if (pitch == 0) pitch = K;
    const int nblk = N / 32, kb = item / nblk, nb = item % nblk, k0 = 64 * kb, n0 = 32 * nb;
    { f32x4 w[8];
#pragma unroll
      for (int i = 0; i < 8; ++i) w[i] = __builtin_nontemporal_load((const f32x4*)(W + (size_t)(k0 + 8 * i + (lane >> 3)) * N + n0 + 4 * (lane & 7)));
#pragma unroll
      for (int i = 0; i < 8; ++i) { LAS float* d = scr + (8 * i + (lane >> 3)) * 33 + 4 * (lane & 7); d[0] = w[i][0]; d[1] = w[i][1]; d[2] = w[i][2]; d[3] = w[i][3]; } }
    LDS_WAIT(); asm volatile("" ::: "memory");
    const int c = lane & 7;
#pragma unroll
    for (int j = 0; j < 4; ++j) { const int n = (lane >> 3) + 8 * j; const LAS float* s = scr + (8 * c) * 33 + n;
        v4u o; o.x = cvtpk(s[0 * 33], s[1 * 33]); o.y = cvtpk(s[2 * 33], s[3 * 33]); o.z = cvtpk(s[4 * 33], s[5 * 33]); o.w = cvtpk(s[6 * 33], s[7 * 33]);
        bf16* dp = WT + (size_t)rm(n0 + n) * pitch + k0 + 8 * c; *(v4u*)dp = o; if (dup) *(v4u*)(dp + dup) = o; }
    LDS_WAIT(); asm volatile("" ::: "memory");
}
struct RmId { int off; __device__ __forceinline__ int operator()(int n) const { return off + n; } };
struct RmWin { __device__ __forceinline__ int operator()(int n) const {
        if (n < 2048 || n >= 2816) return n; const int t = (n - 2048) >> 8, cl = (n - 2048) & 255, hh = cl >> 6, jl = cl & 63; return 2048 + t * 256 + 128 * (jl >> 5) + 32 * hh + (jl & 31); } };
struct RmGlu { __device__ __forceinline__ int operator()(int c) const { const int half = c >> 9, cc = c & 511; return 256 * (cc >> 7) + 128 * half + (cc & 127); } };

__device__ __forceinline__ void adaln_layer(const Ctx& C, int l, int blo) {
    LAS float* sil = (LAS float*)C.lds;
    LAS float* red = sil + 3072;
    if (C.vcu >= blo && C.vcu < blo + 48) {
        const int ch = C.vcu - blo;
        const int rg = C.lane >> 4, cq = C.lane & 15;
        const float* W = C.in[I_ADAW] + (size_t)l * 1024 * 3072 + ch * 64 + cq * 4;
        f32x4 w[16];
#pragma unroll
        for (int i = 0; i < 16; ++i) w[i] = __builtin_nontemporal_load((const f32x4*)(W + (size_t)(C.wave * 128 + 4 * i + rg) * 3072));
        float cx[6];
#pragma unroll
        for (int j = 0; j < 6; ++j) { const int i = C.tid + j * NTHR; cx[j] = i < 1024 ? C.in[I_CCTX][i] : C.in[I_C][i - 1024]; }
        float bsv = 0.f, ngv = 0.f; const int fcol = ch * 64 + (C.tid & 63);
        if (C.tid < 192) { bsv = C.in[I_ADAB][(size_t)l * 3072 + fcol]; if (fcol >= 1024 && fcol < 2048) ngv = C.in[I_NORMG][l * 1024 + fcol - 1024]; }
        asm volatile("" ::: "memory");
#pragma unroll
        for (int j = 0; j < 6; ++j) sil[C.tid + j * NTHR] = cx[j] * sigmoidf_(cx[j]);
        __syncthreads();
        f32x4 a0 = {0.f, 0.f, 0.f, 0.f}, a1 = a0, a2 = a0;
        for (int i0 = 0; i0 < 32; i0 += 16) {
            if (i0) {
#pragma unroll
                for (int i = 0; i < 16; ++i) w[i] = __builtin_nontemporal_load((const f32x4*)(W + (size_t)(C.wave * 128 + 4 * (16 + i) + rg) * 3072));
            }
#pragma unroll
            for (int i = 0; i < 16; ++i) { const int k = C.wave * 128 + 4 * (i0 + i) + rg; a0 += w[i] * sil[k]; a1 += w[i] * sil[1024 + k]; a2 += w[i] * sil[2048 + k]; }
        }
#pragma unroll
        for (int e = 0; e < 4; ++e) { a0[e] += shx(a0[e], 16, C.lane); a0[e] += shx(a0[e], 32, C.lane); a1[e] += shx(a1[e], 16, C.lane); a1[e] += shx(a1[e], 32, C.lane); a2[e] += shx(a2[e], 16, C.lane); a2[e] += shx(a2[e], 32, C.lane); }
        if (rg == 0) {
#pragma unroll
            for (int e = 0; e < 4; ++e) { red[(C.wave * 3 + 0) * 64 + cq * 4 + e] = a0[e]; red[(C.wave * 3 + 1) * 64 + cq * 4 + e] = a1[e]; red[(C.wave * 3 + 2) * 64 + cq * 4 + e] = a2[e]; } }
        __syncthreads();
        if (C.tid < 192) { const int ci = C.tid >> 6; float s = bsv;
#pragma unroll
            for (int w8 = 0; w8 < 8; ++w8) s += red[(w8 * 3 + ci) * 64 + (C.tid & 63)];
            if (fcol >= 1024 && fcol < 2048) s = (1.0f + s) * ngv;
            C.w<float>(WS_MODF)[((size_t)l * 3 + ci) * 3072 + fcol] = s; }
        __syncthreads();
    }
}

__device__ __forceinline__ void ph_prologue(const Ctx& C) {
    adaln_layer(C, 0, 0);
    const int gt = C.bid * NTHR + C.tid, ngt = GRID * NTHR;
    constexpr int T_A2L = 2048 * 2048 / 8, T_A2C = 256 * 512 / 8, T_A1P = 512 * 256 / 8;
    for (int t = gt; t < T_A2L + T_A2C + T_A1P; t += ngt) {
        float v[8]; bf16* dst;
        if (t < T_A2L) { const int r = t >> 8, c0 = (t & 255) * 8, kk = 2 * (r & 1023) + (r >> 10); dst = C.w<bf16>(WS_A2L) + (size_t)r * 2048 + c0;
#pragma unroll
            for (int e = 0; e < 8; ++e) { const int col = c0 + e, s = col & 1023, mm = (kk * s) & 2047; float sn, cs; sincospif((float)mm * (1.0f / 1024.0f), &sn, &cs); v[e] = (col < 1024 ? cs : sn) * 0.02209708691207961f; } }
        else if (t < T_A2L + T_A2C) { const int tt = t - T_A2L, k = tt >> 6, c0 = (tt & 63) * 8; dst = C.w<bf16>(WS_A2C) + (size_t)k * 512 + c0;
#pragma unroll
            for (int e = 0; e < 8; ++e) { const int col = c0 + e, s = col & 255, mm = (k * s) & 255; float sn, cs; sincospif((float)mm * (1.0f / 128.0f), &sn, &cs); v[e] = (col < 256 ? cs : sn) * 0.0625f; } }
        else { const int tt = t - T_A2L - T_A2C, r = tt >> 5, c0 = (tt & 31) * 8; dst = C.w<bf16>(WS_A1P) + (size_t)r * 256 + c0; const int gl = r >> 8, reim = (r >> 7) & 1, j = r & 127;
#pragma unroll
            for (int e = 0; e < 8; ++e) { const int col = c0 + e, glc = col >> 7, c = col & 127, mm = (j * c) & 127; float sn, cs; sincospif((float)mm * (1.0f / 64.0f), &sn, &cs);
                v[e] = (glc == gl) ? (reim ? -sn : cs) * 0.08838834764831845f : 0.f; } }
        v4u o; o.x = cvtpk(v[0], v[1]); o.y = cvtpk(v[2], v[3]); o.z = cvtpk(v[4], v[5]); o.w = cvtpk(v[6], v[7]); *(v4u*)dst = o;
    }
    if (gt < 1024) { const int pos = gt >> 4, f = gt & 15; const float inv = powf(10000.0f, -(float)f / 16.0f), ang = (float)pos * inv;
        C.w<float>(WS_ROPE)[gt * 2] = cosf(ang); C.w<float>(WS_ROPE)[gt * 2 + 1] = sinf(ang); }
}

__device__ __forceinline__ void s5_mats_block(const Ctx& C, int l, int g, int part) {
    LAS f32x2* pw = (LAS f32x2*)C.lds;
    LAS f32x2* Bb = pw + 2 * 17 * 64;
    LAS f32x2* Cm = Bb + 2 * 64 * 16;
    LAS float* Kl = (LAS float*)(Cm + 2 * 16 * 64);
    const int tid = C.tid;
    f32x2 cmv[4];
#pragma unroll
    for (int k = 0; k < 4; ++k) { const int idx = tid + k * NTHR, d = idx >> 10, p = (idx >> 6) & 15, n = idx & 63; const size_t o = (((size_t)(l * 2 + d) * 32 + g) * 16 + p) * 64 + n; cmv[k] = (f32x2){C.in[I_CRE][o], C.in[I_CIM][o]}; }
    const float dskp = C.in[I_SD][(size_t)l * 512 + g * 16 + ((tid >> 1) & 15)];
    float lr = 0.f, li = 0.f, ldt = 0.f; f32x4 brv[4], biv[4];
    if (tid < 128) {
        const int d = tid >> 6, n = tid & 63; const size_t gi = ((size_t)(l * 2 + d) * 32 + g);
        lr = C.in[I_ARE][gi * 64 + n]; li = C.in[I_AIM][gi * 64 + n]; ldt = C.in[I_LDT][gi];
        const float* br = C.in[I_BRE] + (gi * 64 + n) * 16; const float* bi = C.in[I_BIM] + (gi * 64 + n) * 16;
#pragma unroll
        for (int k = 0; k < 4; ++k) { brv[k] = *(const f32x4*)(br + 4 * k); biv[k] = *(const f32x4*)(bi + 4 * k); }
    }
    asm volatile("" ::: "memory");
#pragma unroll
    for (int k = 0; k < 4; ++k) Cm[tid + k * NTHR] = cmv[k];
    if (tid < 128) {
        const int d = tid >> 6, n = tid & 63; const size_t gi = ((size_t)(l * 2 + d) * 32 + g);
        const float dt = expf(ldt);
        float mag = expf(dt * lr), sn, cs; sincosf(dt * li, &sn, &cs);
        { const float are = mag * cs, aim = mag * sn; float pr = 1.0f, pi = 0.0f;
          for (int tau = 0; tau <= 16; ++tau) { pw[(d * 17 + tau) * 64 + n] = (f32x2){pr, pi}; const float nr = pr * are - pi * aim, ni = pr * aim + pi * are; pr = nr; pi = ni; } }
        const float x = mag * cs - 1.0f, y = mag * sn, den = 1.0f / (lr * lr + li * li), cr = (x * lr + y * li) * den, cim = (y * lr - x * li) * den;
#pragma unroll
        for (int q = 0; q < 16; ++q) { const float brq = brv[q >> 2][q & 3], biq = biv[q >> 2][q & 3]; Bb[(d * 64 + n) * 16 + q] = (f32x2){cr * brq - cim * biq, cr * biq + cim * brq}; }
        if (part == 0) { const f32x2 p16 = pw[(d * 17 + 16) * 64 + n]; C.w<float>(WS_A16)[(gi * 64 + n) * 2] = p16.x; C.w<float>(WS_A16)[(gi * 64 + n) * 2 + 1] = p16.y; }
    }
    __syncthreads();
    {
        const int d = tid >> 8, p = (tid >> 4) & 15, q = tid & 15; float a0 = 0.f, a1 = 0.f;
        for (int n = 0; n < 64; ++n) { const f32x2 c = Cm[(d * 16 + p) * 64 + n], bq = Bb[(d * 64 + n) * 16 + q]; const float wr = c.x * bq.x - c.y * bq.y, wi = c.x * bq.y + c.y * bq.x;
            const f32x2 p0 = pw[(d * 17 + 2 * part) * 64 + n], p1 = pw[(d * 17 + 2 * part + 1) * 64 + n]; a0 += wr * p0.x - wi * p0.y; a1 += wr * p1.x - wi * p1.y; }
        Kl[(d * 2 + 0) * 256 + p * 16 + q] = a0; Kl[(d * 2 + 1) * 256 + p * 16 + q] = a1;
    }
    __syncthreads();
    bf16* BtE = C.w<bf16>(WS_BTE) + (size_t)g * 256 * 256; bf16* BtY = C.w<bf16>(WS_BTY) + (size_t)g * 256 * 512;
    for (int task = tid; task < 2 * 2 * 16 * 32; task += NTHR) {
        const int e = task >> 10, d = (task >> 9) & 1, blk = (task >> 5) & 15, p = (task >> 1) & 15, q0 = (task & 1) * 8, tau = 2 * part + e;
        if (blk >= 16 - tau || (tau == 0 && d == 1)) continue;
        const int t = d == 0 ? blk + tau : blk, j = d == 0 ? blk : blk + tau; float v[8];
#pragma unroll
        for (int k = 0; k < 8; ++k) { float s = Kl[(d * 2 + e) * 256 + p * 16 + q0 + k]; if (tau == 0) { s += Kl[(1 * 2 + e) * 256 + p * 16 + q0 + k]; if (q0 + k == p) s += dskp; } v[k] = s; }
        v4u o; o.x = cvtpk(v[0], v[1]); o.y = cvtpk(v[2], v[3]); o.z = cvtpk(v[4], v[5]); o.w = cvtpk(v[6], v[7]); *(v4u*)(BtY + (size_t)(t * 16 + p) * 512 + j * 16 + q0) = o;
    }
    for (int task = tid; task < 2 * 32 * 32; task += NTHR) {
        const int which = task >> 10, r = 32 * part + ((task >> 5) & 31), c0 = (task & 31) * 8; float v[8]; bf16* dst;
        if (which == 0) { const int d = r >> 7, reim = (r >> 6) & 1, n = r & 63, j = c0 >> 4, q0 = c0 & 15, ex = d == 0 ? 15 - j : j; dst = BtE + (size_t)r * 256 + c0; const f32x2 a = pw[(d * 17 + ex) * 64 + n];
#pragma unroll
            for (int k = 0; k < 8; ++k) { const f32x2 bq = Bb[(d * 64 + n) * 16 + q0 + k]; v[k] = reim ? (a.x * bq.y + a.y * bq.x) : (a.x * bq.x - a.y * bq.y); } }
        else { const int t = r >> 4, p = r & 15, d = c0 >> 7, reim = (c0 >> 6) & 1, n0 = c0 & 63, ex = d == 0 ? t + 1 : 16 - t; dst = BtY + (size_t)r * 512 + 256 + c0;
#pragma unroll
            for (int k = 0; k < 8; ++k) { const f32x2 c = Cm[(d * 16 + p) * 64 + n0 + k], a = pw[(d * 17 + ex) * 64 + n0 + k]; v[k] = reim ? -(c.x * a.y + c.y * a.x) : (c.x * a.x - c.y * a.y); } }
        v4u o; o.x = cvtpk(v[0], v[1]); o.y = cvtpk(v[2], v[3]); o.z = cvtpk(v[4], v[5]); o.w = cvtpk(v[6], v[7]); *(v4u*)dst = o;
    }
    __syncthreads();
}

__device__ __forceinline__ void prep_layer(const Ctx& C, int l, int parts, int blo, int bcnt) {
    if (C.vcu < blo || C.vcu >= blo + bcnt) return;
    const int bi = C.vcu - blo, wi = bi * NWAVES + C.wave, nw = bcnt * NWAVES;
    if (parts & 8) for (int it = bi; it < 256; it += bcnt) s5_mats_block(C, l, it >> 3, it & 7);
    LAS float* scr = (LAS float*)(C.lds + C.wave * 16384);
    constexpr int I_1 = 16 * 104, I_2 = 16 * 96, I_3 = 8 * 32, I_4 = 8 * 16, I_5 = 8 * 32, I_6 = 16 * 32;
    if (parts & 1) {
        for (int it = wi; it < I_1 + I_2 + I_3 + I_4; it += nw) {
            int r = it;
            if (r < I_1) { transpose_item(C.in[I_WIN] + (size_t)l * 1024 * INW, 1024, INW, C.w<bf16>(WS_WCAT), RmWin{}, scr, r, C.lane); continue; } r -= I_1;
            if (r < I_2) { transpose_item(C.in[I_MW] + (size_t)l * 1024 * 3072, 1024, 3072, C.w<bf16>(WS_WCAT), RmId{INW}, scr, r, C.lane); continue; } r -= I_2;
            if (r < I_3) { transpose_item(C.in[I_GLU] + (size_t)l * 512 * 1024, 512, 1024, C.w<bf16>(WS_WGLU), RmGlu{}, scr, r, C.lane); continue; } r -= I_3;
            transpose_item(C.in[I_FN] + (size_t)l * 512 * 512, 512, 512, C.w<bf16>(WS_WFN), RmId{0}, scr, r, C.lane, 1024, 512);
        }
        for (int t = bi * NTHR + C.tid; t < 2 * 2 * 256 * 16; t += bcnt * NTHR) {
            const int kv = t >> 13, r = t & 8191, b = r >> 12, s = (r >> 4) & 255, c0 = (r & 15) * 8;
            const float* src = C.in[kv ? I_CV : I_CK] + (((size_t)b * DEPTH + l) * 256 + s) * KVW + c0;
            const f32x4 a = *(const f32x4*)src, bq = *(const f32x4*)(src + 4);
            v4u o; o.x = cvtpk(a[0], a[1]); o.y = cvtpk(a[2], a[3]); o.z = cvtpk(bq[0], bq[1]); o.w = cvtpk(bq[2], bq[3]);
            *(v4u*)(C.w<bf16>(kv ? WS_VL : WS_KL) + ((size_t)b * LKV + S_LAT + s) * KVW + c0) = o;
        }
    }
    if (parts & 2) for (int it = wi; it < 3 * I_5; it += nw) { const int nb = it / I_5;
        transpose_item(C.in[I_WBR] + ((size_t)l * 3 + nb) * 512 * 1024, 512, 1024, C.w<bf16>(ws_wbr(l)) + (size_t)nb * 1024 * 512, RmId{0}, scr, it - nb * I_5, C.lane); }
    if (parts & 4) for (int it = wi; it < I_6; it += nw) transpose_item(C.in[I_WOUT] + (size_t)l * 1024 * 1024, 1024, 1024, C.w<bf16>(ws_wout(l)), RmId{0}, scr, it, C.lane);
}

__device__ __forceinline__ void rows_phase(const Ctx& C, int l, bool last);
__device__ __forceinline__ void ph_l1(const Ctx& C, int l) {
    rows_phase(C, l, false);
}

__device__ __forceinline__ void rows_phase(const Ctx& C, int l, bool last) {
    const float* modf = C.w<float>(WS_MODF); bf16* XR = C.w<bf16>(WS_XRES);
    const bf16* T0 = C.w<bf16>(WS_PB); const bf16* T1 = C.w<bf16>(WS_GA);
    const int c8 = C.lane * 8;
    f32x4 v[4][2][2];
#pragma unroll
    for (int i = 0; i < 4; ++i) { const int row = C.gw + i * 2048;
        if (l == 0) { const float* xr = i < 2 ? C.in[I_XP] + (size_t)row * 1024 : C.in[I_XS] + (size_t)(row - T_CTX) * 1024;
#pragma unroll
            for (int j = 0; j < 2; ++j) { v[i][j][0] = __builtin_nontemporal_load((const f32x4*)(xr + c8 + 512 * j)); v[i][j][1] = __builtin_nontemporal_load((const f32x4*)(xr + c8 + 512 * j + 4)); }
        } else {
#pragma unroll
            for (int j = 0; j < 2; ++j) { const v4u w = __builtin_nontemporal_load((const v4u*)(XR + (size_t)row * 1024 + c8 + 512 * j)); v[i][j][0] = bf8_lo(w); v[i][j][1] = bf8_hi(w); } } }
#pragma unroll
    for (int i = 0; i < 4; ++i) { const int row = C.gw + i * 2048, ci = i < 2 ? 0 : i - 1; float ss = 0.f;
        if (l > 0) {
            const float* gp = modf + ((size_t)(l - 1) * 3 + ci) * 3072 + 2048 + c8; v4u t0[2], t1[2]; f32x4 gt[2][2];
#pragma unroll
            for (int j = 0; j < 2; ++j) { t0[j] = __builtin_nontemporal_load((const v4u*)(T0 + (size_t)row * 1024 + c8 + 512 * j)); t1[j] = __builtin_nontemporal_load((const v4u*)(T1 + (size_t)row * 1024 + c8 + 512 * j));
                gt[j][0] = *(const f32x4*)(gp + 512 * j); gt[j][1] = *(const f32x4*)(gp + 512 * j + 4); }
#pragma unroll
            for (int j = 0; j < 2; ++j) { v[i][j][0] += gt[j][0] * (bf8_lo(t0[j]) + bf8_lo(t1[j])); v[i][j][1] += gt[j][1] * (bf8_hi(t0[j]) + bf8_hi(t1[j])); }
        }
        if (!last) {
#pragma unroll
            for (int j = 0; j < 2; ++j) st_bf8(XR + (size_t)row * 1024 + c8 + 512 * j, v[i][j][0], v[i][j][1]);
        }
#pragma unroll
        for (int j = 0; j < 2; ++j) {
#pragma unroll
            for (int h = 0; h < 2; ++h) { const f32x4 t = v[i][j][h]; ss += (t[0] * t[0] + t[1] * t[1]) + (t[2] * t[2] + t[3] * t[3]); } }
        const float rstd = rsqrtf(wave_sum(ss, C.lane) * (1.0f / 1024.0f) + RMS_EPS);
        if (last) {
#pragma unroll
            for (int j = 0; j < 2; ++j) {
#pragma unroll
                for (int h = 0; h < 2; ++h) *(f32x4*)(C.out + (size_t)row * 1024 + c8 + 512 * j + 4 * h) = v[i][j][h] * rstd * *(const f32x4*)(C.in[I_FG] + c8 + 512 * j + 4 * h); }
        } else {
            const float* mp = modf + ((size_t)l * 3 + ci) * 3072 + c8; bf16* hr = C.w<bf16>(WS_H) + (size_t)row * 1024;
#pragma unroll
            for (int j = 0; j < 2; ++j) { const f32x4 sh0 = *(const f32x4*)(mp + 512 * j), sh1 = *(const f32x4*)(mp + 512 * j + 4), gs0 = *(const f32x4*)(mp + 1024 + 512 * j), gs1 = *(const f32x4*)(mp + 1024 + 512 * j + 4);
                st_bf8(hr + c8 + 512 * j, v[i][j][0] * rstd * gs0 + sh0, v[i][j][1] * rstd * gs1 + sh1); }
        }
    }
}

__device__ __forceinline__ void scan_unit(const Ctx& C, int l, int g, int pm) {
    const bf16* SC = C.w<bf16>(WS_SC); bf16* UH = C.w<bf16>(WS_UH); const int lane = C.lane;
    const int nitems = pm ? 4 : 32;
    for (int item = C.wave; item < nitems; item += NWAVES) {
        const int bsel = item >> 1, d = item & 1, nch = pm ? 128 : 16, c0 = pm ? 256 + bsel * 128 : bsel * 16;
        const size_t gi = ((size_t)(l * 2 + d) * 32 + g) * 64 + lane;
        const float ar = C.w<float>(WS_A16)[gi * 2], ai = C.w<float>(WS_A16)[gi * 2 + 1];
        float hr = 0.f, hi = 0.f;
        if (pm) { const float* st = C.in[I_ST] + ((((size_t)bsel * DEPTH + l) * 2 + d) * 32 + g) * 128 + lane * 2; hr = st[0]; hi = st[1]; }
        float sr[16], si[16], tr[16], ti[16];
#pragma unroll
        for (int k = 0; k < 16; ++k) { const int c = d == 0 ? c0 + k : c0 + nch - 1 - k; const size_t o = ((size_t)g * 512 + c) * 256 + d * 128 + lane; sr[k] = bf2f(SC[o]); si[k] = bf2f(SC[o + 64]); }
        for (int i0 = 0; i0 < nch; i0 += 16) {
            if (i0 + 16 < nch) {
#pragma unroll
                for (int k = 0; k < 16; ++k) { const int c = d == 0 ? c0 + i0 + 16 + k : c0 + nch - 1 - i0 - 16 - k; const size_t o = ((size_t)g * 512 + c) * 256 + d * 128 + lane; tr[k] = bf2f(SC[o]); ti[k] = bf2f(SC[o + 64]); }
            }
#pragma unroll
            for (int k = 0; k < 16; ++k) { const int c = d == 0 ? c0 + i0 + k : c0 + nch - 1 - i0 - k; const size_t oh = ((size_t)g * 512 + c) * 512 + 256 + d * 128 + lane;
                UH[oh] = (bf16)(cvtpk(hr, hr) & 0xffffu); UH[oh + 64] = (bf16)(cvtpk(hi, hi) & 0xffffu);
                const float nr = ar * hr - ai * hi + sr[k], ni = ar * hi + ai * hr + si[k]; hr = nr; hi = ni; }
#pragma unroll
            for (int k = 0; k < 16; ++k) { sr[k] = tr[k]; si[k] = ti[k]; }
        }
        if (!pm) { float* o = C.out + OUT_S + ((((size_t)bsel * DEPTH + l) * 2 + d) * 32 + g) * 128 + lane * 2; o[0] = hr; o[1] = hi; }
    }
}

__device__ __forceinline__ void ph_final(const Ctx& C) { rows_phase(C, DEPTH, true); }

__device__ __forceinline__ void attn_any(const Ctx& C, int uidx) {
    size_t tok0, kvoff; int NT, h;
    if (uidx < 128) { const int b = uidx >> 6, qb = uidx & 7; h = (uidx >> 3) & 7; tok0 = (size_t)T_CTX + b * 2048 + qb * 256; kvoff = (size_t)(WS_KL - WS_KC) / 2 + (size_t)b * LKV * KVW; NT = LKV / 64; }
    else { const int u2 = uidx - 128, b = u2 >> 3; h = u2 & 7; tok0 = (size_t)b * 256; kvoff = tok0 * KVW; NT = 4; }
    kvoff += (h >> 2) * 64;
    const attn_body::bf16* Q = (const attn_body::bf16*)C.w<bf16>(WS_Q) + tok0 * 512 + h * 64;
    const attn_body::bf16* Kp = (const attn_body::bf16*)C.w<bf16>(WS_KC) + kvoff;
    attn_body::attn_unit<8>(Q, Kp, Kp + (WS_VC - WS_KC) / 2, (attn_body::bf16*)Q, (const attn_body::bf16*)C.w<bf16>(WS_GC) + tok0 * 512 + h * 64, 512, KVW, NT, (char*)C.lds, C.tid);
}

#ifndef MK_PER_PHASE
#define MK_PER_PHASE 0
#endif
constexpr int NSUB = 7, N_PHASES = 2 + NSUB * DEPTH;


__global__ void __launch_bounds__(NTHR, 2) fwd_kernel(KArgs args) {
    extern __shared__ __attribute__((aligned(16))) unsigned char lds_raw[];
    Ctx C; C.lds = (LAS unsigned char*)lds_raw; C.tid = threadIdx.x; C.lane = C.tid & 63; C.wave = __builtin_amdgcn_readfirstlane(C.tid >> 6); C.bid = blockIdx.x;
    int wave_s = C.wave;
    C.gw = C.bid * NWAVES + C.wave; C.ngw = GRID * NWAVES; C.in = args.in; C.out = args.out; C.ws = args.ws;
    for (int u = C.tid; u < (LDS_BYTES - LDSCTL_OFF) / 4; u += NTHR) ((LAS unsigned*)(C.lds + LDSCTL_OFF))[u] = 0u;
    __syncthreads();
    volatile LAS unsigned* MISC = (volatile LAS unsigned*)(C.lds + MISC_OFF);
    XcdBarrier bar; bar.bar = (unsigned*)(C.ws + WS_CTL) + CW_BAR; bar.x = 0; bar.st = nullptr;
    const bool multi = args.ph_hi - args.ph_lo > 1;
    if (multi) bar = xcd_barrier_post((unsigned*)(C.ws + WS_CTL) + CW_BAR, MISC + 8, C.tid);

    for (int ph = args.ph_lo; ph < args.ph_hi; ++ph) {
        { int l_; asm volatile("v_mbcnt_lo_u32_b32 %0, -1, 0\n\tv_mbcnt_hi_u32_b32 %0, -1, %0" : "=v"(l_)); asm volatile("" : "+s"(wave_s)); int b_ = blockIdx.x; asm volatile("" : "+s"(b_)); C.bid = b_; C.vcu = b_;   C.lane = l_; C.wave = wave_s; C.tid = wave_s * 64 + l_; C.gw = C.bid * NWAVES + C.wave;
          unsigned char* w_ = args.ws; asm volatile("" : "+s"(w_)); C.ws = w_; float* o_ = args.out; asm volatile("" : "+s"(o_)); C.out = o_; }
        const int c = C.vcu;
        if (ph == 0) { ph_prologue(C); __syncthreads(); prep_layer(C, 0, 15, 0, GRID); }
        else if (ph == N_PHASES - 1) ph_final(C);
        else {
            const int l = (ph - 1) / NSUB, sub = (ph - 1) % NSUB;
            if (sub == 0) ph_l1(C, l);
            else {
                if (sub == 2 && c < 128) for (int i = 0; i < 2; ++i) attn_any(C, xswz(c, 128) + 128 * i);
                if (sub == 3 && c >= 64 && c < 128) { const int L = xswz(c - 64, 64); scan_unit(C, l, L >> 1, L & 1); VM_WAIT(); }
                __syncthreads();
                { PhaseSched S{sub, c, C.bid, C.ws, l}; EpiAll E{C.ws, C.out, C.in, l}; int t_ = C.tid; asm volatile("" : "+v"(t_));
                  pg8::gemm_stream<EpiAll, PhaseSched>(C.lds, S, E, t_); }
                if (sub == 2 && l + 1 < DEPTH) { __syncthreads(); adaln_layer(C, l + 1, 192); }
                if (sub == 5 && l + 1 < DEPTH) { __syncthreads(); prep_layer(C, l + 1, 15, 128, 128); }
            }
        }
        if (ph + 1 < args.ph_hi) xcd_barrier(bar, C.tid);
    }
}

extern "C" void kernel_launch(void* const* d_in, const int* in_sizes, int n_in, void* d_out, int out_size, void* d_ws, size_t ws_size, hipStream_t stream) {
    static int ready = 0;
    if (ready == 0) {
        if (n_in != 28 || out_size != (int)OUT_N || ws_size < WS_END) { fprintf(stderr, "kernel_launch: unexpected problem shape (n_in %d, out %d, ws %zu)\n", n_in, out_size, ws_size); ready = -1; return; }
        int dev = 0, cus = 0;
        if (hipGetDevice(&dev) != hipSuccess || hipDeviceGetAttribute(&cus, hipDeviceAttributeMultiprocessorCount, dev) != hipSuccess) { ready = -1; return; }
        if (hipFuncSetAttribute((const void*)fwd_kernel, hipFuncAttributeMaxDynamicSharedMemorySize, LDS_BYTES) != hipSuccess) { fprintf(stderr, "kernel_launch: hipFuncSetAttribute failed\n"); ready = -1; return; }
        if (cus < GRID) { fprintf(stderr, "kernel_launch: device has %d CUs, this kernel needs %d resident workgroups\n", cus, GRID); ready = -1; return; }
        ready = 1;
    }
    if (ready < 0) return;
    (void)hipMemsetAsync((char*)d_ws + WS_CTL, 0, CTL_ZERO_BYTES, stream);
    KArgs a{};
    for (int i = 0; i < 28; ++i) a.in[i] = (const float*)d_in[i];
    a.out = (float*)d_out; a.ws = (unsigned char*)d_ws;
#if MK_PER_PHASE
    for (int ph = 0; ph < N_PHASES; ++ph) { a.ph_lo = ph; a.ph_hi = ph + 1; hipLaunchKernelGGL(fwd_kernel, dim3(GRID), dim3(NTHR), LDS_BYTES, stream, a); }
#else
    a.ph_lo = 0; a.ph_hi = N_PHASES; hipLaunchKernelGGL(fwd_kernel, dim3(GRID), dim3(NTHR), LDS_BYTES, stream, a);
#endif
}
```
